# Optimizing an MI355X kernel written in HIP

```python
import math
import jax, jax.numpy as jnp
from jax import lax
import numpy as np

D_MODEL = 1024
BATCH = 4
SEQ = 8192
DEPTH = 1

GRID_W = 64
HEAD_DIM = 64
N_Q_HEADS = 8
N_KV_HEADS = 2
Q_PER_KV = N_Q_HEADS // N_KV_HEADS
ATTN_WIDTH = N_Q_HEADS * HEAD_DIM
KV_WIDTH = N_KV_HEADS * HEAD_DIM
ROPE_THETA = 10000.0
Q_BLOCK = 128
HYENA_WIDTH = D_MODEL // 2
HYENA_ORDER = 2
SHORT_CONV = 3
FILTER_EMB = 33
FILTER_HIDDEN = 64
FAST_DECAY_PCT = 0.3
SLOW_DECAY_PCT = 1.5
DECAY_TARGET = 1e-2
N_BRANCHES = 2
IN_COLS = 3 * HYENA_WIDTH + ATTN_WIDTH + 2 * KV_WIDTH + N_BRANCHES * D_MODEL
N_EXPERTS = 32
TOP_K = 4
D_FF = D_MODEL
SWIGLU_LIMIT = 7.0
SWIGLU_ALPHA = 1.702
MOE_BLOCK = 256
EPS = 1e-6

kernel_name = "hybrid_hyena_gqa_axialrope_moe_encoder"


def rmsnorm(x, g):
    xf = x.astype(jnp.float32)
    y = xf * lax.rsqrt(jnp.mean(xf * xf, axis=-1, keepdims=True) + EPS)
    return (y * g.astype(jnp.float32)).astype(x.dtype)


def short_conv(z, w, b):
    L = z.shape[1]
    pad = SHORT_CONV // 2
    zp = jnp.pad(z, ((0, 0), (pad, pad), (0, 0)))
    out = b
    for k in range(SHORT_CONV):
        out = out + zp[:, k:k + L] * w[k]
    return out


def hyena_filters(L, fw1, fb1, ff1, fw2, fb2, ff2, fw3, fb3):
    f32 = jnp.float32
    t = jnp.linspace(0.0, 1.0, L, dtype=f32)[:, None]
    bands = (FILTER_EMB - 1) // 2
    w = 2.0 * math.pi * jnp.arange(L, dtype=f32)[:, None] / L
    fr = jnp.linspace(1e-4, bands - 1, bands, dtype=f32)[None, :]
    feats = jnp.concatenate([t, jnp.cos(w * fr), -jnp.sin(w * fr)], axis=-1)
    h = jnp.sin(ff1.astype(f32) * (feats @ fw1.astype(f32) + fb1.astype(f32)))
    h = jnp.sin(ff2.astype(f32) * (h @ fw2.astype(f32) + fb2.astype(f32)))
    h = h @ fw3.astype(f32) + fb3.astype(f32)
    h = h.reshape(L, HYENA_ORDER, 2, HYENA_WIDTH)
    max_decay = math.log(DECAY_TARGET) / FAST_DECAY_PCT
    min_decay = math.log(DECAY_TARGET) / SLOW_DECAY_PCT
    deltas = jnp.abs(jnp.linspace(min_decay, max_decay, HYENA_WIDTH, dtype=f32))
    h = h * jnp.exp(-t[:, :, None, None] * deltas)
    fwd, bwd = h[:, :, 0], h[:, :, 1]
    kern = jnp.concatenate([fwd, jnp.zeros((1, HYENA_ORDER, HYENA_WIDTH), f32), bwd[1:][::-1]], axis=0)
    return kern / jnp.sum(jnp.abs(kern), axis=0, keepdims=True)


def hyena_mixer(z, conv_w, conv_b, fw1, fb1, ff1, fw2, fb2, ff2, fw3, fb3, hyena_d):
    L = z.shape[1]
    zc = short_conv(z, conv_w, conv_b)
    v, x1, x2 = jnp.split(zc, 3, axis=-1)
    kern = hyena_filters(L, fw1, fb1, ff1, fw2, fb2, ff2, fw3, fb3)
    K = jnp.fft.rfft(kern, axis=0)
    y = v.astype(jnp.float32)
    for o, gate in enumerate((x1, x2)):
        Y = jnp.fft.rfft(y, n=2 * L, axis=1)
        conv = jnp.fft.irfft(Y * K[None, :, o, :], n=2 * L, axis=1)[:, :L]
        y = gate.astype(jnp.float32) * (conv + y * hyena_d[o].astype(jnp.float32))
    return y.astype(z.dtype)


def axial_rope_tables(L):
    rows = L // GRID_W
    row = jnp.repeat(jnp.arange(rows, dtype=jnp.float32), GRID_W)
    col = jnp.tile(jnp.arange(GRID_W, dtype=jnp.float32), rows)
    half = HEAD_DIM // 2
    freqs = ROPE_THETA ** (-jnp.arange(0, half, 2, dtype=jnp.float32) / half)
    ang = jnp.concatenate([row[:, None] * freqs, col[:, None] * freqs], axis=-1)
    return jnp.cos(ang), jnp.sin(ang)


def apply_rope(x, cos, sin):
    xr = x.reshape(x.shape[:-1] + (HEAD_DIM // 2, 2))
    x0, x1 = xr[..., 0], xr[..., 1]
    c, s = cos[None, :, None, :], sin[None, :, None, :]
    return jnp.stack([x0 * c - x1 * s, x0 * s + x1 * c], axis=-1).reshape(x.shape)


def head_rmsnorm(x, g):
    xf = x.astype(jnp.float32)
    return xf * lax.rsqrt(jnp.mean(xf * xf, axis=-1, keepdims=True) + EPS) * g.astype(jnp.float32)


def attention_mixer(q, k, v, q_norm_g, k_norm_g):
    B, L, _ = q.shape
    q = head_rmsnorm(q.reshape(B, L, N_Q_HEADS, HEAD_DIM), q_norm_g)
    k = head_rmsnorm(k.reshape(B, L, N_KV_HEADS, HEAD_DIM), k_norm_g)
    v = v.reshape(B, L, N_KV_HEADS, HEAD_DIM).astype(jnp.float32)
    cos, sin = axial_rope_tables(L)
    q = apply_rope(q, cos, sin) * (HEAD_DIM ** -0.5)
    k = apply_rope(k, cos, sin)
    nb = L // Q_BLOCK
    qb = q.reshape(B, nb, Q_BLOCK, N_KV_HEADS, Q_PER_KV, HEAD_DIM).transpose(1, 0, 2, 3, 4, 5)

    def attend(q_blk):
        s = jnp.einsum('bqkgd,bskd->bkgqs', q_blk, k)
        p = jax.nn.softmax(s, axis=-1)
        return jnp.einsum('bkgqs,bskd->bqkgd', p, v)

    o = lax.map(attend, qb)
    o = o.transpose(1, 0, 2, 3, 4, 5).reshape(B, L, ATTN_WIDTH)
    return o


def clamped_swiglu(h):
    x_glu, x_lin = h[..., ::2], h[..., 1::2]
    x_glu = jnp.minimum(x_glu, SWIGLU_LIMIT)
    x_lin = jnp.clip(x_lin, -SWIGLU_LIMIT, SWIGLU_LIMIT)
    return x_glu * jax.nn.sigmoid(SWIGLU_ALPHA * x_glu) * (x_lin + 1.0)


def moe(h, router_w, router_b, w1, b1, w2, b2):
    B, L, D = h.shape
    T = B * L
    xt = h.reshape(T, D)
    logits = (xt @ router_w + router_b).astype(jnp.float32)
    top_val, top_idx = lax.top_k(logits, TOP_K)
    gates = jax.nn.softmax(top_val, axis=-1)
    TK = T * TOP_K
    e_flat = top_idx.reshape(TK)
    tok_flat = jnp.arange(TK, dtype=jnp.int32) // TOP_K
    g_flat = gates.reshape(TK)
    order = jnp.argsort(e_flat)
    e_s, tok_s, g_s = e_flat[order], tok_flat[order], g_flat[order]
    counts = jnp.bincount(e_flat, length=N_EXPERTS)
    starts = jnp.cumsum(counts) - counts
    padded = ((counts + MOE_BLOCK - 1) // MOE_BLOCK) * MOE_BLOCK
    pad_ends = jnp.cumsum(padded)
    pad_starts = pad_ends - padded
    dest = pad_starts[e_s] + jnp.arange(TK, dtype=jnp.int32) - starts[e_s]
    n_blocks = (TK + N_EXPERTS * (MOE_BLOCK - 1) + MOE_BLOCK - 1) // MOE_BLOCK
    P = n_blocks * MOE_BLOCK
    src = jnp.zeros((P,), jnp.int32).at[dest].set(tok_s)
    gpad = jnp.zeros((P,), jnp.float32).at[dest].set(g_s)
    block_start = jnp.arange(n_blocks, dtype=jnp.int32) * MOE_BLOCK
    block_expert = jnp.minimum(jnp.sum(block_start[:, None] >= pad_ends[None, :], axis=1),
                               N_EXPERTS - 1).astype(jnp.int32)
    xg = xt[src].reshape(n_blocks, MOE_BLOCK, D)

    def expert_block(args):
        xb, e = args
        hb = clamped_swiglu(xb @ w1[e] + b1[e])
        return hb @ w2[e] + b2[e]

    y = lax.map(expert_block, (xg, block_expert)).reshape(P, D)
    y = y.astype(jnp.float32) * gpad[:, None]
    out = jax.ops.segment_sum(y, src, num_segments=T)
    return out.reshape(B, L, D).astype(h.dtype)


def setup_inputs(seed: int = 0) -> dict:
    key = jax.random.key(seed)
    ks = jax.random.split(key, 32)
    f32 = jnp.float32

    def nrm(k, shape, scale):
        return jax.random.normal(k, shape, f32) * scale

    Dp = DEPTH
    return {
        "x": jax.random.normal(ks[0], (BATCH, SEQ, D_MODEL), f32),
        "norm1_g": 1.0 + nrm(ks[1], (Dp, D_MODEL), 0.02),
        "w_in": nrm(ks[2], (Dp, D_MODEL, IN_COLS), D_MODEL ** -0.5),
        "conv_w": nrm(ks[3], (Dp, SHORT_CONV, 3 * HYENA_WIDTH), SHORT_CONV ** -0.5),
        "conv_b": nrm(ks[4], (Dp, 3 * HYENA_WIDTH), 0.02),
        "filt_w1": nrm(ks[5], (Dp, FILTER_EMB, FILTER_HIDDEN), FILTER_EMB ** -0.5),
        "filt_b1": nrm(ks[6], (Dp, FILTER_HIDDEN), 0.1),
        "filt_freq1": 1.0 + nrm(ks[7], (Dp, FILTER_HIDDEN), 0.05),
        "filt_w2": nrm(ks[8], (Dp, FILTER_HIDDEN, FILTER_HIDDEN), FILTER_HIDDEN ** -0.5),
        "filt_b2": nrm(ks[9], (Dp, FILTER_HIDDEN), 0.1),
        "filt_freq2": 1.0 + nrm(ks[10], (Dp, FILTER_HIDDEN), 0.05),
        "filt_w3": nrm(ks[11], (Dp, FILTER_HIDDEN, HYENA_ORDER * 2 * HYENA_WIDTH), FILTER_HIDDEN ** -0.5),
        "filt_b3": nrm(ks[12], (Dp, HYENA_ORDER * 2 * HYENA_WIDTH), 0.02),
        "hyena_d": nrm(ks[13], (Dp, HYENA_ORDER, HYENA_WIDTH), 0.5),
        "q_norm_g": 1.0 + nrm(ks[14], (Dp, HEAD_DIM), 0.02),
        "k_norm_g": 1.0 + nrm(ks[15], (Dp, HEAD_DIM), 0.02),
        "w_hyena_up": nrm(ks[16], (Dp, HYENA_WIDTH, D_MODEL), HYENA_WIDTH ** -0.5),
        "w_attn_up": nrm(ks[17], (Dp, ATTN_WIDTH, D_MODEL), ATTN_WIDTH ** -0.5),
        "w_out": nrm(ks[18], (Dp, D_MODEL, D_MODEL), D_MODEL ** -0.5),
        "norm2_g": 1.0 + nrm(ks[19], (Dp, D_MODEL), 0.02),
        "router_w": nrm(ks[20], (Dp, D_MODEL, N_EXPERTS), D_MODEL ** -0.5),
        "router_b": nrm(ks[21], (Dp, N_EXPERTS), 0.01),
        "expert_w1": nrm(ks[22], (Dp, N_EXPERTS, D_MODEL, 2 * D_FF), D_MODEL ** -0.5),
        "expert_b1": nrm(ks[23], (Dp, N_EXPERTS, 2 * D_FF), 0.02),
        "expert_w2": nrm(ks[24], (Dp, N_EXPERTS, D_FF, D_MODEL), D_FF ** -0.5),
        "expert_b2": nrm(ks[25], (Dp, N_EXPERTS, D_MODEL), 0.02),
    }


def reference(x, norm1_g, w_in, conv_w, conv_b, filt_w1, filt_b1, filt_freq1, filt_w2, filt_b2,
              filt_freq2, filt_w3, filt_b3, hyena_d, q_norm_g, k_norm_g, w_hyena_up, w_attn_up,
              w_out, norm2_g, router_w, router_b, expert_w1, expert_b1, expert_w2, expert_b2):
    o_q = 3 * HYENA_WIDTH
    o_k = o_q + ATTN_WIDTH
    o_v = o_k + KV_WIDTH
    o_g = o_v + KV_WIDTH
    for layer in range(DEPTH):
        u = rmsnorm(x, norm1_g[layer])
        proj = u @ w_in[layer]
        y_hy = hyena_mixer(proj[..., :o_q], conv_w[layer], conv_b[layer],
                           filt_w1[layer], filt_b1[layer], filt_freq1[layer],
                           filt_w2[layer], filt_b2[layer], filt_freq2[layer],
                           filt_w3[layer], filt_b3[layer], hyena_d[layer])
        y_at = attention_mixer(proj[..., o_q:o_k], proj[..., o_k:o_v], proj[..., o_v:o_g],
                               q_norm_g[layer], k_norm_g[layer]).astype(x.dtype)
        g_hy = jax.nn.sigmoid(proj[..., o_g:o_g + D_MODEL])
        g_at = jax.nn.sigmoid(proj[..., o_g + D_MODEL:])
        merged = g_hy * (y_hy @ w_hyena_up[layer]) + g_at * (y_at @ w_attn_up[layer])
        x = x + merged @ w_out[layer]
        hn = rmsnorm(x, norm2_g[layer])
        x = x + moe(hn, router_w[layer], router_b[layer], expert_w1[layer], expert_b1[layer],
                    expert_w2[layer], expert_b2[layer])
    return x
```

```cpp
#include <hip/hip_runtime.h>
#include <cstdio>
#include <cstdint>
namespace pg8 {
#define PG8_LAS __attribute__((address_space(3)))
typedef unsigned short bf16_t;
typedef short bf16x8 __attribute__((ext_vector_type(8)));
typedef float f32x4 __attribute__((ext_vector_type(4)));
typedef unsigned u32x4 __attribute__((ext_vector_type(4)));
constexpr int BM = 256, BK = 64, HALF = 128, HTB = HALF * BK * 2  , STAGE_BYTES = 8 * HTB, NXCD = 8, WGM = 8;

__host__ __device__ __forceinline__ int lds_byte(int r, int c) { const int st = (r >> 4) * 2 + (c >> 5), rr = r & 15, cc = c & 31, ob = rr * 64 + cc * 2; return st * 1024 + (ob ^ (((ob >> 9) & 1) << 5)); }
__host__ __device__ __forceinline__ void stage_rc(int b, int& R, int& C) { const int st = b / 1024, sb = b % 1024, swz = sb ^ (((sb >> 9) & 1) << 5); R = (st >> 1) * 16 + swz / 64; C = (st & 1) * 32 + (swz % 64) / 2; }
__host__ __device__ __forceinline__ int perm32(int rho) { const int n = rho >> 4, i = rho & 15; return 8 * (i >> 2) + 4 * n + (i & 3); }

struct Unit { int pm, pn, pb; };
struct Gemm { const bf16_t* A; const bf16_t* Bt; int M, N, K; };

struct StaticOrder {
    int nM, nN, nwg, G, c;
    __host__ __device__ void init(int M, int N, int G_, int c_) { nM = M / BM; nN = N / BM; nwg = nM * nN; G = G_; c = c_; }
    __host__ __device__ bool next(int i, Unit& u) const {
        const long L = (long)i * G + c; if (L >= nwg) return false;
        int wgid = (int)L; { const int q = nwg / NXCD, r = nwg % NXCD, xcd = wgid % NXCD, off = wgid / NXCD; wgid = (xcd < r ? xcd * (q + 1) : r * (q + 1) + (xcd - r) * q) + off; }
        const int nig = WGM * nN, gid = wgid / nig, fm = gid * WGM, gsz = (nM - fm) < WGM ? (nM - fm) : WGM;
        u.pm = fm + ((wgid % nig) % gsz); u.pn = (wgid % nig) / gsz; u.pb = u.pn; return true;
    }
    __device__ __forceinline__ void a_ready(const Unit&) const {}
    __device__ __forceinline__ void done(const Unit&) const {}
};

__device__ __forceinline__ unsigned cvt_pk_bf16(float lo, float hi) { unsigned r; asm volatile("v_cvt_pk_bf16_f32 %0, %1, %2" : "=v"(r) : "v"(lo), "v"(hi)); return r; }
typedef float f32x2 __attribute__((ext_vector_type(2)));
template <int ACT  > struct EpiBf16 {
    static constexpr bool PERM = true, AFTER_DRAIN = false; static_assert(ACT == 0, "EpiBf16: ACT is 0 (none)");
    bf16_t* O; int ldc; const float* bias; int split_cols; size_t split_stride; float scale0;
    __device__ __forceinline__ void operator()(const f32x4 (&acc)[2][2][4][2], const Unit& u, int wr, int wc, int fr, int fq) const {
        const int row0 = u.pm * BM + wr * 64 + fr; int colt = u.pn * BM; bf16_t* base = O;
        float sc = 1.f; if (split_cols) { const int t = colt / split_cols; base += (size_t)t * split_stride; colt -= t * split_cols; if (t == 0) sc = scale0; }
        const int col0 = colt + wc * 32 + 8 * fq, bcol0 = u.pn * BM + wc * 32 + 8 * fq;
        f32x4 bv[2][2];
#pragma unroll
        for (int bj = 0; bj < 2; ++bj)
#pragma unroll
            for (int n = 0; n < 2; ++n) bv[bj][n] = bias ? *(const f32x4*)(bias + bcol0 + bj * HALF + 4 * n) : (f32x4){0.f, 0.f, 0.f, 0.f};
#pragma unroll
        for (int ai = 0; ai < 2; ++ai)
#pragma unroll
            for (int m = 0; m < 4; ++m) { bf16_t* rowp = base + (size_t)(row0 + ai * HALF + m * 16) * ldc + col0;
#pragma unroll
                for (int bj = 0; bj < 2; ++bj) { f32x4 v0 = acc[ai][bj][m][0] + bv[bj][0], v1 = acc[ai][bj][m][1] + bv[bj][1];
                    v0 = v0 * sc; v1 = v1 * sc; u32x4 w; w.x = cvt_pk_bf16(v0[0], v0[1]); w.y = cvt_pk_bf16(v0[2], v0[3]); w.z = cvt_pk_bf16(v1[0], v1[1]); w.w = cvt_pk_bf16(v1[2], v1[3]);
                    *(u32x4*)(rowp + bj * HALF) = w; } }
    }
};
__device__ __forceinline__ float bf_lo(unsigned w) { return __uint_as_float(w << 16); }
__device__ __forceinline__ float bf_hi(unsigned w) { return __uint_as_float(w & 0xffff0000u); }
__device__ __forceinline__ float sigmoid_f(float x) { return __builtin_amdgcn_rcpf(1.f + __builtin_amdgcn_exp2f(-1.4426950408889634f * x)); }
struct MoeOrder {
    int nM, nN, nwg, G, c; const PG8_LAS int* rbe;
    __device__ void init(int nM_, int nN_, int G_, int c_, const PG8_LAS int* rbe_) { nM = nM_; nN = nN_; nwg = nM * nN; G = G_; c = c_; rbe = rbe_; }
    __device__ bool next(int i, Unit& u) const {
        const long L = (long)i * G + c; if (L >= nwg) return false;
        int wgid = (int)L; { const int q = nwg / NXCD, r = nwg % NXCD, xcd = wgid % NXCD, off = wgid / NXCD; wgid = (xcd < r ? xcd * (q + 1) : r * (q + 1) + (xcd - r) * q) + off; }
        const int nig = WGM * nN, gid = wgid / nig, fm = gid * WGM, gsz = (nM - fm) < WGM ? (nM - fm) : WGM;
        u.pm = fm + ((wgid % nig) % gsz); u.pn = (wgid % nig) / gsz; u.pb = rbe[u.pm] * nN + u.pn; return true;
    }
    __device__ __forceinline__ void a_ready(const Unit&) const {}
    __device__ __forceinline__ void done(const Unit&) const {}
};
template <int PASS> struct EpiGate {
    static constexpr bool PERM = true, AFTER_DRAIN = false;
    bf16_t* O; int ldc; const bf16_t* G; int ldg;
    __device__ __forceinline__ void operator()(const f32x4 (&acc)[2][2][4][2], const Unit& u, int wr, int wc, int fr, int fq) const {
        const int row0 = u.pm * BM + wr * 64 + fr, col0 = u.pn * BM + wc * 32 + 8 * fq;
#pragma unroll
        for (int ai = 0; ai < 2; ++ai)
#pragma unroll
            for (int m = 0; m < 4; ++m) { const size_t row = (size_t)(row0 + ai * HALF + m * 16);
#pragma unroll
                for (int bj = 0; bj < 2; ++bj) { const int col = col0 + bj * HALF;
                    const u32x4 gw = *(const u32x4*)(G + row * ldg + col);
                    float v[8];
#pragma unroll
                    for (int i = 0; i < 4; ++i) { v[2 * i] = sigmoid_f(bf_lo(gw[i])) * acc[ai][bj][m][i >> 1][(2 * i) & 3]; v[2 * i + 1] = sigmoid_f(bf_hi(gw[i])) * acc[ai][bj][m][i >> 1][(2 * i + 1) & 3]; }
                    bf16_t* op = O + row * ldc + col;
                    if (PASS == 1) { const u32x4 tw = *(const u32x4*)op;
#pragma unroll
                        for (int i = 0; i < 4; ++i) { v[2 * i] += bf_lo(tw[i]); v[2 * i + 1] += bf_hi(tw[i]); } }
                    u32x4 w; w.x = cvt_pk_bf16(v[0], v[1]); w.y = cvt_pk_bf16(v[2], v[3]); w.z = cvt_pk_bf16(v[4], v[5]); w.w = cvt_pk_bf16(v[6], v[7]);
                    *(u32x4*)op = w; } }
    }
};
struct EpiResF32 {
    static constexpr bool PERM = false, AFTER_DRAIN = false;
    const float* X; float* out; int ldc;
    __device__ __forceinline__ void operator()(const f32x4 (&acc)[2][2][4][2], const Unit& u, int wr, int wc, int fr, int fq) const {
        const int row0 = u.pm * BM + wr * 64 + fr, col0 = u.pn * BM + wc * 32 + 4 * fq;
#pragma unroll
        for (int ai = 0; ai < 2; ++ai)
#pragma unroll
            for (int m = 0; m < 4; ++m) { const size_t off = (size_t)(row0 + ai * HALF + m * 16) * ldc + col0;
#pragma unroll
                for (int bj = 0; bj < 2; ++bj)
#pragma unroll
                    for (int n = 0; n < 2; ++n) { const f32x4 xv = *(const f32x4*)(X + off + bj * HALF + n * 16); *(f32x4*)(out + off + bj * HALF + n * 16) = xv + acc[ai][bj][m][n]; } }
    }
};
struct EpiSwiglu {
    static constexpr bool PERM = true, AFTER_DRAIN = false;
    bf16_t* H; const float* b1;
    __device__ __forceinline__ void operator()(const f32x4 (&acc)[2][2][4][2], const Unit& u, int wr, int wc, int fr, int fq) const {
        const int row0 = u.pm * BM + wr * 64 + fr, e = u.pb >> 3, j0 = u.pn * HALF + wc * 32 + 8 * fq;
        const float* bp = b1 + (size_t)e * 2048 + 2 * j0; float bg[8], bl[8];
#pragma unroll
        for (int i = 0; i < 4; ++i) { const f32x4 t = *(const f32x4*)(bp + 4 * i); bg[2 * i] = t[0]; bl[2 * i] = t[1]; bg[2 * i + 1] = t[2]; bl[2 * i + 1] = t[3]; }
#pragma unroll
        for (int ai = 0; ai < 2; ++ai)
#pragma unroll
            for (int m = 0; m < 4; ++m) { const size_t row = (size_t)(row0 + ai * HALF + m * 16); float o[8];
#pragma unroll
                for (int i = 0; i < 8; ++i) { float g = acc[ai][0][m][i >> 2][i & 3] + bg[i], l = acc[ai][1][m][i >> 2][i & 3] + bl[i];
                    g = fminf(g, 7.0f); l = fminf(fmaxf(l, -7.0f), 7.0f); o[i] = g * sigmoid_f(1.702f * g) * (l + 1.0f); }
                u32x4 w; w.x = cvt_pk_bf16(o[0], o[1]); w.y = cvt_pk_bf16(o[2], o[3]); w.z = cvt_pk_bf16(o[4], o[5]); w.w = cvt_pk_bf16(o[6], o[7]);
                *(u32x4*)(H + row * 1024 + j0) = w; }
    }
};
struct EpiMoe2 {
    static constexpr bool PERM = true, AFTER_DRAIN = false;
    bf16_t* Y; const float* b2; const float* gate;
    __device__ __forceinline__ void operator()(const f32x4 (&acc)[2][2][4][2], const Unit& u, int wr, int wc, int fr, int fq) const {
        const int row0 = u.pm * BM + wr * 64 + fr, e = u.pb >> 2, col0 = u.pn * BM + wc * 32 + 8 * fq;
        f32x4 bv[2][2];
#pragma unroll
        for (int bj = 0; bj < 2; ++bj)
#pragma unroll
            for (int n = 0; n < 2; ++n) bv[bj][n] = *(const f32x4*)(b2 + (size_t)e * 1024 + col0 + bj * HALF + 4 * n);
#pragma unroll
        for (int ai = 0; ai < 2; ++ai)
#pragma unroll
            for (int m = 0; m < 4; ++m) { const size_t row = (size_t)(row0 + ai * HALF + m * 16); const float gt = gate[row];
#pragma unroll
                for (int bj = 0; bj < 2; ++bj) { const f32x4 v0 = (acc[ai][bj][m][0] + bv[bj][0]) * gt, v1 = (acc[ai][bj][m][1] + bv[bj][1]) * gt;
                    u32x4 w; w.x = cvt_pk_bf16(v0[0], v0[1]); w.y = cvt_pk_bf16(v0[2], v0[3]); w.z = cvt_pk_bf16(v1[0], v1[1]); w.w = cvt_pk_bf16(v1[2], v1[3]);
                    *(u32x4*)(Y + row * 1024 + col0 + bj * HALF) = w; } }
    }
};
template <class Epi, class Sched, bool ALIGN_EPI = false, bool SP2 = false>
__device__ __forceinline__ void gemm_phase(PG8_LAS unsigned char* lds, const Gemm g, const Sched& S, const Epi& E) {
    const int tid = threadIdx.x, wid = __builtin_amdgcn_readfirstlane(tid >> 6), lane = tid & 63, wr = wid >> 2, wc = wid & 3, fr = lane & 15, fq = lane >> 4;
    const int K = g.K, nt = K / BK;
    unsigned voffA[2], voffB[2];
#pragma unroll
    for (int i = 0; i < 2; ++i) { int R, C; stage_rc(tid * 16 + i * 8192, R, C); const int Rb = Epi::PERM ? ((R & ~31) + perm32(R & 31)) : R;
        voffA[i] = (unsigned)(R * K + C) * 2u; voffB[i] = (unsigned)(Rb * K + C) * 2u; }
    const size_t kstep = (size_t)(BK * 2);
    const size_t hstep = (size_t)HALF * K * 2;
    const size_t tstep = 2 * hstep;
    const unsigned ldsw = (unsigned)wid * 1024u;
    const int aoff = lds_byte(wr * 64 + fr, fq * 8), boff = lds_byte(wc * 32 + fr, fq * 8);
#define PG8_SA(b, h) (((b) * 2 + (h)) * HTB)
#define PG8_SB(b, h) ((4 + (b) * 2 + (h)) * HTB)
#define PG8_STAGE(bufoff, gbase, voff) do { _Pragma("unroll") for (int _i = 0; _i < 2; ++_i) \
        __builtin_amdgcn_global_load_lds((const unsigned*)((const char*)(gbase) + (voff)[_i]), (PG8_LAS unsigned*)(lds + (bufoff) + ldsw + _i * 8192), 16, 0, 0); } while (0)
#define PG8_LDA(dst, b, h) do { _Pragma("unroll") for (int m = 0; m < 4; ++m) _Pragma("unroll") for (int k = 0; k < 2; ++k) dst[m][k] = *(const PG8_LAS bf16x8*)(lds + PG8_SA(b, h) + aoff + m * 2048 + k * 1024); } while (0)
#define PG8_LDB(dst, b, h) do { _Pragma("unroll") for (int n = 0; n < 2; ++n) _Pragma("unroll") for (int k = 0; k < 2; ++k) dst[n][k] = *(const PG8_LAS bf16x8*)(lds + PG8_SB(b, h) + boff + n * 2048 + k * 1024); } while (0)
#define PG8_MMA(ai, bj, At, Bt) do { __builtin_amdgcn_s_setprio(1); _Pragma("unroll") for (int m = 0; m < 4; ++m) _Pragma("unroll") for (int n = 0; n < 2; ++n) _Pragma("unroll") for (int k = 0; k < 2; ++k) \
        acc[ai][bj][m][n] = __builtin_amdgcn_mfma_f32_16x16x32_bf16(Bt[n][k], At[m][k], acc[ai][bj][m][n], 0, 0, 0); __builtin_amdgcn_s_setprio(0); } while (0)
#define PG8_WAIT_V(n) asm volatile("s_waitcnt vmcnt(" #n ")" ::: "memory")
#define PG8_WAIT_L(n) asm volatile("s_waitcnt lgkmcnt(" #n ")" ::: "memory")
#define PG8_BAR __builtin_amdgcn_s_barrier()
#define PG8_SCHED __builtin_amdgcn_sched_barrier(0)
    Unit cur, nxt; int ui = 0;
    if (!S.next(0, cur)) return;
    f32x4 acc[2][2][4][2];
#pragma unroll
    for (int a = 0; a < 2; ++a)
#pragma unroll
        for (int b = 0; b < 2; ++b)
#pragma unroll
            for (int m = 0; m < 4; ++m)
#pragma unroll
                for (int n = 0; n < 2; ++n) acc[a][b][m][n] = (f32x4){0.f, 0.f, 0.f, 0.f};
    bf16x8 At[4][2], B0[2][2], B1[2][2];
    const char* cA = (const char*)g.A + (size_t)cur.pm * tstep; const char* cB = (const char*)g.Bt + (size_t)cur.pb * tstep;
    S.a_ready(cur);
    if constexpr (SP2) {
        PG8_STAGE(PG8_SB(0, 0), cB, voffB); PG8_STAGE(PG8_SB(0, 1), cB + hstep, voffB); PG8_STAGE(PG8_SA(0, 0), cA, voffA); PG8_STAGE(PG8_SA(0, 1), cA + hstep, voffA);
        if (wr == 1) PG8_BAR;
        PG8_WAIT_V(2); PG8_BAR;
        PG8_STAGE(PG8_SB(1, 0), cB + kstep, voffB); PG8_STAGE(PG8_SA(1, 0), cA + kstep, voffA); PG8_STAGE(PG8_SB(1, 1), cB + hstep + kstep, voffB);
        PG8_WAIT_V(6); PG8_BAR;
    } else {
        PG8_STAGE(PG8_SB(0, 0), cB, voffB); PG8_STAGE(PG8_SA(0, 0), cA, voffA); PG8_STAGE(PG8_SB(0, 1), cB + hstep, voffB); PG8_STAGE(PG8_SA(0, 1), cA + hstep, voffA);
        if (wr == 1) PG8_BAR;
        PG8_WAIT_V(4); PG8_BAR;
        PG8_STAGE(PG8_SB(1, 0), cB + kstep, voffB); PG8_STAGE(PG8_SA(1, 0), cA + kstep, voffA); PG8_STAGE(PG8_SB(1, 1), cB + hstep + kstep, voffB);
        PG8_WAIT_V(6); PG8_BAR;
    }
    for (;;) {
        const bool has_next = S.next(ui + 1, nxt);
        const char* nA = has_next ? (const char*)g.A + (size_t)nxt.pm * tstep : cA; const char* nB = has_next ? (const char*)g.Bt + (size_t)nxt.pb * tstep : cB;
        for (int t = 0; t < nt; t += 2) {
            const bool last = (t == nt - 2);
            const char* a1 = cA + (size_t)(t + 1) * kstep;
            const char* a2 = last ? nA : cA + (size_t)(t + 2) * kstep; const char* b2 = last ? nB : cB + (size_t)(t + 2) * kstep;
            const char* a3 = a2 + kstep; const char* b3 = b2 + kstep;
            if (last && has_next) S.a_ready(nxt);
            if constexpr (SP2) {
            PG8_LDB(B0, 0, 0); PG8_LDB(B1, 0, 1); PG8_SCHED; PG8_LDA(At, 0, 0); PG8_STAGE(PG8_SA(1, 1), a1 + hstep, voffA);
            PG8_WAIT_V(8); PG8_WAIT_L(0); PG8_BAR; PG8_MMA(0, 0, At, B0); PG8_MMA(0, 1, At, B1); PG8_BAR; PG8_SCHED;
            PG8_LDA(At, 0, 1); PG8_STAGE(PG8_SB(0, 0), b2, voffB); PG8_STAGE(PG8_SB(0, 1), b2 + hstep, voffB); PG8_STAGE(PG8_SA(0, 0), a2, voffA);
            PG8_WAIT_V(8); PG8_WAIT_L(0); PG8_BAR; PG8_MMA(1, 0, At, B0); PG8_MMA(1, 1, At, B1); PG8_BAR; PG8_SCHED;
            PG8_LDB(B0, 1, 0); PG8_LDB(B1, 1, 1); PG8_SCHED; PG8_LDA(At, 1, 0); PG8_STAGE(PG8_SA(0, 1), a2 + hstep, voffA);
            PG8_WAIT_V(8); PG8_WAIT_L(0); PG8_BAR; PG8_MMA(0, 0, At, B0); PG8_MMA(0, 1, At, B1); PG8_BAR; PG8_SCHED;
            PG8_LDA(At, 1, 1); PG8_STAGE(PG8_SB(1, 0), b3, voffB); PG8_STAGE(PG8_SB(1, 1), b3 + hstep, voffB); PG8_STAGE(PG8_SA(1, 0), a3, voffA);
            PG8_WAIT_V(8); PG8_WAIT_L(0); PG8_BAR; PG8_MMA(1, 0, At, B0); PG8_MMA(1, 1, At, B1); PG8_BAR; PG8_SCHED;
            } else {
            PG8_LDB(B0, 0, 0); PG8_SCHED; PG8_LDA(At, 0, 0); PG8_STAGE(PG8_SA(1, 1), a1 + hstep, voffA);
            PG8_WAIT_L(8); PG8_BAR; PG8_WAIT_L(0); PG8_MMA(0, 0, At, B0); PG8_BAR; PG8_SCHED;
            PG8_LDB(B1, 0, 1); PG8_STAGE(PG8_SB(0, 0), b2, voffB);
            PG8_BAR; PG8_WAIT_L(0); PG8_MMA(0, 1, At, B1); PG8_BAR;
            PG8_LDA(At, 0, 1); PG8_STAGE(PG8_SA(0, 0), a2, voffA);
            PG8_BAR; PG8_WAIT_L(0); PG8_MMA(1, 0, At, B0); PG8_BAR; PG8_SCHED;
            PG8_STAGE(PG8_SB(0, 1), b2 + hstep, voffB);
            PG8_WAIT_V(6); PG8_BAR; PG8_MMA(1, 1, At, B1); PG8_BAR;
            PG8_LDB(B0, 1, 0); PG8_SCHED; PG8_LDA(At, 1, 0); PG8_STAGE(PG8_SA(0, 1), a2 + hstep, voffA);
            PG8_WAIT_L(8); PG8_BAR; PG8_WAIT_L(0); PG8_MMA(0, 0, At, B0); PG8_BAR; PG8_SCHED;
            PG8_LDB(B1, 1, 1); PG8_STAGE(PG8_SB(1, 0), b3, voffB);
            PG8_BAR; PG8_WAIT_L(0); PG8_MMA(0, 1, At, B1); PG8_BAR;
            PG8_LDA(At, 1, 1); PG8_STAGE(PG8_SA(1, 0), a3, voffA);
            PG8_BAR; PG8_WAIT_L(0); PG8_MMA(1, 0, At, B0); PG8_BAR; PG8_SCHED;
            PG8_STAGE(PG8_SB(1, 1), b3 + hstep, voffB);
            PG8_WAIT_V(6); PG8_BAR; PG8_MMA(1, 1, At, B1); PG8_BAR;
            }
        }
        if constexpr (ALIGN_EPI) { if (wr == 0) PG8_BAR; }
        if constexpr (!Epi::AFTER_DRAIN) { E(acc, cur, wr, wc, fr, fq); S.done(cur); }
        if (!has_next) break;
#pragma unroll
        for (int a = 0; a < 2; ++a)
#pragma unroll
            for (int b = 0; b < 2; ++b)
#pragma unroll
                for (int m = 0; m < 4; ++m)
#pragma unroll
                    for (int n = 0; n < 2; ++n) acc[a][b][m][n] = (f32x4){0.f, 0.f, 0.f, 0.f};
        cur = nxt; cA = nA; cB = nB; ++ui;
        if constexpr (ALIGN_EPI) { if (wr == 1) PG8_BAR; }
    }
    PG8_WAIT_V(0);
    if constexpr (!ALIGN_EPI) { if (wr == 0) PG8_BAR; }
    PG8_BAR;
    if constexpr (Epi::AFTER_DRAIN) { E.fused(acc, cur, wr, wc, fr, fq, lds, wid, lane); S.done(cur); }
#undef PG8_SA
#undef PG8_SB
#undef PG8_STAGE
#undef PG8_LDA
#undef PG8_LDB
#undef PG8_MMA
#undef PG8_WAIT_V
#undef PG8_WAIT_L
#undef PG8_BAR
#undef PG8_SCHED
}
}
#include <hip/hip_bf16.h>
#include <cmath>
namespace attn_body {
using bf16=__hip_bfloat16;
using bf16x8=__attribute__((ext_vector_type(8)))short;
using s16x4=__attribute__((ext_vector_type(4)))short;
using f32x16=__attribute__((ext_vector_type(16)))float;
using u32x4=__attribute__((ext_vector_type(4)))unsigned;
constexpr int BATCH=4,NHEAD=8,NKVH=2,SEQ=8192,D=64,QP=NHEAD*D,KP=NKVH*D;
constexpr int NW=8,QBLK=32,QB=QBLK*NW,KVBLK=64,NQB=SEQ/QB;
constexpr int ATTN_UNIT_ROWS=QB;
__device__ __forceinline__ int crow(int r,int hi){return (r&3)+8*(r>>2)+4*hi;}
#define SBAR() __builtin_amdgcn_sched_barrier(0)
constexpr int NSLOT=3, SLOTB=8192;
constexpr int LDS_K=0, LDS_V=NSLOT*SLOTB, LDS_WS=2*NSLOT*SLOTB, LDS_OST=LDS_WS+NW*64*4, LDS_BYTES=LDS_OST+NW*4096;
constexpr float C2=0.125f*1.4426950408889634f;
__device__ __forceinline__ void glds16(const void*gsrc,unsigned lds_dst){unsigned keep;
  asm volatile("s_mov_b32 %0, m0\n\ts_mov_b32 m0, %2\n\ts_nop 0\n\tglobal_load_lds_dwordx4 %1, off\n\ts_mov_b32 m0, %0":"=&s"(keep):"v"(gsrc),"s"(lds_dst):"memory");}
__device__ __forceinline__ float max3f(float a,float b,float c){float r;asm("v_max3_f32 %0, %1, %2, %3":"=v"(r):"v"(a),"v"(b),"v"(c));return r;}
__device__ __forceinline__ float max2f(float a,float b){float r;asm("v_max_f32_e32 %0, %1, %2":"=v"(r):"v"(a),"v"(b));return r;}
__device__ __forceinline__ float fadd_s(float a,float b){float r;asm("v_add_f32_e32 %0, %1, %2":"=v"(r):"v"(a),"v"(b));return r;}
__device__ __forceinline__ float fsub_s(float a,float b){float r;asm("v_sub_f32_e32 %0, %1, %2":"=v"(r):"v"(a),"v"(b));return r;}
typedef float f32x2_t __attribute__((ext_vector_type(2))); typedef __bf16 bf16x2_t __attribute__((ext_vector_type(2)));
__device__ __forceinline__ unsigned cvtpk_s(float lo,float hi){f32x2_t v={lo,hi};bf16x2_t b=__builtin_convertvector(v,bf16x2_t);return __builtin_bit_cast(unsigned,b);}
#define WAIT_BAR(N) asm volatile("s_waitcnt vmcnt(" #N ") lgkmcnt(0)\n\ts_barrier":::"memory")

__device__ __forceinline__ void qkt(f32x16&p0,f32x16&p1,const char*Kslot,const bf16x8*qr,const f32x16&negm,int r32,int hi){
  const char*kb=Kslot+hi*1024+r32*16;
  #pragma unroll
  for(int d0=0;d0<4;++d0){
    const bf16x8 b0=*reinterpret_cast<const bf16x8*>(kb+d0*2048);
    const bf16x8 b1=*reinterpret_cast<const bf16x8*>(kb+d0*2048+512);
    if(d0==0){p0=__builtin_amdgcn_mfma_f32_32x32x16_bf16(b0,qr[0],negm,0,0,0);p1=__builtin_amdgcn_mfma_f32_32x32x16_bf16(b1,qr[0],negm,0,0,0);}
    else{p0=__builtin_amdgcn_mfma_f32_32x32x16_bf16(b0,qr[d0],p0,0,0,0);p1=__builtin_amdgcn_mfma_f32_32x32x16_bf16(b1,qr[d0],p1,0,0,0);}}
}
typedef __attribute__((address_space(3))) const char* lds_cptr;
typedef short v4i16_t __attribute__((ext_vector_type(4)));
__device__ __forceinline__ void kload8(bf16x8*kf,lds_cptr kp){
  kf[0]=*(const __attribute__((address_space(3))) bf16x8*)(kp);      kf[1]=*(const __attribute__((address_space(3))) bf16x8*)(kp+512);
  kf[2]=*(const __attribute__((address_space(3))) bf16x8*)(kp+2048); kf[3]=*(const __attribute__((address_space(3))) bf16x8*)(kp+2560);
  kf[4]=*(const __attribute__((address_space(3))) bf16x8*)(kp+4096); kf[5]=*(const __attribute__((address_space(3))) bf16x8*)(kp+4608);
  kf[6]=*(const __attribute__((address_space(3))) bf16x8*)(kp+6144); kf[7]=*(const __attribute__((address_space(3))) bf16x8*)(kp+6656);
}
__device__ __forceinline__ void kload2(bf16x8*kf,lds_cptr kp,int j){ kf[2*j]=*(const __attribute__((address_space(3))) bf16x8*)(kp+j*2048); kf[2*j+1]=*(const __attribute__((address_space(3))) bf16x8*)(kp+j*2048+512); }
__device__ __forceinline__ s16x4 vtr(lds_cptr p){ return __builtin_bit_cast(s16x4,__builtin_amdgcn_ds_read_tr16_b64_v4i16((__attribute__((address_space(3))) v4i16_t*)p)); }
__device__ __forceinline__ float rowmax(const f32x16&p0,const f32x16&p1){
  float a=max3f(p0[0],p0[1],p1[0]),b=max3f(p0[2],p0[3],p1[1]);a=max3f(a,p1[2],p1[3]);
  #pragma unroll
  for(int r=4;r<16;r+=4){a=max3f(a,p0[r],p0[r+1]);b=max3f(b,p0[r+2],p0[r+3]);a=max3f(a,p1[r],p1[r+1]);b=max3f(b,p1[r+2],p1[r+3]);}
  const float m=max2f(a,b);
  auto rr=__builtin_amdgcn_permlane32_swap(__float_as_uint(m),__float_as_uint(m),false,false);
  return max2f(__uint_as_float(rr[0]),__uint_as_float(rr[1]));
}
__device__ __forceinline__ void pv(f32x16*o,int vb,bf16x8 pa0,bf16x8 pa1,bf16x8 pa2,bf16x8 pa3){
  #pragma unroll
  for(int d0=0;d0<2;++d0){s16x4 lo[4],hi[4];
    #pragma unroll
    for(int ks=0;ks<4;++ks){
      asm volatile("ds_read_b64_tr_b16 %0,%1 offset:%c2":"=&v"(lo[ks]):"v"(vb),"i"(d0*4096+ks*1024):"memory");
      asm volatile("ds_read_b64_tr_b16 %0,%1 offset:%c2":"=&v"(hi[ks]):"v"(vb),"i"(d0*4096+ks*1024+512):"memory");}
    asm volatile("s_waitcnt lgkmcnt(0)":::"memory");SBAR();
    #define PK(k) (bf16x8){lo[k][0],lo[k][1],lo[k][2],lo[k][3],hi[k][0],hi[k][1],hi[k][2],hi[k][3]}
    o[d0]=__builtin_amdgcn_mfma_f32_32x32x16_bf16(pa0,PK(0),o[d0],0,0,0);
    o[d0]=__builtin_amdgcn_mfma_f32_32x32x16_bf16(pa1,PK(1),o[d0],0,0,0);
    o[d0]=__builtin_amdgcn_mfma_f32_32x32x16_bf16(pa2,PK(2),o[d0],0,0,0);
    o[d0]=__builtin_amdgcn_mfma_f32_32x32x16_bf16(pa3,PK(3),o[d0],0,0,0);
    #undef PK
  }
}

#ifndef ATTN_STORE16
#define ATTN_STORE16(p,v) (*(u32x4*)(p)=(v))
#endif
template<int THRL> __device__ __forceinline__ void attn_unit(int b,int h,int qb,const bf16*Q,const bf16*__restrict__ K,const bf16*__restrict__ V,bf16*O,char*shm){
  const int tid=threadIdx.x,lane=tid&63,r32=lane&31,hi=lane>>5; const int wid=__builtin_amdgcn_readfirstlane(tid>>6);
  const long rowbase=(long)b*SEQ; const int q0=qb*QB;
  const bf16*Qw=Q+(rowbase+q0+wid*QBLK)*QP+h*D;
  const int hk=h/(NHEAD/NKVH); const bf16*Kh=K+rowbase*KP+hk*D,*Vh=V+rowbase*KP+hk*D;
  const unsigned lds0=(unsigned)(uintptr_t)shm;
  float*wsf=(float*)(shm+LDS_WS)+wid*64;
  const bf16*ksrc=Kh+(long)lane*KP+wid*8;
  const bf16*vsrc=Vh+(long)(16*(wid&3)+(lane>>2))*KP+(wid>>2)*32+(lane&3)*8;
  const unsigned kdst=lds0+LDS_K+wid*1024, vdst=lds0+LDS_V+wid*1024;
  #define DMA_K(t,slot) glds16(ksrc+(long)(t)*KVBLK*KP,(unsigned)__builtin_amdgcn_readfirstlane(kdst+(slot)))
  #define DMA_V(t,slot) glds16(vsrc+(long)(t)*KVBLK*KP,(unsigned)__builtin_amdgcn_readfirstlane(vdst+(slot)))
  const int vb0=(int)(lds0+LDS_V)+((lane>>4)&1)*32+(lane&3)*8+(4*hi+((lane&15)>>2))*64;
  const char*Kbase=shm+LDS_K; bf16x8 kf[8];
  const lds_cptr shm3=(lds_cptr)shm; const lds_cptr kp0=shm3+LDS_K+hi*1024+r32*16; const lds_cptr vp0=shm3+LDS_V+((lane>>4)&1)*32+(lane&3)*8+(4*hi+((lane&15)>>2))*64;
  constexpr int NT=SEQ/KVBLK;
  DMA_K(0,0);DMA_V(0,0);DMA_K(1,SLOTB);
  bf16x8 qr[4];
  #pragma unroll
  for(int d0=0;d0<4;++d0)qr[d0]=*reinterpret_cast<const bf16x8*>(&Qw[(long)r32*QP+d0*16+hi*8]);
  float mhat=0.f,l_reg=0.f;f32x16 o[2];o[0]=f32x16{};o[1]=f32x16{};f32x16 negm=f32x16{};asm volatile("":"+v"(negm));
    #define CMASK(P0,P1,t) do{}while(0)
  bool resc=false;
  #define START(P0,P1) do{ const float rm=rowmax(P0,P1); resc=false; \
    { const float dl=rm; mhat=fadd_s(mhat,dl); \
      _Pragma("unroll") for(int r=0;r<16;++r){P0[r]=fsub_s(P0[r],dl);P1[r]=fsub_s(P1[r],dl);} \
      _Pragma("unroll") for(int r=0;r<16;++r)negm[r]=-mhat; asm volatile("":"+v"(negm)); } \
    _Pragma("unroll") for(int r=0;r<16;++r)P0[r]=__builtin_amdgcn_exp2f(P0[r]); }while(0)
  #define RESC() do{ if(resc){ asm volatile("s_waitcnt lgkmcnt(0)":::"memory"); \
      _Pragma("unroll") for(int d_=0;d_<2;++d_) _Pragma("unroll") for(int r=0;r<16;++r)o[d_][r]*=wsf[crow(r,hi)]; } }while(0)
  f32x16 pA0,pA1,pB0,pB1;
  int sl_prev=0,sl_cur=0,sl_next=SLOTB;
  #define ROT() do{sl_prev=sl_cur;sl_cur=sl_next;sl_next=(sl_next==(NSLOT-1)*SLOTB)?0:sl_next+SLOTB;}while(0)
  DMA_K(2,2*SLOTB);
  WAIT_BAR(3);
  qkt(pA0,pA1,Kbase,qr,negm,r32,hi);asm volatile("s_nop 15\n\ts_nop 7":"+v"(pA0),"+v"(pA1));CMASK(pA0,pA1,0);
  START(pA0,pA1);
  _Pragma("unroll") for(int r=0;r<16;++r)pA1[r]=__builtin_amdgcn_exp2f(pA1[r]);
  WAIT_BAR(0);
  DMA_K(3,0);DMA_V(1,SLOTB);
  ROT();
  kload8(kf,kp0+sl_cur);
  WAIT_BAR(2);
  s16x4 vlo[8],vhi[8]; u32x4 pw0,pw1,pw2,pw3;
  #define PKW(P,B) cvtpk_s(P[B],P[B+1])
  #define PAF(k) __builtin_bit_cast(bf16x8,pw##k)
  #define VFR(i) (bf16x8){vlo[i][0],vlo[i][1],vlo[i][2],vlo[i][3],vhi[i][0],vhi[i][1],vhi[i][2],vhi[i][3]}
  #define PIN(x) asm volatile("":"+v"(x))
  #define MX3(a,b,c) __builtin_fmaxf(__builtin_fmaxf((a),(b)),(c))
  #define GAPA(MF,A0,A1,A2,A3,W0,W1,PW) do{ MF; sacc+=A0; sacc+=A1; sacc+=A2; sacc+=A3; PIN(sacc); W0; W1; PIN(PW); SBAR(); }while(0)
  #define EX(v) __builtin_amdgcn_exp2f(v)
  #define GAPB(MF,X,B) do{ MF; X[B]=EX(X[B]); X[B+1]=EX(X[B+1]); X[B+2]=EX(X[B+2]); X[B+3]=EX(X[B+3]); PIN(X); SBAR(); }while(0)
  #define VRD(i) do{ vlo[i]=vtr(vp_+(((i)>>2)*4096+((i)&3)*1024)); vhi[i]=vtr(vp_+(((i)>>2)*4096+((i)&3)*1024+512)); }while(0)
  #define KRD(G,j) do{ if(G){ kload2(kf,kp0+sl_next,j); SBAR(); } }while(0)
  #define STEP(C0,C1,P0,P1,t,GK,GV,GL) do{ SBAR(); \
    const lds_cptr vp_=vp0+sl_prev; \
    VRD(0); SBAR(); float sacc=(P0[0]+P0[1]); \
    GAPA(C0=__builtin_amdgcn_mfma_f32_32x32x16_bf16(kf[0],qr[0],negm,0,0,0), P0[2],P0[3],P0[4],P0[5],     pw0[0]=PKW(P0,0), pw0[1]=PKW(P0,2), pw0); \
    VRD(4); SBAR(); GAPA(C1=__builtin_amdgcn_mfma_f32_32x32x16_bf16(kf[1],qr[0],negm,0,0,0), P0[6],P0[7],P0[8],P0[9],     pw0[2]=PKW(P0,4), pw0[3]=PKW(P0,6), pw0); \
    VRD(1); SBAR(); GAPA(C0=__builtin_amdgcn_mfma_f32_32x32x16_bf16(kf[2],qr[1],C0,0,0,0),   P0[10],P0[11],P0[12],P0[13], pw1[0]=PKW(P0,8), pw1[1]=PKW(P0,10), pw1); \
    VRD(5); SBAR(); GAPA(C1=__builtin_amdgcn_mfma_f32_32x32x16_bf16(kf[3],qr[1],C1,0,0,0),   P0[14],P0[15],P1[0],P1[1],   pw1[2]=PKW(P0,12),pw1[3]=PKW(P0,14), pw1); \
    VRD(2); SBAR(); GAPA(C0=__builtin_amdgcn_mfma_f32_32x32x16_bf16(kf[4],qr[2],C0,0,0,0),   P1[2],P1[3],P1[4],P1[5],     pw2[0]=PKW(P1,0), pw2[1]=PKW(P1,2), pw2); \
    VRD(6); SBAR(); GAPA(C1=__builtin_amdgcn_mfma_f32_32x32x16_bf16(kf[5],qr[2],C1,0,0,0),   P1[6],P1[7],P1[8],P1[9],     pw2[2]=PKW(P1,4), pw2[3]=PKW(P1,6), pw2); \
    VRD(3); SBAR(); GAPA(C0=__builtin_amdgcn_mfma_f32_32x32x16_bf16(kf[6],qr[3],C0,0,0,0),   P1[10],P1[11],P1[12],P1[13], pw3[0]=PKW(P1,8), pw3[1]=PKW(P1,10), pw3); \
    VRD(7); SBAR(); GAPA(C1=__builtin_amdgcn_mfma_f32_32x32x16_bf16(kf[7],qr[3],C1,0,0,0),   P1[14],P1[15],0.f,0.f,       pw3[2]=PKW(P1,12),pw3[3]=PKW(P1,14), pw3); \
    l_reg+=sacc; \
    if(GK){DMA_K((t)+3,sl_cur);} if(GV){DMA_V((t)+1,sl_next);} \
    CMASK(C0,C1,t); \
    { float a=MX3(C0[0],C0[1],C1[0]),b=MX3(C0[2],C0[3],C1[1]); a=MX3(a,C1[2],C1[3]); \
      _Pragma("unroll") for(int r=4;r<16;r+=4){a=MX3(a,C0[r],C0[r+1]);b=MX3(b,C0[r+2],C0[r+3]);a=MX3(a,C1[r],C1[r+1]);b=MX3(b,C1[r+2],C1[r+3]);} \
      float rm=__builtin_fmaxf(a,b); { auto rr=__builtin_amdgcn_permlane32_swap(__float_as_uint(rm),__float_as_uint(rm),false,false); rm=__builtin_fmaxf(__uint_as_float(rr[0]),__uint_as_float(rr[1])); } \
      resc=false; \
      if(__builtin_expect(__any(rm>(float)THRL),0)){ const float dl=__builtin_fmaxf(rm,0.f); mhat+=dl; \
        _Pragma("unroll") for(int r=0;r<16;++r){C0[r]-=dl;C1[r]-=dl;} \
        _Pragma("unroll") for(int r=0;r<16;++r)negm[r]=-mhat; asm volatile("":"+v"(negm)); \
        const float f=__builtin_amdgcn_exp2f(-dl); l_reg*=f; if(hi==0)wsf[r32]=f; resc=true; } } \
    SBAR(); \
    GAPB(o[0]=__builtin_amdgcn_mfma_f32_32x32x16_bf16(PAF(0),VFR(0),o[0],0,0,0), C0,0); \
    GAPB(o[1]=__builtin_amdgcn_mfma_f32_32x32x16_bf16(PAF(0),VFR(4),o[1],0,0,0), C0,4); \
    KRD(GL,0); GAPB(o[0]=__builtin_amdgcn_mfma_f32_32x32x16_bf16(PAF(1),VFR(1),o[0],0,0,0), C0,8); \
    KRD(GL,1); GAPB(o[1]=__builtin_amdgcn_mfma_f32_32x32x16_bf16(PAF(1),VFR(5),o[1],0,0,0), C0,12); \
    KRD(GL,2); GAPB(o[0]=__builtin_amdgcn_mfma_f32_32x32x16_bf16(PAF(2),VFR(2),o[0],0,0,0), C1,0); \
    KRD(GL,3); GAPB(o[1]=__builtin_amdgcn_mfma_f32_32x32x16_bf16(PAF(2),VFR(6),o[1],0,0,0), C1,4); \
    GAPB(o[0]=__builtin_amdgcn_mfma_f32_32x32x16_bf16(PAF(3),VFR(3),o[0],0,0,0), C1,8); \
    GAPB(o[1]=__builtin_amdgcn_mfma_f32_32x32x16_bf16(PAF(3),VFR(7),o[1],0,0,0), C1,12); \
    }while(0)
  int t=1;
  #undef CMASK
  #define CMASK(P0,P1,t) do{}while(0)
  for(;t+5<NT;t+=2){
    STEP(pB0,pB1,pA0,pA1,t,true,true,true);     WAIT_BAR(2); RESC(); ROT();
    STEP(pA0,pA1,pB0,pB1,t+1,true,true,true);   WAIT_BAR(2); RESC(); ROT();
  }
  #undef CMASK
  #define CMASK(P0,P1,t) do{}while(0)
  #define ENDW(tt) do{ if((tt)+3<NT){WAIT_BAR(2);} else if((tt)+2<NT){WAIT_BAR(1);} else {WAIT_BAR(0);} }while(0)
  for(;t+1<NT;t+=2){
    STEP(pB0,pB1,pA0,pA1,t,(t+3<NT),(t+1<NT),(t+1<NT));       ENDW(t);   RESC(); ROT();
    STEP(pA0,pA1,pB0,pB1,t+1,(t+4<NT),(t+2<NT),(t+2<NT));     ENDW(t+1); RESC(); ROT();
  }
  STEP(pB0,pB1,pA0,pA1,NT-1,false,false,false); RESC();
  { float sacc=pB0[0]+pB0[1]; _Pragma("unroll") for(int r=2;r<16;++r)sacc+=pB0[r]; _Pragma("unroll") for(int r=0;r<16;++r)sacc+=pB1[r]; l_reg+=sacc;
    pw0=(u32x4){PKW(pB0,0),PKW(pB0,2),PKW(pB0,4),PKW(pB0,6)};pw1=(u32x4){PKW(pB0,8),PKW(pB0,10),PKW(pB0,12),PKW(pB0,14)};pw2=(u32x4){PKW(pB1,0),PKW(pB1,2),PKW(pB1,4),PKW(pB1,6)};pw3=(u32x4){PKW(pB1,8),PKW(pB1,10),PKW(pB1,12),PKW(pB1,14)};
    SBAR(); pv(o,vb0+sl_cur,PAF(0),PAF(1),PAF(2),PAF(3)); }
  #undef PKW
  #undef PAF
  #undef VFR
  #undef PIN
  #undef MX3
  #undef GAPA
  #undef GAPB
  #undef EX
  #undef VRD
  #undef KRD
  #undef STEP
  #undef ENDW
  {auto rr=__builtin_amdgcn_permlane32_swap(__float_as_uint(l_reg),__float_as_uint(l_reg),false,false);l_reg=__uint_as_float(rr[0])+__uint_as_float(rr[1]);}
  if(hi==0)wsf[32+r32]=l_reg;asm volatile("s_waitcnt lgkmcnt(0)":::"memory");
  float rli[16];
  #pragma unroll
  for(int r=0;r<16;++r)rli[r]=__builtin_amdgcn_rcpf(wsf[32+crow(r,hi)]);
  bf16*Ow=O+(rowbase+q0+wid*QBLK)*QP+h*D;
  { bf16*stg=(bf16*)(shm+LDS_OST)+wid*2048;
    #pragma unroll
    for(int r=0;r<16;++r){const int orow=crow(r,hi);
      #pragma unroll
      for(int d0=0;d0<2;++d0)stg[orow*64+d0*32+r32]=__float2bfloat16(o[d0][r]*rli[r]);}
    asm volatile("s_waitcnt lgkmcnt(0)":::"memory");
    #pragma unroll
    for(int i=0;i<4;++i){const int row=i*8+(lane>>3),ch=lane&7; const u32x4 v=*(const u32x4*)(stg+row*64+ch*8); ATTN_STORE16(Ow+(long)row*QP+ch*8,v);} }
  asm volatile("s_waitcnt lgkmcnt(0)\n\ts_barrier":::"memory");
  #undef DMA_K
  #undef DMA_V
  #undef CMASK
  #undef START
  #undef RESC
  #undef ROT
}
constexpr int ATTN_LDS_BYTES=LDS_BYTES;
struct AttnTensors { const bf16* Q; const bf16* K; const bf16* V; bf16* O; };
struct AttnUnit { int bh; int qb; };
struct StaticOrder {
  int vcu,per;
  __device__ __forceinline__ explicit StaticOrder(int grid,int vcu_):vcu(vcu_),per((BATCH*NHEAD*NQB+grid-1)/grid){}
  __device__ __forceinline__ bool next(int i,AttnUnit&u)const{ if(i>=per)return false; const int U=vcu*per+i; if(U>=BATCH*NHEAD*NQB)return false; u.bh=U/NQB; u.qb=U%NQB; return true; }
  __device__ __forceinline__ void a_ready(const AttnUnit&)const{}
  __device__ __forceinline__ void done(const AttnUnit&)const{}
};
template<class Sched,int THRL=8> __device__ __forceinline__ void attn_phase(char*lds,const AttnTensors&T,const Sched&S){
  AttnUnit u;
  for(int i=0;S.next(i,u);++i){ S.a_ready(u); attn_unit<THRL>(u.bh/NHEAD,u.bh%NHEAD,u.qb,T.Q,T.K,T.V,T.O,lds); S.done(u); }
}
#undef SBAR
#undef WAIT_BAR
}
#define GAS __attribute__((address_space(1)))
#define LAS __attribute__((address_space(3)))
typedef unsigned short bf16;
typedef unsigned v4u __attribute__((ext_vector_type(4)));
typedef float f32x4 __attribute__((ext_vector_type(4)));
typedef short bf16x8 __attribute__((ext_vector_type(8)));
typedef GAS unsigned gu32;
typedef GAS unsigned long long gu64;
#define RLX_AGENT __ATOMIC_RELAXED, __HIP_MEMORY_SCOPE_AGENT
#define LDS_WAIT() asm volatile("s_waitcnt lgkmcnt(0)" ::: "memory")
#define VM_WAIT() asm volatile("s_waitcnt vmcnt(0)" ::: "memory")
__device__ __forceinline__ unsigned long long rt() { return __builtin_amdgcn_s_memrealtime(); }

#define XB_TMO      128
#define XB_XCNT(j)  (256  + 64 * (j))
#define XB_XSUB(j)  (1280 + 64 * (j))
#define XB_XGEN(j)  (2304 + 64 * (j))
#define XB_TOP      3328
#define XB_TOPGEN   3392
#define XCD_BAR_WORDS 3456
#define XB_SPIN_CAP (1u << 18)

__device__ __forceinline__ unsigned xb_ld(unsigned* p)              { return __hip_atomic_load(p, __ATOMIC_RELAXED, __HIP_MEMORY_SCOPE_AGENT); }
__device__ __forceinline__ unsigned xb_add(unsigned* p, unsigned v) { return __hip_atomic_fetch_add(p, v, __ATOMIC_RELAXED, __HIP_MEMORY_SCOPE_AGENT); }
__device__ __forceinline__ unsigned xb_xcc_id() { return (unsigned)__builtin_amdgcn_s_getreg((3 << 11) | 20) & 0xFu; }
#define XB_SPIN(cond, bar) do { unsigned _sp = 0; while (cond) { __builtin_amdgcn_s_sleep(1); \
    if ((++_sp & 255u) == 0u) { if (xb_ld(&(bar)[XB_TMO])) break; if (_sp > XB_SPIN_CAP) { atomicAdd(&(bar)[XB_TMO], 1u); break; } } } } while (0)

struct XcdBarrier {
    unsigned* bar; unsigned x;
    volatile LAS unsigned* st;
};

__device__ __forceinline__ XcdBarrier xcd_barrier_post(unsigned* bar, volatile LAS unsigned* st) {
    XcdBarrier b; b.bar = bar; b.x = xb_xcc_id(); b.st = st;
    if (threadIdx.x == 0) (void)xb_add(&bar[XB_XCNT(b.x)], 1u);
    return b;
}
__device__ __forceinline__ void xcd_barrier_complete(unsigned* bar, unsigned x, unsigned& nloc, unsigned& nx) {
    const unsigned G = gridDim.x * gridDim.y * gridDim.z;
    unsigned sum, cnt, mine, sp = 0u;
    for (;;) {
        sum = 0u; cnt = 0u; mine = 0u;
#pragma unroll
        for (unsigned j = 0; j < 16; ++j) { const unsigned c = xb_ld(&bar[XB_XCNT(j)]); sum += c; cnt += (c > 0u) ? 1u : 0u; mine = (j == x) ? c : mine; }
        if (sum == G) break;
        __builtin_amdgcn_s_sleep(1);
        if ((++sp & 255u) == 0u) { if (xb_ld(&bar[XB_TMO])) break; if (sp > XB_SPIN_CAP) { atomicAdd(&bar[XB_TMO], 1u); break; } }
    }
    nloc = mine > 0u ? mine : 1u; nx = cnt > 0u ? cnt : 1u;
}

__device__ __forceinline__ void xcd_barrier(const XcdBarrier& b) {
    asm volatile("s_waitcnt vmcnt(0)" ::: "memory");
    __syncthreads();
    if (threadIdx.x == 0) {
        unsigned* bar = b.bar;
        __builtin_amdgcn_s_waitcnt(0);
        unsigned nloc = b.st[0], nx = b.st[1];
        if (nloc == 0u) { xcd_barrier_complete(bar, b.x, nloc, nx); b.st[0] = nloc; b.st[1] = nx; }
        const unsigned old = xb_add(&bar[XB_XSUB(b.x)], 1u);
        const unsigned gen = old / nloc;
        if (old + 1u == (gen + 1u) * nloc) {
            __builtin_amdgcn_fence(__ATOMIC_RELEASE, "agent");
            asm volatile("s_waitcnt vmcnt(0)" ::: "memory");
            const unsigned og = xb_add(&bar[XB_TOP], 1u);
            const unsigned tg = og / nx;
            if (og + 1u == (tg + 1u) * nx) xb_add(&bar[XB_TOPGEN], 1u);
            else XB_SPIN(xb_ld(&bar[XB_TOPGEN]) == tg, bar);
            __builtin_amdgcn_fence(__ATOMIC_ACQUIRE, "agent");
            xb_add(&bar[XB_XGEN(b.x)], 1u);
            asm volatile("s_waitcnt vmcnt(0)" ::: "memory");
        } else {
            XB_SPIN(xb_ld(&bar[XB_XGEN(b.x)]) == gen, bar);
            __builtin_amdgcn_fence(__ATOMIC_ACQUIRE, "agent");
            asm volatile("s_waitcnt vmcnt(0)" ::: "memory");
        }
    }
    __syncthreads();
}
#define HD __device__ __forceinline__
#define OPAQUE(x) asm volatile("" : "+v"(x))
typedef float cf __attribute__((ext_vector_type(2)));
HD cf cadd(cf a, cf b) { return a + b; }
HD cf csub(cf a, cf b) { return a - b; }
HD cf cmul(cf a, cf b) { return cf{a.x * b.x - a.y * b.y, a.x * b.y + a.y * b.x}; }
HD int fft_pad(int i) { return i + ((i >> 6) << 2); }
constexpr int FFT_N = 16384;
constexpr int FFT_LDS_ELEMS = FFT_N + (FFT_N >> 6) * 4;
template <bool INV> HD void dft4(cf& a0, cf& a1, cf& a2, cf& a3) {
    const cf t0 = cadd(a0, a2), t1 = csub(a0, a2), t2 = cadd(a1, a3), t3 = csub(a1, a3);
    a0 = cadd(t0, t2); a2 = csub(t0, t2);
    if (!INV) { a1 = cf{t1.x + t3.y, t1.y - t3.x}; a3 = cf{t1.x - t3.y, t1.y + t3.x}; }
    else      { a1 = cf{t1.x - t3.y, t1.y + t3.x}; a3 = cf{t1.x + t3.y, t1.y - t3.x}; }
}
template <bool INV> HD void dft16(cf (&x)[16]) {
#pragma unroll
    for (int m0 = 0; m0 < 4; ++m0) dft4<INV>(x[m0], x[4 + m0], x[8 + m0], x[12 + m0]);
    const float C1 = 0.92387953251128674f, S1 = 0.38268343236508977f, R2 = 0.70710678118654752f;
#define TW(r, c, s) { const cf w = cf{(c), INV ? (s) : -(s)}; x[r] = cmul(x[r], w); }
    TW(5, C1, S1)
    TW(6, R2, R2)
    TW(7, S1, C1)
    TW(9, R2, R2)
    TW(10, 0.f, 1.f)
    TW(11, -R2, R2)
    TW(13, S1, C1)
    TW(14, -R2, R2)
    TW(15, -C1, -S1)
#undef TW
#pragma unroll
    for (int q1 = 0; q1 < 4; ++q1) dft4<INV>(x[4 * q1], x[4 * q1 + 1], x[4 * q1 + 2], x[4 * q1 + 3]);
}
HD cf tw_base(int j, float inv_ls, bool inv) {
    const float th = 6.283185307179586f * ((float)j * inv_ls), t2 = th * th;
    const float s = th * (1.f + t2 * (-1.f / 6.f + t2 * (1.f / 120.f + t2 * (-1.f / 5040.f + t2 * (1.f / 362880.f)))));
    const float c = 1.f + t2 * (-0.5f + t2 * (1.f / 24.f + t2 * (-1.f / 720.f + t2 * (1.f / 40320.f + t2 * (-1.f / 3628800.f)))));
    return cf{c, inv ? s : -s};
}
HD void tw_powers(cf w, cf (&p)[16]) {
    p[0] = cf{1.f, 0.f}; p[1] = w; p[2] = cmul(w, w); p[3] = cmul(p[2], w); p[4] = cmul(p[2], p[2]); p[5] = cmul(p[4], w); p[6] = cmul(p[3], p[3]); p[7] = cmul(p[6], w);
    p[8] = cmul(p[4], p[4]); p[9] = cmul(p[8], w); p[10] = cmul(p[5], p[5]); p[11] = cmul(p[10], w); p[12] = cmul(p[6], p[6]); p[13] = cmul(p[12], w); p[14] = cmul(p[7], p[7]); p[15] = cmul(p[14], w);
}
template <class Z> HD void r16_fwd(Z z, int base, int S, int j, float inv_ls) {
    cf x[16];
#pragma unroll
    for (int m = 0; m < 16; ++m) x[m] = z[fft_pad(base + j + S * m)];
    dft16<false>(x);
    cf p[16]; tw_powers(tw_base(j, inv_ls, false), p);
#pragma unroll
    for (int r = 0; r < 16; ++r) { const int q = (r >> 2) + 4 * (r & 3); z[fft_pad(base + j + S * q)] = cmul(x[r], p[q]); }
}
template <class Z> HD void r16_inv(Z z, int base, int S, int j, float inv_ls) {
    cf x[16]; cf p[16]; tw_powers(tw_base(j, inv_ls, true), p);
#pragma unroll
    for (int q = 0; q < 16; ++q) x[q] = cmul(z[fft_pad(base + j + S * q)], p[q]);
    dft16<true>(x);
#pragma unroll
    for (int r = 0; r < 16; ++r) { const int m = (r >> 2) + 4 * (r & 3); z[fft_pad(base + j + S * m)] = x[r]; }
}
template <class Z> HD void fft_pass_fwd(Z z, int tid, int stage) {
    OPAQUE(tid);
#pragma unroll 1
    for (int r = 0; r < 2; ++r) { const int bid = tid + 512 * r;
        if (stage == 0) r16_fwd(z, 0, 1024, bid, 1.f / 16384.f);
        else if (stage == 1) r16_fwd(z, (bid >> 6) * 1024, 64, bid & 63, 1.f / 1024.f);
        else r16_fwd(z, (bid >> 2) * 64, 4, bid & 3, 1.f / 64.f); }
}
template <class Z> HD void fft_pass_inv(Z z, int tid, int stage) {
    OPAQUE(tid);
#pragma unroll 1
    for (int r = 0; r < 2; ++r) { const int bid = tid + 512 * r;
        if (stage == 0) r16_inv(z, 0, 1024, bid, 1.f / 16384.f);
        else if (stage == 1) r16_inv(z, (bid >> 6) * 1024, 64, bid & 63, 1.f / 1024.f);
        else r16_inv(z, (bid >> 2) * 64, 4, bid & 3, 1.f / 64.f); }
}
template <class Z> HD void fft_pass_d_fwd(Z z, int tid) {
    OPAQUE(tid);
#pragma unroll 1
    for (int r = 0; r < 8; ++r) { const int b4 = 4 * (tid + 512 * r); const int pb = fft_pad(b4);
        cf a0 = z[pb], a1 = z[pb + 1], a2 = z[pb + 2], a3 = z[pb + 3]; dft4<false>(a0, a1, a2, a3); z[pb] = a0; z[pb + 1] = a1; z[pb + 2] = a2; z[pb + 3] = a3; }
}
template <class Z> HD void fft_pass_dkd(Z z, const cf* K, int tid) {
    OPAQUE(tid);
#pragma unroll 1
    for (int r = 0; r < 8; ++r) { const int b4 = 4 * (tid + 512 * r); const int pb = fft_pad(b4);
        cf a0 = z[pb], a1 = z[pb + 1], a2 = z[pb + 2], a3 = z[pb + 3]; dft4<false>(a0, a1, a2, a3);
        a0 = cmul(a0, K[b4]); a1 = cmul(a1, K[b4 + 1]); a2 = cmul(a2, K[b4 + 2]); a3 = cmul(a3, K[b4 + 3]);
        dft4<true>(a0, a1, a2, a3); z[pb] = a0; z[pb + 1] = a1; z[pb + 2] = a2; z[pb + 3] = a3; }
}
constexpr int NWAVES = 8;
#ifndef MK_N_LAUNCHES
#define MK_N_LAUNCHES 1
#endif
constexpr int N_PHASES = 11;
constexpr int N_LAUNCHES = MK_N_LAUNCHES;

constexpr int NB = 4, T = 8192, D = 1024, M = NB * T;
constexpr int HW = 512, AW = 512, KVW = 128;
constexpr int INC = 4352, NHY = 1536, NREST = INC - NHY;
constexpr int PR_Q = 0, PR_K = 512, PR_V = 640, PR_GH = 768, PR_GA = 1792;
constexpr int NE = 32, TOPK = 4, FF = 1024, RB_MAX = 544, P_MAX = RB_MAX * 256;
constexpr float EPS = 1e-6f;
constexpr int TPB = 128;

constexpr size_t MiB = 1u << 20;
constexpr size_t WS_CTL = 0, CTL_ZERO_BYTES = 1 * MiB;
constexpr size_t WS_WIN = 1 * MiB;
constexpr size_t WS_WHU = 10 * MiB, WS_WAU = 11 * MiB, WS_WOUT = 12 * MiB;
constexpr size_t WS_WRT = 14 * MiB;
constexpr size_t WS_TOKROWS = 14 * MiB + 512 * 1024;
constexpr size_t WS_ROWGATE = 15 * MiB;
constexpr size_t WS_ENT = 16 * MiB;
constexpr size_t WS_W1 = 19 * MiB;
constexpr size_t WS_W2 = 147 * MiB;
constexpr size_t WS_XN = 211 * MiB;
constexpr size_t WS_EARLY = 275 * MiB;
constexpr size_t WS_ZT = WS_EARLY;
constexpr size_t WS_PR = WS_ZT + 96 * MiB;
constexpr size_t WS_QO = WS_PR + 176 * MiB;
constexpr size_t WS_KB = WS_QO + 32 * MiB, WS_VB = WS_KB + 8 * MiB;
constexpr size_t WS_HT = WS_VB + 8 * MiB;
constexpr size_t WS_KSP = WS_HT + 64 * MiB;
constexpr size_t WS_Y1S = WS_KSP + 64 * MiB;
constexpr size_t WS_YHT = WS_Y1S + 16 * MiB;
constexpr size_t WS_YH = WS_YHT + 32 * MiB;
constexpr size_t WS_MG = WS_YH + 32 * MiB;
constexpr size_t WS_EARLY_END = WS_MG + 64 * MiB;
constexpr size_t WS_XG = WS_EARLY;
constexpr size_t WS_H1 = WS_XG + 272 * MiB;
constexpr size_t WS_END = 1024 * MiB;
static_assert(WS_EARLY_END <= WS_END && WS_H1 + 272 * MiB <= WS_END && WS_H1 >= WS_PR + 176 * MiB, "d_ws map");
constexpr int CW_CNT = 64;
constexpr int CW_BAR = 4096;

constexpr int RING_OFF = 0, RING_BYTES = 139264;
constexpr int LX_MISC = RING_BYTES;
constexpr int LX_RBE = LX_MISC + 256;
constexpr int LX_CNT = LX_RBE + 2304;
constexpr int LX_ENT = LX_CNT + 512;
constexpr int LX_RED = LX_ENT + TPB * 4 * 16;
constexpr int LDS_BYTES = LX_RED + 256;
static_assert(LDS_BYTES <= 163840, "LDS map");

struct Frame {
    LAS unsigned char* lds;
    volatile LAS unsigned* MISC;
    gu32* ctl;
    int tid, lane, wave, vcu, G;
    unsigned char* ws;
    const float* in[26]; float* out;
};
__device__ __forceinline__ float wave_sum(float v) {
#pragma unroll
    for (int o = 1; o < 64; o <<= 1) v += __shfl_xor(v, o);
    return v;
}
__device__ __forceinline__ unsigned pk2(float lo, float hi) { return pg8::cvt_pk_bf16(lo, hi); }
__device__ __forceinline__ float bflo(unsigned w) { return __uint_as_float(w << 16); }
__device__ __forceinline__ float bfhi(unsigned w) { return __uint_as_float(w & 0xffff0000u); }
__device__ __forceinline__ float bf1(unsigned short h) { return __uint_as_float((unsigned)h << 16); }
__device__ __forceinline__ float sin_rev(float r) { return __builtin_amdgcn_sinf(r); }
__device__ __forceinline__ float cos_rev(float r) { return __builtin_amdgcn_cosf(r); }

template <int MODE>
__device__ __forceinline__ void p0_transpose_item(const float* W, int K, int N, bf16* WT, int row_off, LAS float* scr, int item, int lane) {
    const int nblk = N / 32, kb = item / nblk, nb = item % nblk, k0 = 64 * kb, n0 = 32 * nb;
#pragma unroll 8
    for (int i = 0; i < 32; ++i) { const int kk = 2 * i + (lane >> 5); scr[kk * 33 + (lane & 31)] = W[(size_t)(k0 + kk) * N + n0 + (lane & 31)]; }
    LDS_WAIT(); asm volatile("" ::: "memory");
    const int c = lane & 7;
#pragma unroll
    for (int j = 0; j < 4; ++j) { const int n = (lane >> 3) + 8 * j; const LAS float* s = scr + (8 * c) * 33 + n;
        v4u o; o.x = pk2(s[0 * 33], s[1 * 33]); o.y = pk2(s[2 * 33], s[3 * 33]); o.z = pk2(s[4 * 33], s[5 * 33]); o.w = pk2(s[6 * 33], s[7 * 33]);
        int dr;
        if (MODE == 0) dr = row_off + n0 + n;
        else { const int nn = n0 + n, jj = nn >> 1; dr = row_off + (jj >> 7) * 256 + (nn & 1) * 128 + (jj & 127); }
        *(GAS v4u*)(WT + (size_t)dr * K + k0 + 8 * c) = o; }
    LDS_WAIT(); asm volatile("" ::: "memory");
}
__device__ __forceinline__ void rms_row_to_bf16(const float* xrow, const float* g, bf16* orow, int lane) {
    const GAS f32x4* xr = (const GAS f32x4*)xrow + lane; const GAS f32x4* gr = (const GAS f32x4*)g + lane;
    f32x4 v[4]; float s = 0.f;
#pragma unroll
    for (int j = 0; j < 4; ++j) { v[j] = xr[64 * j]; s += (v[j].x * v[j].x + v[j].y * v[j].y) + (v[j].z * v[j].z + v[j].w * v[j].w); }
    const float rstd = 1.f / sqrtf(wave_sum(s) * (1.f / D) + EPS);
    GAS unsigned long long* o8 = (GAS unsigned long long*)orow + lane;
#pragma unroll
    for (int j = 0; j < 4; ++j) { const f32x4 gg = gr[64 * j]; o8[64 * j] = (unsigned long long)pk2(v[j].x * rstd * gg.x, v[j].y * rstd * gg.y) | ((unsigned long long)pk2(v[j].z * rstd * gg.z, v[j].w * rstd * gg.w) << 32); }
}
__device__ __forceinline__ void p0_filter_tile(Frame& F, int tile) {
    LAS float* feats = (LAS float*)(F.lds + RING_OFF);
    LAS float* h1 = feats + 32 * 36;
    LAS float* h2 = h1 + 32 * 64;
    const float *fw1 = F.in[5], *fb1 = F.in[6], *ff1 = F.in[7], *fw2 = F.in[8], *fb2 = F.in[9], *ff2 = F.in[10], *fw3 = F.in[11], *fb3 = F.in[12];
    float* HT = (float*)(F.ws + WS_HT);
    const int tid = F.tid;
    for (int i = tid; i < 32 * 33; i += NWAVES * 64) { const int r = i / 33, f = i % 33, t = tile * 32 + r; float val;
        if (f == 0) val = (float)t * (1.0f / 8191.0f);
        else { const int bi = (f - 1) & 15; const float fr = 1e-4f + (float)bi * ((15.0f - 1e-4f) / 15.0f); float rev = (float)t * fr * (1.0f / 8192.0f); rev -= floorf(rev);
               val = (f <= 16) ? cos_rev(rev) : -sin_rev(rev); }
        feats[r * 36 + f] = val; }
    __syncthreads();
#pragma unroll
    for (int k = 0; k < 4; ++k) { const int i = tid + 512 * k, r = i >> 6, n = i & 63; float a = fb1[n];
        for (int f = 0; f < 33; ++f) a += feats[r * 36 + f] * fw1[f * 64 + n];
        float rev = ff1[n] * a * 0.15915494309189535f; rev -= rintf(rev); h1[r * 64 + n] = sin_rev(rev); }
    __syncthreads();
#pragma unroll
    for (int k = 0; k < 4; ++k) { const int i = tid + 512 * k, r = i >> 6, n = i & 63; float a = fb2[n];
        for (int f = 0; f < 64; ++f) a += h1[r * 64 + f] * fw2[f * 64 + n];
        float rev = ff2[n] * a * 0.15915494309189535f; rev -= rintf(rev); h2[r * 64 + n] = sin_rev(rev); }
    __syncthreads();
    for (int k = 0; k < 4; ++k) { const int col = tid + 512 * k; float acc[32];
#pragma unroll
        for (int r = 0; r < 32; ++r) acc[r] = 0.f;
        for (int kk = 0; kk < 64; kk += 4) { const float w0 = fw3[(kk + 0) * 2048 + col], w1 = fw3[(kk + 1) * 2048 + col], w2 = fw3[(kk + 2) * 2048 + col], w3 = fw3[(kk + 3) * 2048 + col];
#pragma unroll
            for (int r = 0; r < 32; ++r) { const f32x4 hv = *(const LAS f32x4*)(h2 + r * 64 + kk); acc[r] += hv.x * w0 + hv.y * w1 + hv.z * w2 + hv.w * w3; } }
        const float bias = fb3[col]; const int c = col & 511;
        const float delta = 3.0701134573253945f + (float)c * ((15.350567286626973f - 3.0701134573253945f) / 511.0f);
        float* dst = HT + (size_t)col * T + tile * 32;
#pragma unroll
        for (int r = 0; r < 32; r += 4) { f32x4 o;
#pragma unroll
            for (int q = 0; q < 4; ++q) { const float tl = (float)(tile * 32 + r + q) * (1.0f / 8191.0f); o[q] = (acc[r + q] + bias) * __expf(-tl * delta); }
            *(f32x4*)(dst + r) = o; } }
    __syncthreads();
}
__device__ __forceinline__ void p0_prologue(Frame& F) {
    for (int tile = F.vcu; tile < T / 32; tile += F.G) p0_filter_tile(F, tile);
    LAS float* scr = (LAS float*)(F.lds + RING_OFF + F.wave * 16384);
    const int gw = F.vcu * NWAVES + F.wave, NGW = F.G * NWAVES;
    constexpr int I_IN = (D / 64) * (INC / 32), I_UP = (512 / 64) * (D / 32), I_OUT = (D / 64) * (D / 32), I_W1 = (D / 64) * (2 * FF / 32), I_W2 = (FF / 64) * (D / 32);
    constexpr int NITEMS = I_IN + 2 * I_UP + I_OUT + NE * (I_W1 + I_W2);
    bf16* win_t = (bf16*)(F.ws + WS_WIN); bf16* whu_t = (bf16*)(F.ws + WS_WHU); bf16* wau_t = (bf16*)(F.ws + WS_WAU); bf16* wout_t = (bf16*)(F.ws + WS_WOUT);
    bf16* w1_t = (bf16*)(F.ws + WS_W1); bf16* w2_t = (bf16*)(F.ws + WS_W2);
    for (int it = gw; it < NITEMS; it += NGW) {
        int r = it;
        if (r < I_IN) { p0_transpose_item<0>(F.in[2], D, INC, win_t, 0, scr, r, F.lane); continue; } r -= I_IN;
        if (r < I_UP) { p0_transpose_item<0>(F.in[16], 512, D, whu_t, 0, scr, r, F.lane); continue; } r -= I_UP;
        if (r < I_UP) { p0_transpose_item<0>(F.in[17], 512, D, wau_t, 0, scr, r, F.lane); continue; } r -= I_UP;
        if (r < I_OUT) { p0_transpose_item<0>(F.in[18], D, D, wout_t, 0, scr, r, F.lane); continue; } r -= I_OUT;
        if (r < NE * I_W1) { const int e = r / I_W1; p0_transpose_item<1>(F.in[22] + (size_t)e * D * 2 * FF, D, 2 * FF, w1_t + (size_t)e * 2 * FF * D, 0, scr, r % I_W1, F.lane); continue; } r -= NE * I_W1;
        { const int e = r / I_W2; p0_transpose_item<0>(F.in[24] + (size_t)e * FF * D, FF, D, w2_t + (size_t)e * D * FF, 0, scr, r % I_W2, F.lane); }
    }
    bf16* XN = (bf16*)(F.ws + WS_XN);
    for (int m = gw; m < M; m += NGW) rms_row_to_bf16(F.in[0] + (size_t)m * D, F.in[1], XN + (size_t)m * D, F.lane);
    float* wrt = (float*)(F.ws + WS_WRT);
    for (int i = F.vcu * NWAVES * 64 + F.tid; i < NE * D; i += F.G * NWAVES * 64) { const int e = i >> 10, d = i & 1023; wrt[i] = F.in[20][d * NE + e]; }
}

__device__ __forceinline__ v4u rope8(const v4u raw, float rms, const float* g, int d0, int trow, int tcol, float scale) {
    float x[8];
#pragma unroll
    for (int i = 0; i < 4; ++i) { x[2 * i] = bflo(raw[i]) * rms * g[d0 + 2 * i]; x[2 * i + 1] = bfhi(raw[i]) * rms * g[d0 + 2 * i + 1]; }
    v4u o;
#pragma unroll
    for (int i = 0; i < 4; ++i) { const int pi = (d0 >> 1) + i;
        const float freq = __builtin_amdgcn_exp2f(-(float)(pi & 15) * (13.287712379549449f / 16.0f));
        float rev = (float)(pi < 16 ? trow : tcol) * freq * 0.15915494309189535f; rev -= floorf(rev);
        const float c = cos_rev(rev), s = sin_rev(rev);
        o[i] = pk2((x[2 * i] * c - x[2 * i + 1] * s) * scale, (x[2 * i] * s + x[2 * i + 1] * c) * scale); }
    return o;
}
__device__ __forceinline__ void p2_qkprep(Frame& F) {
    const bf16* PR = (const bf16*)(F.ws + WS_PR); bf16* QO = (bf16*)(F.ws + WS_QO); bf16* KB = (bf16*)(F.ws + WS_KB); bf16* VB = (bf16*)(F.ws + WS_VB);
    const float* qg = F.in[14]; const float* kg = F.in[15];
    const int gw = F.vcu * NWAVES + F.wave, NGW = F.G * NWAVES, lane = F.lane;
    for (int m = gw; m < M; m += NGW) {
        const int t = m & (T - 1), trow = t >> 6, tcol = t & 63;
        const bf16* pr = PR + (size_t)m * NREST;
        { const v4u raw = *(const GAS v4u*)(pr + PR_Q + 8 * lane); float ss = 0.f;
#pragma unroll
          for (int i = 0; i < 4; ++i) { const float a = bflo(raw[i]), b = bfhi(raw[i]); ss += a * a + b * b; }
          ss += __shfl_xor(ss, 1); ss += __shfl_xor(ss, 2); ss += __shfl_xor(ss, 4);
          const float rms = 1.f / sqrtf(ss * (1.f / 64.f) + EPS);
          *(GAS v4u*)(QO + (size_t)m * AW + 8 * lane) = rope8(raw, rms, qg, 8 * (lane & 7), trow, tcol, 0.125f * 1.4426950408889634f); }
        { const int l2 = lane & 15; const v4u raw = *(const GAS v4u*)(pr + (lane < 16 ? PR_K : PR_V) + 8 * l2); float ss = 0.f;
#pragma unroll
          for (int i = 0; i < 4; ++i) { const float a = bflo(raw[i]), b = bfhi(raw[i]); ss += a * a + b * b; }
          ss += __shfl_xor(ss, 1); ss += __shfl_xor(ss, 2); ss += __shfl_xor(ss, 4);
          const float rms = 1.f / sqrtf(ss * (1.f / 64.f) + EPS);
          const v4u kr = rope8(raw, rms, kg, 8 * (lane & 7), trow, tcol, 1.0f);
          if (lane < 16) *(GAS v4u*)(KB + (size_t)m * KVW + 8 * l2) = kr;
          else if (lane < 32) *(GAS v4u*)(VB + (size_t)m * KVW + 8 * l2) = raw; }
    }
}
typedef LAS cf* zptr;
#define FSYNC() __syncthreads()
__device__ __forceinline__ float block_sum(Frame& F, float v) {
    LAS float* red = (LAS float*)(F.lds + LX_RED);
    v = wave_sum(v); if (F.lane == 0) red[F.wave] = v; __syncthreads();
    float s = 0.f;
#pragma unroll
    for (int w = 0; w < NWAVES; ++w) s += red[w];
    __syncthreads(); return s;
}
__device__ __forceinline__ void sc8(const bf16* row, int t0, float w0, float w1, float w2, float b, float (&o)[8]) {
    const v4u raw = *(const GAS v4u*)(row + t0);
    const float prev = t0 > 0 ? bf1(row[t0 - 1]) : 0.f, next = t0 + 8 < T ? bf1(row[t0 + 8]) : 0.f;
    float z[10]; z[0] = prev; z[9] = next;
#pragma unroll
    for (int i = 0; i < 4; ++i) { z[1 + 2 * i] = bflo(raw[i]); z[2 + 2 * i] = bfhi(raw[i]); }
#pragma unroll
    for (int i = 0; i < 8; ++i) o[i] = b + w0 * z[i] + w1 * z[i + 1] + w2 * z[i + 2];
}
__device__ __forceinline__ void fft_fwd3(zptr Z, int tid) { fft_pass_fwd(Z, tid, 0); FSYNC(); fft_pass_fwd(Z, tid, 1); FSYNC(); fft_pass_fwd(Z, tid, 2); FSYNC(); }
__device__ __forceinline__ void fft_inv3(zptr Z, int tid) { fft_pass_inv(Z, tid, 2); FSYNC(); fft_pass_inv(Z, tid, 1); FSYNC(); fft_pass_inv(Z, tid, 0); FSYNC(); }
__device__ __forceinline__ void hyena_channel(Frame& F, int c) {
    zptr Z = (zptr)(F.lds + RING_OFF);
    const int tid = F.tid;
    cf* Ksp = (cf*)(F.ws + WS_KSP) + (size_t)blockIdx.x * 2 * FFT_N;
    float* Y1S = (float*)(F.ws + WS_Y1S) + (size_t)blockIdx.x * 2 * T;
    const float* HT = (const float*)(F.ws + WS_HT);
    const bf16* ZT = (const bf16*)(F.ws + WS_ZT); bf16* YHT = (bf16*)(F.ws + WS_YHT);
    const float* cw = F.in[3]; const float* cb = F.in[4]; const float* hd = F.in[13];
    for (int o = 0; o < 2; ++o) {
        const float* fwd = HT + (size_t)(o * 1024 + c) * T; const float* bwd = HT + (size_t)(o * 1024 + 512 + c) * T;
        float asum = 0.f;
#pragma unroll 1
        for (int r = 0; r < 2; ++r) { int tl_ = tid; OPAQUE(tl_); const int t0 = 8 * (tl_ + 512 * r);
#pragma unroll
            for (int h = 0; h < 2; ++h) { const f32x4 f = *(const GAS f32x4*)(fwd + t0 + 4 * h), b = *(const GAS f32x4*)(bwd + t0 + 4 * h);
#pragma unroll
                for (int i = 0; i < 4; ++i) { const int t = t0 + 4 * h + i; Z[fft_pad(t)] = cf{f[i], 0.f}; asum += fabsf(f[i]);
                    if (t >= 1) { Z[fft_pad(FFT_N - t)] = cf{b[i], 0.f}; asum += fabsf(b[i]); } else Z[fft_pad(T)] = cf{0.f, 0.f}; } } }
        const float S = block_sum(F, asum);
        fft_fwd3(Z, tid); fft_pass_d_fwd(Z, tid); FSYNC();
        const float sc = 1.0f / (S * (float)FFT_N);
#pragma unroll 1
        for (int r = 0; r < 16; ++r) { int tl_ = tid; OPAQUE(tl_); const int p = 2 * (tl_ + 512 * r); const cf a = Z[fft_pad(p)], b = Z[fft_pad(p + 1)];
            *(GAS f32x4*)((float*)(Ksp + (size_t)o * FFT_N + p)) = (f32x4){a.x * sc, a.y * sc, b.x * sc, b.y * sc}; }
        FSYNC();
    }
    const float wv0 = cw[c], wv1 = cw[NHY + c], wv2 = cw[2 * NHY + c], bv = cb[c];
    const float wa0 = cw[512 + c], wa1 = cw[NHY + 512 + c], wa2 = cw[2 * NHY + 512 + c], ba = cb[512 + c];
    const float wb0 = cw[1024 + c], wb1 = cw[NHY + 1024 + c], wb2 = cw[2 * NHY + 1024 + c], bb = cb[1024 + c];
    const float d0 = hd[c], d1 = hd[HW + c];
    for (int pair = 0; pair < 2; ++pair) {
        const bf16* v0 = ZT + (size_t)c * M + (size_t)(2 * pair) * T;          const bf16* v1 = v0 + T;
        const bf16* a0 = ZT + (size_t)(512 + c) * M + (size_t)(2 * pair) * T;  const bf16* a1 = a0 + T;
        const bf16* b0 = ZT + (size_t)(1024 + c) * M + (size_t)(2 * pair) * T; const bf16* b1 = b0 + T;
#pragma unroll 1
        for (int r = 0; r < 2; ++r) { int tl_ = tid; OPAQUE(tl_); const int t0 = 8 * (tl_ + 512 * r); float x0[8], x1[8]; sc8(v0, t0, wv0, wv1, wv2, bv, x0); sc8(v1, t0, wv0, wv1, wv2, bv, x1);
#pragma unroll
            for (int i = 0; i < 8; ++i) { Z[fft_pad(t0 + i)] = cf{x0[i], x1[i]}; Z[fft_pad(T + t0 + i)] = cf{0.f, 0.f}; } }
        FSYNC();
        fft_fwd3(Z, tid); fft_pass_dkd(Z, (const cf*)Ksp, tid); FSYNC(); fft_inv3(Z, tid);
#pragma unroll 1
        for (int r = 0; r < 2; ++r) { int tl_ = tid; OPAQUE(tl_); const int t0 = 8 * (tl_ + 512 * r); float x0[8], x1[8], g0[8], g1[8]; sc8(v0, t0, wv0, wv1, wv2, bv, x0); sc8(v1, t0, wv0, wv1, wv2, bv, x1);
            sc8(a0, t0, wa0, wa1, wa2, ba, g0); sc8(a1, t0, wa0, wa1, wa2, ba, g1); float y0[8], y1[8];
#pragma unroll
            for (int i = 0; i < 8; ++i) { const cf cv = Z[fft_pad(t0 + i)]; y0[i] = g0[i] * (cv.x + x0[i] * d0); y1[i] = g1[i] * (cv.y + x1[i] * d0);
                Z[fft_pad(t0 + i)] = cf{y0[i], y1[i]}; Z[fft_pad(T + t0 + i)] = cf{0.f, 0.f}; }
            *(GAS f32x4*)(Y1S + t0) = (f32x4){y0[0], y0[1], y0[2], y0[3]}; *(GAS f32x4*)(Y1S + t0 + 4) = (f32x4){y0[4], y0[5], y0[6], y0[7]};
            *(GAS f32x4*)(Y1S + T + t0) = (f32x4){y1[0], y1[1], y1[2], y1[3]}; *(GAS f32x4*)(Y1S + T + t0 + 4) = (f32x4){y1[4], y1[5], y1[6], y1[7]}; }
        FSYNC();
        fft_fwd3(Z, tid); fft_pass_dkd(Z, (const cf*)(Ksp + FFT_N), tid); FSYNC(); fft_inv3(Z, tid);
#pragma unroll 1
        for (int r = 0; r < 2; ++r) { int tl_ = tid; OPAQUE(tl_); const int t0 = 8 * (tl_ + 512 * r); float g0[8], g1[8]; sc8(b0, t0, wb0, wb1, wb2, bb, g0); sc8(b1, t0, wb0, wb1, wb2, bb, g1);
            const f32x4 p0 = *(const GAS f32x4*)(Y1S + t0), p1 = *(const GAS f32x4*)(Y1S + t0 + 4), q0 = *(const GAS f32x4*)(Y1S + T + t0), q1 = *(const GAS f32x4*)(Y1S + T + t0 + 4);
            float y0[8], y1[8];
#pragma unroll
            for (int i = 0; i < 8; ++i) { const cf cv = Z[fft_pad(t0 + i)]; const float pa = i < 4 ? p0[i & 3] : p1[i & 3], pb = i < 4 ? q0[i & 3] : q1[i & 3];
                y0[i] = g0[i] * (cv.x + pa * d1); y1[i] = g1[i] * (cv.y + pb * d1); }
            v4u w0, w1;
#pragma unroll
            for (int i = 0; i < 4; ++i) { w0[i] = pk2(y0[2 * i], y0[2 * i + 1]); w1[i] = pk2(y1[2 * i], y1[2 * i + 1]); }
            *(GAS v4u*)(YHT + (size_t)c * M + (size_t)(2 * pair) * T + t0) = w0; *(GAS v4u*)(YHT + (size_t)c * M + (size_t)(2 * pair + 1) * T + t0) = w1; }
        FSYNC();
    }
}
__device__ __forceinline__ void p3_transpose(Frame& F) {
    LAS unsigned short* scr = (LAS unsigned short*)(F.lds + RING_OFF + F.wave * 16384);
    const unsigned short* YHT = (const unsigned short*)(F.ws + WS_YHT); unsigned short* YH = (unsigned short*)(F.ws + WS_YH);
    const int gw = F.vcu * NWAVES + F.wave, NGW = F.G * NWAVES, lane = F.lane;
    for (int it = gw; it < (HW / 64) * (M / 64); it += NGW) { const int cb = it & 7, mb = it >> 3, c0 = cb * 64, m0 = mb * 64;
#pragma unroll 8
        for (int r = 0; r < 64; ++r) scr[r * 66 + lane] = YHT[(size_t)(c0 + r) * M + m0 + lane];
        LDS_WAIT(); asm volatile("" ::: "memory");
#pragma unroll 8
        for (int i = 0; i < 64; ++i) YH[(size_t)(m0 + i) * HW + c0 + lane] = scr[lane * 66 + i];
        LDS_WAIT(); asm volatile("" ::: "memory"); }
}
typedef int RouteEnt __attribute__((ext_vector_type(4)));
__device__ __forceinline__ void p6_route(Frame& F) {
    LAS float* W = (LAS float*)(F.lds + RING_OFF);
    LAS int* lcnt = (LAS int*)(F.lds + LX_CNT); LAS int* lbase = lcnt + 32;
    LAS RouteEnt* ent = (LAS RouteEnt*)(F.lds + LX_ENT);
    const float* wrt = (const float*)(F.ws + WS_WRT); const float* g2 = F.in[19]; const float* rb = F.in[21];
    const float* h = F.out; bf16* HN = (bf16*)(F.ws + WS_XN);
    const int tid = F.tid, lane = F.lane;
    for (int i = tid; i < NE * D / 4; i += NWAVES * 64) ((LAS f32x4*)W)[i] = ((const GAS f32x4*)wrt)[i];
    if (tid < 32) lcnt[tid] = 0;
    __syncthreads();
    f32x4 gg[4];
#pragma unroll
    for (int j = 0; j < 4; ++j) gg[j] = ((const GAS f32x4*)g2)[lane + 64 * j];
    const int el = ((lane >> 5) & 1) * 16 + ((lane >> 4) & 1) * 8 + ((lane >> 3) & 1) * 4 + ((lane >> 2) & 1) * 2 + ((lane >> 1) & 1);
    const float rbias = rb[el];
    const int m0 = blockIdx.x * TPB;
    for (int lt = F.wave; lt < TPB; lt += NWAVES) { const int m = m0 + lt;
        const GAS f32x4* xr = (const GAS f32x4*)(h + (size_t)m * D) + lane; f32x4 v[4]; float ss = 0.f;
#pragma unroll
        for (int j = 0; j < 4; ++j) { v[j] = xr[64 * j]; ss += (v[j].x * v[j].x + v[j].y * v[j].y) + (v[j].z * v[j].z + v[j].w * v[j].w); }
        const float rstd = 1.f / sqrtf(wave_sum(ss) * (1.f / D) + EPS);
        GAS unsigned long long* o8 = (GAS unsigned long long*)(HN + (size_t)m * D) + lane;
#pragma unroll
        for (int j = 0; j < 4; ++j) { v[j] = v[j] * rstd * gg[j]; o8[64 * j] = (unsigned long long)pk2(v[j].x, v[j].y) | ((unsigned long long)pk2(v[j].z, v[j].w) << 32); }
        float p[32];
#pragma unroll
        for (int e = 0; e < 32; ++e) { float a = 0.f;
#pragma unroll
            for (int j = 0; j < 4; ++j) { const f32x4 w = *(const LAS f32x4*)(W + e * D + 4 * lane + 256 * j); a += (v[j].x * w.x + v[j].y * w.y) + (v[j].z * w.z + v[j].w * w.w); }
            p[e] = a; }
#pragma unroll
        for (int i = 0; i < 16; ++i) { const bool up = (lane & 32) != 0; const float snd = up ? p[i] : p[i + 16], kp = up ? p[i + 16] : p[i]; p[i] = kp + __shfl_xor(snd, 32); }
#pragma unroll
        for (int i = 0; i < 8; ++i) { const bool up = (lane & 16) != 0; const float snd = up ? p[i] : p[i + 8], kp = up ? p[i + 8] : p[i]; p[i] = kp + __shfl_xor(snd, 16); }
#pragma unroll
        for (int i = 0; i < 4; ++i) { const bool up = (lane & 8) != 0; const float snd = up ? p[i] : p[i + 4], kp = up ? p[i + 4] : p[i]; p[i] = kp + __shfl_xor(snd, 8); }
#pragma unroll
        for (int i = 0; i < 2; ++i) { const bool up = (lane & 4) != 0; const float snd = up ? p[i] : p[i + 2], kp = up ? p[i + 2] : p[i]; p[i] = kp + __shfl_xor(snd, 4); }
        { const bool up = (lane & 2) != 0; const float snd = up ? p[0] : p[1], kp = up ? p[1] : p[0]; p[0] = kp + __shfl_xor(snd, 2); }
        float lg = p[0] + __shfl_xor(p[0], 1) + rbias;
        float tv[4]; int te[4];
#pragma unroll
        for (int k = 0; k < 4; ++k) { float mv = lg; int me = el;
#pragma unroll
            for (int o = 1; o < 64; o <<= 1) { const float ov = __shfl_xor(mv, o); const int oe = __shfl_xor(me, o); if (ov > mv || (ov == mv && oe < me)) { mv = ov; me = oe; } }
            tv[k] = mv; te[k] = me; if (el == me) lg = -INFINITY; }
        const float e1 = __expf(tv[1] - tv[0]), e2 = __expf(tv[2] - tv[0]), e3 = __expf(tv[3] - tv[0]); const float inv = 1.0f / (1.0f + e1 + e2 + e3);
        if (lane < 4) { const int e = lane == 0 ? te[0] : lane == 1 ? te[1] : lane == 2 ? te[2] : te[3]; const float gt = (lane == 0 ? 1.0f : lane == 1 ? e1 : lane == 2 ? e2 : e3) * inv;
            const int lp = atomicAdd((int*)(lcnt + e), 1); ent[lt * 4 + lane] = (RouteEnt){e, lp, (int)__float_as_uint(gt), 0}; }
    }
    __syncthreads();
    if (tid < 32) lbase[tid] = (int)__hip_atomic_fetch_add(F.ctl + CW_CNT + tid, (unsigned)lcnt[tid], __ATOMIC_RELAXED, __HIP_MEMORY_SCOPE_AGENT);
    __syncthreads();
    { RouteEnt en = ent[tid]; en.y += lbase[en.x]; ((GAS RouteEnt*)(F.ws + WS_ENT))[(size_t)m0 * 4 + tid] = en; }
}
__device__ __forceinline__ void build_layout(Frame& F) {
    LAS int* pstart = (LAS int*)(F.lds + LX_CNT) + 64; LAS int* rbe = (LAS int*)(F.lds + LX_RBE); LAS int* gcnt = (LAS int*)(F.lds + LX_RED);
    __syncthreads();
    if (F.tid < 32) gcnt[F.tid] = (int)__hip_atomic_load(F.ctl + CW_CNT + F.tid, __ATOMIC_RELAXED, __HIP_MEMORY_SCOPE_AGENT);
    __syncthreads();
    if (F.tid == 0) { int rb = 0;
        for (int e = 0; e < NE; ++e) { pstart[e] = rb * 256; const int nb = (gcnt[e] + 255) >> 8; for (int b = 0; b < nb && rb < RB_MAX; ++b) rbe[rb++] = e; }
        pstart[NE] = rb * 256; F.MISC[16] = (unsigned)rb; }
    __syncthreads();
}
__device__ __forceinline__ void p7_layout(Frame& F) {
    build_layout(F);
    LAS int* pstart = (LAS int*)(F.lds + LX_CNT) + 64; LAS int* gcnt = (LAS int*)(F.lds + LX_RED);
    const int lane = F.lane;
    const bf16* HN = (const bf16*)(F.ws + WS_XN); bf16* XG = (bf16*)(F.ws + WS_XG);
    int* tokrows = (int*)(F.ws + WS_TOKROWS); float* rowgate = (float*)(F.ws + WS_ROWGATE);
    const int m0 = blockIdx.x * TPB;
    for (int lt = F.wave; lt < TPB; lt += NWAVES) { const int m = m0 + lt;
        const GAS v4u* src = (const GAS v4u*)(HN + (size_t)m * D) + lane; const v4u x0 = src[0], x1 = src[64];
#pragma unroll
        for (int k = 0; k < 4; ++k) { const RouteEnt en = ((const GAS RouteEnt*)(F.ws + WS_ENT))[(size_t)m * 4 + k]; const int row = pstart[en.x] + en.y;
            GAS v4u* dst = (GAS v4u*)(XG + (size_t)row * D) + lane; dst[0] = x0; dst[64] = x1;
            if (lane == 0) { tokrows[m * 4 + k] = row; rowgate[row] = __uint_as_float((unsigned)en.z); } }
    }
    if (blockIdx.x < NE) { const int e = blockIdx.x, r0 = pstart[e] + gcnt[e], r1 = pstart[e + 1];
        for (int row = r0 + F.wave; row < r1; row += NWAVES) { GAS v4u* dst = (GAS v4u*)(XG + (size_t)row * D) + lane; dst[0] = (v4u){0u, 0u, 0u, 0u}; dst[64] = (v4u){0u, 0u, 0u, 0u}; if (lane == 0) rowgate[row] = 0.f; } }
}
__device__ __forceinline__ void p10_combine(Frame& F) {
    const bf16* Y2 = (const bf16*)(F.ws + WS_XG); const int* tokrows = (const int*)(F.ws + WS_TOKROWS); float* out = F.out;
    const int gw = F.vcu * NWAVES + F.wave, NGW = F.G * NWAVES, lane = F.lane;
    for (int m = gw; m < M; m += NGW) { const int r0 = tokrows[m * 4], r1 = tokrows[m * 4 + 1], r2 = tokrows[m * 4 + 2], r3 = tokrows[m * 4 + 3];
#pragma unroll
        for (int j = 0; j < 2; ++j) { const int col = 8 * lane + 512 * j; float* op = out + (size_t)m * D + col;
            f32x4 a = *(const GAS f32x4*)op, b = *(const GAS f32x4*)(op + 4);
            const int rr[4] = {r0, r1, r2, r3};
#pragma unroll
            for (int k = 0; k < 4; ++k) { const v4u w = *(const GAS v4u*)(Y2 + (size_t)rr[k] * D + col);
                a.x += bflo(w.x); a.y += bfhi(w.x); a.z += bflo(w.y); a.w += bfhi(w.y); b.x += bflo(w.z); b.y += bfhi(w.z); b.z += bflo(w.w); b.w += bfhi(w.w); }
            *(GAS f32x4*)op = a; *(GAS f32x4*)(op + 4) = b; } }
}
struct Args { const float* in[26]; float* out; unsigned char* ws; int ph_lo, ph_hi; };
__global__ void __launch_bounds__(NWAVES * 64, 2) hybrid_fwd(Args args) {
    extern __shared__ __attribute__((aligned(16))) unsigned char lds[];
    Frame F;
    F.lds = (LAS unsigned char*)lds;
    F.MISC = (volatile LAS unsigned*)(F.lds + LX_MISC);
    F.tid = threadIdx.x; F.lane = F.tid & 63; F.wave = __builtin_amdgcn_readfirstlane(F.tid >> 6);
    F.G = gridDim.x; { const int bx = blockIdx.x; F.vcu = (F.G % 8 == 0) ? (bx % 8) * (F.G / 8) + bx / 8 : bx; }
    F.ws = args.ws; F.ctl = (gu32*)(args.ws + WS_CTL); F.out = args.out;
#pragma unroll
    for (int i = 0; i < 26; ++i) F.in[i] = args.in[i];
    if (F.tid < 64) F.MISC[F.tid] = 0u;
    __syncthreads();
    XcdBarrier bar; bar.bar = (unsigned*)(F.ctl + CW_BAR); bar.x = 0; bar.st = nullptr;
    if (N_LAUNCHES == 1) bar = xcd_barrier_post((unsigned*)(F.ctl + CW_BAR), F.MISC + 8);
#define GRID_BAR() do { if (N_LAUNCHES == 1) xcd_barrier(bar); } while (0)
    const int lo = args.ph_lo, hi = args.ph_hi;
#ifndef ONLYP
#define ONLYP -1
#endif
#define IN(k) (lo <= (k) && (k) < hi && (ONLYP < 0 || ONLYP == (k)))
    bf16* const XN = (bf16*)(F.ws + WS_XN);

    if (IN(0)) { p0_prologue(F); GRID_BAR(); }

    if (IN(1)) {
        { pg8::Gemm g{(const bf16*)(F.ws + WS_WIN), XN, NHY, M, D}; pg8::StaticOrder S; S.init(NHY, M, F.G, (int)blockIdx.x);
          pg8::EpiBf16<0> E{(bf16*)(F.ws + WS_ZT), M, nullptr, 0, 0, 1.f};
          pg8::gemm_phase<pg8::EpiBf16<0>, pg8::StaticOrder, true, true>(F.lds + RING_OFF, g, S, E); }
        { pg8::Gemm g{XN, (const bf16*)(F.ws + WS_WIN) + (size_t)NHY * D, M, NREST, D}; pg8::StaticOrder S; S.init(M, NREST, F.G, (int)blockIdx.x);
          pg8::EpiBf16<0> E{(bf16*)(F.ws + WS_PR), NREST, nullptr, 0, 0, 1.f};
          pg8::gemm_phase<pg8::EpiBf16<0>, pg8::StaticOrder, true, true>(F.lds + RING_OFF, g, S, E); }
        GRID_BAR();
    }

    if (IN(2)) {
        p2_qkprep(F);
        for (int c = F.vcu; c < HW; c += F.G) hyena_channel(F, c);
        GRID_BAR();
    }

    if (IN(3)) {
        p3_transpose(F);
        __syncthreads();
        static_assert(attn_body::ATTN_LDS_BYTES <= RING_BYTES, "attention LDS");
        const attn_body::AttnTensors AT{(const attn_body::bf16*)(F.ws + WS_QO), (const attn_body::bf16*)(F.ws + WS_KB), (const attn_body::bf16*)(F.ws + WS_VB), (attn_body::bf16*)(F.ws + WS_QO)};
        const attn_body::StaticOrder S((int)F.G, F.vcu);
        attn_body::attn_phase<attn_body::StaticOrder>((char*)lds + RING_OFF, AT, S);
        GRID_BAR();
    }

    if (IN(4)) {
        const bf16* PR = (const bf16*)(F.ws + WS_PR); bf16* MG = (bf16*)(F.ws + WS_MG);
        { pg8::Gemm g{(const bf16*)(F.ws + WS_YH), (const bf16*)(F.ws + WS_WHU), M, D, 512}; pg8::StaticOrder S; S.init(M, D, F.G, (int)blockIdx.x);
          pg8::EpiGate<0> E{MG, D, PR + PR_GH, NREST};
          pg8::gemm_phase<pg8::EpiGate<0>, pg8::StaticOrder, true, true>(F.lds + RING_OFF, g, S, E); }
        { pg8::Gemm g{(const bf16*)(F.ws + WS_QO), (const bf16*)(F.ws + WS_WAU), M, D, 512}; pg8::StaticOrder S; S.init(M, D, F.G, (int)blockIdx.x);
          pg8::EpiGate<1> E{MG, D, PR + PR_GA, NREST};
          pg8::gemm_phase<pg8::EpiGate<1>, pg8::StaticOrder, true, true>(F.lds + RING_OFF, g, S, E); }
        GRID_BAR();
    }

    if (IN(5)) {
        pg8::Gemm g{(const bf16*)(F.ws + WS_MG), (const bf16*)(F.ws + WS_WOUT), M, D, D}; pg8::StaticOrder S; S.init(M, D, F.G, (int)blockIdx.x);
        pg8::EpiResF32 E{F.in[0], F.out, D};
        pg8::gemm_phase<pg8::EpiResF32, pg8::StaticOrder, true, true>(F.lds + RING_OFF, g, S, E);
        GRID_BAR();
    }

    if (IN(6)) { p6_route(F); GRID_BAR(); }
    if (IN(7)) { p7_layout(F); GRID_BAR(); }

    if (IN(8)) {
        build_layout(F); const int nrb = (int)F.MISC[16];
        pg8::Gemm g{(const bf16*)(F.ws + WS_XG), (const bf16*)(F.ws + WS_W1), nrb * 256, 2 * FF, D}; pg8::MoeOrder S; S.init(nrb, 8, F.G, (int)blockIdx.x, (const LAS int*)(F.lds + LX_RBE));
        pg8::EpiSwiglu E{(bf16*)(F.ws + WS_H1), F.in[23]};
        pg8::gemm_phase<pg8::EpiSwiglu, pg8::MoeOrder, true, true>(F.lds + RING_OFF, g, S, E);
        GRID_BAR();
    }
    if (IN(9)) {
        build_layout(F); const int nrb = (int)F.MISC[16];
        pg8::Gemm g{(const bf16*)(F.ws + WS_H1), (const bf16*)(F.ws + WS_W2), nrb * 256, D, FF}; pg8::MoeOrder S; S.init(nrb, 4, F.G, (int)blockIdx.x, (const LAS int*)(F.lds + LX_RBE));
        pg8::EpiMoe2 E{(bf16*)(F.ws + WS_XG), F.in[25], (const float*)(F.ws + WS_ROWGATE)};
        pg8::gemm_phase<pg8::EpiMoe2, pg8::MoeOrder, true, true>(F.lds + RING_OFF, g, S, E);
        GRID_BAR();
    }
    if (IN(10)) p10_combine(F);
#undef IN
}

extern "C" void kernel_launch(void* const* d_in, const int* in_sizes, int n_in, void* d_out, int out_size, void* d_ws, size_t ws_size, hipStream_t stream) {
    static int grid = 0;
    if (grid == 0) {
        if (n_in != 26 || in_sizes[0] != M * D || out_size != M * D || ws_size < WS_END) { fprintf(stderr, "kernel_launch: unexpected shapes (n_in %d, in0 %d, out %d, ws %zu); nothing launched\n", n_in, n_in > 0 ? in_sizes[0] : -1, out_size, ws_size); grid = -1; return; }
        int dev = 0, cus = 0, per_cu = 0;
        if (hipGetDevice(&dev) != hipSuccess || hipDeviceGetAttribute(&cus, hipDeviceAttributeMultiprocessorCount, dev) != hipSuccess) { grid = -1; return; }
        if (hipFuncSetAttribute((const void*)hybrid_fwd, hipFuncAttributeMaxDynamicSharedMemorySize, LDS_BYTES) != hipSuccess) { fprintf(stderr, "kernel_launch: hipFuncSetAttribute failed\n"); grid = -1; return; }
        if (hipOccupancyMaxActiveBlocksPerMultiprocessor(&per_cu, (const void*)hybrid_fwd, NWAVES * 64, LDS_BYTES) != hipSuccess || per_cu < 1) fprintf(stderr, "kernel_launch: occupancy query reports %d\n", per_cu);
        (void)hipGetLastError();
        grid = cus;
        if (grid != 256) { fprintf(stderr, "kernel_launch: built for 256 CUs, device has %d\n", grid); grid = -1; return; }
    }
    if (grid < 0) return;
    if (hipMemsetAsync((char*)d_ws + WS_CTL, 0, CTL_ZERO_BYTES, stream) != hipSuccess) return;
    Args a{};
    for (int i = 0; i < 26; ++i) a.in[i] = (const float*)d_in[i];
    a.out = (float*)d_out; a.ws = (unsigned char*)d_ws;
    if (N_LAUNCHES == 1) { a.ph_lo = 0; a.ph_hi = N_PHASES; hipLaunchKernelGGL(hybrid_fwd, dim3(grid), dim3(NWAVES * 64), LDS_BYTES, stream, a); }
    else for (int p = 0; p < N_PHASES; ++p) { a.ph_lo = p; a.ph_hi = p + 1; hipLaunchKernelGGL(hybrid_fwd, dim3(grid), dim3(NWAVES * 64), LDS_BYTES, stream, a); }
}
```

```cpp
#include <hip/hip_runtime.h>
#include <cstdio>
#include <cstdint>
namespace pg8 {
#define PG8_LAS __attribute__((address_space(3)))
typedef unsigned short bf16_t;
typedef short bf16x8 __attribute__((ext_vector_type(8)));
typedef float f32x4 __attribute__((ext_vector_type(4)));
typedef unsigned u32x4 __attribute__((ext_vector_type(4)));
typedef int i32x4 __attribute__((ext_vector_type(4)));
constexpr int BM = 256, BK = 64, HALF = 128, HTB = HALF * BK * 2  , STAGE_BYTES = 8 * HTB, NXCD = 8, WGM = 8;

__host__ __device__ __forceinline__ int lds_byte(int r, int c) { const int st = (r >> 4) * 2 + (c >> 5), rr = r & 15, cc = c & 31, ob = rr * 64 + cc * 2; return st * 1024 + (ob ^ (((ob >> 9) & 1) << 5)); }
__host__ __device__ __forceinline__ void stage_rc(int b, int& R, int& C) { const int st = b / 1024, sb = b % 1024, swz = sb ^ (((sb >> 9) & 1) << 5); R = (st >> 1) * 16 + swz / 64; C = (st & 1) * 32 + (swz % 64) / 2; }
__host__ __device__ __forceinline__ int perm32(int rho) { const int n = rho >> 4, i = rho & 15; return 8 * (i >> 2) + 4 * n + (i & 3); }

struct Unit { int pm, pn, pb, sel; };
struct Gemm { const bf16_t* A; const bf16_t* Bt; int M, N, K; const PG8_LAS unsigned short* lidx; const bf16_t* A2; const bf16_t* Bt2; };

struct StaticOrder {
    int nM, nN, nwg, G, c;
    __host__ __device__ void init(int M, int N, int G_, int c_) { nM = M / BM; nN = N / BM; nwg = nM * nN; G = G_; c = c_; }
    __host__ __device__ bool next(int i, Unit& u) const {
        const long L = (long)i * G + c; if (L >= nwg) return false;
        int wgid = (int)L; { const int q = nwg / NXCD, r = nwg % NXCD, xcd = wgid % NXCD, off = wgid / NXCD; wgid = (xcd < r ? xcd * (q + 1) : r * (q + 1) + (xcd - r) * q) + off; }
        const int nig = WGM * nN, gid = wgid / nig, fm = gid * WGM, gsz = (nM - fm) < WGM ? (nM - fm) : WGM;
        u.pm = fm + ((wgid % nig) % gsz); u.pn = (wgid % nig) / gsz; u.pb = u.pn; u.sel = 0; return true;
    }
    __device__ __forceinline__ void a_ready(const Unit&) const {}
    __device__ __forceinline__ void done(const Unit&) const {}
};

__device__ __forceinline__ unsigned cvt_pk_bf16(float lo, float hi) { unsigned r; asm volatile("v_cvt_pk_bf16_f32 %0, %1, %2" : "=v"(r) : "v"(lo), "v"(hi)); return r; }
typedef float f32x2 __attribute__((ext_vector_type(2)));
template <int ACT  > struct EpiBf16 {
    static constexpr bool PERM = true, AFTER_DRAIN = false, CHAIN = false; static_assert(ACT == 0, "EpiBf16: ACT is 0 (none)");
    struct Pre {}; __device__ __forceinline__ Pre pre(const Unit&, int, int, int, int) const { return Pre{}; }
    bf16_t* O; int ldc; const float* bias; int split_cols; size_t split_stride; float scale0;
    __device__ __forceinline__ void operator()(const f32x4 (&acc)[2][2][4][2], const Unit& u, int wr, int wc, int fr, int fq, const Pre&) const {
        const int row0 = u.pm * BM + wr * 64 + fr; int colt = u.pn * BM; bf16_t* base = O;
        float sc = 1.f; if (split_cols) { const int t = colt / split_cols; base += (size_t)t * split_stride; colt -= t * split_cols; if (t == 0) sc = scale0; }
        const int col0 = colt + wc * 32 + 8 * fq, bcol0 = u.pn * BM + wc * 32 + 8 * fq;
        f32x4 bv[2][2];
#pragma unroll
        for (int bj = 0; bj < 2; ++bj)
#pragma unroll
            for (int n = 0; n < 2; ++n) bv[bj][n] = bias ? *(const f32x4*)(bias + bcol0 + bj * HALF + 4 * n) : (f32x4){0.f, 0.f, 0.f, 0.f};
#pragma unroll
        for (int ai = 0; ai < 2; ++ai)
#pragma unroll
            for (int m = 0; m < 4; ++m) { bf16_t* rowp = base + (size_t)(row0 + ai * HALF + m * 16) * ldc + col0;
#pragma unroll
                for (int bj = 0; bj < 2; ++bj) { f32x4 v0 = acc[ai][bj][m][0] + bv[bj][0], v1 = acc[ai][bj][m][1] + bv[bj][1];
                    v0 = v0 * sc; v1 = v1 * sc; u32x4 w; w.x = cvt_pk_bf16(v0[0], v0[1]); w.y = cvt_pk_bf16(v0[2], v0[3]); w.z = cvt_pk_bf16(v1[0], v1[1]); w.w = cvt_pk_bf16(v1[2], v1[3]);
                    *(u32x4*)(rowp + bj * HALF) = w; } }
    }
};
struct EpiBf16Plain {
    static constexpr bool PERM = true, AFTER_DRAIN = false, CHAIN = false;
    struct Pre {}; __device__ __forceinline__ Pre pre(const Unit&, int, int, int, int) const { return Pre{}; }
    bf16_t* O; int ldc;
    __device__ __forceinline__ void operator()(const f32x4 (&acc)[2][2][4][2], const Unit& u, int wr, int wc, int fr, int fq, const Pre&) const {
        const int row0 = u.pm * BM + wr * 64 + fr, col0 = u.pn * BM + wc * 32 + 8 * fq;
#pragma unroll
        for (int ai = 0; ai < 2; ++ai)
#pragma unroll
            for (int m = 0; m < 4; ++m) { bf16_t* rowp = O + (size_t)(row0 + ai * HALF + m * 16) * ldc + col0;
#pragma unroll
                for (int bj = 0; bj < 2; ++bj) { const f32x4 v0 = acc[ai][bj][m][0], v1 = acc[ai][bj][m][1];
                    u32x4 w; w.x = cvt_pk_bf16(v0[0], v0[1]); w.y = cvt_pk_bf16(v0[2], v0[3]); w.z = cvt_pk_bf16(v1[0], v1[1]); w.w = cvt_pk_bf16(v1[2], v1[3]);
                    *(u32x4*)(rowp + bj * HALF) = w; } }
    }
};
__device__ __forceinline__ float bf_lo(unsigned w) { return __uint_as_float(w << 16); }
__device__ __forceinline__ float bf_hi(unsigned w) { return __uint_as_float(w & 0xffff0000u); }
__device__ __forceinline__ float sigmoid_f(float x) { return __builtin_amdgcn_rcpf(1.f + __builtin_amdgcn_exp2f(-1.4426950408889634f * x)); }
struct MoeOrder {
    int nM, nN, nwg, G, c; const PG8_LAS int* rbe;
    __device__ void init(int nM_, int nN_, int G_, int c_, const PG8_LAS int* rbe_) { nM = nM_; nN = nN_; nwg = nM * nN; G = G_; c = c_; rbe = rbe_; dup = 0; }
    int dup;
    __device__ bool next(int i, Unit& u) const {
        const long L = (long)(i >> dup) * G + c; if (L >= nwg) return false;
        int wgid = (int)L; { const int q = nwg / NXCD, r = nwg % NXCD, xcd = wgid % NXCD, off = wgid / NXCD; wgid = (xcd < r ? xcd * (q + 1) : r * (q + 1) + (xcd - r) * q) + off; }
        const int nig = WGM * nN, gid = wgid / nig, fm = gid * WGM, gsz = (nM - fm) < WGM ? (nM - fm) : WGM;
        u.pm = fm + ((wgid % nig) % gsz); u.pn = (wgid % nig) / gsz; u.pb = rbe[u.pm] * nN + u.pn; u.sel = dup ? (i & 1) : 0; return true;
    }
    __device__ __forceinline__ void a_ready(const Unit&) const {}
    __device__ __forceinline__ void done(const Unit&) const {}
};
template <int PASS> struct EpiGate {
    static constexpr bool PERM = true, AFTER_DRAIN = false, CHAIN = false;
    struct Pre {}; __device__ __forceinline__ Pre pre(const Unit&, int, int, int, int) const { return Pre{}; }
    bf16_t* O; int ldc; const bf16_t* G; int ldg;
    __device__ __forceinline__ void operator()(const f32x4 (&acc)[2][2][4][2], const Unit& u, int wr, int wc, int fr, int fq, const Pre&) const {
        const int row0 = u.pm * BM + wr * 64 + fr, col0 = u.pn * BM + wc * 32 + 8 * fq;
#pragma unroll
        for (int ai = 0; ai < 2; ++ai)
#pragma unroll
            for (int m = 0; m < 4; ++m) { const size_t row = (size_t)(row0 + ai * HALF + m * 16);
#pragma unroll
                for (int bj = 0; bj < 2; ++bj) { const int col = col0 + bj * HALF;
                    const u32x4 gw = *(const u32x4*)(G + row * ldg + col);
                    float v[8];
#pragma unroll
                    for (int i = 0; i < 4; ++i) { v[2 * i] = sigmoid_f(bf_lo(gw[i])) * acc[ai][bj][m][i >> 1][(2 * i) & 3]; v[2 * i + 1] = sigmoid_f(bf_hi(gw[i])) * acc[ai][bj][m][i >> 1][(2 * i + 1) & 3]; }
                    bf16_t* op = O + row * ldc + col;
                    if (PASS == 1) { const u32x4 tw = *(const u32x4*)op;
#pragma unroll
                        for (int i = 0; i < 4; ++i) { v[2 * i] += bf_lo(tw[i]); v[2 * i + 1] += bf_hi(tw[i]); } }
                    u32x4 w; w.x = cvt_pk_bf16(v[0], v[1]); w.y = cvt_pk_bf16(v[2], v[3]); w.z = cvt_pk_bf16(v[4], v[5]); w.w = cvt_pk_bf16(v[6], v[7]);
                    *(u32x4*)op = w; } }
    }
};
struct EpiResF32 {
    static constexpr bool PERM = false, AFTER_DRAIN = false, CHAIN = false;
    struct Pre {}; __device__ __forceinline__ Pre pre(const Unit&, int, int, int, int) const { return Pre{}; }
    const float* X; float* out; int ldc;
    __device__ __forceinline__ void operator()(const f32x4 (&acc)[2][2][4][2], const Unit& u, int wr, int wc, int fr, int fq, const Pre&) const {
        const int row0 = u.pm * BM + wr * 64 + fr, col0 = u.pn * BM + wc * 32 + 4 * fq;
#pragma unroll
        for (int ai = 0; ai < 2; ++ai)
#pragma unroll
            for (int m = 0; m < 4; ++m) { const size_t off = (size_t)(row0 + ai * HALF + m * 16) * ldc + col0;
#pragma unroll
                for (int bj = 0; bj < 2; ++bj)
#pragma unroll
                    for (int n = 0; n < 2; ++n) { const f32x4 xv = *(const f32x4*)(X + off + bj * HALF + n * 16); *(f32x4*)(out + off + bj * HALF + n * 16) = xv + acc[ai][bj][m][n]; } }
    }
};
struct EpiResBf16 {
    static constexpr bool PERM = true, AFTER_DRAIN = false, CHAIN = false;
    struct Pre {}; __device__ __forceinline__ Pre pre(const Unit&, int, int, int, int) const { return Pre{}; }
    const float* X; bf16_t* out; int ldc;
    __device__ __forceinline__ void operator()(const f32x4 (&acc)[2][2][4][2], const Unit& u, int wr, int wc, int fr, int fq, const Pre&) const {
        const int row0 = u.pm * BM + wr * 64 + fr, col0 = u.pn * BM + wc * 32 + 8 * fq;
#pragma unroll
        for (int ai = 0; ai < 2; ++ai)
#pragma unroll
            for (int m = 0; m < 4; ++m) { const size_t off = (size_t)(row0 + ai * HALF + m * 16) * ldc + col0;
#pragma unroll
                for (int bj = 0; bj < 2; ++bj) { const f32x4 v0 = *(const f32x4*)(X + off + bj * HALF) + acc[ai][bj][m][0], v1 = *(const f32x4*)(X + off + bj * HALF + 4) + acc[ai][bj][m][1];
                    u32x4 w; w.x = cvt_pk_bf16(v0[0], v0[1]); w.y = cvt_pk_bf16(v0[2], v0[3]); w.z = cvt_pk_bf16(v1[0], v1[1]); w.w = cvt_pk_bf16(v1[2], v1[3]);
                    *(u32x4*)(out + off + bj * HALF) = w; } }
    }
};
typedef unsigned u32x2 __attribute__((ext_vector_type(2)));
__device__ __forceinline__ unsigned pack4_fp8(float a, float b, float c, float d) { int w = 0; w = __builtin_amdgcn_cvt_pk_fp8_f32(a, b, w, false); w = __builtin_amdgcn_cvt_pk_fp8_f32(c, d, w, true); return (unsigned)w; }
__device__ __forceinline__ float clamp8(float x) { return __builtin_amdgcn_fmed3f(x, -448.0f, 448.0f); }
struct EpiSwiglu {
    static constexpr bool PERM = true, AFTER_DRAIN = false, CHAIN = false, C0START = true;
    bf16_t* H; const float* b1; float ascale, hscale;
    struct Pre { f32x4 t[4]; };
    __device__ __forceinline__ Pre pre(const Unit& u, int wr, int wc, int fr, int fq) const {
        const int e = u.pb >> 3, j0 = u.pn * HALF + wc * 32 + 8 * fq; const float* bp = b1 + (size_t)e * 2048 + 2 * j0; Pre p;
#pragma unroll
        for (int i = 0; i < 4; ++i) p.t[i] = *(const f32x4*)(bp + 4 * i);
        return p; }
    __device__ __forceinline__ void operator()(const f32x4 (&acc)[2][2][4][2], const Unit& u, int wr, int wc, int fr, int fq, const Pre& pr) const {
#if defined(PROBE_EPI) && PROBE_EPI == 1
        if (u.sel) {
#pragma unroll
            for (int ai = 0; ai < 2; ++ai)
#pragma unroll
                for (int bj = 0; bj < 2; ++bj)
#pragma unroll
                    for (int m = 0; m < 4; ++m) { asm volatile("" :: "v"(acc[ai][bj][m][0]), "v"(acc[ai][bj][m][1])); }
            return; }
#endif
        const int row0 = u.pm * BM + wr * 64 + fr, j0 = u.pn * HALF + wc * 32 + 8 * fq;
        typedef float f32x2 __attribute__((ext_vector_type(2)));
        f32x2 bg[4], bl[4];
#pragma unroll
        for (int i = 0; i < 4; ++i) { const f32x4 t = pr.t[i]; bg[i] = (f32x2){t[0], t[2]}; bl[i] = (f32x2){t[1], t[3]}; }
        const f32x2 as2 = {ascale, ascale}, hs2 = {hscale, hscale}, one2 = {1.0f, 1.0f};
        const f32x2 c1 = {-1.702f * 1.4426950408889634f * 8388608.0f, -1.702f * 1.4426950408889634f * 8388608.0f}, c0 = {1064986823.0f, 1064986823.0f};
#pragma unroll
        for (int ai = 0; ai < 2; ++ai)
#pragma unroll
            for (int mp = 0; mp < 2; ++mp) { u32x2 wm[2];
#pragma unroll
                for (int mi = 0; mi < 2; ++mi) { const int m = 2 * mp + mi; f32x2 o[4];
#pragma unroll
                for (int i = 0; i < 4; ++i) { const f32x4 ag = acc[ai][0][m][i >> 1], al = acc[ai][1][m][i >> 1];
                    f32x2 g = (i & 1) ? (f32x2){ag[2], ag[3]} : (f32x2){ag[0], ag[1]}, l = (i & 1) ? (f32x2){al[2], al[3]} : (f32x2){al[0], al[1]};
                    g = g * as2 + bg[i]; l = l * as2 + bl[i];
                    g[0] = __builtin_amdgcn_fmed3f(g[0], -30.0f, 7.0f); g[1] = __builtin_amdgcn_fmed3f(g[1], -30.0f, 7.0f);
                    l[0] = __builtin_amdgcn_fmed3f(l[0], -7.0f, 7.0f); l[1] = __builtin_amdgcn_fmed3f(l[1], -7.0f, 7.0f);
                    const f32x2 ex = g * c1 + c0; f32x2 e2; e2[0] = __int_as_float((int)ex[0]); e2[1] = __int_as_float((int)ex[1]);
                    const f32x2 den = e2 + one2; f32x2 r0; r0[0] = __int_as_float(0x7EF311C7 - __float_as_int(den[0])); r0[1] = __int_as_float(0x7EF311C7 - __float_as_int(den[1]));
                    const f32x2 r = r0 * ((f32x2){2.0f, 2.0f} - den * r0);
                    o[i] = (g * r) * (l * hs2 + hs2); }
                    wm[mi].x = pack4_fp8(o[0][0], o[0][1], o[1][0], o[1][1]); wm[mi].y = pack4_fp8(o[2][0], o[2][1], o[3][0], o[3][1]); }
                const auto s0 = __builtin_amdgcn_permlane16_swap(wm[0].x, wm[1].x, false, false), s1 = __builtin_amdgcn_permlane16_swap(wm[0].y, wm[1].y, false, false);
                u32x4 w; w.x = s0[0]; w.y = s1[0]; w.z = s0[1]; w.w = s1[1];
                const size_t row = (size_t)(row0 + ai * HALF + (2 * mp + (fq & 1)) * 16);
                *(u32x4*)((unsigned char*)H + row * 1024 + (j0 - 8 * (fq & 1))) = w; }
    }
};
struct EpiMoe2 {
    static constexpr bool PERM = true, AFTER_DRAIN = false, CHAIN = false; static constexpr int PERM2 = 2;
    bf16_t* Y; const float* b2; const float* gate; int nostore; float ascale, yscale;
    struct Pre { f32x4 bv[4]; float gt[2][4]; };
    __device__ __forceinline__ Pre pre(const Unit& u, int wr, int wc, int fr, int fq) const {
        const int row0 = u.pm * BM + wr * 64 + fr, e = u.pb >> 2, col0 = u.pn * BM + wc * 64 + 16 * fq; Pre p;
#pragma unroll
        for (int q = 0; q < 4; ++q) p.bv[q] = *(const f32x4*)(b2 + (size_t)e * 1024 + col0 + 4 * q);
#pragma unroll
        for (int ai = 0; ai < 2; ++ai)
#pragma unroll
            for (int m = 0; m < 4; ++m) p.gt[ai][m] = gate[row0 + ai * HALF + m * 16];
        return p; }
    __device__ __forceinline__ void operator()(const f32x4 (&acc)[2][2][4][2], const Unit& u, int wr, int wc, int fr, int fq, const Pre& pr) const {
#if defined(PROBE_EPI) && PROBE_EPI == 1
        if (u.sel) {
#pragma unroll
            for (int ai = 0; ai < 2; ++ai)
#pragma unroll
                for (int bj = 0; bj < 2; ++bj)
#pragma unroll
                    for (int m = 0; m < 4; ++m) { asm volatile("" :: "v"(acc[ai][bj][m][0]), "v"(acc[ai][bj][m][1])); }
            return; }
#endif
        const int row0 = u.pm * BM + wr * 64 + fr, col0 = u.pn * BM + wc * 64 + 16 * fq;
#pragma unroll
        for (int ai = 0; ai < 2; ++ai)
#pragma unroll
            for (int m = 0; m < 4; ++m) { const size_t row = (size_t)(row0 + ai * HALF + m * 16); const float gs = pr.gt[ai][m] * yscale, a2 = ascale * gs; u32x4 w;
#pragma unroll
                for (int q = 0; q < 4; ++q) { const f32x4 v = acc[ai][q >> 1][m][q & 1] * a2 + pr.bv[q] * gs;
                    w[q] = pack4_fp8(clamp8(v[0]), clamp8(v[1]), clamp8(v[2]), clamp8(v[3])); }
#if defined(PROBE_EPI) && PROBE_EPI == 2
                if (u.sel) { asm volatile("" :: "v"(w)); continue; }
#endif
                if (!nostore) *(u32x4*)((unsigned char*)Y + row * 1024 + col0) = w; else asm volatile("" :: "v"(w)); }
    }
};
struct ChainOrder {
    StaticOrder base;
    __device__ bool next(int i, Unit& u) const { if (!base.next(i >> 1, u)) return false; u.sel = i & 1; return true; }
    __device__ __forceinline__ void a_ready(const Unit&) const {}
    __device__ __forceinline__ void done(const Unit&) const {}
};
struct EpiGateChain {
    static constexpr bool PERM = true, AFTER_DRAIN = false, CHAIN = true;
    struct Pre {}; __device__ __forceinline__ Pre pre(const Unit&, int, int, int, int) const { return Pre{}; }
    bf16_t* O; int ldc; const bf16_t* GH; const bf16_t* GA; int ldg;
    __device__ __forceinline__ static float eneg(float x) { return __builtin_amdgcn_exp2f(-1.4426950408889634f * fminf(fmaxf(x, -30.f), 30.f)); }
    typedef float f32x2g __attribute__((ext_vector_type(2)));
    __device__ __forceinline__ static f32x2g en2(unsigned w) {
        f32x2g x = {__builtin_amdgcn_fmed3f(bf_lo(w), -30.f, 30.f), __builtin_amdgcn_fmed3f(bf_hi(w), -30.f, 30.f)};
        x = x * (f32x2g){-1.4426950408889634f, -1.4426950408889634f};
        return (f32x2g){__builtin_amdgcn_exp2f(x[0]), __builtin_amdgcn_exp2f(x[1])}; }
    __device__ __forceinline__ void mid(f32x4 (&acc)[2][2][4][2], const Unit& u, int wr, int wc, int fr, int fq) const {
        const int row0 = u.pm * BM + wr * 64 + fr, col0 = u.pn * BM + wc * 32 + 8 * fq; const f32x2g one2 = {1.f, 1.f};
#pragma unroll
        for (int ai = 0; ai < 2; ++ai)
#pragma unroll
            for (int m = 0; m < 4; ++m) { const size_t row = (size_t)(row0 + ai * HALF + m * 16);
#pragma unroll
                for (int bj = 0; bj < 2; ++bj) { const int col = col0 + bj * HALF;
                    const u32x4 hw = *(const u32x4*)(GH + row * ldg + col), aw = *(const u32x4*)(GA + row * ldg + col);
#pragma unroll
                    for (int i = 0; i < 4; ++i) { const f32x2g na = en2(aw[i]) + one2, nh = en2(hw[i]) + one2;
                        const f32x2g r = na * (f32x2g){__builtin_amdgcn_rcpf(nh[0]), __builtin_amdgcn_rcpf(nh[1])};
                        acc[ai][bj][m][i >> 1][(2 * i) & 3] *= r[0]; acc[ai][bj][m][i >> 1][(2 * i + 1) & 3] *= r[1]; } } }
    }
    __device__ __forceinline__ void operator()(const f32x4 (&acc)[2][2][4][2], const Unit& u, int wr, int wc, int fr, int fq, const Pre&) const {
        const int row0 = u.pm * BM + wr * 64 + fr, col0 = u.pn * BM + wc * 32 + 8 * fq; const f32x2g one2 = {1.f, 1.f};
#pragma unroll
        for (int ai = 0; ai < 2; ++ai)
#pragma unroll
            for (int m = 0; m < 4; ++m) { const size_t row = (size_t)(row0 + ai * HALF + m * 16);
#pragma unroll
                for (int bj = 0; bj < 2; ++bj) { const int col = col0 + bj * HALF;
                    const u32x4 aw = *(const u32x4*)(GA + row * ldg + col); float v[8];
#pragma unroll
                    for (int i = 0; i < 4; ++i) { const f32x2g na = en2(aw[i]) + one2;
                        v[2 * i] = acc[ai][bj][m][i >> 1][(2 * i) & 3] * __builtin_amdgcn_rcpf(na[0]); v[2 * i + 1] = acc[ai][bj][m][i >> 1][(2 * i + 1) & 3] * __builtin_amdgcn_rcpf(na[1]); }
                    u32x4 w; w.x = cvt_pk_bf16(v[0], v[1]); w.y = cvt_pk_bf16(v[2], v[3]); w.z = cvt_pk_bf16(v[4], v[5]); w.w = cvt_pk_bf16(v[6], v[7]);
                    *(u32x4*)(O + row * ldc + col) = w; } }
    }
};
template <class E, class = void> struct C0Of { static constexpr bool v = false; };
template <class E> struct C0Of<E, decltype((void)E::C0START)> { static constexpr bool v = E::C0START; };
template <class E, class = void> struct Perm2Of { static constexpr int v = 0; };
template <class E> struct Perm2Of<E, decltype((void)E::PERM2)> { static constexpr int v = (int)E::PERM2; };
template <class Epi, class Sched, bool ALIGN_EPI = false, bool SP2 = false, bool GATHER = false, bool FP8 = false, bool ATILE = false>
__device__ __forceinline__ void gemm_phase(PG8_LAS unsigned char* lds, const Gemm g, const Sched& S, const Epi& E) {
    const int tid = threadIdx.x, wid = __builtin_amdgcn_readfirstlane(tid >> 6), lane = tid & 63, wr = wid >> 2, wc = wid & 3, fr = lane & 15, fq = lane >> 4;
    const int K = g.K, nt = K / BK;
    constexpr int PERM2 = Perm2Of<Epi>::v;
    unsigned voffA[2], voffB[2], voffB1[2];
#pragma unroll
    for (int i = 0; i < 2; ++i) { int R, C; stage_rc(tid * 16 + i * 8192, R, C); const int Rb = Epi::PERM ? ((R & ~31) + perm32(R & 31)) : R;
        const int R2 = (R >> 5) * 64 + ((R >> 2) & 3) * (PERM2 == 3 ? 8 : 16) + ((R >> 4) & 1) * 4 + (R & 3);
        voffA[i] = ATILE ? (unsigned)((R >> 2) * 4096 + (R & 3) * 32 + ((2 * C) >> 5) * 128 + ((2 * C) & 31)) : (unsigned)(R * K + C) * 2u; voffB[i] = (unsigned)((PERM2 ? R2 : Rb) * K + C) * 2u; voffB1[i] = (unsigned)((R2 + (PERM2 == 3 ? 32 : 8)) * K + C) * 2u; }
    unsigned goffC[2][2] = {{0u, 0u}, {0u, 0u}}, goffN[2][2] = {{0u, 0u}, {0u, 0u}}; int gR[2], gC[2];
#pragma unroll
    for (int i = 0; i < 2; ++i) stage_rc(tid * 16 + i * 8192, gR[i], gC[i]);
    const size_t kstep = (size_t)(BK * 2);
    const size_t kstepA = ATILE ? (size_t)(BK * 2) * 4 : kstep;
    static_assert(!ATILE || !GATHER, "ATILE: dense A only");
    const size_t hstep = (size_t)HALF * K * 2;
    const size_t tstep = 2 * hstep;
    const unsigned ldsw = (unsigned)wid * 1024u;
    const int aoff = FP8 ? lds_byte(wr * 64 + fr, 16 * (fq & 1)) + (fq >> 1) * 1024 : lds_byte(wr * 64 + fr, fq * 8), boff = FP8 ? lds_byte(wc * 32 + fr, 16 * (fq & 1)) + (fq >> 1) * 1024 : lds_byte(wc * 32 + fr, fq * 8);

#define PG8_SA(b, h) (((b) * 2 + (h)) * HTB)
#define PG8_SB(b, h) ((4 + (b) * 2 + (h)) * HTB)
#define PG8_STAGE(bufoff, gbase, voff) do { _Pragma("unroll") for (int _i = 0; _i < 2; ++_i) \
        __builtin_amdgcn_global_load_lds((const unsigned*)((const char*)(gbase) + (voff)[_i]), (PG8_LAS unsigned*)(lds + (bufoff) + ldsw + _i * 8192), 16, 0, 0); } while (0)
#define PG8_STAGE_B(bufoff, gbase, h) do { if constexpr (PERM2) { if (h) PG8_STAGE(bufoff, gbase, voffB1); else PG8_STAGE(bufoff, gbase, voffB); } else PG8_STAGE(bufoff, (gbase) + ((h) ? hstep : 0), voffB); } while (0)
#define PG8_GOFF(dst, u_) do { if constexpr (GATHER) { _Pragma("unroll") for (int h_ = 0; h_ < 2; ++h_) _Pragma("unroll") for (int i_ = 0; i_ < 2; ++i_) \
        dst[h_][i_] = ((unsigned)g.lidx[(u_) * BM + h_ * HALF + gR[i_]] * (unsigned)K + (unsigned)gC[i_]) * 2u; } } while (0)
#define PG8_STAGE_A(bufoff, gbase, h, nx) do { if constexpr (GATHER) { unsigned vo_[2] = { (nx) ? goffN[h][0] : goffC[h][0], (nx) ? goffN[h][1] : goffC[h][1] }; PG8_STAGE(bufoff, gbase, vo_); } \
        else { PG8_STAGE(bufoff, (gbase) + ((h) ? hstep : 0), voffA); } } while (0)
#define PG8_LDA(dst, b, h) do { _Pragma("unroll") for (int m = 0; m < 4; ++m) _Pragma("unroll") for (int k = 0; k < 2; ++k) { if constexpr (FP8) { if (k == 0) dst##8[m] = PG8_CAT2(*(const PG8_LAS i32x4*)(lds + PG8_SA(b, h) + aoff + m * 2048), *(const PG8_LAS i32x4*)(lds + PG8_SA(b, h) + aoff + m * 2048 + 16)); } else dst[m][k] = *(const PG8_LAS bf16x8*)(lds + PG8_SA(b, h) + aoff + m * 2048 + k * 1024); } } while (0)
#define PG8_LDB(dst, b, h) do { _Pragma("unroll") for (int n = 0; n < 2; ++n) _Pragma("unroll") for (int k = 0; k < 2; ++k) { if constexpr (FP8) { if (k == 0) dst##8[n] = PG8_CAT2(*(const PG8_LAS i32x4*)(lds + PG8_SB(b, h) + boff + n * 2048), *(const PG8_LAS i32x4*)(lds + PG8_SB(b, h) + boff + n * 2048 + 16)); } else dst[n][k] = *(const PG8_LAS bf16x8*)(lds + PG8_SB(b, h) + boff + n * 2048 + k * 1024); } } while (0)
#define PG8_CAT2(lo_, hi_) __builtin_shufflevector(lo_, hi_, 0, 1, 2, 3, 4, 5, 6, 7)
#define PG8_MMA(ai, bj, At, Bt) do { __builtin_amdgcn_s_setprio(1); _Pragma("unroll") for (int m = 0; m < 4; ++m) _Pragma("unroll") for (int n = 0; n < 2; ++n) { \
        if constexpr (FP8) asm volatile("v_mfma_scale_f32_16x16x128_f8f6f4 %0, %1, %2, %0, %3, %3 op_sel_hi:[0,0,0]" : "+v"(acc[ai][bj][m][n]) : "v"(Bt##8[n]), "v"(At##8[m]), "v"(mxone));     \
        else { _Pragma("unroll") for (int k = 0; k < 2; ++k) acc[ai][bj][m][n] = __builtin_amdgcn_mfma_f32_16x16x32_bf16(Bt[n][k], At[m][k], acc[ai][bj][m][n], 0, 0, 0); } } __builtin_amdgcn_s_setprio(0); } while (0)
#define PG8_MF_(d, a, b, c) "v_mfma_scale_f32_16x16x128_f8f6f4 " d ", " b ", " a ", " c ", %14, %14 op_sel_hi:[0,0,0]\n\t"
#define PG8_MMA0(ai, bj, At, Bt, first) do { if constexpr (C0) { __builtin_amdgcn_s_setprio(1); asm volatile("s_cmp_eq_u32 %15, 0\n\ts_cbranch_scc1 .Lma_%=\n\t" \
        PG8_MF_("%0", "%8", "%12", "0") PG8_MF_("%1", "%8", "%13", "0") PG8_MF_("%2", "%9", "%12", "0") PG8_MF_("%3", "%9", "%13", "0") \
        PG8_MF_("%4", "%10", "%12", "0") PG8_MF_("%5", "%10", "%13", "0") PG8_MF_("%6", "%11", "%12", "0") PG8_MF_("%7", "%11", "%13", "0") \
        "s_branch .Lmd_%=\n.Lma_%=:\n\t" \
        PG8_MF_("%0", "%8", "%12", "%0") PG8_MF_("%1", "%8", "%13", "%1") PG8_MF_("%2", "%9", "%12", "%2") PG8_MF_("%3", "%9", "%13", "%3") \
        PG8_MF_("%4", "%10", "%12", "%4") PG8_MF_("%5", "%10", "%13", "%5") PG8_MF_("%6", "%11", "%12", "%6") PG8_MF_("%7", "%11", "%13", "%7") \
        ".Lmd_%=:" \
        : "+v"(acc[ai][bj][0][0]), "+v"(acc[ai][bj][0][1]), "+v"(acc[ai][bj][1][0]), "+v"(acc[ai][bj][1][1]), "+v"(acc[ai][bj][2][0]), "+v"(acc[ai][bj][2][1]), "+v"(acc[ai][bj][3][0]), "+v"(acc[ai][bj][3][1]) \
        : "v"(At##8[0]), "v"(At##8[1]), "v"(At##8[2]), "v"(At##8[3]), "v"(Bt##8[0]), "v"(Bt##8[1]), "v"(mxone), "s"(first) : "scc"); __builtin_amdgcn_s_setprio(0); } else PG8_MMA(ai, bj, At, Bt); } while (0)
#define PG8_WAIT_V(n) asm volatile("s_waitcnt vmcnt(" #n ")" ::: "memory")
#define PG8_WAIT_L(n) asm volatile("s_waitcnt lgkmcnt(" #n ")" ::: "memory")
#define PG8_BAR __builtin_amdgcn_s_barrier()
#define PG8_SCHED __builtin_amdgcn_sched_barrier(0)
    Unit cur, nxt; int ui = 0;
    if (!S.next(0, cur)) return;
    constexpr bool C0 = FP8 && C0Of<Epi>::v; static_assert(!C0 || (SP2 && !Epi::CHAIN), "C0START: the SP2 loop starts the accumulators itself (no zeroing), no chaining");
    f32x4 acc[2][2][4][2];
    if constexpr (!C0) {
#pragma unroll
    for (int a = 0; a < 2; ++a)
#pragma unroll
        for (int b = 0; b < 2; ++b)
#pragma unroll
            for (int m = 0; m < 4; ++m)
#pragma unroll
                for (int n = 0; n < 2; ++n) acc[a][b][m][n] = (f32x4){0.f, 0.f, 0.f, 0.f}; }
    bf16x8 At[4][2], B0[2][2], B1[2][2];
    typedef int i32x8 __attribute__((ext_vector_type(8)));
    i32x8 At8[4], B08[2], B18[2];
    const int mxone = 0x7f7f7f7f;
    const char* cA = (const char*)((Epi::CHAIN && cur.sel) ? g.A2 : g.A) + (GATHER ? (size_t)0 : (size_t)cur.pm * tstep); PG8_GOFF(goffC, 0); const char* cB = (const char*)((Epi::CHAIN && cur.sel) ? g.Bt2 : g.Bt) + (size_t)cur.pb * tstep;
    S.a_ready(cur);
    if constexpr (SP2) {
        PG8_STAGE_B(PG8_SB(0, 0), cB, 0); PG8_STAGE_B(PG8_SB(0, 1), cB, 1); PG8_STAGE_A(PG8_SA(0, 0), cA, 0, false); PG8_STAGE_A(PG8_SA(0, 1), cA, 1, false);
        if (wr == 1) PG8_BAR;
        PG8_WAIT_V(2); PG8_BAR;
        PG8_STAGE_B(PG8_SB(1, 0), cB + kstep, 0); PG8_STAGE_A(PG8_SA(1, 0), cA + kstepA, 0, false); PG8_STAGE_B(PG8_SB(1, 1), cB + kstep, 1);
        PG8_WAIT_V(6); PG8_BAR;
    } else {
        PG8_STAGE_B(PG8_SB(0, 0), cB, 0); PG8_STAGE(PG8_SA(0, 0), cA, voffA); PG8_STAGE_B(PG8_SB(0, 1), cB, 1); PG8_STAGE(PG8_SA(0, 1), cA + hstep, voffA);
        if (wr == 1) PG8_BAR;
        PG8_WAIT_V(4); PG8_BAR;
        PG8_STAGE_B(PG8_SB(1, 0), cB + kstep, 0); PG8_STAGE(PG8_SA(1, 0), cA + kstepA, voffA); PG8_STAGE_B(PG8_SB(1, 1), cB + kstep, 1);
        PG8_WAIT_V(6); PG8_BAR;
    }
    for (;;) {
        const typename Epi::Pre pre = E.pre(cur, wr, wc, fr, fq);
        const bool has_next = S.next(ui + 1, nxt);
        if (has_next) PG8_GOFF(goffN, ui + 1); else { _Pragma("unroll") for (int h_ = 0; h_ < 2; ++h_) _Pragma("unroll") for (int i_ = 0; i_ < 2; ++i_) goffN[h_][i_] = goffC[h_][i_]; }
        const char* nA = (has_next && !GATHER) ? (const char*)((Epi::CHAIN && nxt.sel) ? g.A2 : g.A) + (size_t)nxt.pm * tstep : cA; const char* nB = has_next ? (const char*)((Epi::CHAIN && nxt.sel) ? g.Bt2 : g.Bt) + (size_t)nxt.pb * tstep : cB;
        for (int t = 0; t < nt; t += 2) {
            const bool last = (t == nt - 2); const int first = __builtin_amdgcn_readfirstlane(t == 0 ? 1 : 0);
            const char* a1 = cA + (size_t)(t + 1) * kstepA;
            const char* a2 = last ? nA : cA + (size_t)(t + 2) * kstepA; const char* b2 = last ? nB : cB + (size_t)(t + 2) * kstep;
            const char* a3 = a2 + kstepA; const char* b3 = b2 + kstep;
            if (last && has_next) S.a_ready(nxt);
            if constexpr (SP2) {
            PG8_LDB(B0, 0, 0); PG8_LDB(B1, 0, 1); PG8_SCHED; PG8_LDA(At, 0, 0); PG8_STAGE_A(PG8_SA(1, 1), a1, 1, false);
            PG8_WAIT_V(8); PG8_WAIT_L(0); PG8_BAR; PG8_MMA0(0, 0, At, B0, first); PG8_MMA0(0, 1, At, B1, first); PG8_BAR; PG8_SCHED;
            PG8_LDA(At, 0, 1); PG8_STAGE_B(PG8_SB(0, 0), b2, 0); PG8_STAGE_B(PG8_SB(0, 1), b2, 1); PG8_STAGE_A(PG8_SA(0, 0), a2, 0, last);
            PG8_WAIT_V(8); PG8_WAIT_L(0); PG8_BAR; PG8_MMA0(1, 0, At, B0, first); PG8_MMA0(1, 1, At, B1, first); PG8_BAR; PG8_SCHED;
            PG8_LDB(B0, 1, 0); PG8_LDB(B1, 1, 1); PG8_SCHED; PG8_LDA(At, 1, 0); PG8_STAGE_A(PG8_SA(0, 1), a2, 1, last);
            PG8_WAIT_V(8); PG8_WAIT_L(0); PG8_BAR; PG8_MMA(0, 0, At, B0); PG8_MMA(0, 1, At, B1); PG8_BAR; PG8_SCHED;
            PG8_LDA(At, 1, 1); PG8_STAGE_B(PG8_SB(1, 0), b3, 0); PG8_STAGE_B(PG8_SB(1, 1), b3, 1); PG8_STAGE_A(PG8_SA(1, 0), a3, 0, last);
            PG8_WAIT_V(8); PG8_WAIT_L(0); PG8_BAR; PG8_MMA(1, 0, At, B0); PG8_MMA(1, 1, At, B1); PG8_BAR; PG8_SCHED;
            } else {
            PG8_LDB(B0, 0, 0); PG8_SCHED; PG8_LDA(At, 0, 0); PG8_STAGE(PG8_SA(1, 1), a1 + hstep, voffA);
            PG8_WAIT_L(8); PG8_BAR; PG8_WAIT_L(0); PG8_MMA(0, 0, At, B0); PG8_BAR; PG8_SCHED;
            PG8_LDB(B1, 0, 1); PG8_STAGE_B(PG8_SB(0, 0), b2, 0);
            PG8_BAR; PG8_WAIT_L(0); PG8_MMA(0, 1, At, B1); PG8_BAR;
            PG8_LDA(At, 0, 1); PG8_STAGE(PG8_SA(0, 0), a2, voffA);
            PG8_BAR; PG8_WAIT_L(0); PG8_MMA(1, 0, At, B0); PG8_BAR; PG8_SCHED;
            PG8_STAGE_B(PG8_SB(0, 1), b2, 1);
            PG8_WAIT_V(6); PG8_BAR; PG8_MMA(1, 1, At, B1); PG8_BAR;
            PG8_LDB(B0, 1, 0); PG8_SCHED; PG8_LDA(At, 1, 0); PG8_STAGE(PG8_SA(0, 1), a2 + hstep, voffA);
            PG8_WAIT_L(8); PG8_BAR; PG8_WAIT_L(0); PG8_MMA(0, 0, At, B0); PG8_BAR; PG8_SCHED;
            PG8_LDB(B1, 1, 1); PG8_STAGE_B(PG8_SB(1, 0), b3, 0);
            PG8_BAR; PG8_WAIT_L(0); PG8_MMA(0, 1, At, B1); PG8_BAR;
            PG8_LDA(At, 1, 1); PG8_STAGE(PG8_SA(1, 0), a3, voffA);
            PG8_BAR; PG8_WAIT_L(0); PG8_MMA(1, 0, At, B0); PG8_BAR; PG8_SCHED;
            PG8_STAGE_B(PG8_SB(1, 1), b3, 1);
            PG8_WAIT_V(6); PG8_BAR; PG8_MMA(1, 1, At, B1); PG8_BAR;
            }
        }
        if constexpr (FP8) asm volatile("s_nop 15\n\ts_nop 15" ::: "memory");
        if constexpr (ALIGN_EPI) { if (wr == 0) PG8_BAR; }
        bool keep_acc = false;
        if constexpr (Epi::CHAIN) { if (cur.sel == 0) { E.mid(acc, cur, wr, wc, fr, fq); keep_acc = true; } else E(acc, cur, wr, wc, fr, fq, pre); S.done(cur); }
        else if constexpr (!Epi::AFTER_DRAIN) { E(acc, cur, wr, wc, fr, fq, pre); S.done(cur); }
        if (!has_next) break;
        if (!keep_acc && !C0) {
#pragma unroll
        for (int a = 0; a < 2; ++a)
#pragma unroll
            for (int b = 0; b < 2; ++b)
#pragma unroll
                for (int m = 0; m < 4; ++m)
#pragma unroll
                    for (int n = 0; n < 2; ++n) acc[a][b][m][n] = (f32x4){0.f, 0.f, 0.f, 0.f};
        }
        cur = nxt; cA = nA; cB = nB; ++ui;
#pragma unroll
        for (int h_ = 0; h_ < 2; ++h_)
#pragma unroll
            for (int i_ = 0; i_ < 2; ++i_) goffC[h_][i_] = goffN[h_][i_];
        if constexpr (ALIGN_EPI) { if (wr == 1) PG8_BAR; }
    }
    PG8_WAIT_V(0);
    if constexpr (!ALIGN_EPI) { if (wr == 0) PG8_BAR; }
    PG8_BAR;
    if constexpr (Epi::AFTER_DRAIN) { E.fused(acc, cur, wr, wc, fr, fq, lds, wid, lane); S.done(cur); }
#undef PG8_SA
#undef PG8_SB
#undef PG8_STAGE
#undef PG8_GOFF
#undef PG8_STAGE_A
#undef PG8_STAGE_B
#undef PG8_CAT2
#undef PG8_LDA
#undef PG8_LDB
#undef PG8_MMA
#undef PG8_MMA0
#undef PG8_MF_
#undef PG8_WAIT_V
#undef PG8_WAIT_L
#undef PG8_BAR
#undef PG8_SCHED
}
}
#include <hip/hip_bf16.h>
#include <cmath>
namespace attn_body {
using bf16=__hip_bfloat16;
using bf16x8=__attribute__((ext_vector_type(8)))short;
using s16x4=__attribute__((ext_vector_type(4)))short;
using f32x16=__attribute__((ext_vector_type(16)))float;
using u32x4=__attribute__((ext_vector_type(4)))unsigned;
constexpr int BATCH=4,NHEAD=8,NKVH=2,SEQ=8192,D=64,QP=NHEAD*D,KP=NKVH*D;
constexpr int NW=8,QBLK=32,QB=QBLK*NW,KVBLK=64,NQB=SEQ/QB;
constexpr int ATTN_UNIT_ROWS=QB;
__device__ __forceinline__ int crow(int r,int hi){return (r&3)+8*(r>>2)+4*hi;}
#define SBAR() __builtin_amdgcn_sched_barrier(0)
constexpr int NSLOT=3, SLOTB=8192;
constexpr int LDS_K=0, LDS_V=NSLOT*SLOTB, LDS_WS=2*NSLOT*SLOTB, LDS_OST=LDS_WS+NW*64*4, LDS_BYTES=LDS_OST+NW*4096;
constexpr float C2=0.125f*1.4426950408889634f;
__device__ __forceinline__ void glds16(const void*gsrc,unsigned lds_dst){unsigned keep;
  asm volatile("s_mov_b32 %0, m0\n\ts_mov_b32 m0, %2\n\ts_nop 0\n\tglobal_load_lds_dwordx4 %1, off\n\ts_mov_b32 m0, %0":"=&s"(keep):"v"(gsrc),"s"(lds_dst):"memory");}
__device__ __forceinline__ float max3f(float a,float b,float c){float r;asm("v_max3_f32 %0, %1, %2, %3":"=v"(r):"v"(a),"v"(b),"v"(c));return r;}
__device__ __forceinline__ float max2f(float a,float b){float r;asm("v_max_f32_e32 %0, %1, %2":"=v"(r):"v"(a),"v"(b));return r;}
__device__ __forceinline__ float fadd_s(float a,float b){float r;asm("v_add_f32_e32 %0, %1, %2":"=v"(r):"v"(a),"v"(b));return r;}
__device__ __forceinline__ float fsub_s(float a,float b){float r;asm("v_sub_f32_e32 %0, %1, %2":"=v"(r):"v"(a),"v"(b));return r;}
typedef float f32x2_t __attribute__((ext_vector_type(2))); typedef __bf16 bf16x2_t __attribute__((ext_vector_type(2)));
__device__ __forceinline__ unsigned cvtpk_s(float lo,float hi){f32x2_t v={lo,hi};bf16x2_t b=__builtin_convertvector(v,bf16x2_t);return __builtin_bit_cast(unsigned,b);}
#define WAIT_BAR(N) asm volatile("s_waitcnt vmcnt(" #N ") lgkmcnt(0)\n\ts_barrier":::"memory")

__device__ __forceinline__ void qkt(f32x16&p0,f32x16&p1,const char*Kslot,const bf16x8*qr,const f32x16&negm,int r32,int hi){
  const char*kb=Kslot+hi*1024+r32*16;
  #pragma unroll
  for(int d0=0;d0<4;++d0){
    const bf16x8 b0=*reinterpret_cast<const bf16x8*>(kb+d0*2048);
    const bf16x8 b1=*reinterpret_cast<const bf16x8*>(kb+d0*2048+512);
    if(d0==0){p0=__builtin_amdgcn_mfma_f32_32x32x16_bf16(b0,qr[0],negm,0,0,0);p1=__builtin_amdgcn_mfma_f32_32x32x16_bf16(b1,qr[0],negm,0,0,0);}
    else{p0=__builtin_amdgcn_mfma_f32_32x32x16_bf16(b0,qr[d0],p0,0,0,0);p1=__builtin_amdgcn_mfma_f32_32x32x16_bf16(b1,qr[d0],p1,0,0,0);}}
}
typedef __attribute__((address_space(3))) const char* lds_cptr;
typedef short v4i16_t __attribute__((ext_vector_type(4)));
__device__ __forceinline__ void kload8(bf16x8*kf,lds_cptr kp){
  kf[0]=*(const __attribute__((address_space(3))) bf16x8*)(kp);      kf[1]=*(const __attribute__((address_space(3))) bf16x8*)(kp+512);
  kf[2]=*(const __attribute__((address_space(3))) bf16x8*)(kp+2048); kf[3]=*(const __attribute__((address_space(3))) bf16x8*)(kp+2560);
  kf[4]=*(const __attribute__((address_space(3))) bf16x8*)(kp+4096); kf[5]=*(const __attribute__((address_space(3))) bf16x8*)(kp+4608);
  kf[6]=*(const __attribute__((address_space(3))) bf16x8*)(kp+6144); kf[7]=*(const __attribute__((address_space(3))) bf16x8*)(kp+6656);
}
__device__ __forceinline__ void kload2(bf16x8*kf,lds_cptr kp,int j){ kf[2*j]=*(const __attribute__((address_space(3))) bf16x8*)(kp+j*2048); kf[2*j+1]=*(const __attribute__((address_space(3))) bf16x8*)(kp+j*2048+512); }
__device__ __forceinline__ s16x4 vtr(lds_cptr p){ return __builtin_bit_cast(s16x4,__builtin_amdgcn_ds_read_tr16_b64_v4i16((__attribute__((address_space(3))) v4i16_t*)p)); }
__device__ __forceinline__ float rowmax(const f32x16&p0,const f32x16&p1){
  float a=max3f(p0[0],p0[1],p1[0]),b=max3f(p0[2],p0[3],p1[1]);a=max3f(a,p1[2],p1[3]);
  #pragma unroll
  for(int r=4;r<16;r+=4){a=max3f(a,p0[r],p0[r+1]);b=max3f(b,p0[r+2],p0[r+3]);a=max3f(a,p1[r],p1[r+1]);b=max3f(b,p1[r+2],p1[r+3]);}
  const float m=max2f(a,b);
  auto rr=__builtin_amdgcn_permlane32_swap(__float_as_uint(m),__float_as_uint(m),false,false);
  return max2f(__uint_as_float(rr[0]),__uint_as_float(rr[1]));
}
__device__ __forceinline__ void pv(f32x16*o,int vb,bf16x8 pa0,bf16x8 pa1,bf16x8 pa2,bf16x8 pa3){
  #pragma unroll
  for(int d0=0;d0<2;++d0){s16x4 lo[4],hi[4];
    #pragma unroll
    for(int ks=0;ks<4;++ks){
      asm volatile("ds_read_b64_tr_b16 %0,%1 offset:%c2":"=&v"(lo[ks]):"v"(vb),"i"(d0*4096+ks*1024):"memory");
      asm volatile("ds_read_b64_tr_b16 %0,%1 offset:%c2":"=&v"(hi[ks]):"v"(vb),"i"(d0*4096+ks*1024+512):"memory");}
    asm volatile("s_waitcnt lgkmcnt(0)":::"memory");SBAR();
    #define PK(k) (bf16x8){lo[k][0],lo[k][1],lo[k][2],lo[k][3],hi[k][0],hi[k][1],hi[k][2],hi[k][3]}
    o[d0]=__builtin_amdgcn_mfma_f32_32x32x16_bf16(pa0,PK(0),o[d0],0,0,0);
    o[d0]=__builtin_amdgcn_mfma_f32_32x32x16_bf16(pa1,PK(1),o[d0],0,0,0);
    o[d0]=__builtin_amdgcn_mfma_f32_32x32x16_bf16(pa2,PK(2),o[d0],0,0,0);
    o[d0]=__builtin_amdgcn_mfma_f32_32x32x16_bf16(pa3,PK(3),o[d0],0,0,0);
    #undef PK
  }
}

#ifndef ATTN_STORE16
#define ATTN_STORE16(p,v) (*(u32x4*)(p)=(v))
#endif
template<int THRL> __device__ __forceinline__ void attn_unit(int b,int h,int qb,const bf16*Q,const bf16*__restrict__ K,const bf16*__restrict__ V,bf16*O,char*shm,const float mref){
  const int tid=threadIdx.x,lane=tid&63,r32=lane&31,hi=lane>>5; const int wid=__builtin_amdgcn_readfirstlane(tid>>6);
  const long rowbase=(long)b*SEQ; const int q0=qb*QB;
  const bf16*Qw=Q+(rowbase+q0+wid*QBLK)*QP+h*D;
  const int hk=h/(NHEAD/NKVH); const bf16*Kh=K+rowbase*KP+hk*D,*Vh=V+rowbase*KP+hk*D;
  const unsigned lds0=(unsigned)(uintptr_t)shm;
  float*wsf=(float*)(shm+LDS_WS)+wid*64;
  const bf16*ksrc=Kh+(long)lane*KP+wid*8;
  const bf16*vsrc=Vh+(long)(16*(wid&3)+(lane>>2))*KP+(wid>>2)*32+(lane&3)*8;
  const unsigned kdst=lds0+LDS_K+wid*1024, vdst=lds0+LDS_V+wid*1024;
  #define DMA_K(t,slot) glds16(ksrc+(long)(t)*KVBLK*KP,(unsigned)__builtin_amdgcn_readfirstlane(kdst+(slot)))
  #define DMA_V(t,slot) glds16(vsrc+(long)(t)*KVBLK*KP,(unsigned)__builtin_amdgcn_readfirstlane(vdst+(slot)))
  const int vb0=(int)(lds0+LDS_V)+((lane>>4)&1)*32+(lane&3)*8+(4*hi+((lane&15)>>2))*64;
  const char*Kbase=shm+LDS_K; bf16x8 kf[8];
  const lds_cptr shm3=(lds_cptr)shm; const lds_cptr kp0=shm3+LDS_K+hi*1024+r32*16; const lds_cptr vp0=shm3+LDS_V+((lane>>4)&1)*32+(lane&3)*8+(4*hi+((lane&15)>>2))*64;
  constexpr int NT=SEQ/KVBLK;
  DMA_K(0,0);DMA_V(0,0);DMA_K(1,SLOTB);
  bf16x8 qr[4];
  #pragma unroll
  for(int d0=0;d0<4;++d0)qr[d0]=*reinterpret_cast<const bf16x8*>(&Qw[(long)r32*QP+d0*16+hi*8]);
  float mhat=0.f,l_reg=0.f;f32x16 o[2];o[0]=f32x16{};o[1]=f32x16{};f32x16 negm=f32x16{};asm volatile("":"+v"(negm));
    #define CMASK(P0,P1,t) do{}while(0)
  bool resc=false;
  #define START(P0,P1) do{ resc=false; \
    { const float dl=mref; mhat=fadd_s(mhat,dl); \
      _Pragma("unroll") for(int r=0;r<16;++r){P0[r]=fsub_s(P0[r],dl);P1[r]=fsub_s(P1[r],dl);} \
      _Pragma("unroll") for(int r=0;r<16;++r)negm[r]=-mhat; asm volatile("":"+v"(negm)); } \
    _Pragma("unroll") for(int r=0;r<16;++r)P0[r]=__builtin_amdgcn_exp2f(P0[r]); }while(0)
  #define RESC() do{ if(resc){ asm volatile("s_waitcnt lgkmcnt(0)":::"memory"); \
      _Pragma("unroll") for(int d_=0;d_<2;++d_) _Pragma("unroll") for(int r=0;r<16;++r)o[d_][r]*=wsf[crow(r,hi)]; } }while(0)
  f32x16 pA0,pA1,pB0,pB1;
  int sl_prev=0,sl_cur=0,sl_next=SLOTB;
  #define ROT() do{sl_prev=sl_cur;sl_cur=sl_next;sl_next=(sl_next==(NSLOT-1)*SLOTB)?0:sl_next+SLOTB;}while(0)
  DMA_K(2,2*SLOTB);
  WAIT_BAR(3);
  qkt(pA0,pA1,Kbase,qr,negm,r32,hi);asm volatile("s_nop 15\n\ts_nop 7":"+v"(pA0),"+v"(pA1));CMASK(pA0,pA1,0);
  START(pA0,pA1);
  _Pragma("unroll") for(int r=0;r<16;++r)pA1[r]=__builtin_amdgcn_exp2f(pA1[r]);
  WAIT_BAR(0);
  DMA_K(3,0);DMA_V(1,SLOTB);
  ROT();
  kload8(kf,kp0+sl_cur);
  WAIT_BAR(2);
  s16x4 vlo[8],vhi[8]; u32x4 pw0,pw1,pw2,pw3;
  #define PKW(P,B) cvtpk_s(P[B],P[B+1])
  #define PAF(k) __builtin_bit_cast(bf16x8,pw##k)
  #define VFR(i) (bf16x8){vlo[i][0],vlo[i][1],vlo[i][2],vlo[i][3],vhi[i][0],vhi[i][1],vhi[i][2],vhi[i][3]}
  #define PIN(x) asm volatile("":"+v"(x))
  #define MX3(a,b,c) __builtin_fmaxf(__builtin_fmaxf((a),(b)),(c))
  #define GAPA(MF,A0,A1,A2,A3,W0,W1,PW) do{ MF; sacc+=A0; sacc+=A1; sacc+=A2; sacc+=A3; PIN(sacc); W0; W1; PIN(PW); SBAR(); }while(0)
  #define EX(v) __builtin_amdgcn_exp2f(v)
  #define GAPB(MF,X,B) do{ MF; X[B]=EX(X[B]); X[B+1]=EX(X[B+1]); X[B+2]=EX(X[B+2]); X[B+3]=EX(X[B+3]); PIN(X); SBAR(); }while(0)
  #define VRD(i) do{ vlo[i]=vtr(vp_+(((i)>>2)*4096+((i)&3)*1024)); vhi[i]=vtr(vp_+(((i)>>2)*4096+((i)&3)*1024+512)); }while(0)
  #define KRD(G,j) do{ if(G){ kload2(kf,kp0+sl_next,j); SBAR(); } }while(0)
  #define STEP(C0,C1,P0,P1,t,GK,GV,GL) do{ SBAR(); \
    const lds_cptr vp_=vp0+sl_prev; \
    VRD(0); SBAR(); float sacc=(P0[0]+P0[1]); \
    GAPA(C0=__builtin_amdgcn_mfma_f32_32x32x16_bf16(kf[0],qr[0],negm,0,0,0), P0[2],P0[3],P0[4],P0[5],     pw0[0]=PKW(P0,0), pw0[1]=PKW(P0,2), pw0); \
    VRD(4); SBAR(); GAPA(C1=__builtin_amdgcn_mfma_f32_32x32x16_bf16(kf[1],qr[0],negm,0,0,0), P0[6],P0[7],P0[8],P0[9],     pw0[2]=PKW(P0,4), pw0[3]=PKW(P0,6), pw0); \
    VRD(1); SBAR(); GAPA(C0=__builtin_amdgcn_mfma_f32_32x32x16_bf16(kf[2],qr[1],C0,0,0,0),   P0[10],P0[11],P0[12],P0[13], pw1[0]=PKW(P0,8), pw1[1]=PKW(P0,10), pw1); \
    VRD(5); SBAR(); GAPA(C1=__builtin_amdgcn_mfma_f32_32x32x16_bf16(kf[3],qr[1],C1,0,0,0),   P0[14],P0[15],P1[0],P1[1],   pw1[2]=PKW(P0,12),pw1[3]=PKW(P0,14), pw1); \
    VRD(2); SBAR(); GAPA(C0=__builtin_amdgcn_mfma_f32_32x32x16_bf16(kf[4],qr[2],C0,0,0,0),   P1[2],P1[3],P1[4],P1[5],     pw2[0]=PKW(P1,0), pw2[1]=PKW(P1,2), pw2); \
    VRD(6); SBAR(); GAPA(C1=__builtin_amdgcn_mfma_f32_32x32x16_bf16(kf[5],qr[2],C1,0,0,0),   P1[6],P1[7],P1[8],P1[9],     pw2[2]=PKW(P1,4), pw2[3]=PKW(P1,6), pw2); \
    VRD(3); SBAR(); GAPA(C0=__builtin_amdgcn_mfma_f32_32x32x16_bf16(kf[6],qr[3],C0,0,0,0),   P1[10],P1[11],P1[12],P1[13], pw3[0]=PKW(P1,8), pw3[1]=PKW(P1,10), pw3); \
    VRD(7); SBAR(); GAPA(C1=__builtin_amdgcn_mfma_f32_32x32x16_bf16(kf[7],qr[3],C1,0,0,0),   P1[14],P1[15],0.f,0.f,       pw3[2]=PKW(P1,12),pw3[3]=PKW(P1,14), pw3); \
    l_reg+=sacc; \
    if(GK){DMA_K((t)+3,sl_cur);} if(GV){DMA_V((t)+1,sl_next);} \
    CMASK(C0,C1,t); \
    resc=false;   \
    SBAR(); \
    GAPB(o[0]=__builtin_amdgcn_mfma_f32_32x32x16_bf16(PAF(0),VFR(0),o[0],0,0,0), C0,0); \
    GAPB(o[1]=__builtin_amdgcn_mfma_f32_32x32x16_bf16(PAF(0),VFR(4),o[1],0,0,0), C0,4); \
    KRD(GL,0); GAPB(o[0]=__builtin_amdgcn_mfma_f32_32x32x16_bf16(PAF(1),VFR(1),o[0],0,0,0), C0,8); \
    KRD(GL,1); GAPB(o[1]=__builtin_amdgcn_mfma_f32_32x32x16_bf16(PAF(1),VFR(5),o[1],0,0,0), C0,12); \
    KRD(GL,2); GAPB(o[0]=__builtin_amdgcn_mfma_f32_32x32x16_bf16(PAF(2),VFR(2),o[0],0,0,0), C1,0); \
    KRD(GL,3); GAPB(o[1]=__builtin_amdgcn_mfma_f32_32x32x16_bf16(PAF(2),VFR(6),o[1],0,0,0), C1,4); \
    GAPB(o[0]=__builtin_amdgcn_mfma_f32_32x32x16_bf16(PAF(3),VFR(3),o[0],0,0,0), C1,8); \
    GAPB(o[1]=__builtin_amdgcn_mfma_f32_32x32x16_bf16(PAF(3),VFR(7),o[1],0,0,0), C1,12); \
    }while(0)
  int t=1;
  #undef CMASK
  #define CMASK(P0,P1,t) do{}while(0)
  for(;t+5<NT;t+=2){
    STEP(pB0,pB1,pA0,pA1,t,true,true,true);     WAIT_BAR(2); RESC(); ROT();
    STEP(pA0,pA1,pB0,pB1,t+1,true,true,true);   WAIT_BAR(2); RESC(); ROT();
  }
  #undef CMASK
  #define CMASK(P0,P1,t) do{}while(0)
  #define ENDW(tt) do{ if((tt)+3<NT){WAIT_BAR(2);} else if((tt)+2<NT){WAIT_BAR(1);} else {WAIT_BAR(0);} }while(0)
  for(;t+1<NT;t+=2){
    STEP(pB0,pB1,pA0,pA1,t,(t+3<NT),(t+1<NT),(t+1<NT));       ENDW(t);   RESC(); ROT();
    STEP(pA0,pA1,pB0,pB1,t+1,(t+4<NT),(t+2<NT),(t+2<NT));     ENDW(t+1); RESC(); ROT();
  }
  STEP(pB0,pB1,pA0,pA1,NT-1,false,false,false); RESC();
  { float sacc=pB0[0]+pB0[1]; _Pragma("unroll") for(int r=2;r<16;++r)sacc+=pB0[r]; _Pragma("unroll") for(int r=0;r<16;++r)sacc+=pB1[r]; l_reg+=sacc;
    pw0=(u32x4){PKW(pB0,0),PKW(pB0,2),PKW(pB0,4),PKW(pB0,6)};pw1=(u32x4){PKW(pB0,8),PKW(pB0,10),PKW(pB0,12),PKW(pB0,14)};pw2=(u32x4){PKW(pB1,0),PKW(pB1,2),PKW(pB1,4),PKW(pB1,6)};pw3=(u32x4){PKW(pB1,8),PKW(pB1,10),PKW(pB1,12),PKW(pB1,14)};
    SBAR(); pv(o,vb0+sl_cur,PAF(0),PAF(1),PAF(2),PAF(3)); }
  #undef PKW
  #undef PAF
  #undef VFR
  #undef PIN
  #undef MX3
  #undef GAPA
  #undef GAPB
  #undef EX
  #undef VRD
  #undef KRD
  #undef STEP
  #undef ENDW
  {auto rr=__builtin_amdgcn_permlane32_swap(__float_as_uint(l_reg),__float_as_uint(l_reg),false,false);l_reg=__uint_as_float(rr[0])+__uint_as_float(rr[1]);}
  if(hi==0)wsf[32+r32]=l_reg;asm volatile("s_waitcnt lgkmcnt(0)":::"memory");
  float rli[16];
  #pragma unroll
  for(int r=0;r<16;++r)rli[r]=__builtin_amdgcn_rcpf(wsf[32+crow(r,hi)]);
  bf16*Ow=O+(rowbase+q0+wid*QBLK)*QP+h*D;
  { bf16*stg=(bf16*)(shm+LDS_OST)+wid*2048;
    #pragma unroll
    for(int r=0;r<16;++r){const int orow=crow(r,hi);
      #pragma unroll
      for(int d0=0;d0<2;++d0)stg[orow*64+d0*32+r32]=__float2bfloat16(o[d0][r]*rli[r]);}
    asm volatile("s_waitcnt lgkmcnt(0)":::"memory");
    #pragma unroll
    for(int i=0;i<4;++i){const int row=i*8+(lane>>3),ch=lane&7; const u32x4 v=*(const u32x4*)(stg+row*64+ch*8); ATTN_STORE16(Ow+(long)row*QP+ch*8,v);} }
  asm volatile("s_waitcnt lgkmcnt(0)\n\ts_barrier":::"memory");
  #undef DMA_K
  #undef DMA_V
  #undef CMASK
  #undef START
  #undef RESC
  #undef ROT
}
constexpr int ATTN_LDS_BYTES=LDS_BYTES;
struct AttnTensors { const bf16* Q; const bf16* K; const bf16* V; bf16* O; float mref; };
struct AttnUnit { int bh; int qb; };
struct StaticOrder {
  int vcu,per;
  __device__ __forceinline__ explicit StaticOrder(int grid,int vcu_):vcu(vcu_),per((BATCH*NHEAD*NQB+grid-1)/grid){}
  __device__ __forceinline__ bool next(int i,AttnUnit&u)const{ if(i>=per)return false; const int U=vcu*per+i; if(U>=BATCH*NHEAD*NQB)return false; u.bh=U/NQB; u.qb=U%NQB; return true; }
  __device__ __forceinline__ void a_ready(const AttnUnit&)const{}
  __device__ __forceinline__ void done(const AttnUnit&)const{}
};
typedef int i32x8v __attribute__((ext_vector_type(8)));
typedef int i32x4v __attribute__((ext_vector_type(4)));
constexpr int S8=4096, NS8=8, L8_K=0, L8_V=NS8*S8, L8_WS=2*NS8*S8, L8_OST=L8_WS+NW*64*4, L8_BYTES=L8_OST+NW*4096;
__device__ __forceinline__ unsigned pknorm16(float a,float b){ typedef unsigned short u16x2 __attribute__((ext_vector_type(2))); const u16x2 r=__builtin_amdgcn_cvt_pknorm_u16(a,b); return (unsigned)r[0]|((unsigned)r[1]<<16); }
__device__ __forceinline__ int pk4_fp8_over(int w,float a,float b,float c,float d){w=__builtin_amdgcn_cvt_pk_fp8_f32(a,b,w,false);w=__builtin_amdgcn_cvt_pk_fp8_f32(c,d,w,true);return w;}
__device__ __forceinline__ unsigned pk4_fp8(float a,float b,float c,float d){int w=0;w=__builtin_amdgcn_cvt_pk_fp8_f32(a,b,w,false);w=__builtin_amdgcn_cvt_pk_fp8_f32(c,d,w,true);return (unsigned)w;}
#define MFMA8_NEW(D_,A_,B_,C_,SA_,SB_) asm volatile("v_mfma_scale_f32_32x32x64_f8f6f4 %0, %1, %2, %3, %4, %5 op_sel_hi:[0,0,0]":"=&v"(D_):"v"(A_),"v"(B_),"v"(C_),"v"(SA_),"v"(SB_))
#define MFMA8_ACC(D_,A_,B_,SA_,SB_) asm volatile("v_mfma_scale_f32_32x32x64_f8f6f4 %0, %1, %2, %0, %3, %4 op_sel_hi:[0,0,0]":"+v"(D_):"v"(A_),"v"(B_),"v"(SA_),"v"(SB_))
__device__ __forceinline__ void attn_unit8(int b,int h,int qb,const unsigned char*Q8,const unsigned char*K8,const unsigned char*VT8,bf16*O,char*shm,const float m0){
  int tid_=threadIdx.x; asm volatile("":"+v"(tid_));
  const int tid=tid_,lane=tid&63,r32=lane&31,hi=lane>>5; const int wid=__builtin_amdgcn_readfirstlane(tid>>6);
  const long rowbase=(long)b*SEQ; const int q0=qb*QB; const int hk=h/(NHEAD/NKVH);
  constexpr int NT=SEQ/KVBLK;
  const unsigned lds0=(unsigned)(uintptr_t)shm;

  const unsigned char*qp=Q8+(size_t)(rowbase+q0+wid*QBLK+r32)*QP+h*D+32*hi;
  const i32x4v qlo=*(const i32x4v*)qp, qhi=*(const i32x4v*)(qp+16);
  i32x8v qf=__builtin_shufflevector(qlo,qhi,0,1,2,3,4,5,6,7);
  asm volatile("":"+v"(qf));
  const int pc=wid&3, hip=pc>>1, ch=pc&1;
  const unsigned char*ksrc=K8+(size_t)(rowbase+lane)*KP+hk*D+32*hip+16*ch;
  const unsigned char*vsrc=VT8+((size_t)(b*NT)*NKVH+hk)*4096+(size_t)(hip*64+lane)*32+16*ch;
  const unsigned mydst=lds0+(wid<4?L8_K:L8_V)+pc*1024;
  #define DMA8(t,slot) do{ if(wid<4) glds16(ksrc+(size_t)(t)*KVBLK*KP,(unsigned)__builtin_amdgcn_readfirstlane(mydst+(slot)*S8)); \
                           else glds16(vsrc+(size_t)(t)*NKVH*4096,(unsigned)__builtin_amdgcn_readfirstlane(mydst+(slot)*S8)); }while(0)
  const lds_cptr shm3=(lds_cptr)shm;
  const lds_cptr kfp=shm3+L8_K+hi*2048+r32*16;
  const lds_cptr vfp=shm3+L8_V+hi*2048+r32*16;
  f32x16 negm;
  #pragma unroll
  for(int r=0;r<16;++r)negm[r]=(-8.0f*m0+56.16f)*(1.0f/256.0f);
  const int sV=0x7d7d7d7d, s1=0x7f7f7f7f, sK=0x77777777;
  i32x8v ones; { const int onev=(((lane>>4)&1)==((lane>>3)&1))?0x38383838:0;
  #pragma unroll
  for(int i=0;i<8;++i)ones[i]=onev; }
  asm volatile("":"+v"(ones));
  typedef float f32x4s __attribute__((ext_vector_type(4)));
  f32x4s lsum=f32x4s{}; f32x16 o[2]; o[0]=f32x16{}; o[1]=f32x16{};
  #define KFRAG(A0,A1,SLOT) do{ const lds_cptr kp_=kfp+(SLOT)*S8; \
      const i32x4v x0=*(const __attribute__((address_space(3))) i32x4v*)(kp_), x1=*(const __attribute__((address_space(3))) i32x4v*)(kp_+1024); A0=__builtin_shufflevector(x0,x1,0,1,2,3,4,5,6,7); \
      const i32x4v y0=*(const __attribute__((address_space(3))) i32x4v*)(kp_+512), y1=*(const __attribute__((address_space(3))) i32x4v*)(kp_+1536); A1=__builtin_shufflevector(y0,y1,0,1,2,3,4,5,6,7); }while(0)
  #define VFRAG(A0,A1,SLOT) do{ const lds_cptr vp_=vfp+(SLOT)*S8; \
      const i32x4v x0=*(const __attribute__((address_space(3))) i32x4v*)(vp_), x1=*(const __attribute__((address_space(3))) i32x4v*)(vp_+1024); A0=__builtin_shufflevector(x0,x1,0,1,2,3,4,5,6,7); \
      const i32x4v y0=*(const __attribute__((address_space(3))) i32x4v*)(vp_+512), y1=*(const __attribute__((address_space(3))) i32x4v*)(vp_+1536); A1=__builtin_shufflevector(y0,y1,0,1,2,3,4,5,6,7); }while(0)
  #define STEP8(TT,KS2,VS1,UA0,UA1,LA0,LA1,S0,S1,N0,N1,v0,v1,W0,W1) do{ \
    if((TT)+1<NT){ MFMA8_NEW(N0,UA0,qf,negm,sK,s1); MFMA8_NEW(N1,UA1,qf,negm,sK,s1); } \
    if((TT)+2<NT){ KFRAG(LA0,LA1,KS2); }                                                     \
    if((TT)+1<NT){ VFRAG(W0,W1,VS1); }                                                      \
      \
    _Pragma("unroll") for(int w=0;w<4;++w){ \
      const unsigned a0=pknorm16(S0[4*w],S0[4*w+1]), a1=pknorm16(S0[4*w+2],S0[4*w+3]), b0=pknorm16(S1[4*w],S1[4*w+1]), b1=pknorm16(S1[4*w+2],S1[4*w+3]); \
      P8[w]=(int)__builtin_amdgcn_perm(a1,a0,0x07050301u); P8[4+w]=(int)__builtin_amdgcn_perm(b1,b0,0x07050301u); } \
    asm volatile("s_nop 3":"+v"(P8)); \
    MFMA8_ACC(o[0],P8,v0,s1,sV); MFMA8_ACC(o[1],P8,v1,s1,sV); asm volatile("v_mfma_scale_f32_16x16x128_f8f6f4 %0, %1, %2, %0, %3, %3 op_sel_hi:[0,0,0]":"+v"(lsum):"v"(P8),"v"(ones),"v"(s1)); \
    if((TT)+1<NT){ asm volatile("":"+v"(N0),"+v"(N1)); } }while(0)
  if(wid<4){ DMA8(0,0); DMA8(1,1); DMA8(2,2); DMA8(3,3); DMA8(4,4); DMA8(5,5); DMA8(6,6); } else { DMA8(0,0); DMA8(1,1); DMA8(2,2); DMA8(3,3); DMA8(4,4); DMA8(5,5); }
  asm volatile("s_waitcnt vmcnt(5) lgkmcnt(0)\n\ts_barrier":::"memory");
  f32x16 S0,S1,T0,T1; i32x8v xa0,xa1,ya0,ya1; i32x8v P8={};
  { KFRAG(ya0,ya1,0); MFMA8_NEW(S0,ya0,qf,negm,sK,s1); MFMA8_NEW(S1,ya1,qf,negm,sK,s1); }
  KFRAG(xa0,xa1,1);
  i32x8v vx0,vx1,vy0,vy1; VFRAG(vx0,vx1,0);
  asm volatile("s_nop 15\n\ts_nop 15\n\ts_nop 15":"+v"(S0),"+v"(S1));
  const bool kw=wid<4;
  const unsigned char*dsrc=kw?(ksrc+(size_t)7*KVBLK*KP):(vsrc+(size_t)6*NKVH*4096);
  static_assert(KVBLK*KP==8192&&NKVH*4096==8192,"K and V streams advance by the same 8 KiB per tile");
  static_assert(NS8==8,"slot constants below are for 8-slot rings");
  #define DSLOT(a_,b_) (unsigned)__builtin_amdgcn_readfirstlane(mydst+(kw?(a_):(b_))*S8)
  const unsigned dA0=DSLOT(7,6), dA1=DSLOT(0,7);
  const unsigned dB0=DSLOT(1,0), dB1=DSLOT(2,1);
  const unsigned dC0=DSLOT(3,2), dC1=DSLOT(4,3);
  const unsigned dD0=DSLOT(5,4), dD1=DSLOT(6,5);
  #undef DSLOT
  #define PAIR8(TT,SL,D0,D1) do{ asm volatile("s_waitcnt vmcnt(3)\n\ts_barrier":::"memory"); \
    STEP8(TT,((SL)+2)%NS8,((SL)+1)%NS8,xa0,xa1,ya0,ya1,S0,S1,T0,T1,vx0,vx1,vy0,vy1); \
    glds16(dsrc,D0); glds16(dsrc+8192,D1); dsrc+=16384; \
    STEP8((TT)+1,((SL)+3)%NS8,((SL)+2)%NS8,ya0,ya1,xa0,xa1,T0,T1,S0,S1,vy0,vy1,vx0,vx1); }while(0)
  static_assert(NT==128,"the peeled tail below is written for 128 tiles");
  #pragma unroll 1
  for(int t=0;t<120;t+=8){ PAIR8(t,0,dA0,dA1); PAIR8(t+2,2,dB0,dB1); PAIR8(t+4,4,dC0,dC1); PAIR8(t+6,6,dD0,dD1); }
  #undef PAIR8
  #define PAIR8T(TT,SL,WAITS,ISSUE) do{ asm volatile(WAITS "\n\ts_barrier":::"memory"); \
    STEP8(TT,((SL)+2)%NS8,((SL)+1)%NS8,xa0,xa1,ya0,ya1,S0,S1,T0,T1,vx0,vx1,vy0,vy1); \
    ISSUE; \
    STEP8((TT)+1,((SL)+3)%NS8,((SL)+2)%NS8,ya0,ya1,xa0,xa1,T0,T1,S0,S1,vy0,vy1,vx0,vx1); }while(0)
  PAIR8T(120,0,"s_waitcnt vmcnt(3)",{ glds16(dsrc,dA0); if(!kw){ glds16(dsrc+8192,dA1); } });
  PAIR8T(122,2,"s_waitcnt vmcnt(2)",{});
  PAIR8T(124,4,"s_waitcnt vmcnt(0)",{});
  PAIR8T(126,6,"s_waitcnt vmcnt(0)",{});
  #undef PAIR8T
  #undef STEP8
  #undef KFRAG
  #undef VFRAG
  asm volatile("s_nop 15\n\ts_nop 15\n\ts_nop 15":"+v"(o[0]),"+v"(o[1]),"+v"(lsum));
  float*wsf=(float*)(shm+L8_WS)+wid*64;
  if((lane&7)==0){
    #pragma unroll
    for(int v=0;v<4;++v)wsf[32+4*(lane>>4)+v+((lane&8)?16:0)]=lsum[v]; }
  asm volatile("s_waitcnt lgkmcnt(0)":::"memory");
  float rli[16];
  #pragma unroll
  for(int r=0;r<16;++r)rli[r]=__builtin_amdgcn_rcpf(wsf[32+crow(r,hi)]);
  bf16*Ow=O+(rowbase+q0+wid*QBLK)*QP+h*D;
  { bf16*stg=(bf16*)(shm+L8_OST)+wid*2048;
    #pragma unroll
    for(int r=0;r<16;++r){const int orow=crow(r,hi);
      #pragma unroll
      for(int d0=0;d0<2;++d0)stg[orow*64+d0*32+r32]=__float2bfloat16(o[d0][r]*rli[r]);}
    asm volatile("s_waitcnt lgkmcnt(0)":::"memory");
    #pragma unroll
    for(int i=0;i<4;++i){const int row=i*8+(lane>>3),chn=lane&7; const u32x4 v=*(const u32x4*)(stg+row*64+chn*8); ATTN_STORE16(Ow+(long)row*QP+chn*8,v);} }
  asm volatile("s_waitcnt lgkmcnt(0)\n\ts_barrier":::"memory");
  #undef DMA8
}
struct AttnTensors8 { const unsigned char* Q8; const unsigned char* K8; const unsigned char* VT8; bf16* O; float m0; };
template<class Sched> __device__ __forceinline__ void attn_phase8(char*lds,const AttnTensors8&T,const Sched&S){
  AttnUnit u;
  for(int i=0;S.next(i,u);++i){ attn_unit8(u.bh/NHEAD,u.bh%NHEAD,u.qb,T.Q8,T.K8,T.VT8,T.O,lds,T.m0); }
}
#undef MFMA8_NEW
#undef MFMA8_ACC
template<class Sched,int THRL=8> __device__ __forceinline__ void attn_phase(char*lds,const AttnTensors&T,const Sched&S){
  AttnUnit u;
  for(int i=0;S.next(i,u);++i){ S.a_ready(u); attn_unit<THRL>(u.bh/NHEAD,u.bh%NHEAD,u.qb,T.Q,T.K,T.V,T.O,lds,T.mref); S.done(u); }
}
#undef SBAR
#undef WAIT_BAR
}
#define GAS __attribute__((address_space(1)))
#define LAS __attribute__((address_space(3)))
typedef unsigned short bf16;
typedef unsigned v4u __attribute__((ext_vector_type(4)));
typedef float f32x4 __attribute__((ext_vector_type(4)));
typedef short bf16x8 __attribute__((ext_vector_type(8)));
typedef GAS unsigned gu32;
typedef GAS unsigned long long gu64;
#define RLX_AGENT __ATOMIC_RELAXED, __HIP_MEMORY_SCOPE_AGENT
#define LDS_WAIT() asm volatile("s_waitcnt lgkmcnt(0)" ::: "memory")
#define VM_WAIT() asm volatile("s_waitcnt vmcnt(0)" ::: "memory")
__device__ __forceinline__ unsigned long long rt() { return __builtin_amdgcn_s_memrealtime(); }

#define XB_TMO      128
#define XB_XCNT(j)  (256  + 64 * (j))
#define XB_XSUB(j)  (1280 + 64 * (j))
#define XB_XGEN(j)  (2304 + 64 * (j))
#define XB_TOP      3328
#define XB_TOPGEN   3392
#define XCD_BAR_WORDS 3456
#define XB_SPIN_CAP (1u << 18)

__device__ __forceinline__ unsigned xb_ld(unsigned* p)              { return __hip_atomic_load(p, __ATOMIC_RELAXED, __HIP_MEMORY_SCOPE_AGENT); }
__device__ __forceinline__ unsigned xb_add(unsigned* p, unsigned v) { return __hip_atomic_fetch_add(p, v, __ATOMIC_RELAXED, __HIP_MEMORY_SCOPE_AGENT); }
__device__ __forceinline__ unsigned xb_xcc_id() { return (unsigned)__builtin_amdgcn_s_getreg((3 << 11) | 20) & 0xFu; }
#define XB_SPIN(cond, bar) do { unsigned _sp = 0; while (cond) { __builtin_amdgcn_s_sleep(1); \
    if ((++_sp & 255u) == 0u) { if (xb_ld(&(bar)[XB_TMO])) break; if (_sp > XB_SPIN_CAP) { atomicAdd(&(bar)[XB_TMO], 1u); break; } } } } while (0)

struct XcdBarrier {
    unsigned* bar; unsigned x;
    volatile LAS unsigned* st;
};

__device__ __forceinline__ XcdBarrier xcd_barrier_post(unsigned* bar, volatile LAS unsigned* st) {
    XcdBarrier b; b.bar = bar; b.x = xb_xcc_id(); b.st = st;
    if (threadIdx.x == 0) (void)xb_add(&bar[XB_XCNT(b.x)], 1u);
    return b;
}
__device__ __forceinline__ void xcd_barrier_complete(unsigned* bar, unsigned x, unsigned& nloc, unsigned& nx) {
    const unsigned G = gridDim.x * gridDim.y * gridDim.z;
    unsigned sum, cnt, mine, sp = 0u;
    for (;;) {
        sum = 0u; cnt = 0u; mine = 0u;
#pragma unroll
        for (unsigned j = 0; j < 16; ++j) { const unsigned c = xb_ld(&bar[XB_XCNT(j)]); sum += c; cnt += (c > 0u) ? 1u : 0u; mine = (j == x) ? c : mine; }
        if (sum == G) break;
        __builtin_amdgcn_s_sleep(1);
        if ((++sp & 255u) == 0u) { if (xb_ld(&bar[XB_TMO])) break; if (sp > XB_SPIN_CAP) { atomicAdd(&bar[XB_TMO], 1u); break; } }
    }
    nloc = mine > 0u ? mine : 1u; nx = cnt > 0u ? cnt : 1u;
}

__device__ __forceinline__ void xcd_barrier(const XcdBarrier& b) {
    asm volatile("s_waitcnt vmcnt(0)" ::: "memory");
    __syncthreads();
    if (threadIdx.x == 0) {
        unsigned* bar = b.bar;
        __builtin_amdgcn_s_waitcnt(0);
        unsigned nloc = b.st[0], nx = b.st[1];
        if (nloc == 0u) { xcd_barrier_complete(bar, b.x, nloc, nx); b.st[0] = nloc; b.st[1] = nx; }
        const unsigned old = xb_add(&bar[XB_XSUB(b.x)], 1u);
        const unsigned gen = old / nloc;
        if (old + 1u == (gen + 1u) * nloc) {
            __builtin_amdgcn_fence(__ATOMIC_RELEASE, "agent");
            asm volatile("s_waitcnt vmcnt(0)" ::: "memory");
            const unsigned og = xb_add(&bar[XB_TOP], 1u);
            const unsigned tg = og / nx;
            if (og + 1u == (tg + 1u) * nx) xb_add(&bar[XB_TOPGEN], 1u);
            else XB_SPIN(xb_ld(&bar[XB_TOPGEN]) == tg, bar);
            __builtin_amdgcn_fence(__ATOMIC_ACQUIRE, "agent");
            xb_add(&bar[XB_XGEN(b.x)], 1u);
            asm volatile("s_waitcnt vmcnt(0)" ::: "memory");
        } else {
            XB_SPIN(xb_ld(&bar[XB_XGEN(b.x)]) == gen, bar);
            __builtin_amdgcn_fence(__ATOMIC_ACQUIRE, "agent");
            asm volatile("s_waitcnt vmcnt(0)" ::: "memory");
        }
    }
    __syncthreads();
}
#define HD __device__ __forceinline__
#define FFT_ASM_CMUL 1
#define FFT_DEVICE 1
#define OPAQUE(x) asm volatile("" : "+v"(x))
typedef _Float16 hc __attribute__((ext_vector_type(2)));
typedef float cf __attribute__((ext_vector_type(2)));
HD int fft_pad(int i) { return i + ((i >> 6) << 2); }
constexpr int FFT_N = 16384;
constexpr int FFT_LDS_ELEMS = FFT_N + (FFT_N >> 6) * 4;
constexpr int TW_A = 0, TW_B = 16384, TW_C = 16384 + 1024, TW_ELEMS = 16384 + 1024 + 64;
#ifdef FFT_ASM_CMUL
HD hc hmul(hc a, hc b) { hc t, r;
    asm("v_pk_mul_f16 %0, %1, %2 op_sel:[0,0] op_sel_hi:[0,1]" : "=v"(t) : "v"(a), "v"(b));
    asm("v_pk_fma_f16 %0, %1, %2, %3 op_sel:[1,1,0] op_sel_hi:[1,0,1] neg_lo:[1,0,0] neg_hi:[0,0,0]" : "=v"(r) : "v"(a), "v"(b), "v"(t));
    return r; }
HD hc hmulc(hc a, hc b) { hc t, r;
    asm("v_pk_mul_f16 %0, %1, %2 op_sel:[0,0] op_sel_hi:[0,1] neg_lo:[0,0] neg_hi:[0,1]" : "=v"(t) : "v"(a), "v"(b));
    asm("v_pk_fma_f16 %0, %1, %2, %3 op_sel:[1,1,0] op_sel_hi:[1,0,1] neg_lo:[0,0,0] neg_hi:[0,0,0]" : "=v"(r) : "v"(a), "v"(b), "v"(t));
    return r; }
HD hc add_mi(hc a, hc b) { hc r; asm("v_pk_add_f16 %0, %1, %2 op_sel:[0,1] op_sel_hi:[1,0] neg_lo:[0,0] neg_hi:[0,1]" : "=v"(r) : "v"(a), "v"(b)); return r; }
HD hc sub_mi(hc a, hc b) { hc r; asm("v_pk_add_f16 %0, %1, %2 op_sel:[0,1] op_sel_hi:[1,0] neg_lo:[0,1] neg_hi:[0,0]" : "=v"(r) : "v"(a), "v"(b)); return r; }
#else
HD hc hmul(hc a, hc b) { const hc t = hc{(_Float16)(a.x * b.x), (_Float16)(a.x * b.y)}; return hc{(_Float16)(-a.y * b.y + t.x), (_Float16)(a.y * b.x + t.y)}; }
HD hc hmulc(hc a, hc b) { const hc t = hc{(_Float16)(a.x * b.x), (_Float16)(-(a.x * b.y))}; return hc{(_Float16)(a.y * b.y + t.x), (_Float16)(a.y * b.x + t.y)}; }
HD hc add_mi(hc a, hc b) { return hc{(_Float16)(a.x + b.y), (_Float16)(a.y - b.x)}; }
HD hc sub_mi(hc a, hc b) { return hc{(_Float16)(a.x - b.y), (_Float16)(a.y + b.x)}; }
#endif
typedef _Float16 hc2v __attribute__((ext_vector_type(4)));
#ifdef FFT_DEVICE
HD __attribute__((address_space(3))) hc2v* zb2(__attribute__((address_space(3))) hc* p) { return (__attribute__((address_space(3))) hc2v*)p; }
#else
inline hc2v* zb2(hc* p) { return (hc2v*)p; }
#endif
template <bool INV> HD void dft4(hc& a0, hc& a1, hc& a2, hc& a3) {
    const hc t0 = a0 + a2, t1 = a0 - a2, t2 = a1 + a3, t3 = a1 - a3;
    a0 = t0 + t2; a2 = t0 - t2;
    if (!INV) { a1 = add_mi(t1, t3); a3 = sub_mi(t1, t3); } else { a1 = sub_mi(t1, t3); a3 = add_mi(t1, t3); }
}
template <bool INV> HD void dft16(hc (&x)[16]) {
#pragma unroll
    for (int m0 = 0; m0 < 4; ++m0) dft4<INV>(x[m0], x[4 + m0], x[8 + m0], x[12 + m0]);
    const float C1 = 0.92387953251128674f, S1 = 0.38268343236508977f, R2 = 0.70710678118654752f;
#define TW(r, c, s) { const hc w = hc{(_Float16)(c), (_Float16)(-(s))}; x[r] = INV ? hmulc(x[r], w) : hmul(x[r], w); }
    TW(5, C1, S1) TW(6, R2, R2) TW(7, S1, C1) TW(9, R2, R2) TW(10, 0.f, 1.f) TW(11, -R2, R2) TW(13, S1, C1) TW(14, -R2, R2) TW(15, -C1, -S1)
#undef TW
#pragma unroll
    for (int q1 = 0; q1 < 4; ++q1) dft4<INV>(x[4 * q1], x[4 * q1 + 1], x[4 * q1 + 2], x[4 * q1 + 3]);
}
template <int ST, int TS, class Z, class TT> HD void r16_fwd2(Z zb, TT tw) {
    hc x0[16], x1[16];
#pragma unroll
    for (int m = 0; m < 16; ++m) { const hc2v v = *zb2(zb + ST * m); x0[m] = hc{v.x, v.y}; x1[m] = hc{v.z, v.w}; }
    dft16<false>(x0); dft16<false>(x1);
    const hc sc = hc{(_Float16)0.0625f, (_Float16)0.0625f};
#pragma unroll
    for (int r = 0; r < 16; ++r) { const int q = (r >> 2) + 4 * (r & 3); hc y0, y1;
        if (q == 0) { y0 = x0[r] * sc; y1 = x1[r] * sc; }
        else { const hc2v t = *zb2(tw + TS * q); y0 = hmul(x0[r], hc{t.x, t.y}); y1 = hmul(x1[r], hc{t.z, t.w}); }
        *zb2(zb + ST * q) = hc2v{y0.x, y0.y, y1.x, y1.y}; }
}
template <int ST, int TS, class Z, class TT> HD void r16_inv2(Z zb, TT tw) {
    hc x0[16], x1[16];
    const hc sc = hc{(_Float16)0.0625f, (_Float16)0.0625f};
#pragma unroll
    for (int q = 0; q < 16; ++q) { const hc2v v = *zb2(zb + ST * q); const hc v0 = hc{v.x, v.y}, v1 = hc{v.z, v.w};
        if (q == 0) { x0[q] = v0 * sc; x1[q] = v1 * sc; }
        else { const hc2v t = *zb2(tw + TS * q); x0[q] = hmulc(v0, hc{t.x, t.y}); x1[q] = hmulc(v1, hc{t.z, t.w}); } }
    dft16<true>(x0); dft16<true>(x1);
#pragma unroll
    for (int r = 0; r < 16; ++r) { const int m = (r >> 2) + 4 * (r & 3); *zb2(zb + ST * m) = hc2v{x0[r].x, x0[r].y, x1[r].x, x1[r].y}; }
}
template <class Z, class TT> HD void fft_pass_fwd(Z z, TT tw, int tid, int stage) {
    OPAQUE(tid);
    const int bid = 2 * tid;
    if (stage == 0) r16_fwd2<1088, 1024>(z + fft_pad(bid), tw + TW_A + bid);
    else if (stage == 1) r16_fwd2<68, 64>(z + fft_pad((bid >> 6) * 1024 + (bid & 63)), tw + TW_B + (bid & 63));
    else r16_fwd2<4, 4>(z + fft_pad((bid >> 2) * 64 + (bid & 3)), tw + TW_C + (bid & 3));
}
template <class Z, class TT> HD void fft_pass_inv(Z z, TT tw, int tid, int stage) {
    OPAQUE(tid);
    const int bid = 2 * tid;
    if (stage == 0) r16_inv2<1088, 1024>(z + fft_pad(bid), tw + TW_A + bid);
    else if (stage == 1) r16_inv2<68, 64>(z + fft_pad((bid >> 6) * 1024 + (bid & 63)), tw + TW_B + (bid & 63));
    else r16_inv2<4, 4>(z + fft_pad((bid >> 2) * 64 + (bid & 3)), tw + TW_C + (bid & 3));
}
template <class Z> HD void fft_pass_d_fwd(Z z, int tid) {
    OPAQUE(tid);
    const hc q4 = hc{(_Float16)0.25f, (_Float16)0.25f};
#pragma unroll 1
    for (int r = 0; r < 8; ++r) { const int pb = fft_pad(4 * (tid + 512 * r));
        hc a0 = z[pb], a1 = z[pb + 1], a2 = z[pb + 2], a3 = z[pb + 3]; dft4<false>(a0, a1, a2, a3); z[pb] = a0 * q4; z[pb + 1] = a1 * q4; z[pb + 2] = a2 * q4; z[pb + 3] = a3 * q4; }
}
struct KPre { hc k[8][4]; };
HD void fft_dkd_prefetch(KPre& kp, const hc* K, int tid) {
#pragma unroll
    for (int r = 0; r < 8; ++r) { const int b4 = 4 * (tid + 512 * r);
#pragma unroll
        for (int i = 0; i < 4; ++i) kp.k[r][i] = K[b4 + i]; }
}
template <class Z> HD void fft_pass_dkd(Z z, const KPre& kp, int tid) {
    OPAQUE(tid);
#pragma unroll
    for (int r = 0; r < 8; ++r) { const int b4 = 4 * (tid + 512 * r); const int pb = fft_pad(b4);
        hc a0 = z[pb], a1 = z[pb + 1], a2 = z[pb + 2], a3 = z[pb + 3]; dft4<false>(a0, a1, a2, a3);
        a0 = hmul(a0, kp.k[r][0]); a1 = hmul(a1, kp.k[r][1]); a2 = hmul(a2, kp.k[r][2]); a3 = hmul(a3, kp.k[r][3]);
        dft4<true>(a0, a1, a2, a3); z[pb] = a0; z[pb + 1] = a1; z[pb + 2] = a2; z[pb + 3] = a3; }
}
constexpr int NWAVES = 8;
#ifndef MK_N_LAUNCHES
#define MK_N_LAUNCHES 1
#endif
constexpr int N_PHASES = 11;
constexpr int N_LAUNCHES = MK_N_LAUNCHES;

constexpr int NB = 4, T = 8192, D = 1024, M = NB * T;
constexpr int HW = 512, AW = 512, KVW = 128;
constexpr int INC = 4352, NHY = 1536, NREST = INC - NHY;
constexpr int PR_Q = 0, PR_K = 512, PR_V = 640, PR_GH = 768, PR_GA = 1792;
constexpr int NE = 32, TOPK = 4, FF = 1024, RB_MAX = 544, P_MAX = RB_MAX * 256;
constexpr float EPS = 1e-6f;
constexpr int TPB = 128;

constexpr size_t MiB = 1u << 20;
constexpr size_t WS_CTL = 0, CTL_ZERO_BYTES = 1 * MiB;
constexpr size_t WS_WIN = 1 * MiB;
constexpr size_t WS_WHU = 10 * MiB, WS_WAU = 11 * MiB, WS_WOUT = 12 * MiB;
constexpr size_t WS_WRT = 14 * MiB;
constexpr size_t WS_TOKROWS = 14 * MiB + 512 * 1024;
constexpr size_t WS_ROWGATE = 15 * MiB;
constexpr size_t WS_ENT = 16 * MiB;
constexpr size_t WS_SRC = 18 * MiB;
constexpr size_t WS_W1 = 19 * MiB;
constexpr size_t WS_W2 = 147 * MiB;
constexpr size_t WS_XN = 211 * MiB;
constexpr size_t WS_EARLY = 275 * MiB;
constexpr size_t WS_ZT = WS_EARLY;
constexpr size_t WS_PR = WS_ZT + 96 * MiB;
constexpr size_t WS_QO = WS_PR + 176 * MiB;
constexpr size_t WS_KB = WS_QO + 32 * MiB, WS_VB = WS_KB + 8 * MiB;
constexpr size_t WS_HT = WS_VB + 8 * MiB;
constexpr size_t WS_KSP = WS_HT + 64 * MiB;
constexpr size_t WS_Y1S = WS_KSP + 64 * MiB;
constexpr size_t WS_YHT = WS_Y1S + 16 * MiB;
constexpr size_t WS_YH = WS_YHT + 32 * MiB;
constexpr size_t WS_MG = WS_YH + 32 * MiB;
constexpr size_t WS_EARLY_END = WS_MG + 64 * MiB;
constexpr size_t WS_AO = WS_EARLY_END;
constexpr size_t WS_HB = WS_AO + 32 * MiB;
static_assert(WS_HB + 64 * MiB <= 1024 * MiB, "d_ws map");
constexpr size_t WS_XG = WS_EARLY;
constexpr size_t WS_H1 = WS_XG + 272 * MiB;
constexpr size_t WS_END = 1024 * MiB;
static_assert(WS_EARLY_END <= WS_END && WS_H1 + 272 * MiB <= WS_END && WS_H1 >= WS_PR + 176 * MiB, "d_ws map");
constexpr int CW_CNT = 64;
constexpr int CW_BAR = 4096;

constexpr int RING_OFF = 0, RING_BYTES = 139520;
constexpr int FFT_TW_OFF = 69632;
constexpr int LX_MISC = RING_BYTES;
constexpr int LX_RBE = LX_MISC + 256;
constexpr int LX_CNT = LX_RBE + 2304;
constexpr int LX_ENT = LX_CNT + 512;
constexpr int LX_RED = LX_ENT + TPB * 4 * 16;
constexpr int LX_GIDX = LX_RED + 256;
constexpr int GIDX_UNITS = 17;
constexpr int LDS_BYTES = LX_GIDX + GIDX_UNITS * 512;
static_assert(LDS_BYTES <= 163840, "LDS map");

struct Frame {
    LAS unsigned char* lds;
    volatile LAS unsigned* MISC;
    gu32* ctl;
    int tid, lane, wave, vcu, G;
    unsigned char* ws;
    const float* in[26]; float* out;
};
__device__ __forceinline__ float wave_sum(float v) {
#pragma unroll
    for (int o = 1; o < 64; o <<= 1) v += __shfl_xor(v, o);
    return v;
}
__device__ __forceinline__ unsigned pk2(float lo, float hi) { return pg8::cvt_pk_bf16(lo, hi); }
__device__ __forceinline__ float bflo(unsigned w) { return __uint_as_float(w << 16); }
__device__ __forceinline__ float bfhi(unsigned w) { return __uint_as_float(w & 0xffff0000u); }
__device__ __forceinline__ float bf1(unsigned short h) { return __uint_as_float((unsigned)h << 16); }
__device__ __forceinline__ float sin_rev(float r) { return __builtin_amdgcn_sinf(r); }
__device__ __forceinline__ float cos_rev(float r) { return __builtin_amdgcn_cosf(r); }

struct P0Item { const float* W; bf16* WT; int K, N, item, mode; };
__device__ __forceinline__ void p0_item_load(const P0Item& it, f32x4 (&v)[8], int lane) {
    const int nblk = it.N / 32, kb = it.item / nblk, nb = it.item % nblk, k0 = 64 * kb, n0 = 32 * nb;
    const float* src = it.W + (size_t)(k0 + 8 * (lane >> 3)) * it.N + n0 + 4 * (lane & 7);
#pragma unroll
    for (int i = 0; i < 8; ++i) v[i] = *(const GAS f32x4*)(src + (size_t)i * it.N);
}
template <int NOST>
__device__ __forceinline__ void p0_item_store(const P0Item& it, const f32x4 (&v)[8], int lane) {
    const int nblk = it.N / 32, kb = it.item / nblk, nb = it.item % nblk, k0 = 64 * kb, n0 = 32 * nb;
#pragma unroll
    for (int nn = 0; nn < 4; ++nn) { const int n = n0 + 4 * (lane & 7) + nn;
        v4u o; o.x = pk2(v[0][nn], v[1][nn]); o.y = pk2(v[2][nn], v[3][nn]); o.z = pk2(v[4][nn], v[5][nn]); o.w = pk2(v[6][nn], v[7][nn]);
        int dr;
        if (it.mode == 0) dr = n;
        else { const int jj = n >> 1; dr = (jj >> 7) * 256 + (n & 1) * 128 + (jj & 127); }
        if (!NOST) *(GAS v4u*)(it.WT + (size_t)dr * it.K + k0 + 8 * (lane >> 3)) = o; else asm volatile("" :: "v"(o), "v"(dr)); }
}
__device__ __forceinline__ unsigned cvt4_fp8(float a, float b, float c, float d) { int w = 0; w = __builtin_amdgcn_cvt_pk_fp8_f32(a, b, w, false); w = __builtin_amdgcn_cvt_pk_fp8_f32(c, d, w, true); return (unsigned)w; }
constexpr float WSCALE = 32.0f, ASCALE = 8.0f, HSCALE = 4.0f, YSCALE = 16.0f;
__device__ __forceinline__ void p0_item8_load(const P0Item& it, f32x4 (&v)[16], int lane) {
    const int nblk = it.N / 32, kb = it.item / nblk, nb = it.item % nblk, k0 = 128 * kb, n0 = 32 * nb;
    const float* src = it.W + (size_t)(k0 + 16 * (lane >> 3)) * it.N + n0 + 4 * (lane & 7);
#pragma unroll
    for (int i = 0; i < 16; ++i) v[i] = *(const GAS f32x4*)(src + (size_t)i * it.N);
}
__device__ __forceinline__ void p0_item8_store(const P0Item& it, const f32x4 (&v)[16], int lane) {
    const int nblk = it.N / 32, kb = it.item / nblk, nb = it.item % nblk, k0 = 128 * kb, n0 = 32 * nb;
    unsigned char* WT8 = (unsigned char*)it.WT;
#pragma unroll
    for (int nn = 0; nn < 4; ++nn) { const int n = n0 + 4 * (lane & 7) + nn;
        v4u o;
#pragma unroll
        for (int w = 0; w < 4; ++w) o[w] = cvt4_fp8(v[4 * w][nn] * WSCALE, v[4 * w + 1][nn] * WSCALE, v[4 * w + 2][nn] * WSCALE, v[4 * w + 3][nn] * WSCALE);
        int dr;
        if (it.mode == 0) dr = n;
        else { const int jj = n >> 1; dr = (jj >> 7) * 256 + (n & 1) * 128 + (jj & 127); }
        *(GAS v4u*)(WT8 + (size_t)dr * it.K + k0 + 16 * (lane >> 3)) = o; }
}
template <int NR>
__device__ __forceinline__ void rms_rows_to_bf16(const float* x, const float* g, bf16* o, int m, int rs, int lane) {
    f32x4 v[NR][4];
#pragma unroll
    for (int r = 0; r < NR; ++r) { const GAS f32x4* xr = (const GAS f32x4*)(x + (size_t)(m + r * rs) * D) + lane;
#pragma unroll
        for (int j = 0; j < 4; ++j) v[r][j] = xr[64 * j]; }
    const GAS f32x4* gr = (const GAS f32x4*)g + lane; f32x4 gg[4];
#pragma unroll
    for (int j = 0; j < 4; ++j) gg[j] = gr[64 * j];
#pragma unroll
    for (int r = 0; r < NR; ++r) { float s = 0.f;
#pragma unroll
        for (int j = 0; j < 4; ++j) s += (v[r][j].x * v[r][j].x + v[r][j].y * v[r][j].y) + (v[r][j].z * v[r][j].z + v[r][j].w * v[r][j].w);
        const float rstd = 1.f / sqrtf(wave_sum(s) * (1.f / D) + EPS);
        GAS unsigned long long* o8 = (GAS unsigned long long*)(o + (size_t)(m + r * rs) * D) + lane;
#pragma unroll
        for (int j = 0; j < 4; ++j) o8[64 * j] = (unsigned long long)pk2(v[r][j].x * rstd * gg[j].x, v[r][j].y * rstd * gg[j].y) | ((unsigned long long)pk2(v[r][j].z * rstd * gg[j].z, v[r][j].w * rstd * gg[j].w) << 32); }
}
__device__ __forceinline__ void p0_filter_tile(Frame& F, int tile) {
    LAS float* feats = (LAS float*)(F.lds + RING_OFF);
    LAS float* h1 = feats + 32 * 36;
    LAS float* h2 = h1 + 32 * 64;
    LAS float* w1s = h2 + 32 * 64;
    LAS float* w2s = w1s + 33 * 64;
    const float *fw1 = F.in[5], *fb1 = F.in[6], *ff1 = F.in[7], *fw2 = F.in[8], *fb2 = F.in[9], *ff2 = F.in[10], *fw3 = F.in[11], *fb3 = F.in[12];
    float* HT = (float*)(F.ws + WS_HT);
    const int tid = F.tid;
    for (int i = tid; i < 33 * 64; i += NWAVES * 64) w1s[i] = fw1[i];
    for (int i = tid; i < 64 * 64; i += NWAVES * 64) w2s[i] = fw2[i];
    for (int i = tid; i < 32 * 33; i += NWAVES * 64) { const int r = i / 33, f = i % 33, t = tile * 32 + r; float val;
        if (f == 0) val = (float)t * (1.0f / 8191.0f);
        else { const int bi = (f - 1) & 15; const float fr = 1e-4f + (float)bi * ((15.0f - 1e-4f) / 15.0f); float rev = (float)t * fr * (1.0f / 8192.0f); rev -= floorf(rev);
               val = (f <= 16) ? cos_rev(rev) : -sin_rev(rev); }
        feats[r * 36 + f] = val; }
    __syncthreads();
#pragma unroll 1
    for (int k = 0; k < 4; ++k) { const int i = tid + 512 * k, r = i >> 6, n = i & 63; float a = fb1[n];
#pragma unroll 11
        for (int f = 0; f < 33; ++f) a += feats[r * 36 + f] * w1s[f * 64 + n];
        float rev = ff1[n] * a * 0.15915494309189535f; rev -= rintf(rev); h1[r * 64 + n] = sin_rev(rev); }
    __syncthreads();
#pragma unroll 1
    for (int k = 0; k < 4; ++k) { const int i = tid + 512 * k, r = i >> 6, n = i & 63; float a = fb2[n];
#pragma unroll 16
        for (int f = 0; f < 64; ++f) a += h1[r * 64 + f] * w2s[f * 64 + n];
        float rev = ff2[n] * a * 0.15915494309189535f; rev -= rintf(rev); h2[r * 64 + n] = sin_rev(rev); }
    __syncthreads();
    { typedef float f32x16 __attribute__((ext_vector_type(16)));
      const int lane = F.lane, r32 = lane & 31, hi = lane >> 5;
      float a[32];
#pragma unroll
      for (int s = 0; s < 32; ++s) a[s] = h2[r32 * 64 + 2 * s + hi];
#pragma unroll 1
      for (int i = 0; i < 8; ++i) { const int col = 32 * (F.wave + 8 * i) + r32; float bq[32];
#pragma unroll
          for (int s = 0; s < 32; ++s) bq[s] = fw3[(2 * s + hi) * 2048 + col];
          f32x16 acc = {};
#pragma unroll
          for (int s = 0; s < 32; ++s) acc = __builtin_amdgcn_mfma_f32_32x32x2f32(a[s], bq[s], acc, 0, 0, 0);
          const float bias = fb3[col]; const int c = col & 511;
          const float delta = 3.0701134573253945f + (float)c * ((15.350567286626973f - 3.0701134573253945f) / 511.0f);
          float* dst = HT + (size_t)col * T + tile * 32 + 4 * hi;
#pragma unroll
          for (int g = 0; g < 4; ++g) { f32x4 o;
#pragma unroll
              for (int q = 0; q < 4; ++q) { const float tl = (float)(tile * 32 + 8 * g + 4 * hi + q) * (1.0f / 8191.0f); o[q] = (acc[4 * g + q] + bias) * __expf(-tl * delta); }
              *(f32x4*)(dst + 8 * g) = o; } } }
    __syncthreads();
}
__device__ __forceinline__ P0Item p0_item(Frame& F, int r) {
    constexpr int I_IN = (D / 64) * (INC / 32), I_UP = (512 / 64) * (D / 32);
    if (r < I_IN) return P0Item{F.in[2], (bf16*)(F.ws + WS_WIN), D, INC, r, 0}; r -= I_IN;
    if (r < I_UP) return P0Item{F.in[16], (bf16*)(F.ws + WS_WHU), 512, D, r, 0}; r -= I_UP;
    if (r < I_UP) return P0Item{F.in[17], (bf16*)(F.ws + WS_WAU), 512, D, r, 0}; r -= I_UP;
    return P0Item{F.in[18], (bf16*)(F.ws + WS_WOUT), D, D, r, 0};
}
__device__ __forceinline__ P0Item p0_item8(Frame& F, int r) {
    constexpr int I_W1 = (D / 128) * (2 * FF / 32), I_W2 = (FF / 128) * (D / 32);
    if (r < NE * I_W1) { const int e = r / I_W1; return P0Item{F.in[22] + (size_t)e * D * 2 * FF, (bf16*)(F.ws + WS_W1 + (size_t)e * 2 * FF * D), D, 2 * FF, r % I_W1, 1}; } r -= NE * I_W1;
    { const int e = r / I_W2; return P0Item{F.in[24] + (size_t)e * FF * D, (bf16*)(F.ws + WS_W2 + (size_t)e * D * FF), FF, D, r % I_W2, 0}; }
}
#ifndef PROBE_SUB
#define PROBE_SUB 0
#endif
__device__ __forceinline__ void p0_xn(Frame& F) {
    const int gw = F.vcu * NWAVES + F.wave, NGW = F.G * NWAVES;
    bf16* XN = (bf16*)(F.ws + WS_XN);
    for (int m = gw; m < M; m += 4 * NGW) rms_rows_to_bf16<4>(F.in[0], F.in[1], XN, m, NGW, F.lane);
}
template <int NOST>
__device__ __forceinline__ void p0_transposes(Frame& F) {
    const int gw = F.vcu * NWAVES + F.wave, NGW = F.G * NWAVES;
    constexpr int NITEMS = (D / 64) * (INC / 32) + 2 * (512 / 64) * (D / 32) + (D / 64) * (D / 32);
    static_assert(NITEMS % 4 == 0, "items are taken four at a time");
    for (int it = 4 * gw; it < NITEMS; it += 4 * NGW) {
        const P0Item a = p0_item(F, it), b = p0_item(F, it + 1), c = p0_item(F, it + 2), d = p0_item(F, it + 3);
        f32x4 va[8], vb[8], vc[8], vd[8];
        p0_item_load(a, va, F.lane); p0_item_load(b, vb, F.lane); p0_item_load(c, vc, F.lane); p0_item_load(d, vd, F.lane);
        p0_item_store<NOST>(a, va, F.lane); p0_item_store<NOST>(b, vb, F.lane); p0_item_store<NOST>(c, vc, F.lane); p0_item_store<NOST>(d, vd, F.lane);
    }
    constexpr int NITEMS8 = NE * ((D / 128) * (2 * FF / 32) + (FF / 128) * (D / 32));
    static_assert(NITEMS8 % 2 == 0, "expert items are taken two at a time");
    for (int it = 2 * gw; it < NITEMS8; it += 2 * NGW) {
        const P0Item a = p0_item8(F, it), b = p0_item8(F, it + 1);
        f32x4 va[16], vb[16];
        p0_item8_load(a, va, F.lane); p0_item8_load(b, vb, F.lane);
        p0_item8_store(a, va, F.lane); p0_item8_store(b, vb, F.lane);
    }
}
__device__ __forceinline__ void p0_prologue(Frame& F) {
    p0_xn(F); if (PROBE_SUB & 1) p0_xn(F);
    for (int tile = F.vcu; tile < T / 32; tile += F.G) p0_filter_tile(F, tile);
    if (PROBE_SUB & 2) for (int tile = F.vcu; tile < T / 32; tile += F.G) p0_filter_tile(F, tile);
    p0_transposes<0>(F); if (PROBE_SUB & 4) p0_transposes<0>(F); if (PROBE_SUB & 512) p0_transposes<1>(F);
    float* wrt = (float*)(F.ws + WS_WRT);
    for (int i = F.vcu * NWAVES * 64 + F.tid; i < NE * D; i += F.G * NWAVES * 64) { const int e = i >> 10, d = i & 1023; wrt[i] = F.in[20][d * NE + e]; }
}

__device__ __forceinline__ void rope8f(const v4u raw, float rms, const float* g, int d0, int trow, int tcol, float scale, float (&o)[8]) {
    float x[8];
#pragma unroll
    for (int i = 0; i < 4; ++i) { x[2 * i] = bflo(raw[i]) * rms * g[d0 + 2 * i]; x[2 * i + 1] = bfhi(raw[i]) * rms * g[d0 + 2 * i + 1]; }
#pragma unroll
    for (int i = 0; i < 4; ++i) { const int pi = (d0 >> 1) + i;
        const float freq = __builtin_amdgcn_exp2f(-(float)(pi & 15) * (13.287712379549449f / 16.0f));
        float rev = (float)(pi < 16 ? trow : tcol) * freq * 0.15915494309189535f; rev -= floorf(rev);
        const float c = cos_rev(rev), sn = sin_rev(rev);
        o[2 * i] = (x[2 * i] * c - x[2 * i + 1] * sn) * scale; o[2 * i + 1] = (x[2 * i] * sn + x[2 * i + 1] * c) * scale; }
}
constexpr float QSCALE8 = 8.0f, VSCALE8 = 4.0f;
__device__ __forceinline__ void p2_qkprep(Frame& F) {
    const bf16* PR = (const bf16*)(F.ws + WS_PR); unsigned char* Q8 = (unsigned char*)(F.ws + WS_QO); unsigned char* K8 = (unsigned char*)(F.ws + WS_KB);
    const float* qg = F.in[14]; const float* kg = F.in[15];
    const int gw = F.vcu * NWAVES + F.wave, NGW = F.G * NWAVES, lane = F.lane;
    typedef unsigned u32x2v __attribute__((ext_vector_type(2)));
    for (int m = gw; m < M; m += NGW) {
        const int t = m & (T - 1), trow = t >> 6, tcol = t & 63;
        const bf16* pr = PR + (size_t)m * NREST;
        { const v4u raw = *(const GAS v4u*)(pr + PR_Q + 8 * lane); float ss = 0.f;
#pragma unroll
          for (int i = 0; i < 4; ++i) { const float a = bflo(raw[i]), b = bfhi(raw[i]); ss += a * a + b * b; }
          ss += __shfl_xor(ss, 1); ss += __shfl_xor(ss, 2); ss += __shfl_xor(ss, 4);
          const float rms = 1.f / sqrtf(ss * (1.f / 64.f) + EPS); float o[8];
          rope8f(raw, rms, qg, 8 * (lane & 7), trow, tcol, 0.125f * 1.4426950408889634f * QSCALE8, o);
          u32x2v w; w.x = cvt4_fp8(o[0], o[1], o[2], o[3]); w.y = cvt4_fp8(o[4], o[5], o[6], o[7]);
          *(GAS u32x2v*)(Q8 + (size_t)m * AW + 8 * lane) = w; }
    }
    for (int j = 0; gw + j * NGW < M; j += 4) {
        const int m = gw + (j + (lane >> 4)) * NGW; if (m >= M) continue;
        const int t = m & (T - 1), trow = t >> 6, tcol = t & 63, l2 = lane & 15;
        const v4u raw = *(const GAS v4u*)(PR + (size_t)m * NREST + PR_K + 8 * l2); float ss = 0.f;
#pragma unroll
        for (int i = 0; i < 4; ++i) { const float a = bflo(raw[i]), b = bfhi(raw[i]); ss += a * a + b * b; }
        ss += __shfl_xor(ss, 1); ss += __shfl_xor(ss, 2); ss += __shfl_xor(ss, 4);
        const float rms = 1.f / sqrtf(ss * (1.f / 64.f) + EPS); float o[8];
        rope8f(raw, rms, kg, 8 * (lane & 7), trow, tcol, 1.0f, o);
        u32x2v w; w.x = cvt4_fp8(o[0], o[1], o[2], o[3]); w.y = cvt4_fp8(o[4], o[5], o[6], o[7]);
        *(GAS u32x2v*)(K8 + (size_t)m * KVW + 8 * l2) = w;
    }
    unsigned char* VT8 = (unsigned char*)(F.ws + WS_VB);
    for (int it = gw; it < (M / 64) * 2; it += NGW) { const int tile = it >> 1, kvh = it & 1;
        const unsigned short* vp = (const unsigned short*)(PR + (size_t)tile * 64 * NREST + PR_V + kvh * 64 + lane);
        unsigned wv[2][8];
#pragma unroll
        for (int hh = 0; hh < 2; ++hh)
#pragma unroll
            for (int w = 0; w < 8; ++w) wv[hh][w] = 0u;
#pragma unroll
        for (int kp = 0; kp < 64; kp += 2) {
            const float a = __builtin_amdgcn_fmed3f(bf1(vp[(size_t)kp * NREST]) * VSCALE8, -448.f, 448.f), b = __builtin_amdgcn_fmed3f(bf1(vp[(size_t)(kp + 1) * NREST]) * VSCALE8, -448.f, 448.f);
            const int k5 = kp & 31, hh = (k5 >> 2) & 1, r = (k5 & 3) + 4 * (k5 >> 3), byte = r + 16 * (kp >> 5);
            if ((byte >> 1) & 1) wv[hh][byte >> 2] = (unsigned)__builtin_amdgcn_cvt_pk_fp8_f32(a, b, (int)wv[hh][byte >> 2], true); else wv[hh][byte >> 2] = (unsigned)__builtin_amdgcn_cvt_pk_fp8_f32(a, b, (int)wv[hh][byte >> 2], false); }
        unsigned char* dst = VT8 + (size_t)it * 4096 + lane * 32;
#pragma unroll
        for (int hh = 0; hh < 2; ++hh) { *(GAS v4u*)(dst + hh * 2048) = (v4u){wv[hh][0], wv[hh][1], wv[hh][2], wv[hh][3]}; *(GAS v4u*)(dst + hh * 2048 + 16) = (v4u){wv[hh][4], wv[hh][5], wv[hh][6], wv[hh][7]}; } }
}
typedef LAS hc* zptr;
#define FSYNC() __syncthreads()
#define LSYNC() asm volatile("s_waitcnt lgkmcnt(0)\n\ts_barrier" ::: "memory")
__device__ __forceinline__ float block_sum(Frame& F, float v) {
    LAS float* red = (LAS float*)(F.lds + LX_RED);
    v = wave_sum(v); if (F.lane == 0) red[F.wave] = v; __syncthreads();
    float s = 0.f;
#pragma unroll
    for (int w = 0; w < NWAVES; ++w) s += red[w];
    __syncthreads(); return s;
}
__device__ __forceinline__ hc f2h(float a, float b) { return __builtin_convertvector((cf){a, b}, hc); }
__device__ __forceinline__ void fft_tables(Frame& F) {
    zptr tw = (zptr)(F.lds + FFT_TW_OFF);
    for (int i = F.tid; i < TW_ELEMS; i += NWAVES * 64) { int jq, ls;
        if (i < TW_B) { jq = (i & 1023) * (i >> 10); ls = 16384; } else if (i < TW_C) { const int k = i - TW_B; jq = (k & 63) * (k >> 6); ls = 1024; } else { const int k = i - TW_C; jq = (k & 3) * (k >> 2); ls = 64; }
        const float rev = (float)(jq & (ls - 1)) / (float)ls;
        tw[i] = f2h(0.0625f * cos_rev(rev), -0.0625f * sin_rev(rev)); }
    __syncthreads();
}
struct Raw8 { v4u c; unsigned p, n; };
__device__ __forceinline__ Raw8 sc8_load(const bf16* row, int t0) { Raw8 r; r.c = *(const GAS v4u*)(row + t0); r.p = t0 > 0 ? (unsigned)row[t0 - 1] : 0u; r.n = t0 + 8 < T ? (unsigned)row[t0 + 8] : 0u; return r; }
__device__ __forceinline__ void sc8_eval(const Raw8& r, float w0, float w1, float w2, float b, float (&o)[8]) {
    float z[10]; z[0] = __uint_as_float(r.p << 16); z[9] = __uint_as_float(r.n << 16);
#pragma unroll
    for (int i = 0; i < 4; ++i) { z[1 + 2 * i] = bflo(r.c[i]); z[2 + 2 * i] = bfhi(r.c[i]); }
#pragma unroll
    for (int i = 0; i < 8; ++i) o[i] = b + w0 * z[i] + w1 * z[i + 1] + w2 * z[i + 2];
}
__device__ __forceinline__ void fft_fwd3(zptr Z, zptr tw, int tid) { fft_pass_fwd(Z, tw, tid, 0); LSYNC(); fft_pass_fwd(Z, tw, tid, 1); LSYNC(); fft_pass_fwd(Z, tw, tid, 2); LSYNC(); }
__device__ __forceinline__ void fft_inv3(zptr Z, zptr tw, int tid) { fft_pass_inv(Z, tw, tid, 2); LSYNC(); fft_pass_inv(Z, tw, tid, 1); LSYNC(); fft_pass_inv(Z, tw, tid, 0); LSYNC(); }
__device__ __forceinline__ void hyena_channel(Frame& F, int c) {
    zptr Z = (zptr)(F.lds + RING_OFF); zptr tw = (zptr)(F.lds + FFT_TW_OFF);
    const int tid = F.tid;
    hc* Ksp = (hc*)(F.ws + WS_KSP) + (size_t)blockIdx.x * 2 * FFT_N;
    const float* HT = (const float*)(F.ws + WS_HT);
    const bf16* ZT = (const bf16*)(F.ws + WS_ZT); bf16* YHT = (bf16*)(F.ws + WS_YHT);
    const float* cw = F.in[3]; const float* cb = F.in[4]; const float* hd = F.in[13];
    const hc hzero = f2h(0.f, 0.f);
    {
        const float* f0 = HT + (size_t)c * T; const float* b0 = HT + (size_t)(512 + c) * T; const float* f1 = HT + (size_t)(1024 + c) * T; const float* b1 = HT + (size_t)(1536 + c) * T;
        float as0 = 0.f, as1 = 0.f;
#pragma unroll
        for (int r = 0; r < 2; ++r) { int tl_ = tid; OPAQUE(tl_); const int t0 = 8 * (tl_ + 512 * r);
#pragma unroll
            for (int h = 0; h < 2; ++h) { const f32x4 fa = *(const GAS f32x4*)(f0 + t0 + 4 * h), ba = *(const GAS f32x4*)(b0 + t0 + 4 * h), fb = *(const GAS f32x4*)(f1 + t0 + 4 * h), bb = *(const GAS f32x4*)(b1 + t0 + 4 * h);
#pragma unroll
                for (int i = 0; i < 4; ++i) { const int t = t0 + 4 * h + i; Z[fft_pad(t)] = f2h(fa[i], fb[i]); as0 += fabsf(fa[i]); as1 += fabsf(fb[i]);
                    if (t >= 1) { Z[fft_pad(FFT_N - t)] = f2h(ba[i], bb[i]); as0 += fabsf(ba[i]); as1 += fabsf(bb[i]); } else Z[fft_pad(T)] = hzero; } } }
        const float S0 = block_sum(F, as0), S1 = block_sum(F, as1);
        fft_fwd3(Z, tw, tid); fft_pass_d_fwd(Z, tid); FSYNC();
        const float sc0 = 0.5f * 16384.0f * 1024.0f / S0, sc1 = 0.5f * 16384.0f * 1024.0f / S1;
#pragma unroll 2
        for (int r = 0; r < 8; ++r) { int tl_ = tid; OPAQUE(tl_); const int p0 = 4 * (tl_ + 512 * r); v4u w0, w1;
#pragma unroll
            for (int i = 0; i < 4; ++i) { const int p = p0 + i;
                const int k = (p >> 10) + 16 * ((p >> 6) & 15) + 256 * ((p >> 2) & 15) + 4096 * (p & 3), kn = (FFT_N - k) & (FFT_N - 1);
                const int pn = 1024 * (kn & 15) + 64 * ((kn >> 4) & 15) + 4 * ((kn >> 8) & 15) + (kn >> 12);
                const cf a = __builtin_convertvector(Z[fft_pad(p)], cf), b = __builtin_convertvector(Z[fft_pad(pn)], cf);
                w0[i] = __builtin_bit_cast(unsigned, f2h((a.x + b.x) * sc0, (a.y - b.y) * sc0));
                w1[i] = __builtin_bit_cast(unsigned, f2h((a.y + b.y) * sc1, (b.x - a.x) * sc1)); }
            *(GAS v4u*)(Ksp + p0) = w0; *(GAS v4u*)(Ksp + FFT_N + p0) = w1; }
        FSYNC();
    }
    const float wv0 = cw[c], wv1 = cw[NHY + c], wv2 = cw[2 * NHY + c], bv = cb[c];
    const float wa0 = cw[512 + c], wa1 = cw[NHY + 512 + c], wa2 = cw[2 * NHY + 512 + c], ba = cb[512 + c];
    const float wb0 = cw[1024 + c], wb1 = cw[NHY + 1024 + c], wb2 = cw[2 * NHY + 1024 + c], bb = cb[1024 + c];
    const float d0 = hd[c], d1 = hd[HW + c];
    const int tq0 = 8 * tid, tq1 = 8 * (tid + 512);
    Raw8 rv[2][2];
    { const bf16* v0 = ZT + (size_t)c * M; rv[0][0] = sc8_load(v0, tq0); rv[0][1] = sc8_load(v0, tq1); rv[1][0] = sc8_load(v0 + T, tq0); rv[1][1] = sc8_load(v0 + T, tq1); }
    for (int pair_ = 0; pair_ < ((PROBE_SUB & 32) ? 4 : 2); ++pair_) { const int pair = pair_ & 1;
        const bf16* a0 = ZT + (size_t)(512 + c) * M + (size_t)(2 * pair) * T;  const bf16* a1 = a0 + T;
        const bf16* b0 = ZT + (size_t)(1024 + c) * M + (size_t)(2 * pair) * T; const bf16* b1 = b0 + T;
        float x[2][2][8];
#pragma unroll
        for (int r = 0; r < 2; ++r) { const int t0 = r ? tq1 : tq0; sc8_eval(rv[0][r], wv0, wv1, wv2, bv, x[0][r]); sc8_eval(rv[1][r], wv0, wv1, wv2, bv, x[1][r]);
#pragma unroll
            for (int i = 0; i < 8; ++i) { Z[fft_pad(t0 + i)] = f2h(x[0][r][i], x[1][r][i]); Z[fft_pad(T + t0 + i)] = hzero; } }
        KPre kp; fft_dkd_prefetch(kp, (const hc*)Ksp, tid);
        Raw8 rg[2][2]; rg[0][0] = sc8_load(a0, tq0); rg[0][1] = sc8_load(a0, tq1); rg[1][0] = sc8_load(a1, tq0); rg[1][1] = sc8_load(a1, tq1);
        LSYNC();
        fft_fwd3(Z, tw, tid); fft_pass_dkd(Z, kp, tid); LSYNC();
        fft_dkd_prefetch(kp, (const hc*)(Ksp + FFT_N), tid);
        fft_inv3(Z, tw, tid);
        float y[2][2][8];
#pragma unroll
        for (int r = 0; r < 2; ++r) { const int t0 = r ? tq1 : tq0; float g0[8], g1[8]; sc8_eval(rg[0][r], wa0, wa1, wa2, ba, g0); sc8_eval(rg[1][r], wa0, wa1, wa2, ba, g1);
#pragma unroll
            for (int i = 0; i < 8; ++i) { const cf cv = __builtin_convertvector(Z[fft_pad(t0 + i)], cf); y[0][r][i] = g0[i] * (cv.x + x[0][r][i] * d0); y[1][r][i] = g1[i] * (cv.y + x[1][r][i] * d0);
                Z[fft_pad(t0 + i)] = f2h(y[0][r][i], y[1][r][i]); Z[fft_pad(T + t0 + i)] = hzero; } }
        rg[0][0] = sc8_load(b0, tq0); rg[0][1] = sc8_load(b0, tq1); rg[1][0] = sc8_load(b1, tq0); rg[1][1] = sc8_load(b1, tq1);
        { const bf16* v0 = ZT + (size_t)c * M + (size_t)(2 * ((pair + 1) & 1)) * T; rv[0][0] = sc8_load(v0, tq0); rv[0][1] = sc8_load(v0, tq1); rv[1][0] = sc8_load(v0 + T, tq0); rv[1][1] = sc8_load(v0 + T, tq1); }
        LSYNC();
        fft_fwd3(Z, tw, tid); fft_pass_dkd(Z, kp, tid); LSYNC(); fft_inv3(Z, tw, tid);
#pragma unroll
        for (int r = 0; r < 2; ++r) { const int t0 = r ? tq1 : tq0; float g0[8], g1[8]; sc8_eval(rg[0][r], wb0, wb1, wb2, bb, g0); sc8_eval(rg[1][r], wb0, wb1, wb2, bb, g1);
            float y0[8], y1[8];
#pragma unroll
            for (int i = 0; i < 8; ++i) { const cf cv = __builtin_convertvector(Z[fft_pad(t0 + i)], cf); y0[i] = g0[i] * (cv.x + y[0][r][i] * d1); y1[i] = g1[i] * (cv.y + y[1][r][i] * d1); }
            v4u w0, w1;
#pragma unroll
            for (int i = 0; i < 4; ++i) { w0[i] = pk2(y0[2 * i], y0[2 * i + 1]); w1[i] = pk2(y1[2 * i], y1[2 * i + 1]); }
            *(GAS v4u*)(YHT + (size_t)c * M + (size_t)(2 * pair) * T + t0) = w0; *(GAS v4u*)(YHT + (size_t)c * M + (size_t)(2 * pair + 1) * T + t0) = w1; }
        LSYNC();
    }
}
__device__ __forceinline__ void p3_transpose(Frame& F) {
    const unsigned short* YHT = (const unsigned short*)(F.ws + WS_YHT); unsigned short* YH = (unsigned short*)(F.ws + WS_YH);
    const int gw = F.vcu * NWAVES + F.wave, NGW = F.G * NWAVES, lane = F.lane, cb8 = lane >> 3, mb8 = lane & 7;
    for (int it = gw; it < (HW / 64) * (M / 64); it += NGW) { const int cb = it & 7, mb = it >> 3, c0 = cb * 64 + 8 * cb8, m0 = mb * 64 + 8 * mb8;
        const unsigned short* src = YHT + (size_t)c0 * M + m0;
        v4u R[8];
#pragma unroll
        for (int r = 0; r < 8; ++r) R[r] = *(const GAS v4u*)(src + (size_t)r * M);
#pragma unroll
        for (int j = 0; j < 8; ++j) { v4u o;
#pragma unroll
            for (int w = 0; w < 4; ++w) o[w] = __builtin_amdgcn_perm(R[2 * w + 1][j >> 1], R[2 * w][j >> 1], (j & 1) ? 0x07060302u : 0x05040100u);
            *(GAS v4u*)(YH + (size_t)(m0 + j) * HW + c0) = o; } }
}
typedef int RouteEnt __attribute__((ext_vector_type(4)));
__device__ __forceinline__ void top4_insert(float (&tv)[4], int (&te)[4], float v, int e) {
    if (v > tv[3]) { tv[3] = v; te[3] = e;
        if (tv[3] > tv[2]) { const float a = tv[2]; const int b = te[2]; tv[2] = tv[3]; te[2] = te[3]; tv[3] = a; te[3] = b;
            if (tv[2] > tv[1]) { const float a2 = tv[1]; const int b2 = te[1]; tv[1] = tv[2]; te[1] = te[2]; tv[2] = a2; te[2] = b2;
                if (tv[1] > tv[0]) { const float a3 = tv[0]; const int b3 = te[0]; tv[0] = tv[1]; te[0] = te[1]; tv[1] = a3; te[1] = b3; } } } }
}
__device__ __forceinline__ bool top4_before(float va, int ea, float vb, int eb) { return va > vb || (va == vb && ea < eb); }
template <int DRY>
__device__ __forceinline__ void p6_route(Frame& F) {
    typedef float f32x16 __attribute__((ext_vector_type(16)));
    constexpr int WP = 1028;
    LAS float* W = (LAS float*)(F.lds + RING_OFF);
    LAS float* rstab = (LAS float*)(F.lds + RING_OFF + 32 * WP * 4);
    LAS int* lcnt = (LAS int*)(F.lds + LX_CNT); LAS int* lbase = lcnt + 32;
    LAS RouteEnt* ent = (LAS RouteEnt*)(F.lds + LX_ENT);
    const float* wrt = (const float*)(F.ws + WS_WRT); const float* g2 = F.in[19]; const float* rb = F.in[21];
    const bf16* h = (const bf16*)(F.ws + WS_HB); bf16* HN = (bf16*)(F.ws + WS_XN);
    const int tid = F.tid, lane = F.lane;
    for (int i = tid; i < NE * D / 4; i += NWAVES * 64) { const int e = i >> 8, k4 = (i & 255) * 4; const f32x4 w = ((const GAS f32x4*)wrt)[i], g = *(const GAS f32x4*)(g2 + k4); *(LAS f32x4*)(W + e * WP + k4) = w * g; }
    if (tid < 32) lcnt[tid] = 0;
    __syncthreads();
    const int m0 = blockIdx.x * TPB;
    f32x16 acc = {};
    if (F.wave >= 4) {
        f32x4 gg[4];
#pragma unroll
        for (int j = 0; j < 4; ++j) gg[j] = ((const GAS f32x4*)g2)[lane + 64 * j];
        unsigned long long nx[4];
        { const GAS unsigned long long* xr = (const GAS unsigned long long*)(h + (size_t)(m0 + F.wave - 4) * D) + lane;
#pragma unroll
          for (int j = 0; j < 4; ++j) nx[j] = xr[64 * j]; }
        for (int lt = F.wave - 4; lt < TPB; lt += 4) { const int m = m0 + lt;
            f32x4 v[4]; float ss = 0.f;
#pragma unroll
            for (int j = 0; j < 4; ++j) { const unsigned lo = (unsigned)nx[j], hi = (unsigned)(nx[j] >> 32); v[j] = (f32x4){bflo(lo), bfhi(lo), bflo(hi), bfhi(hi)}; ss += (v[j].x * v[j].x + v[j].y * v[j].y) + (v[j].z * v[j].z + v[j].w * v[j].w); }
            if (lt + 4 < TPB) { const GAS unsigned long long* xr = (const GAS unsigned long long*)(h + (size_t)(m + 4) * D) + lane;
#pragma unroll
                for (int j = 0; j < 4; ++j) nx[j] = xr[64 * j]; }
            const float rstd = 1.f / sqrtf(wave_sum(ss) * (1.f / D) + EPS);
            if (lane == 0) rstab[lt] = rstd;
            GAS unsigned* o4 = (GAS unsigned*)((unsigned char*)HN + (size_t)m * D) + lane;
#pragma unroll
            for (int j = 0; j < 4; ++j) { v[j] = v[j] * (rstd * ASCALE) * gg[j]; o4[64 * j] = cvt4_fp8(fminf(fmaxf(v[j].x, -448.f), 448.f), fminf(fmaxf(v[j].y, -448.f), 448.f), fminf(fmaxf(v[j].z, -448.f), 448.f), fminf(fmaxf(v[j].w, -448.f), 448.f)); } }
    } else {
        const int tok = lane & 31, kh = lane >> 5;
        const GAS v4u* hp = (const GAS v4u*)(h + (size_t)(m0 + 32 * F.wave + tok) * D + 8 * kh);
        const LAS float* wp = W + tok * WP + 8 * kh;
        v4u hb[2]; hb[0] = hp[0]; hb[1] = hp[2];
#pragma unroll 2
        for (int S = 0; S < 64; ++S) { const v4u raw = hb[S & 1]; if (S + 2 < 64) hb[S & 1] = hp[2 * (S + 2)];
            const f32x4 w0 = *(const LAS f32x4*)(wp + 16 * S), w1 = *(const LAS f32x4*)(wp + 16 * S + 4);
            const float b[8] = {bflo(raw.x), bfhi(raw.x), bflo(raw.y), bfhi(raw.y), bflo(raw.z), bfhi(raw.z), bflo(raw.w), bfhi(raw.w)};
            const float a[8] = {w0.x, w0.y, w0.z, w0.w, w1.x, w1.y, w1.z, w1.w};
#pragma unroll
            for (int i = 0; i < 8; ++i) acc = __builtin_amdgcn_mfma_f32_32x32x2f32(a[i], b[i], acc, 0, 0, 0); }
    }
    __syncthreads();
    if (F.wave < 4) {
        const int tok = lane & 31, hh = lane >> 5, lt = 32 * F.wave + tok;
        const float rstd = rstab[lt];
        float tv[4] = {-INFINITY, -INFINITY, -INFINITY, -INFINITY}; int te[4] = {0, 0, 0, 0};
#pragma unroll
        for (int i = 0; i < 16; ++i) { const int e = (i & 3) + 8 * (i >> 2) + 4 * hh; top4_insert(tv, te, acc[i] * rstd + rb[e], e); }
        float pv[4]; int pe[4];
#pragma unroll
        for (int k = 0; k < 4; ++k) { pv[k] = __shfl_xor(tv[k], 32); pe[k] = __shfl_xor(te[k], 32); }
        float mv[4]; int me[4]; int ia = 0, ib = 0;
#pragma unroll
        for (int k = 0; k < 4; ++k) {
            const float va = ia == 0 ? tv[0] : ia == 1 ? tv[1] : ia == 2 ? tv[2] : tv[3]; const int ea = ia == 0 ? te[0] : ia == 1 ? te[1] : ia == 2 ? te[2] : te[3];
            const float vb = ib == 0 ? pv[0] : ib == 1 ? pv[1] : ib == 2 ? pv[2] : pv[3]; const int eb = ib == 0 ? pe[0] : ib == 1 ? pe[1] : ib == 2 ? pe[2] : pe[3];
            const bool ta = top4_before(va, ea, vb, eb); mv[k] = ta ? va : vb; me[k] = ta ? ea : eb; ia += ta ? 1 : 0; ib += ta ? 0 : 1; }
        const float e1 = __expf(mv[1] - mv[0]), e2 = __expf(mv[2] - mv[0]), e3 = __expf(mv[3] - mv[0]); const float inv = 1.0f / (1.0f + e1 + e2 + e3);
        if (hh == 0) { const float gt[4] = {inv, e1 * inv, e2 * inv, e3 * inv};
#pragma unroll
            for (int k = 0; k < 4; ++k) { const int lp = atomicAdd((int*)(lcnt + me[k]), 1); ent[lt * 4 + k] = (RouteEnt){me[k], lp, (int)__float_as_uint(gt[k]), 0}; } }
    }
    __syncthreads();
    if (DRY) return;
    if (tid < 32) lbase[tid] = (int)__hip_atomic_fetch_add(F.ctl + CW_CNT + tid, (unsigned)lcnt[tid], __ATOMIC_RELAXED, __HIP_MEMORY_SCOPE_AGENT);
    __syncthreads();
    { RouteEnt en = ent[tid]; en.y += lbase[en.x]; ((GAS RouteEnt*)(F.ws + WS_ENT))[(size_t)m0 * 4 + tid] = en; }
}
__device__ __forceinline__ void build_layout(Frame& F) {
    LAS int* pstart = (LAS int*)(F.lds + LX_CNT) + 64; LAS int* rbe = (LAS int*)(F.lds + LX_RBE); LAS int* gcnt = (LAS int*)(F.lds + LX_RED);
    __syncthreads();
    if (F.tid < 32) gcnt[F.tid] = (int)__hip_atomic_load(F.ctl + CW_CNT + F.tid, __ATOMIC_RELAXED, __HIP_MEMORY_SCOPE_AGENT);
    __syncthreads();
    if (F.tid == 0) { int rb = 0;
        for (int e = 0; e < NE; ++e) { pstart[e] = rb * 256; const int nb = (gcnt[e] + 255) >> 8; for (int b = 0; b < nb && rb < RB_MAX; ++b) rbe[rb++] = e; }
        pstart[NE] = rb * 256; F.MISC[16] = (unsigned)rb; }
    __syncthreads();
}
__device__ __forceinline__ void p7_layout(Frame& F) {
    build_layout(F);
    LAS int* pstart = (LAS int*)(F.lds + LX_CNT) + 64; LAS int* gcnt = (LAS int*)(F.lds + LX_RED);
    int* tokrows = (int*)(F.ws + WS_TOKROWS); float* rowgate = (float*)(F.ws + WS_ROWGATE); int* srctok = (int*)(F.ws + WS_SRC);
    const int m0 = blockIdx.x * TPB;
    { const int m = m0 + (F.tid >> 2), k = F.tid & 3;
      const RouteEnt en = ((const GAS RouteEnt*)(F.ws + WS_ENT))[(size_t)m * 4 + k]; const int row = pstart[en.x] + en.y;
      tokrows[m * 4 + k] = row; rowgate[row] = __uint_as_float((unsigned)en.z); srctok[row] = m; }
    if (blockIdx.x < NE) { const int e = blockIdx.x, r0 = pstart[e] + gcnt[e], r1 = pstart[e + 1];
        for (int row = r0 + F.tid; row < r1; row += NWAVES * 64) { srctok[row] = 0; rowgate[row] = 0.f; } }
}
__device__ __forceinline__ void p10_combine(Frame& F) {
    const unsigned char* Y2 = (const unsigned char*)(F.ws + WS_XG); const bf16* HB = (const bf16*)(F.ws + WS_HB); const int* tokrows = (const int*)(F.ws + WS_TOKROWS); float* out = F.out;
    const int gw = F.vcu * NWAVES + F.wave, NGW = F.G * NWAVES, lane = F.lane;
    typedef float f32x2v __attribute__((ext_vector_type(2)));
#pragma unroll 1
    for (int mm = gw; mm < M; mm += 2 * NGW) {
        int rr[2][4];
#pragma unroll
        for (int u = 0; u < 2; ++u) { const RouteEnt t4 = *(const GAS RouteEnt*)(tokrows + (size_t)(mm + u * NGW) * 4); rr[u][0] = t4.x; rr[u][1] = t4.y; rr[u][2] = t4.z; rr[u][3] = t4.w; }
#pragma unroll
        for (int u = 0; u < 2; ++u) { const int m = mm + u * NGW, col = 16 * lane;
            const v4u h0 = *(const GAS v4u*)(HB + (size_t)m * D + col), h1 = *(const GAS v4u*)(HB + (size_t)m * D + col + 8);
            v4u w[4];
#pragma unroll
            for (int k = 0; k < 4; ++k) w[k] = *(const GAS v4u*)(Y2 + (size_t)rr[u][k] * D + col);
            float a[16];
#pragma unroll
            for (int i = 0; i < 4; ++i) { a[2 * i] = bflo(h0[i]); a[2 * i + 1] = bfhi(h0[i]); a[8 + 2 * i] = bflo(h1[i]); a[8 + 2 * i + 1] = bfhi(h1[i]); }
#pragma unroll
            for (int i = 0; i < 4; ++i) { f32x2v s0 = {0.f, 0.f}, s1 = {0.f, 0.f};
#pragma unroll
                for (int k = 0; k < 4; ++k) { s0 += __builtin_amdgcn_cvt_pk_f32_fp8((int)w[k][i], false); s1 += __builtin_amdgcn_cvt_pk_f32_fp8((int)w[k][i], true); }
                a[4 * i] += s0.x * (1.0f / YSCALE); a[4 * i + 1] += s0.y * (1.0f / YSCALE); a[4 * i + 2] += s1.x * (1.0f / YSCALE); a[4 * i + 3] += s1.y * (1.0f / YSCALE); }
            float* op = out + (size_t)m * D + col;
#pragma unroll
            for (int i = 0; i < 4; ++i) *(GAS f32x4*)(op + 4 * i) = (f32x4){a[4 * i], a[4 * i + 1], a[4 * i + 2], a[4 * i + 3]}; } }
}
template <int NOSTORE = 0> __device__ __forceinline__ void ph1(Frame& F) {
    bf16* const XN = (bf16*)(F.ws + WS_XN);
    { pg8::Gemm g{(const bf16*)(F.ws + WS_WIN), XN, NHY, M, D}; pg8::StaticOrder S; S.init(NHY, M, F.G, (int)blockIdx.x);
      pg8::EpiBf16Plain E{(bf16*)(F.ws + WS_ZT), M};
      pg8::gemm_phase<pg8::EpiBf16Plain, pg8::StaticOrder, true, true>(F.lds + RING_OFF, g, S, E); }
    { pg8::Gemm g{XN, (const bf16*)(F.ws + WS_WIN) + (size_t)NHY * D, M, NREST, D}; pg8::StaticOrder S; S.init(M, NREST, F.G, (int)blockIdx.x);
      pg8::EpiBf16Plain E{(bf16*)(F.ws + WS_PR), NREST};
      pg8::gemm_phase<pg8::EpiBf16Plain, pg8::StaticOrder, true, true>(F.lds + RING_OFF, g, S, E); }
}
__device__ __forceinline__ void ph2(Frame& F) {
    p2_qkprep(F); if (PROBE_SUB & 8) p2_qkprep(F);
    __syncthreads(); fft_tables(F);
    for (int c = F.vcu; c < HW; c += F.G) hyena_channel(F, c);
}
__device__ __forceinline__ void ph3(Frame& F, unsigned char* lds) {
    p3_transpose(F);
    __syncthreads();
    static_assert(attn_body::L8_BYTES <= RING_BYTES, "attention LDS");
    float gq = fabsf(F.in[14][F.lane]), gk = fabsf(F.in[15][F.lane]);
#pragma unroll
    for (int o = 1; o < 64; o <<= 1) { gq = fmaxf(gq, __shfl_xor(gq, o)); gk = fmaxf(gk, __shfl_xor(gk, o)); }
    const float mref = 64.0f * 0.125f * 1.4426950408889634f * gq * gk;
    const attn_body::AttnTensors8 AT{(const unsigned char*)(F.ws + WS_QO), (const unsigned char*)(F.ws + WS_KB), (const unsigned char*)(F.ws + WS_VB), (attn_body::bf16*)(F.ws + WS_AO), mref - 7.0f};
    const attn_body::StaticOrder S((int)F.G, F.vcu);
    attn_body::attn_phase8<attn_body::StaticOrder>((char*)lds + RING_OFF, AT, S);
}
__device__ __forceinline__ void ph4(Frame& F) {
    const bf16* PR = (const bf16*)(F.ws + WS_PR); bf16* MG = (bf16*)(F.ws + WS_MG);
    pg8::Gemm g{(const bf16*)(F.ws + WS_YH), (const bf16*)(F.ws + WS_WHU), M, D, 512, nullptr, (const bf16*)(F.ws + WS_AO), (const bf16*)(F.ws + WS_WAU)};
    pg8::ChainOrder S; S.base.init(M, D, F.G, (int)blockIdx.x);
    pg8::EpiGateChain E{MG, D, PR + PR_GH, PR + PR_GA, NREST};
    pg8::gemm_phase<pg8::EpiGateChain, pg8::ChainOrder, true, true>(F.lds + RING_OFF, g, S, E);
}
__device__ __forceinline__ void ph5(Frame& F) {
    pg8::Gemm g{(const bf16*)(F.ws + WS_MG), (const bf16*)(F.ws + WS_WOUT), M, D, D}; pg8::StaticOrder S; S.init(M, D, F.G, (int)blockIdx.x);
    pg8::EpiResBf16 E{F.in[0], (bf16*)(F.ws + WS_HB), D};
    pg8::gemm_phase<pg8::EpiResBf16, pg8::StaticOrder, true, true>(F.lds + RING_OFF, g, S, E);
}
__device__ __forceinline__ void ph8(Frame& F) {
    build_layout(F); const int nrb = (int)F.MISC[16];
    pg8::MoeOrder S; S.init(nrb, 8, F.G, (int)blockIdx.x, (const LAS int*)(F.lds + LX_RBE));
    LAS unsigned short* lidx = (LAS unsigned short*)(F.lds + LX_GIDX); const int* srctok = (const int*)(F.ws + WS_SRC);
    { pg8::Unit u; for (int i = 0; i < GIDX_UNITS && S.next(i, u); ++i) if (F.tid < 256) lidx[i * 256 + F.tid] = (unsigned short)srctok[u.pm * 256 + F.tid]; }
    __syncthreads();
    pg8::Gemm g{(const bf16*)(F.ws + WS_XN), (const bf16*)(F.ws + WS_W1), nrb * 256, 2 * FF, D / 2, lidx};
    pg8::EpiSwiglu E{(bf16*)(F.ws + WS_H1), F.in[23], 1.0f / (ASCALE * WSCALE), HSCALE};
    pg8::gemm_phase<pg8::EpiSwiglu, pg8::MoeOrder, true, true, true, true>(F.lds + RING_OFF, g, S, E);
}
template <int NOSTORE>
__device__ __forceinline__ void ph9(Frame& F) {
    build_layout(F); const int nrb = (int)F.MISC[16];
    pg8::Gemm g{(const bf16*)(F.ws + WS_H1), (const bf16*)(F.ws + WS_W2), nrb * 256, D, FF / 2}; pg8::MoeOrder S; S.init(nrb, 4, F.G, (int)blockIdx.x, (const LAS int*)(F.lds + LX_RBE)); if (PROBE_SUB & 2048) S.dup = 1;
    pg8::EpiMoe2 E{(bf16*)(F.ws + WS_XG), F.in[25], (const float*)(F.ws + WS_ROWGATE), NOSTORE, 1.0f / (HSCALE * WSCALE), YSCALE};
    pg8::gemm_phase<pg8::EpiMoe2, pg8::MoeOrder, true, true, false, true>(F.lds + RING_OFF, g, S, E);
}
struct Args { const float* in[26]; float* out; unsigned char* ws; int ph_lo, ph_hi; };
__global__ void __launch_bounds__(NWAVES * 64, 2) hybrid_fwd(Args args) {
    extern __shared__ __attribute__((aligned(16))) unsigned char lds[];
    Frame F;
    F.lds = (LAS unsigned char*)lds;
    F.MISC = (volatile LAS unsigned*)(F.lds + LX_MISC);
    F.tid = threadIdx.x; F.lane = F.tid & 63; F.wave = __builtin_amdgcn_readfirstlane(F.tid >> 6);
    F.G = gridDim.x; { const int bx = blockIdx.x; F.vcu = (F.G % 8 == 0) ? (bx % 8) * (F.G / 8) + bx / 8 : bx; }
    F.ws = args.ws; F.ctl = (gu32*)(args.ws + WS_CTL); F.out = args.out;
#pragma unroll
    for (int i = 0; i < 26; ++i) F.in[i] = args.in[i];
    if (F.tid < 64) F.MISC[F.tid] = 0u;
    __syncthreads();
    XcdBarrier bar; bar.bar = (unsigned*)(F.ctl + CW_BAR); bar.x = 0; bar.st = nullptr;
    if (N_LAUNCHES == 1) bar = xcd_barrier_post((unsigned*)(F.ctl + CW_BAR), F.MISC + 8);
#define GRID_BAR() do { if (N_LAUNCHES == 1) xcd_barrier(bar); } while (0)
    const int lo = args.ph_lo, hi = args.ph_hi;
#ifndef ONLYP
#define ONLYP -1
#endif
#define IN(k) (lo <= (k) && (k) < hi && (ONLYP < 0 || ONLYP == (k)))
#ifndef PROBE_DUP
#define PROBE_DUP 0
#endif
#define DUP(k) (((PROBE_DUP) >> (k)) & 1)
#define FRESH() do { int t_ = threadIdx.x; asm volatile("" : "+v"(t_)); F.tid = t_; F.lane = t_ & 63; } while (0)
    if (IN(0)) { FRESH(); p0_prologue(F); if (DUP(0)) { __syncthreads(); p0_prologue(F); } GRID_BAR(); }
    if (IN(1)) { FRESH(); ph1(F); if (DUP(1)) ph1(F); GRID_BAR(); }
    if (IN(2)) { FRESH(); ph2(F); if (DUP(2)) ph2(F); GRID_BAR(); }
    if (IN(3)) { FRESH(); ph3(F, lds); if (DUP(3)) { __syncthreads(); ph3(F, lds); } GRID_BAR(); }
    if (IN(4)) { FRESH(); ph4(F); if (DUP(4)) ph4(F); GRID_BAR(); }
    if (IN(5)) { FRESH(); ph5(F); if (DUP(5)) ph5(F); GRID_BAR(); }
    if (IN(6)) { FRESH(); if (PROBE_SUB & 128) { p6_route<1>(F); __syncthreads(); } p6_route<0>(F); GRID_BAR(); if (PROBE_SUB & 256) { for (int i = 0; i < 10; ++i) GRID_BAR(); } }
    if (IN(7)) { FRESH(); p7_layout(F); if (DUP(7)) p7_layout(F); GRID_BAR(); }
    if (IN(8)) { FRESH(); ph8(F); if (DUP(8)) ph8(F); GRID_BAR(); }
    if (IN(9)) { FRESH(); ph9<0>(F); if (DUP(9)) ph9<0>(F); if (PROBE_SUB & 64) ph9<1>(F); GRID_BAR(); }
    if (IN(10)) { FRESH(); p10_combine(F); if (DUP(10)) p10_combine(F); }
#undef IN
}

extern "C" void kernel_launch(void* const* d_in, const int* in_sizes, int n_in, void* d_out, int out_size, void* d_ws, size_t ws_size, hipStream_t stream) {
    static int grid = 0;
    if (grid == 0) {
        if (n_in != 26 || in_sizes[0] != M * D || out_size != M * D || ws_size < WS_END) { fprintf(stderr, "kernel_launch: unexpected shapes (n_in %d, in0 %d, out %d, ws %zu); nothing launched\n", n_in, n_in > 0 ? in_sizes[0] : -1, out_size, ws_size); grid = -1; return; }
        int dev = 0, cus = 0, per_cu = 0;
        if (hipGetDevice(&dev) != hipSuccess || hipDeviceGetAttribute(&cus, hipDeviceAttributeMultiprocessorCount, dev) != hipSuccess) { grid = -1; return; }
        if (hipFuncSetAttribute((const void*)hybrid_fwd, hipFuncAttributeMaxDynamicSharedMemorySize, LDS_BYTES) != hipSuccess) { fprintf(stderr, "kernel_launch: hipFuncSetAttribute failed\n"); grid = -1; return; }
        if (hipOccupancyMaxActiveBlocksPerMultiprocessor(&per_cu, (const void*)hybrid_fwd, NWAVES * 64, LDS_BYTES) != hipSuccess || per_cu < 1) fprintf(stderr, "kernel_launch: occupancy query reports %d\n", per_cu);
        (void)hipGetLastError();
        grid = cus;
        if (grid != 256) { fprintf(stderr, "kernel_launch: built for 256 CUs, device has %d\n", grid); grid = -1; return; }
    }
    if (grid < 0) return;
    if (hipMemsetAsync((char*)d_ws + WS_CTL, 0, CTL_ZERO_BYTES, stream) != hipSuccess) return;
    Args a{};
    for (int i = 0; i < 26; ++i) a.in[i] = (const float*)d_in[i];
    a.out = (float*)d_out; a.ws = (unsigned char*)d_ws;
    if (N_LAUNCHES == 1) { a.ph_lo = 0; a.ph_hi = N_PHASES; hipLaunchKernelGGL(hybrid_fwd, dim3(grid), dim3(NWAVES * 64), LDS_BYTES, stream, a); }
    else for (int p = 0; p < N_PHASES; ++p) { a.ph_lo = p; a.ph_hi = p + 1; hipLaunchKernelGGL(hybrid_fwd, dim3(grid), dim3(NWAVES * 64), LDS_BYTES, stream, a); }
}
```

```cpp
#include <hip/hip_runtime.h>
#include <cstdio>
#include <cstdint>
namespace pg8 {
#define PG8_LAS __attribute__((address_space(3)))
typedef unsigned short bf16_t;
typedef short bf16x8 __attribute__((ext_vector_type(8)));
typedef float f32x4 __attribute__((ext_vector_type(4)));
typedef unsigned u32x4 __attribute__((ext_vector_type(4)));
typedef int i32x4 __attribute__((ext_vector_type(4)));
constexpr int BM = 256, BK = 64, HALF = 128, HTB = HALF * BK * 2  , STAGE_BYTES = 8 * HTB, NXCD = 8, WGM = 8;

__host__ __device__ __forceinline__ int lds_byte(int r, int c) { const int st = (r >> 4) * 2 + (c >> 5), rr = r & 15, cc = c & 31, ob = rr * 64 + cc * 2; return st * 1024 + (ob ^ (((ob >> 9) & 1) << 5)); }
__host__ __device__ __forceinline__ void stage_rc(int b, int& R, int& C) { const int st = b / 1024, sb = b % 1024, swz = sb ^ (((sb >> 9) & 1) << 5); R = (st >> 1) * 16 + swz / 64; C = (st & 1) * 32 + (swz % 64) / 2; }
__host__ __device__ __forceinline__ int perm32(int rho) { const int n = rho >> 4, i = rho & 15; return 8 * (i >> 2) + 4 * n + (i & 3); }

struct Unit { int pm, pn, pb, sel; };
struct Gemm { const bf16_t* A; const bf16_t* Bt; int M, N, K; const PG8_LAS unsigned short* lidx; const bf16_t* A2; const bf16_t* Bt2; };

struct StaticOrder {
    int nM, nN, nwg, G, c;
    __host__ __device__ void init(int M, int N, int G_, int c_) { nM = M / BM; nN = N / BM; nwg = nM * nN; G = G_; c = c_; }
    __host__ __device__ bool next(int i, Unit& u) const {
        const long L = (long)i * G + c; if (L >= nwg) return false;
        int wgid = (int)L; { const int q = nwg / NXCD, r = nwg % NXCD, xcd = wgid % NXCD, off = wgid / NXCD; wgid = (xcd < r ? xcd * (q + 1) : r * (q + 1) + (xcd - r) * q) + off; }
        const int nig = WGM * nN, gid = wgid / nig, fm = gid * WGM, gsz = (nM - fm) < WGM ? (nM - fm) : WGM;
        u.pm = fm + ((wgid % nig) % gsz); u.pn = (wgid % nig) / gsz; u.pb = u.pn; u.sel = 0; return true;
    }
    __device__ __forceinline__ void a_ready(const Unit&) const {}
    __device__ __forceinline__ void done(const Unit&) const {}
};

__device__ __forceinline__ unsigned cvt_pk_bf16(float lo, float hi) { unsigned r; asm volatile("v_cvt_pk_bf16_f32 %0, %1, %2" : "=v"(r) : "v"(lo), "v"(hi)); return r; }
typedef float f32x2 __attribute__((ext_vector_type(2)));
template <int ACT  > struct EpiBf16 {
    static constexpr bool PERM = true, AFTER_DRAIN = false, CHAIN = false; static_assert(ACT == 0, "EpiBf16: ACT is 0 (none)");
    struct Pre {}; __device__ __forceinline__ Pre pre(const Unit&, int, int, int, int) const { return Pre{}; }
    bf16_t* O; int ldc; const float* bias; int split_cols; size_t split_stride; float scale0;
    __device__ __forceinline__ void operator()(const f32x4 (&acc)[2][2][4][2], const Unit& u, int wr, int wc, int fr, int fq, const Pre&) const {
        const int row0 = u.pm * BM + wr * 64 + fr; int colt = u.pn * BM; bf16_t* base = O;
        float sc = 1.f; if (split_cols) { const int t = colt / split_cols; base += (size_t)t * split_stride; colt -= t * split_cols; if (t == 0) sc = scale0; }
        const int col0 = colt + wc * 32 + 8 * fq, bcol0 = u.pn * BM + wc * 32 + 8 * fq;
        f32x4 bv[2][2];
#pragma unroll
        for (int bj = 0; bj < 2; ++bj)
#pragma unroll
            for (int n = 0; n < 2; ++n) bv[bj][n] = bias ? *(const f32x4*)(bias + bcol0 + bj * HALF + 4 * n) : (f32x4){0.f, 0.f, 0.f, 0.f};
#pragma unroll
        for (int ai = 0; ai < 2; ++ai)
#pragma unroll
            for (int m = 0; m < 4; ++m) { bf16_t* rowp = base + (size_t)(row0 + ai * HALF + m * 16) * ldc + col0;
#pragma unroll
                for (int bj = 0; bj < 2; ++bj) { f32x4 v0 = acc[ai][bj][m][0] + bv[bj][0], v1 = acc[ai][bj][m][1] + bv[bj][1];
                    v0 = v0 * sc; v1 = v1 * sc; u32x4 w; w.x = cvt_pk_bf16(v0[0], v0[1]); w.y = cvt_pk_bf16(v0[2], v0[3]); w.z = cvt_pk_bf16(v1[0], v1[1]); w.w = cvt_pk_bf16(v1[2], v1[3]);
                    *(u32x4*)(rowp + bj * HALF) = w; } }
    }
};
struct EpiBf16Plain {
    static constexpr bool PERM = true, AFTER_DRAIN = false, CHAIN = false;
    struct Pre {}; __device__ __forceinline__ Pre pre(const Unit&, int, int, int, int) const { return Pre{}; }
    bf16_t* O; int ldc;
    __device__ __forceinline__ void operator()(const f32x4 (&acc)[2][2][4][2], const Unit& u, int wr, int wc, int fr, int fq, const Pre&) const {
        const int row0 = u.pm * BM + wr * 64 + fr, col0 = u.pn * BM + wc * 32 + 8 * fq;
#pragma unroll
        for (int ai = 0; ai < 2; ++ai)
#pragma unroll
            for (int m = 0; m < 4; ++m) { bf16_t* rowp = O + (size_t)(row0 + ai * HALF + m * 16) * ldc + col0;
#pragma unroll
                for (int bj = 0; bj < 2; ++bj) { const f32x4 v0 = acc[ai][bj][m][0], v1 = acc[ai][bj][m][1];
                    u32x4 w; w.x = cvt_pk_bf16(v0[0], v0[1]); w.y = cvt_pk_bf16(v0[2], v0[3]); w.z = cvt_pk_bf16(v1[0], v1[1]); w.w = cvt_pk_bf16(v1[2], v1[3]);
                    *(u32x4*)(rowp + bj * HALF) = w; } }
    }
};
__device__ __forceinline__ float bf_lo(unsigned w) { return __uint_as_float(w << 16); }
__device__ __forceinline__ float bf_hi(unsigned w) { return __uint_as_float(w & 0xffff0000u); }
__device__ __forceinline__ float sigmoid_f(float x) { return __builtin_amdgcn_rcpf(1.f + __builtin_amdgcn_exp2f(-1.4426950408889634f * x)); }
struct MoeOrder {
    int nM, nN, nwg, G, c; const PG8_LAS int* rbe;
    __device__ void init(int nM_, int nN_, int G_, int c_, const PG8_LAS int* rbe_) { nM = nM_; nN = nN_; nwg = nM * nN; G = G_; c = c_; rbe = rbe_; dup = 0; }
    int dup;
    __device__ bool next(int i, Unit& u) const {
        const long L = (long)(i >> dup) * G + c; if (L >= nwg) return false;
        int wgid = (int)L; { const int q = nwg / NXCD, r = nwg % NXCD, xcd = wgid % NXCD, off = wgid / NXCD; wgid = (xcd < r ? xcd * (q + 1) : r * (q + 1) + (xcd - r) * q) + off; }
        const int nig = WGM * nN, gid = wgid / nig, fm = gid * WGM, gsz = (nM - fm) < WGM ? (nM - fm) : WGM;
        u.pm = fm + ((wgid % nig) % gsz); u.pn = (wgid % nig) / gsz; u.pb = rbe[u.pm] * nN + u.pn; u.sel = dup ? (i & 1) : 0; return true;
    }
    __device__ __forceinline__ void a_ready(const Unit&) const {}
    __device__ __forceinline__ void done(const Unit&) const {}
};
template <int PASS> struct EpiGate {
    static constexpr bool PERM = true, AFTER_DRAIN = false, CHAIN = false;
    struct Pre {}; __device__ __forceinline__ Pre pre(const Unit&, int, int, int, int) const { return Pre{}; }
    bf16_t* O; int ldc; const bf16_t* G; int ldg;
    __device__ __forceinline__ void operator()(const f32x4 (&acc)[2][2][4][2], const Unit& u, int wr, int wc, int fr, int fq, const Pre&) const {
        const int row0 = u.pm * BM + wr * 64 + fr, col0 = u.pn * BM + wc * 32 + 8 * fq;
#pragma unroll
        for (int ai = 0; ai < 2; ++ai)
#pragma unroll
            for (int m = 0; m < 4; ++m) { const size_t row = (size_t)(row0 + ai * HALF + m * 16);
#pragma unroll
                for (int bj = 0; bj < 2; ++bj) { const int col = col0 + bj * HALF;
                    const u32x4 gw = *(const u32x4*)(G + row * ldg + col);
                    float v[8];
#pragma unroll
                    for (int i = 0; i < 4; ++i) { v[2 * i] = sigmoid_f(bf_lo(gw[i])) * acc[ai][bj][m][i >> 1][(2 * i) & 3]; v[2 * i + 1] = sigmoid_f(bf_hi(gw[i])) * acc[ai][bj][m][i >> 1][(2 * i + 1) & 3]; }
                    bf16_t* op = O + row * ldc + col;
                    if (PASS == 1) { const u32x4 tw = *(const u32x4*)op;
#pragma unroll
                        for (int i = 0; i < 4; ++i) { v[2 * i] += bf_lo(tw[i]); v[2 * i + 1] += bf_hi(tw[i]); } }
                    u32x4 w; w.x = cvt_pk_bf16(v[0], v[1]); w.y = cvt_pk_bf16(v[2], v[3]); w.z = cvt_pk_bf16(v[4], v[5]); w.w = cvt_pk_bf16(v[6], v[7]);
                    *(u32x4*)op = w; } }
    }
};
struct EpiResF32 {
    static constexpr bool PERM = false, AFTER_DRAIN = false, CHAIN = false;
    struct Pre {}; __device__ __forceinline__ Pre pre(const Unit&, int, int, int, int) const { return Pre{}; }
    const float* X; float* out; int ldc;
    __device__ __forceinline__ void operator()(const f32x4 (&acc)[2][2][4][2], const Unit& u, int wr, int wc, int fr, int fq, const Pre&) const {
        const int row0 = u.pm * BM + wr * 64 + fr, col0 = u.pn * BM + wc * 32 + 4 * fq;
#pragma unroll
        for (int ai = 0; ai < 2; ++ai)
#pragma unroll
            for (int m = 0; m < 4; ++m) { const size_t off = (size_t)(row0 + ai * HALF + m * 16) * ldc + col0;
#pragma unroll
                for (int bj = 0; bj < 2; ++bj)
#pragma unroll
                    for (int n = 0; n < 2; ++n) { const f32x4 xv = *(const f32x4*)(X + off + bj * HALF + n * 16); *(f32x4*)(out + off + bj * HALF + n * 16) = xv + acc[ai][bj][m][n]; } }
    }
};
struct EpiResBf16 {
    static constexpr bool PERM = true, AFTER_DRAIN = false, CHAIN = false;
    struct Pre {}; __device__ __forceinline__ Pre pre(const Unit&, int, int, int, int) const { return Pre{}; }
    const float* X; bf16_t* out; int ldc;
    __device__ __forceinline__ void operator()(const f32x4 (&acc)[2][2][4][2], const Unit& u, int wr, int wc, int fr, int fq, const Pre&) const {
        const int row0 = u.pm * BM + wr * 64 + fr, col0 = u.pn * BM + wc * 32 + 8 * fq;
#pragma unroll
        for (int ai = 0; ai < 2; ++ai)
#pragma unroll
            for (int m = 0; m < 4; ++m) { const size_t off = (size_t)(row0 + ai * HALF + m * 16) * ldc + col0;
#pragma unroll
                for (int bj = 0; bj < 2; ++bj) { const f32x4 v0 = *(const f32x4*)(X + off + bj * HALF) + acc[ai][bj][m][0], v1 = *(const f32x4*)(X + off + bj * HALF + 4) + acc[ai][bj][m][1];
                    u32x4 w; w.x = cvt_pk_bf16(v0[0], v0[1]); w.y = cvt_pk_bf16(v0[2], v0[3]); w.z = cvt_pk_bf16(v1[0], v1[1]); w.w = cvt_pk_bf16(v1[2], v1[3]);
                    *(u32x4*)(out + off + bj * HALF) = w; } }
    }
};
typedef unsigned u32x2 __attribute__((ext_vector_type(2)));
__device__ __forceinline__ unsigned pack4_fp8(float a, float b, float c, float d) { int w = 0; w = __builtin_amdgcn_cvt_pk_fp8_f32(a, b, w, false); w = __builtin_amdgcn_cvt_pk_fp8_f32(c, d, w, true); return (unsigned)w; }
__device__ __forceinline__ float clamp8(float x) { return __builtin_amdgcn_fmed3f(x, -448.0f, 448.0f); }
struct EpiSwiglu {
    static constexpr bool PERM = true, AFTER_DRAIN = false, CHAIN = false, C0START = true;
    bf16_t* H; const float* b1; float ascale, hscale;
    struct Pre { f32x4 t[4]; };
    __device__ __forceinline__ Pre pre(const Unit& u, int wr, int wc, int fr, int fq) const {
        const int e = u.pb >> 3, j0 = u.pn * HALF + wc * 32 + 8 * fq; const float* bp = b1 + (size_t)e * 2048 + 2 * j0; Pre p;
#pragma unroll
        for (int i = 0; i < 4; ++i) p.t[i] = *(const f32x4*)(bp + 4 * i);
        return p; }
    __device__ __forceinline__ void operator()(const f32x4 (&acc)[2][2][4][2], const Unit& u, int wr, int wc, int fr, int fq, const Pre& pr) const {
#if defined(PROBE_EPI) && PROBE_EPI == 1
        if (u.sel) {
#pragma unroll
            for (int ai = 0; ai < 2; ++ai)
#pragma unroll
                for (int bj = 0; bj < 2; ++bj)
#pragma unroll
                    for (int m = 0; m < 4; ++m) { asm volatile("" :: "v"(acc[ai][bj][m][0]), "v"(acc[ai][bj][m][1])); }
            return; }
#endif
        const int row0 = u.pm * BM + wr * 64 + fr, j0 = u.pn * HALF + wc * 32 + 8 * fq;
        typedef float f32x2 __attribute__((ext_vector_type(2)));
        f32x2 bg[4], bl[4];
#pragma unroll
        for (int i = 0; i < 4; ++i) { const f32x4 t = pr.t[i]; bg[i] = (f32x2){t[0], t[2]}; bl[i] = (f32x2){t[1], t[3]}; }
        const f32x2 as2 = {ascale, ascale}, hs2 = {hscale, hscale}, one2 = {1.0f, 1.0f};
        const f32x2 c1 = {-1.702f * 1.4426950408889634f * 8388608.0f, -1.702f * 1.4426950408889634f * 8388608.0f}, c0 = {1064986823.0f, 1064986823.0f};
#pragma unroll
        for (int ai = 0; ai < 2; ++ai)
#pragma unroll
            for (int mp = 0; mp < 2; ++mp) { u32x2 wm[2];
#pragma unroll
                for (int mi = 0; mi < 2; ++mi) { const int m = 2 * mp + mi; f32x2 o[4];
#pragma unroll
                for (int i = 0; i < 4; ++i) { const f32x4 ag = acc[ai][0][m][i >> 1], al = acc[ai][1][m][i >> 1];
                    f32x2 g = (i & 1) ? (f32x2){ag[2], ag[3]} : (f32x2){ag[0], ag[1]}, l = (i & 1) ? (f32x2){al[2], al[3]} : (f32x2){al[0], al[1]};
                    g = g * as2 + bg[i]; l = l * as2 + bl[i];
                    g[0] = __builtin_amdgcn_fmed3f(g[0], -30.0f, 7.0f); g[1] = __builtin_amdgcn_fmed3f(g[1], -30.0f, 7.0f);
                    l[0] = __builtin_amdgcn_fmed3f(l[0], -7.0f, 7.0f); l[1] = __builtin_amdgcn_fmed3f(l[1], -7.0f, 7.0f);
                    const f32x2 ex = g * c1 + c0; f32x2 e2; e2[0] = __int_as_float((int)ex[0]); e2[1] = __int_as_float((int)ex[1]);
                    const f32x2 den = e2 + one2; f32x2 r; r[0] = __builtin_amdgcn_rcpf(den[0]); r[1] = __builtin_amdgcn_rcpf(den[1]);
                    o[i] = (g * r) * (l * hs2 + hs2); }
                    wm[mi].x = pack4_fp8(o[0][0], o[0][1], o[1][0], o[1][1]); wm[mi].y = pack4_fp8(o[2][0], o[2][1], o[3][0], o[3][1]); }
                const auto s0 = __builtin_amdgcn_permlane16_swap(wm[0].x, wm[1].x, false, false), s1 = __builtin_amdgcn_permlane16_swap(wm[0].y, wm[1].y, false, false);
                u32x4 w; w.x = s0[0]; w.y = s1[0]; w.z = s0[1]; w.w = s1[1];
                const size_t row = (size_t)(row0 + ai * HALF + (2 * mp + (fq & 1)) * 16);
                *(u32x4*)((unsigned char*)H + row * 1024 + (j0 - 8 * (fq & 1))) = w; }
    }
};
struct EpiMoe2 {
    static constexpr bool PERM = true, AFTER_DRAIN = false, CHAIN = false; static constexpr int PERM2 = 2;
    bf16_t* Y; const float* b2; const float* gate; int nostore; float ascale, yscale;
    struct Pre { f32x4 bv[4]; float gt[2][4]; };
    __device__ __forceinline__ Pre pre(const Unit& u, int wr, int wc, int fr, int fq) const {
        const int row0 = u.pm * BM + wr * 64 + fr, e = u.pb >> 2, col0 = u.pn * BM + wc * 64 + 16 * fq; Pre p;
#pragma unroll
        for (int q = 0; q < 4; ++q) p.bv[q] = *(const f32x4*)(b2 + (size_t)e * 1024 + col0 + 4 * q);
#pragma unroll
        for (int ai = 0; ai < 2; ++ai)
#pragma unroll
            for (int m = 0; m < 4; ++m) p.gt[ai][m] = gate[row0 + ai * HALF + m * 16];
        return p; }
    __device__ __forceinline__ void operator()(const f32x4 (&acc)[2][2][4][2], const Unit& u, int wr, int wc, int fr, int fq, const Pre& pr) const {
#if defined(PROBE_EPI) && PROBE_EPI == 1
        if (u.sel) {
#pragma unroll
            for (int ai = 0; ai < 2; ++ai)
#pragma unroll
                for (int bj = 0; bj < 2; ++bj)
#pragma unroll
                    for (int m = 0; m < 4; ++m) { asm volatile("" :: "v"(acc[ai][bj][m][0]), "v"(acc[ai][bj][m][1])); }
            return; }
#endif
        const int row0 = u.pm * BM + wr * 64 + fr, col0 = u.pn * BM + wc * 64 + 16 * fq;
#pragma unroll
        for (int ai = 0; ai < 2; ++ai)
#pragma unroll
            for (int m = 0; m < 4; ++m) { const size_t row = (size_t)(row0 + ai * HALF + m * 16); const float gs = pr.gt[ai][m] * yscale, a2 = ascale * gs; u32x4 w;
#pragma unroll
                for (int q = 0; q < 4; ++q) { const f32x4 v = acc[ai][q >> 1][m][q & 1] * a2 + pr.bv[q] * gs;
                    w[q] = pack4_fp8(clamp8(v[0]), clamp8(v[1]), clamp8(v[2]), clamp8(v[3])); }
#if defined(PROBE_EPI) && PROBE_EPI == 2
                if (u.sel) { asm volatile("" :: "v"(w)); continue; }
#endif
                if (!nostore) *(u32x4*)((unsigned char*)Y + row * 1024 + col0) = w; else asm volatile("" :: "v"(w)); }
    }
};
struct ChainOrder {
    StaticOrder base;
    __device__ bool next(int i, Unit& u) const { if (!base.next(i >> 1, u)) return false; u.sel = i & 1; return true; }
    __device__ __forceinline__ void a_ready(const Unit&) const {}
    __device__ __forceinline__ void done(const Unit&) const {}
};
struct EpiGateChain {
    static constexpr bool PERM = true, AFTER_DRAIN = false, CHAIN = true;
    struct Pre {}; __device__ __forceinline__ Pre pre(const Unit&, int, int, int, int) const { return Pre{}; }
    bf16_t* O; int ldc; const bf16_t* GH; const bf16_t* GA; int ldg;
    __device__ __forceinline__ static float eneg(float x) { return __builtin_amdgcn_exp2f(-1.4426950408889634f * fminf(fmaxf(x, -30.f), 30.f)); }
    typedef float f32x2g __attribute__((ext_vector_type(2)));
    __device__ __forceinline__ static f32x2g en2(unsigned w) {
        f32x2g x = {__builtin_amdgcn_fmed3f(bf_lo(w), -30.f, 30.f), __builtin_amdgcn_fmed3f(bf_hi(w), -30.f, 30.f)};
        x = x * (f32x2g){-1.4426950408889634f, -1.4426950408889634f};
        return (f32x2g){__builtin_amdgcn_exp2f(x[0]), __builtin_amdgcn_exp2f(x[1])}; }
    __device__ __forceinline__ void mid(f32x4 (&acc)[2][2][4][2], const Unit& u, int wr, int wc, int fr, int fq) const {
        const int row0 = u.pm * BM + wr * 64 + fr, col0 = u.pn * BM + wc * 32 + 8 * fq; const f32x2g one2 = {1.f, 1.f};
#pragma unroll
        for (int ai = 0; ai < 2; ++ai)
#pragma unroll
            for (int m = 0; m < 4; ++m) { const size_t row = (size_t)(row0 + ai * HALF + m * 16);
#pragma unroll
                for (int bj = 0; bj < 2; ++bj) { const int col = col0 + bj * HALF;
                    const u32x4 hw = *(const u32x4*)(GH + row * ldg + col), aw = *(const u32x4*)(GA + row * ldg + col);
#pragma unroll
                    for (int i = 0; i < 4; ++i) { const f32x2g na = en2(aw[i]) + one2, nh = en2(hw[i]) + one2;
                        const f32x2g r = na * (f32x2g){__builtin_amdgcn_rcpf(nh[0]), __builtin_amdgcn_rcpf(nh[1])};
                        acc[ai][bj][m][i >> 1][(2 * i) & 3] *= r[0]; acc[ai][bj][m][i >> 1][(2 * i + 1) & 3] *= r[1]; } } }
    }
    __device__ __forceinline__ void operator()(const f32x4 (&acc)[2][2][4][2], const Unit& u, int wr, int wc, int fr, int fq, const Pre&) const {
        const int row0 = u.pm * BM + wr * 64 + fr, col0 = u.pn * BM + wc * 32 + 8 * fq; const f32x2g one2 = {1.f, 1.f};
#pragma unroll
        for (int ai = 0; ai < 2; ++ai)
#pragma unroll
            for (int m = 0; m < 4; ++m) { const size_t row = (size_t)(row0 + ai * HALF + m * 16);
#pragma unroll
                for (int bj = 0; bj < 2; ++bj) { const int col = col0 + bj * HALF;
                    const u32x4 aw = *(const u32x4*)(GA + row * ldg + col); float v[8];
#pragma unroll
                    for (int i = 0; i < 4; ++i) { const f32x2g na = en2(aw[i]) + one2;
                        v[2 * i] = acc[ai][bj][m][i >> 1][(2 * i) & 3] * __builtin_amdgcn_rcpf(na[0]); v[2 * i + 1] = acc[ai][bj][m][i >> 1][(2 * i + 1) & 3] * __builtin_amdgcn_rcpf(na[1]); }
                    u32x4 w; w.x = cvt_pk_bf16(v[0], v[1]); w.y = cvt_pk_bf16(v[2], v[3]); w.z = cvt_pk_bf16(v[4], v[5]); w.w = cvt_pk_bf16(v[6], v[7]);
                    *(u32x4*)(O + row * ldc + col) = w; } }
    }
};
template <class E, class = void> struct C0Of { static constexpr bool v = false; };
template <class E> struct C0Of<E, decltype((void)E::C0START)> { static constexpr bool v = E::C0START; };
template <class E, class = void> struct Perm2Of { static constexpr int v = 0; };
template <class E> struct Perm2Of<E, decltype((void)E::PERM2)> { static constexpr int v = (int)E::PERM2; };
template <class Epi, class Sched, bool ALIGN_EPI = false, bool SP2 = false, bool GATHER = false, bool FP8 = false, bool ATILE = false>
__device__ __forceinline__ void gemm_phase(PG8_LAS unsigned char* lds, const Gemm g, const Sched& S, const Epi& E) {
    const int tid = threadIdx.x, wid = __builtin_amdgcn_readfirstlane(tid >> 6), lane = tid & 63, wr = wid >> 2, wc = wid & 3, fr = lane & 15, fq = lane >> 4;
    const int K = g.K, nt = K / BK;
    constexpr int PERM2 = Perm2Of<Epi>::v;
    unsigned voffA[2], voffB[2], voffB1[2];
#pragma unroll
    for (int i = 0; i < 2; ++i) { int R, C; stage_rc(tid * 16 + i * 8192, R, C); const int Rb = Epi::PERM ? ((R & ~31) + perm32(R & 31)) : R;
        const int R2 = (R >> 5) * 64 + ((R >> 2) & 3) * (PERM2 == 3 ? 8 : 16) + ((R >> 4) & 1) * 4 + (R & 3);
        voffA[i] = ATILE ? (unsigned)((R >> 2) * 4096 + (R & 3) * 32 + ((2 * C) >> 5) * 128 + ((2 * C) & 31)) : (unsigned)(R * K + C) * 2u; voffB[i] = (unsigned)((PERM2 ? R2 : Rb) * K + C) * 2u; voffB1[i] = (unsigned)((R2 + (PERM2 == 3 ? 32 : 8)) * K + C) * 2u; }
    unsigned goffC[2][2] = {{0u, 0u}, {0u, 0u}}, goffN[2][2] = {{0u, 0u}, {0u, 0u}}; int gR[2], gC[2];
#pragma unroll
    for (int i = 0; i < 2; ++i) stage_rc(tid * 16 + i * 8192, gR[i], gC[i]);
    const size_t kstep = (size_t)(BK * 2);
    const size_t kstepA = ATILE ? (size_t)(BK * 2) * 4 : kstep;
    static_assert(!ATILE || !GATHER, "ATILE: dense A only");
    const size_t hstep = (size_t)HALF * K * 2;
    const size_t tstep = 2 * hstep;
    const unsigned ldsw = (unsigned)wid * 1024u;
    const int aoff = FP8 ? lds_byte(wr * 64 + fr, 16 * (fq & 1)) + (fq >> 1) * 1024 : lds_byte(wr * 64 + fr, fq * 8), boff = FP8 ? lds_byte(wc * 32 + fr, 16 * (fq & 1)) + (fq >> 1) * 1024 : lds_byte(wc * 32 + fr, fq * 8);

#define PG8_SA(b, h) (((b) * 2 + (h)) * HTB)
#define PG8_SB(b, h) ((4 + (b) * 2 + (h)) * HTB)
#define PG8_STAGE(bufoff, gbase, voff) do { _Pragma("unroll") for (int _i = 0; _i < 2; ++_i) \
        __builtin_amdgcn_global_load_lds((const unsigned*)((const char*)(gbase) + (voff)[_i]), (PG8_LAS unsigned*)(lds + (bufoff) + ldsw + _i * 8192), 16, 0, 0); } while (0)
#define PG8_STAGE_B(bufoff, gbase, h) do { if constexpr (PERM2) { if (h) PG8_STAGE(bufoff, gbase, voffB1); else PG8_STAGE(bufoff, gbase, voffB); } else PG8_STAGE(bufoff, (gbase) + ((h) ? hstep : 0), voffB); } while (0)
#define PG8_GOFF(dst, u_) do { if constexpr (GATHER) { _Pragma("unroll") for (int h_ = 0; h_ < 2; ++h_) _Pragma("unroll") for (int i_ = 0; i_ < 2; ++i_) \
        dst[h_][i_] = ((unsigned)g.lidx[(u_) * BM + h_ * HALF + gR[i_]] * (unsigned)K + (unsigned)gC[i_]) * 2u; } } while (0)
#define PG8_STAGE_A(bufoff, gbase, h, nx) do { if constexpr (GATHER) { unsigned vo_[2] = { (nx) ? goffN[h][0] : goffC[h][0], (nx) ? goffN[h][1] : goffC[h][1] }; PG8_STAGE(bufoff, gbase, vo_); } \
        else { PG8_STAGE(bufoff, (gbase) + ((h) ? hstep : 0), voffA); } } while (0)
#define PG8_LDA(dst, b, h) do { _Pragma("unroll") for (int m = 0; m < 4; ++m) _Pragma("unroll") for (int k = 0; k < 2; ++k) { if constexpr (FP8) { if (k == 0) dst##8[m] = PG8_CAT2(*(const PG8_LAS i32x4*)(lds + PG8_SA(b, h) + aoff + m * 2048), *(const PG8_LAS i32x4*)(lds + PG8_SA(b, h) + aoff + m * 2048 + 16)); } else dst[m][k] = *(const PG8_LAS bf16x8*)(lds + PG8_SA(b, h) + aoff + m * 2048 + k * 1024); } } while (0)
#define PG8_LDB(dst, b, h) do { _Pragma("unroll") for (int n = 0; n < 2; ++n) _Pragma("unroll") for (int k = 0; k < 2; ++k) { if constexpr (FP8) { if (k == 0) dst##8[n] = PG8_CAT2(*(const PG8_LAS i32x4*)(lds + PG8_SB(b, h) + boff + n * 2048), *(const PG8_LAS i32x4*)(lds + PG8_SB(b, h) + boff + n * 2048 + 16)); } else dst[n][k] = *(const PG8_LAS bf16x8*)(lds + PG8_SB(b, h) + boff + n * 2048 + k * 1024); } } while (0)
#define PG8_CAT2(lo_, hi_) __builtin_shufflevector(lo_, hi_, 0, 1, 2, 3, 4, 5, 6, 7)
#define PG8_MMA(ai, bj, At, Bt) do { __builtin_amdgcn_s_setprio(1); _Pragma("unroll") for (int m = 0; m < 4; ++m) _Pragma("unroll") for (int n = 0; n < 2; ++n) { \
        if constexpr (FP8) asm volatile("v_mfma_scale_f32_16x16x128_f8f6f4 %0, %1, %2, %0, %3, %3 op_sel_hi:[0,0,0]" : "+v"(acc[ai][bj][m][n]) : "v"(Bt##8[n]), "v"(At##8[m]), "v"(mxone));     \
        else { _Pragma("unroll") for (int k = 0; k < 2; ++k) acc[ai][bj][m][n] = __builtin_amdgcn_mfma_f32_16x16x32_bf16(Bt[n][k], At[m][k], acc[ai][bj][m][n], 0, 0, 0); } } __builtin_amdgcn_s_setprio(0); } while (0)
#define PG8_MF_(d, a, b, c) "v_mfma_scale_f32_16x16x128_f8f6f4 " d ", " b ", " a ", " c ", %14, %14 op_sel_hi:[0,0,0]\n\t"
#define PG8_MMA0(ai, bj, At, Bt, first) do { if constexpr (C0) { __builtin_amdgcn_s_setprio(1); asm volatile("s_cmp_eq_u32 %15, 0\n\ts_cbranch_scc1 .Lma_%=\n\t" \
        PG8_MF_("%0", "%8", "%12", "0") PG8_MF_("%1", "%8", "%13", "0") PG8_MF_("%2", "%9", "%12", "0") PG8_MF_("%3", "%9", "%13", "0") \
        PG8_MF_("%4", "%10", "%12", "0") PG8_MF_("%5", "%10", "%13", "0") PG8_MF_("%6", "%11", "%12", "0") PG8_MF_("%7", "%11", "%13", "0") \
        "s_branch .Lmd_%=\n.Lma_%=:\n\t" \
        PG8_MF_("%0", "%8", "%12", "%0") PG8_MF_("%1", "%8", "%13", "%1") PG8_MF_("%2", "%9", "%12", "%2") PG8_MF_("%3", "%9", "%13", "%3") \
        PG8_MF_("%4", "%10", "%12", "%4") PG8_MF_("%5", "%10", "%13", "%5") PG8_MF_("%6", "%11", "%12", "%6") PG8_MF_("%7", "%11", "%13", "%7") \
        ".Lmd_%=:" \
        : "+v"(acc[ai][bj][0][0]), "+v"(acc[ai][bj][0][1]), "+v"(acc[ai][bj][1][0]), "+v"(acc[ai][bj][1][1]), "+v"(acc[ai][bj][2][0]), "+v"(acc[ai][bj][2][1]), "+v"(acc[ai][bj][3][0]), "+v"(acc[ai][bj][3][1]) \
        : "v"(At##8[0]), "v"(At##8[1]), "v"(At##8[2]), "v"(At##8[3]), "v"(Bt##8[0]), "v"(Bt##8[1]), "v"(mxone), "s"(first) : "scc"); __builtin_amdgcn_s_setprio(0); } else PG8_MMA(ai, bj, At, Bt); } while (0)
#define PG8_WAIT_V(n) asm volatile("s_waitcnt vmcnt(" #n ")" ::: "memory")
#define PG8_WAIT_L(n) asm volatile("s_waitcnt lgkmcnt(" #n ")" ::: "memory")
#define PG8_BAR __builtin_amdgcn_s_barrier()
#define PG8_SCHED __builtin_amdgcn_sched_barrier(0)
    Unit cur, nxt; int ui = 0;
    if (!S.next(0, cur)) return;
    constexpr bool C0 = FP8 && C0Of<Epi>::v; static_assert(!C0 || (SP2 && !Epi::CHAIN), "C0START: the SP2 loop starts the accumulators itself (no zeroing), no chaining");
    f32x4 acc[2][2][4][2];
    if constexpr (!C0) {
#pragma unroll
    for (int a = 0; a < 2; ++a)
#pragma unroll
        for (int b = 0; b < 2; ++b)
#pragma unroll
            for (int m = 0; m < 4; ++m)
#pragma unroll
                for (int n = 0; n < 2; ++n) acc[a][b][m][n] = (f32x4){0.f, 0.f, 0.f, 0.f}; }
    bf16x8 At[4][2], B0[2][2], B1[2][2];
    typedef int i32x8 __attribute__((ext_vector_type(8)));
    i32x8 At8[4], B08[2], B18[2];
    const int mxone = 0x7f7f7f7f;
    const char* cA = (const char*)((Epi::CHAIN && cur.sel) ? g.A2 : g.A) + (GATHER ? (size_t)0 : (size_t)cur.pm * tstep); PG8_GOFF(goffC, 0); const char* cB = (const char*)((Epi::CHAIN && cur.sel) ? g.Bt2 : g.Bt) + (size_t)cur.pb * tstep;
    S.a_ready(cur);
    if constexpr (SP2) {
        PG8_STAGE_B(PG8_SB(0, 0), cB, 0); PG8_STAGE_B(PG8_SB(0, 1), cB, 1); PG8_STAGE_A(PG8_SA(0, 0), cA, 0, false); PG8_STAGE_A(PG8_SA(0, 1), cA, 1, false);
        if (wr == 1) PG8_BAR;
        PG8_WAIT_V(2); PG8_BAR;
        PG8_STAGE_B(PG8_SB(1, 0), cB + kstep, 0); PG8_STAGE_A(PG8_SA(1, 0), cA + kstepA, 0, false); PG8_STAGE_B(PG8_SB(1, 1), cB + kstep, 1);
        PG8_WAIT_V(6); PG8_BAR;
    } else {
        PG8_STAGE_B(PG8_SB(0, 0), cB, 0); PG8_STAGE(PG8_SA(0, 0), cA, voffA); PG8_STAGE_B(PG8_SB(0, 1), cB, 1); PG8_STAGE(PG8_SA(0, 1), cA + hstep, voffA);
        if (wr == 1) PG8_BAR;
        PG8_WAIT_V(4); PG8_BAR;
        PG8_STAGE_B(PG8_SB(1, 0), cB + kstep, 0); PG8_STAGE(PG8_SA(1, 0), cA + kstepA, voffA); PG8_STAGE_B(PG8_SB(1, 1), cB + kstep, 1);
        PG8_WAIT_V(6); PG8_BAR;
    }
    for (;;) {
        const typename Epi::Pre pre = E.pre(cur, wr, wc, fr, fq);
        const bool has_next = S.next(ui + 1, nxt);
        if (has_next) PG8_GOFF(goffN, ui + 1); else { _Pragma("unroll") for (int h_ = 0; h_ < 2; ++h_) _Pragma("unroll") for (int i_ = 0; i_ < 2; ++i_) goffN[h_][i_] = goffC[h_][i_]; }
        const char* nA = (has_next && !GATHER) ? (const char*)((Epi::CHAIN && nxt.sel) ? g.A2 : g.A) + (size_t)nxt.pm * tstep : cA; const char* nB = has_next ? (const char*)((Epi::CHAIN && nxt.sel) ? g.Bt2 : g.Bt) + (size_t)nxt.pb * tstep : cB;
        for (int t = 0; t < nt; t += 2) {
            const bool last = (t == nt - 2); const int first = __builtin_amdgcn_readfirstlane(t == 0 ? 1 : 0);
            const char* a1 = cA + (size_t)(t + 1) * kstepA;
            const char* a2 = last ? nA : cA + (size_t)(t + 2) * kstepA; const char* b2 = last ? nB : cB + (size_t)(t + 2) * kstep;
            const char* a3 = a2 + kstepA; const char* b3 = b2 + kstep;
            if (last && has_next) S.a_ready(nxt);
            if constexpr (SP2) {
            PG8_LDB(B0, 0, 0); PG8_LDB(B1, 0, 1); PG8_SCHED; PG8_LDA(At, 0, 0); PG8_STAGE_A(PG8_SA(1, 1), a1, 1, false);
            PG8_WAIT_V(8); PG8_WAIT_L(0); PG8_BAR; PG8_MMA0(0, 0, At, B0, first); PG8_MMA0(0, 1, At, B1, first); PG8_BAR; PG8_SCHED;
            PG8_LDA(At, 0, 1); PG8_STAGE_B(PG8_SB(0, 0), b2, 0); PG8_STAGE_B(PG8_SB(0, 1), b2, 1); PG8_STAGE_A(PG8_SA(0, 0), a2, 0, last);
            PG8_WAIT_V(8); PG8_WAIT_L(0); PG8_BAR; PG8_MMA0(1, 0, At, B0, first); PG8_MMA0(1, 1, At, B1, first); PG8_BAR; PG8_SCHED;
            PG8_LDB(B0, 1, 0); PG8_LDB(B1, 1, 1); PG8_SCHED; PG8_LDA(At, 1, 0); PG8_STAGE_A(PG8_SA(0, 1), a2, 1, last);
            PG8_WAIT_V(8); PG8_WAIT_L(0); PG8_BAR; PG8_MMA(0, 0, At, B0); PG8_MMA(0, 1, At, B1); PG8_BAR; PG8_SCHED;
            PG8_LDA(At, 1, 1); PG8_STAGE_B(PG8_SB(1, 0), b3, 0); PG8_STAGE_B(PG8_SB(1, 1), b3, 1); PG8_STAGE_A(PG8_SA(1, 0), a3, 0, last);
            PG8_WAIT_V(8); PG8_WAIT_L(0); PG8_BAR; PG8_MMA(1, 0, At, B0); PG8_MMA(1, 1, At, B1); PG8_BAR; PG8_SCHED;
            } else {
            PG8_LDB(B0, 0, 0); PG8_SCHED; PG8_LDA(At, 0, 0); PG8_STAGE(PG8_SA(1, 1), a1 + hstep, voffA);
            PG8_WAIT_L(8); PG8_BAR; PG8_WAIT_L(0); PG8_MMA(0, 0, At, B0); PG8_BAR; PG8_SCHED;
            PG8_LDB(B1, 0, 1); PG8_STAGE_B(PG8_SB(0, 0), b2, 0);
            PG8_BAR; PG8_WAIT_L(0); PG8_MMA(0, 1, At, B1); PG8_BAR;
            PG8_LDA(At, 0, 1); PG8_STAGE(PG8_SA(0, 0), a2, voffA);
            PG8_BAR; PG8_WAIT_L(0); PG8_MMA(1, 0, At, B0); PG8_BAR; PG8_SCHED;
            PG8_STAGE_B(PG8_SB(0, 1), b2, 1);
            PG8_WAIT_V(6); PG8_BAR; PG8_MMA(1, 1, At, B1); PG8_BAR;
            PG8_LDB(B0, 1, 0); PG8_SCHED; PG8_LDA(At, 1, 0); PG8_STAGE(PG8_SA(0, 1), a2 + hstep, voffA);
            PG8_WAIT_L(8); PG8_BAR; PG8_WAIT_L(0); PG8_MMA(0, 0, At, B0); PG8_BAR; PG8_SCHED;
            PG8_LDB(B1, 1, 1); PG8_STAGE_B(PG8_SB(1, 0), b3, 0);
            PG8_BAR; PG8_WAIT_L(0); PG8_MMA(0, 1, At, B1); PG8_BAR;
            PG8_LDA(At, 1, 1); PG8_STAGE(PG8_SA(1, 0), a3, voffA);
            PG8_BAR; PG8_WAIT_L(0); PG8_MMA(1, 0, At, B0); PG8_BAR; PG8_SCHED;
            PG8_STAGE_B(PG8_SB(1, 1), b3, 1);
            PG8_WAIT_V(6); PG8_BAR; PG8_MMA(1, 1, At, B1); PG8_BAR;
            }
        }
        if constexpr (FP8) asm volatile("s_nop 15\n\ts_nop 15" ::: "memory");
        if constexpr (ALIGN_EPI) { if (wr == 0) PG8_BAR; }
        bool keep_acc = false;
        if constexpr (Epi::CHAIN) { if (cur.sel == 0) { E.mid(acc, cur, wr, wc, fr, fq); keep_acc = true; } else E(acc, cur, wr, wc, fr, fq, pre); S.done(cur); }
        else if constexpr (!Epi::AFTER_DRAIN) { E(acc, cur, wr, wc, fr, fq, pre); S.done(cur); }
        if (!has_next) break;
        if (!keep_acc && !C0) {
#pragma unroll
        for (int a = 0; a < 2; ++a)
#pragma unroll
            for (int b = 0; b < 2; ++b)
#pragma unroll
                for (int m = 0; m < 4; ++m)
#pragma unroll
                    for (int n = 0; n < 2; ++n) acc[a][b][m][n] = (f32x4){0.f, 0.f, 0.f, 0.f};
        }
        cur = nxt; cA = nA; cB = nB; ++ui;
#pragma unroll
        for (int h_ = 0; h_ < 2; ++h_)
#pragma unroll
            for (int i_ = 0; i_ < 2; ++i_) goffC[h_][i_] = goffN[h_][i_];
        if constexpr (ALIGN_EPI) { if (wr == 1) PG8_BAR; }
    }
    PG8_WAIT_V(0);
    if constexpr (!ALIGN_EPI) { if (wr == 0) PG8_BAR; }
    PG8_BAR;
    if constexpr (Epi::AFTER_DRAIN) { E.fused(acc, cur, wr, wc, fr, fq, lds, wid, lane); S.done(cur); }
#undef PG8_SA
#undef PG8_SB
#undef PG8_STAGE
#undef PG8_GOFF
#undef PG8_STAGE_A
#undef PG8_STAGE_B
#undef PG8_CAT2
#undef PG8_LDA
#undef PG8_LDB
#undef PG8_MMA
#undef PG8_MMA0
#undef PG8_MF_
#undef PG8_WAIT_V
#undef PG8_WAIT_L
#undef PG8_BAR
#undef PG8_SCHED
}
}
#include <hip/hip_bf16.h>
#include <cmath>
namespace attn_body {
using bf16=__hip_bfloat16;
using bf16x8=__attribute__((ext_vector_type(8)))short;
using s16x4=__attribute__((ext_vector_type(4)))short;
using f32x16=__attribute__((ext_vector_type(16)))float;
using u32x4=__attribute__((ext_vector_type(4)))unsigned;
constexpr int BATCH=4,NHEAD=8,NKVH=2,SEQ=8192,D=64,QP=NHEAD*D,KP=NKVH*D;
constexpr int NW=8,QBLK=32,QB=QBLK*NW,KVBLK=64,NQB=SEQ/QB;
constexpr int ATTN_UNIT_ROWS=QB;
__device__ __forceinline__ int crow(int r,int hi){return (r&3)+8*(r>>2)+4*hi;}
#define SBAR() __builtin_amdgcn_sched_barrier(0)
constexpr int NSLOT=3, SLOTB=8192;
constexpr int LDS_K=0, LDS_V=NSLOT*SLOTB, LDS_WS=2*NSLOT*SLOTB, LDS_OST=LDS_WS+NW*64*4, LDS_BYTES=LDS_OST+NW*4096;
constexpr float C2=0.125f*1.4426950408889634f;
__device__ __forceinline__ void glds16(const void*gsrc,unsigned lds_dst){unsigned keep;
  asm volatile("s_mov_b32 %0, m0\n\ts_mov_b32 m0, %2\n\ts_nop 0\n\tglobal_load_lds_dwordx4 %1, off\n\ts_mov_b32 m0, %0":"=&s"(keep):"v"(gsrc),"s"(lds_dst):"memory");}
__device__ __forceinline__ float max3f(float a,float b,float c){float r;asm("v_max3_f32 %0, %1, %2, %3":"=v"(r):"v"(a),"v"(b),"v"(c));return r;}
__device__ __forceinline__ float max2f(float a,float b){float r;asm("v_max_f32_e32 %0, %1, %2":"=v"(r):"v"(a),"v"(b));return r;}
__device__ __forceinline__ float fadd_s(float a,float b){float r;asm("v_add_f32_e32 %0, %1, %2":"=v"(r):"v"(a),"v"(b));return r;}
__device__ __forceinline__ float fsub_s(float a,float b){float r;asm("v_sub_f32_e32 %0, %1, %2":"=v"(r):"v"(a),"v"(b));return r;}
typedef float f32x2_t __attribute__((ext_vector_type(2))); typedef __bf16 bf16x2_t __attribute__((ext_vector_type(2)));
__device__ __forceinline__ unsigned cvtpk_s(float lo,float hi){f32x2_t v={lo,hi};bf16x2_t b=__builtin_convertvector(v,bf16x2_t);return __builtin_bit_cast(unsigned,b);}
#define WAIT_BAR(N) asm volatile("s_waitcnt vmcnt(" #N ") lgkmcnt(0)\n\ts_barrier":::"memory")

__device__ __forceinline__ void qkt(f32x16&p0,f32x16&p1,const char*Kslot,const bf16x8*qr,const f32x16&negm,int r32,int hi){
  const char*kb=Kslot+hi*1024+r32*16;
  #pragma unroll
  for(int d0=0;d0<4;++d0){
    const bf16x8 b0=*reinterpret_cast<const bf16x8*>(kb+d0*2048);
    const bf16x8 b1=*reinterpret_cast<const bf16x8*>(kb+d0*2048+512);
    if(d0==0){p0=__builtin_amdgcn_mfma_f32_32x32x16_bf16(b0,qr[0],negm,0,0,0);p1=__builtin_amdgcn_mfma_f32_32x32x16_bf16(b1,qr[0],negm,0,0,0);}
    else{p0=__builtin_amdgcn_mfma_f32_32x32x16_bf16(b0,qr[d0],p0,0,0,0);p1=__builtin_amdgcn_mfma_f32_32x32x16_bf16(b1,qr[d0],p1,0,0,0);}}
}
typedef __attribute__((address_space(3))) const char* lds_cptr;
typedef short v4i16_t __attribute__((ext_vector_type(4)));
__device__ __forceinline__ void kload8(bf16x8*kf,lds_cptr kp){
  kf[0]=*(const __attribute__((address_space(3))) bf16x8*)(kp);      kf[1]=*(const __attribute__((address_space(3))) bf16x8*)(kp+512);
  kf[2]=*(const __attribute__((address_space(3))) bf16x8*)(kp+2048); kf[3]=*(const __attribute__((address_space(3))) bf16x8*)(kp+2560);
  kf[4]=*(const __attribute__((address_space(3))) bf16x8*)(kp+4096); kf[5]=*(const __attribute__((address_space(3))) bf16x8*)(kp+4608);
  kf[6]=*(const __attribute__((address_space(3))) bf16x8*)(kp+6144); kf[7]=*(const __attribute__((address_space(3))) bf16x8*)(kp+6656);
}
__device__ __forceinline__ void kload2(bf16x8*kf,lds_cptr kp,int j){ kf[2*j]=*(const __attribute__((address_space(3))) bf16x8*)(kp+j*2048); kf[2*j+1]=*(const __attribute__((address_space(3))) bf16x8*)(kp+j*2048+512); }
__device__ __forceinline__ s16x4 vtr(lds_cptr p){ return __builtin_bit_cast(s16x4,__builtin_amdgcn_ds_read_tr16_b64_v4i16((__attribute__((address_space(3))) v4i16_t*)p)); }
__device__ __forceinline__ float rowmax(const f32x16&p0,const f32x16&p1){
  float a=max3f(p0[0],p0[1],p1[0]),b=max3f(p0[2],p0[3],p1[1]);a=max3f(a,p1[2],p1[3]);
  #pragma unroll
  for(int r=4;r<16;r+=4){a=max3f(a,p0[r],p0[r+1]);b=max3f(b,p0[r+2],p0[r+3]);a=max3f(a,p1[r],p1[r+1]);b=max3f(b,p1[r+2],p1[r+3]);}
  const float m=max2f(a,b);
  auto rr=__builtin_amdgcn_permlane32_swap(__float_as_uint(m),__float_as_uint(m),false,false);
  return max2f(__uint_as_float(rr[0]),__uint_as_float(rr[1]));
}
__device__ __forceinline__ void pv(f32x16*o,int vb,bf16x8 pa0,bf16x8 pa1,bf16x8 pa2,bf16x8 pa3){
  #pragma unroll
  for(int d0=0;d0<2;++d0){s16x4 lo[4],hi[4];
    #pragma unroll
    for(int ks=0;ks<4;++ks){
      asm volatile("ds_read_b64_tr_b16 %0,%1 offset:%c2":"=&v"(lo[ks]):"v"(vb),"i"(d0*4096+ks*1024):"memory");
      asm volatile("ds_read_b64_tr_b16 %0,%1 offset:%c2":"=&v"(hi[ks]):"v"(vb),"i"(d0*4096+ks*1024+512):"memory");}
    asm volatile("s_waitcnt lgkmcnt(0)":::"memory");SBAR();
    #define PK(k) (bf16x8){lo[k][0],lo[k][1],lo[k][2],lo[k][3],hi[k][0],hi[k][1],hi[k][2],hi[k][3]}
    o[d0]=__builtin_amdgcn_mfma_f32_32x32x16_bf16(pa0,PK(0),o[d0],0,0,0);
    o[d0]=__builtin_amdgcn_mfma_f32_32x32x16_bf16(pa1,PK(1),o[d0],0,0,0);
    o[d0]=__builtin_amdgcn_mfma_f32_32x32x16_bf16(pa2,PK(2),o[d0],0,0,0);
    o[d0]=__builtin_amdgcn_mfma_f32_32x32x16_bf16(pa3,PK(3),o[d0],0,0,0);
    #undef PK
  }
}

#ifndef ATTN_STORE16
#define ATTN_STORE16(p,v) (*(u32x4*)(p)=(v))
#endif
template<int THRL> __device__ __forceinline__ void attn_unit(int b,int h,int qb,const bf16*Q,const bf16*__restrict__ K,const bf16*__restrict__ V,bf16*O,char*shm,const float mref){
  const int tid=threadIdx.x,lane=tid&63,r32=lane&31,hi=lane>>5; const int wid=__builtin_amdgcn_readfirstlane(tid>>6);
  const long rowbase=(long)b*SEQ; const int q0=qb*QB;
  const bf16*Qw=Q+(rowbase+q0+wid*QBLK)*QP+h*D;
  const int hk=h/(NHEAD/NKVH); const bf16*Kh=K+rowbase*KP+hk*D,*Vh=V+rowbase*KP+hk*D;
  const unsigned lds0=(unsigned)(uintptr_t)shm;
  float*wsf=(float*)(shm+LDS_WS)+wid*64;
  const bf16*ksrc=Kh+(long)lane*KP+wid*8;
  const bf16*vsrc=Vh+(long)(16*(wid&3)+(lane>>2))*KP+(wid>>2)*32+(lane&3)*8;
  const unsigned kdst=lds0+LDS_K+wid*1024, vdst=lds0+LDS_V+wid*1024;
  #define DMA_K(t,slot) glds16(ksrc+(long)(t)*KVBLK*KP,(unsigned)__builtin_amdgcn_readfirstlane(kdst+(slot)))
  #define DMA_V(t,slot) glds16(vsrc+(long)(t)*KVBLK*KP,(unsigned)__builtin_amdgcn_readfirstlane(vdst+(slot)))
  const int vb0=(int)(lds0+LDS_V)+((lane>>4)&1)*32+(lane&3)*8+(4*hi+((lane&15)>>2))*64;
  const char*Kbase=shm+LDS_K; bf16x8 kf[8];
  const lds_cptr shm3=(lds_cptr)shm; const lds_cptr kp0=shm3+LDS_K+hi*1024+r32*16; const lds_cptr vp0=shm3+LDS_V+((lane>>4)&1)*32+(lane&3)*8+(4*hi+((lane&15)>>2))*64;
  constexpr int NT=SEQ/KVBLK;
  DMA_K(0,0);DMA_V(0,0);DMA_K(1,SLOTB);
  bf16x8 qr[4];
  #pragma unroll
  for(int d0=0;d0<4;++d0)qr[d0]=*reinterpret_cast<const bf16x8*>(&Qw[(long)r32*QP+d0*16+hi*8]);
  float mhat=0.f,l_reg=0.f;f32x16 o[2];o[0]=f32x16{};o[1]=f32x16{};f32x16 negm=f32x16{};asm volatile("":"+v"(negm));
    #define CMASK(P0,P1,t) do{}while(0)
  bool resc=false;
  #define START(P0,P1) do{ resc=false; \
    { const float dl=mref; mhat=fadd_s(mhat,dl); \
      _Pragma("unroll") for(int r=0;r<16;++r){P0[r]=fsub_s(P0[r],dl);P1[r]=fsub_s(P1[r],dl);} \
      _Pragma("unroll") for(int r=0;r<16;++r)negm[r]=-mhat; asm volatile("":"+v"(negm)); } \
    _Pragma("unroll") for(int r=0;r<16;++r)P0[r]=__builtin_amdgcn_exp2f(P0[r]); }while(0)
  #define RESC() do{ if(resc){ asm volatile("s_waitcnt lgkmcnt(0)":::"memory"); \
      _Pragma("unroll") for(int d_=0;d_<2;++d_) _Pragma("unroll") for(int r=0;r<16;++r)o[d_][r]*=wsf[crow(r,hi)]; } }while(0)
  f32x16 pA0,pA1,pB0,pB1;
  int sl_prev=0,sl_cur=0,sl_next=SLOTB;
  #define ROT() do{sl_prev=sl_cur;sl_cur=sl_next;sl_next=(sl_next==(NSLOT-1)*SLOTB)?0:sl_next+SLOTB;}while(0)
  DMA_K(2,2*SLOTB);
  WAIT_BAR(3);
  qkt(pA0,pA1,Kbase,qr,negm,r32,hi);asm volatile("s_nop 15\n\ts_nop 7":"+v"(pA0),"+v"(pA1));CMASK(pA0,pA1,0);
  START(pA0,pA1);
  _Pragma("unroll") for(int r=0;r<16;++r)pA1[r]=__builtin_amdgcn_exp2f(pA1[r]);
  WAIT_BAR(0);
  DMA_K(3,0);DMA_V(1,SLOTB);
  ROT();
  kload8(kf,kp0+sl_cur);
  WAIT_BAR(2);
  s16x4 vlo[8],vhi[8]; u32x4 pw0,pw1,pw2,pw3;
  #define PKW(P,B) cvtpk_s(P[B],P[B+1])
  #define PAF(k) __builtin_bit_cast(bf16x8,pw##k)
  #define VFR(i) (bf16x8){vlo[i][0],vlo[i][1],vlo[i][2],vlo[i][3],vhi[i][0],vhi[i][1],vhi[i][2],vhi[i][3]}
  #define PIN(x) asm volatile("":"+v"(x))
  #define MX3(a,b,c) __builtin_fmaxf(__builtin_fmaxf((a),(b)),(c))
  #define GAPA(MF,A0,A1,A2,A3,W0,W1,PW) do{ MF; sacc+=A0; sacc+=A1; sacc+=A2; sacc+=A3; PIN(sacc); W0; W1; PIN(PW); SBAR(); }while(0)
  #define EX(v) __builtin_amdgcn_exp2f(v)
  #define GAPB(MF,X,B) do{ MF; X[B]=EX(X[B]); X[B+1]=EX(X[B+1]); X[B+2]=EX(X[B+2]); X[B+3]=EX(X[B+3]); PIN(X); SBAR(); }while(0)
  #define VRD(i) do{ vlo[i]=vtr(vp_+(((i)>>2)*4096+((i)&3)*1024)); vhi[i]=vtr(vp_+(((i)>>2)*4096+((i)&3)*1024+512)); }while(0)
  #define KRD(G,j) do{ if(G){ kload2(kf,kp0+sl_next,j); SBAR(); } }while(0)
  #define STEP(C0,C1,P0,P1,t,GK,GV,GL) do{ SBAR(); \
    const lds_cptr vp_=vp0+sl_prev; \
    VRD(0); SBAR(); float sacc=(P0[0]+P0[1]); \
    GAPA(C0=__builtin_amdgcn_mfma_f32_32x32x16_bf16(kf[0],qr[0],negm,0,0,0), P0[2],P0[3],P0[4],P0[5],     pw0[0]=PKW(P0,0), pw0[1]=PKW(P0,2), pw0); \
    VRD(4); SBAR(); GAPA(C1=__builtin_amdgcn_mfma_f32_32x32x16_bf16(kf[1],qr[0],negm,0,0,0), P0[6],P0[7],P0[8],P0[9],     pw0[2]=PKW(P0,4), pw0[3]=PKW(P0,6), pw0); \
    VRD(1); SBAR(); GAPA(C0=__builtin_amdgcn_mfma_f32_32x32x16_bf16(kf[2],qr[1],C0,0,0,0),   P0[10],P0[11],P0[12],P0[13], pw1[0]=PKW(P0,8), pw1[1]=PKW(P0,10), pw1); \
    VRD(5); SBAR(); GAPA(C1=__builtin_amdgcn_mfma_f32_32x32x16_bf16(kf[3],qr[1],C1,0,0,0),   P0[14],P0[15],P1[0],P1[1],   pw1[2]=PKW(P0,12),pw1[3]=PKW(P0,14), pw1); \
    VRD(2); SBAR(); GAPA(C0=__builtin_amdgcn_mfma_f32_32x32x16_bf16(kf[4],qr[2],C0,0,0,0),   P1[2],P1[3],P1[4],P1[5],     pw2[0]=PKW(P1,0), pw2[1]=PKW(P1,2), pw2); \
    VRD(6); SBAR(); GAPA(C1=__builtin_amdgcn_mfma_f32_32x32x16_bf16(kf[5],qr[2],C1,0,0,0),   P1[6],P1[7],P1[8],P1[9],     pw2[2]=PKW(P1,4), pw2[3]=PKW(P1,6), pw2); \
    VRD(3); SBAR(); GAPA(C0=__builtin_amdgcn_mfma_f32_32x32x16_bf16(kf[6],qr[3],C0,0,0,0),   P1[10],P1[11],P1[12],P1[13], pw3[0]=PKW(P1,8), pw3[1]=PKW(P1,10), pw3); \
    VRD(7); SBAR(); GAPA(C1=__builtin_amdgcn_mfma_f32_32x32x16_bf16(kf[7],qr[3],C1,0,0,0),   P1[14],P1[15],0.f,0.f,       pw3[2]=PKW(P1,12),pw3[3]=PKW(P1,14), pw3); \
    l_reg+=sacc; \
    if(GK){DMA_K((t)+3,sl_cur);} if(GV){DMA_V((t)+1,sl_next);} \
    CMASK(C0,C1,t); \
    resc=false;   \
    SBAR(); \
    GAPB(o[0]=__builtin_amdgcn_mfma_f32_32x32x16_bf16(PAF(0),VFR(0),o[0],0,0,0), C0,0); \
    GAPB(o[1]=__builtin_amdgcn_mfma_f32_32x32x16_bf16(PAF(0),VFR(4),o[1],0,0,0), C0,4); \
    KRD(GL,0); GAPB(o[0]=__builtin_amdgcn_mfma_f32_32x32x16_bf16(PAF(1),VFR(1),o[0],0,0,0), C0,8); \
    KRD(GL,1); GAPB(o[1]=__builtin_amdgcn_mfma_f32_32x32x16_bf16(PAF(1),VFR(5),o[1],0,0,0), C0,12); \
    KRD(GL,2); GAPB(o[0]=__builtin_amdgcn_mfma_f32_32x32x16_bf16(PAF(2),VFR(2),o[0],0,0,0), C1,0); \
    KRD(GL,3); GAPB(o[1]=__builtin_amdgcn_mfma_f32_32x32x16_bf16(PAF(2),VFR(6),o[1],0,0,0), C1,4); \
    GAPB(o[0]=__builtin_amdgcn_mfma_f32_32x32x16_bf16(PAF(3),VFR(3),o[0],0,0,0), C1,8); \
    GAPB(o[1]=__builtin_amdgcn_mfma_f32_32x32x16_bf16(PAF(3),VFR(7),o[1],0,0,0), C1,12); \
    }while(0)
  int t=1;
  #undef CMASK
  #define CMASK(P0,P1,t) do{}while(0)
  for(;t+5<NT;t+=2){
    STEP(pB0,pB1,pA0,pA1,t,true,true,true);     WAIT_BAR(2); RESC(); ROT();
    STEP(pA0,pA1,pB0,pB1,t+1,true,true,true);   WAIT_BAR(2); RESC(); ROT();
  }
  #undef CMASK
  #define CMASK(P0,P1,t) do{}while(0)
  #define ENDW(tt) do{ if((tt)+3<NT){WAIT_BAR(2);} else if((tt)+2<NT){WAIT_BAR(1);} else {WAIT_BAR(0);} }while(0)
  for(;t+1<NT;t+=2){
    STEP(pB0,pB1,pA0,pA1,t,(t+3<NT),(t+1<NT),(t+1<NT));       ENDW(t);   RESC(); ROT();
    STEP(pA0,pA1,pB0,pB1,t+1,(t+4<NT),(t+2<NT),(t+2<NT));     ENDW(t+1); RESC(); ROT();
  }
  STEP(pB0,pB1,pA0,pA1,NT-1,false,false,false); RESC();
  { float sacc=pB0[0]+pB0[1]; _Pragma("unroll") for(int r=2;r<16;++r)sacc+=pB0[r]; _Pragma("unroll") for(int r=0;r<16;++r)sacc+=pB1[r]; l_reg+=sacc;
    pw0=(u32x4){PKW(pB0,0),PKW(pB0,2),PKW(pB0,4),PKW(pB0,6)};pw1=(u32x4){PKW(pB0,8),PKW(pB0,10),PKW(pB0,12),PKW(pB0,14)};pw2=(u32x4){PKW(pB1,0),PKW(pB1,2),PKW(pB1,4),PKW(pB1,6)};pw3=(u32x4){PKW(pB1,8),PKW(pB1,10),PKW(pB1,12),PKW(pB1,14)};
    SBAR(); pv(o,vb0+sl_cur,PAF(0),PAF(1),PAF(2),PAF(3)); }
  #undef PKW
  #undef PAF
  #undef VFR
  #undef PIN
  #undef MX3
  #undef GAPA
  #undef GAPB
  #undef EX
  #undef VRD
  #undef KRD
  #undef STEP
  #undef ENDW
  {auto rr=__builtin_amdgcn_permlane32_swap(__float_as_uint(l_reg),__float_as_uint(l_reg),false,false);l_reg=__uint_as_float(rr[0])+__uint_as_float(rr[1]);}
  if(hi==0)wsf[32+r32]=l_reg;asm volatile("s_waitcnt lgkmcnt(0)":::"memory");
  float rli[16];
  #pragma unroll
  for(int r=0;r<16;++r)rli[r]=__builtin_amdgcn_rcpf(wsf[32+crow(r,hi)]);
  bf16*Ow=O+(rowbase+q0+wid*QBLK)*QP+h*D;
  { bf16*stg=(bf16*)(shm+LDS_OST)+wid*2048;
    #pragma unroll
    for(int r=0;r<16;++r){const int orow=crow(r,hi);
      #pragma unroll
      for(int d0=0;d0<2;++d0)stg[orow*64+d0*32+r32]=__float2bfloat16(o[d0][r]*rli[r]);}
    asm volatile("s_waitcnt lgkmcnt(0)":::"memory");
    #pragma unroll
    for(int i=0;i<4;++i){const int row=i*8+(lane>>3),ch=lane&7; const u32x4 v=*(const u32x4*)(stg+row*64+ch*8); ATTN_STORE16(Ow+(long)row*QP+ch*8,v);} }
  asm volatile("s_waitcnt lgkmcnt(0)\n\ts_barrier":::"memory");
  #undef DMA_K
  #undef DMA_V
  #undef CMASK
  #undef START
  #undef RESC
  #undef ROT
}
constexpr int ATTN_LDS_BYTES=LDS_BYTES;
struct AttnTensors { const bf16* Q; const bf16* K; const bf16* V; bf16* O; float mref; };
struct AttnUnit { int bh; int qb; };
struct StaticOrder {
  int vcu,per;
  __device__ __forceinline__ explicit StaticOrder(int grid,int vcu_):vcu(vcu_),per((BATCH*NHEAD*NQB+grid-1)/grid){}
  __device__ __forceinline__ bool next(int i,AttnUnit&u)const{ if(i>=per)return false; const int U=vcu*per+i; if(U>=BATCH*NHEAD*NQB)return false; u.bh=U/NQB; u.qb=U%NQB; return true; }
  __device__ __forceinline__ void a_ready(const AttnUnit&)const{}
  __device__ __forceinline__ void done(const AttnUnit&)const{}
};
typedef int i32x8v __attribute__((ext_vector_type(8)));
typedef int i32x4v __attribute__((ext_vector_type(4)));
constexpr int S8=4096, NS8=8, L8_K=0, L8_V=NS8*S8, L8_WS=2*NS8*S8, L8_OST=L8_WS+NW*64*4, L8_BYTES=L8_OST+NW*4096;
__device__ __forceinline__ unsigned pknorm16(float a,float b){ typedef unsigned short u16x2 __attribute__((ext_vector_type(2))); const u16x2 r=__builtin_amdgcn_cvt_pknorm_u16(a,b); return (unsigned)r[0]|((unsigned)r[1]<<16); }
__device__ __forceinline__ int pk4_fp8_over(int w,float a,float b,float c,float d){w=__builtin_amdgcn_cvt_pk_fp8_f32(a,b,w,false);w=__builtin_amdgcn_cvt_pk_fp8_f32(c,d,w,true);return w;}
__device__ __forceinline__ unsigned pk4_fp8(float a,float b,float c,float d){int w=0;w=__builtin_amdgcn_cvt_pk_fp8_f32(a,b,w,false);w=__builtin_amdgcn_cvt_pk_fp8_f32(c,d,w,true);return (unsigned)w;}
#define MFMA8_NEW(D_,A_,B_,C_,SA_,SB_) asm volatile("v_mfma_scale_f32_32x32x64_f8f6f4 %0, %1, %2, %3, %4, %5 op_sel_hi:[0,0,0]":"=&v"(D_):"v"(A_),"v"(B_),"v"(C_),"v"(SA_),"v"(SB_))
#define MFMA8_ACC(D_,A_,B_,SA_,SB_) asm volatile("v_mfma_scale_f32_32x32x64_f8f6f4 %0, %1, %2, %0, %3, %4 op_sel_hi:[0,0,0]":"+v"(D_):"v"(A_),"v"(B_),"v"(SA_),"v"(SB_))
__device__ __forceinline__ void attn_unit8(int b,int h,int qb,const unsigned char*Q8,const unsigned char*K8,const unsigned char*VT8,bf16*O,char*shm,const float m0){
  int tid_=threadIdx.x; asm volatile("":"+v"(tid_));
  const int tid=tid_,lane=tid&63,r32=lane&31,hi=lane>>5; const int wid=__builtin_amdgcn_readfirstlane(tid>>6);
  const long rowbase=(long)b*SEQ; const int q0=qb*QB; const int hk=h/(NHEAD/NKVH);
  constexpr int NT=SEQ/KVBLK;
  const unsigned lds0=(unsigned)(uintptr_t)shm;

  const unsigned char*qp=Q8+(size_t)(rowbase+q0+wid*QBLK+r32)*QP+h*D+32*hi;
  const i32x4v qlo=*(const i32x4v*)qp, qhi=*(const i32x4v*)(qp+16);
  i32x8v qf=__builtin_shufflevector(qlo,qhi,0,1,2,3,4,5,6,7);
  asm volatile("":"+v"(qf));
  const int pc=wid&3, hip=pc>>1, ch=pc&1;
  const unsigned char*ksrc=K8+(size_t)(rowbase+lane)*KP+hk*D+32*hip+16*ch;
  const unsigned char*vsrc=VT8+((size_t)(b*NT)*NKVH+hk)*4096+(size_t)(hip*64+lane)*32+16*ch;
  const unsigned mydst=lds0+(wid<4?L8_K:L8_V)+pc*1024;
  #define DMA8(t,slot) do{ if(wid<4) glds16(ksrc+(size_t)(t)*KVBLK*KP,(unsigned)__builtin_amdgcn_readfirstlane(mydst+(slot)*S8)); \
                           else glds16(vsrc+(size_t)(t)*NKVH*4096,(unsigned)__builtin_amdgcn_readfirstlane(mydst+(slot)*S8)); }while(0)
  const lds_cptr shm3=(lds_cptr)shm;
  const lds_cptr kfp=shm3+L8_K+hi*2048+r32*16;
  const lds_cptr vfp=shm3+L8_V+hi*2048+r32*16;
  f32x16 negm;
  #pragma unroll
  for(int r=0;r<16;++r)negm[r]=(-8.0f*m0+56.16f)*(1.0f/256.0f);
  const int sV=0x7d7d7d7d, s1=0x7f7f7f7f, sK=0x77777777;
  i32x8v ones; { const int onev=(((lane>>4)&1)==((lane>>3)&1))?0x38383838:0;
  #pragma unroll
  for(int i=0;i<8;++i)ones[i]=onev; }
  asm volatile("":"+v"(ones));
  typedef float f32x4s __attribute__((ext_vector_type(4)));
  f32x4s lsum=f32x4s{}; f32x16 o[2]; o[0]=f32x16{}; o[1]=f32x16{};
  #define KFRAG(A0,A1,SLOT) do{ const lds_cptr kp_=kfp+(SLOT)*S8; \
      const i32x4v x0=*(const __attribute__((address_space(3))) i32x4v*)(kp_), x1=*(const __attribute__((address_space(3))) i32x4v*)(kp_+1024); A0=__builtin_shufflevector(x0,x1,0,1,2,3,4,5,6,7); \
      const i32x4v y0=*(const __attribute__((address_space(3))) i32x4v*)(kp_+512), y1=*(const __attribute__((address_space(3))) i32x4v*)(kp_+1536); A1=__builtin_shufflevector(y0,y1,0,1,2,3,4,5,6,7); }while(0)
  #define VFRAG(A0,A1,SLOT) do{ const lds_cptr vp_=vfp+(SLOT)*S8; \
      const i32x4v x0=*(const __attribute__((address_space(3))) i32x4v*)(vp_), x1=*(const __attribute__((address_space(3))) i32x4v*)(vp_+1024); A0=__builtin_shufflevector(x0,x1,0,1,2,3,4,5,6,7); \
      const i32x4v y0=*(const __attribute__((address_space(3))) i32x4v*)(vp_+512), y1=*(const __attribute__((address_space(3))) i32x4v*)(vp_+1536); A1=__builtin_shufflevector(y0,y1,0,1,2,3,4,5,6,7); }while(0)
  #define STEP8(TT,KS2,VS1,UA0,UA1,LA0,LA1,S0,S1,N0,N1,v0,v1,W0,W1) do{ \
    if((TT)+1<NT){ MFMA8_NEW(N0,UA0,qf,negm,sK,s1); MFMA8_NEW(N1,UA1,qf,negm,sK,s1); } \
    if((TT)+2<NT){ KFRAG(LA0,LA1,KS2); }                                                     \
    if((TT)+1<NT){ VFRAG(W0,W1,VS1); }                                                      \
      \
    _Pragma("unroll") for(int w=0;w<4;++w){ \
      const unsigned a0=pknorm16(S0[4*w],S0[4*w+1]), a1=pknorm16(S0[4*w+2],S0[4*w+3]), b0=pknorm16(S1[4*w],S1[4*w+1]), b1=pknorm16(S1[4*w+2],S1[4*w+3]); \
      P8[w]=(int)__builtin_amdgcn_perm(a1,a0,0x07050301u); P8[4+w]=(int)__builtin_amdgcn_perm(b1,b0,0x07050301u); } \
    asm volatile("s_nop 3":"+v"(P8)); \
    MFMA8_ACC(o[0],P8,v0,s1,sV); MFMA8_ACC(o[1],P8,v1,s1,sV); asm volatile("v_mfma_scale_f32_16x16x128_f8f6f4 %0, %1, %2, %0, %3, %3 op_sel_hi:[0,0,0]":"+v"(lsum):"v"(P8),"v"(ones),"v"(s1)); \
    if((TT)+1<NT){ asm volatile("":"+v"(N0),"+v"(N1)); } }while(0)
  if(wid<4){ DMA8(0,0); DMA8(1,1); DMA8(2,2); DMA8(3,3); DMA8(4,4); DMA8(5,5); DMA8(6,6); } else { DMA8(0,0); DMA8(1,1); DMA8(2,2); DMA8(3,3); DMA8(4,4); DMA8(5,5); }
  asm volatile("s_waitcnt vmcnt(5) lgkmcnt(0)\n\ts_barrier":::"memory");
  f32x16 S0,S1,T0,T1; i32x8v xa0,xa1,ya0,ya1; i32x8v P8={};
  { KFRAG(ya0,ya1,0); MFMA8_NEW(S0,ya0,qf,negm,sK,s1); MFMA8_NEW(S1,ya1,qf,negm,sK,s1); }
  KFRAG(xa0,xa1,1);
  i32x8v vx0,vx1,vy0,vy1; VFRAG(vx0,vx1,0);
  asm volatile("s_nop 15\n\ts_nop 15\n\ts_nop 15":"+v"(S0),"+v"(S1));
  const bool kw=wid<4;
  const unsigned char*dsrc=kw?(ksrc+(size_t)7*KVBLK*KP):(vsrc+(size_t)6*NKVH*4096);
  static_assert(KVBLK*KP==8192&&NKVH*4096==8192,"K and V streams advance by the same 8 KiB per tile");
  static_assert(NS8==8,"slot constants below are for 8-slot rings");
  #define DSLOT(a_,b_) (unsigned)__builtin_amdgcn_readfirstlane(mydst+(kw?(a_):(b_))*S8)
  const unsigned dA0=DSLOT(7,6), dA1=DSLOT(0,7);
  const unsigned dB0=DSLOT(1,0), dB1=DSLOT(2,1);
  const unsigned dC0=DSLOT(3,2), dC1=DSLOT(4,3);
  const unsigned dD0=DSLOT(5,4), dD1=DSLOT(6,5);
  #undef DSLOT
  #define PAIR8(TT,SL,D0,D1) do{ asm volatile("s_waitcnt vmcnt(3)\n\ts_barrier":::"memory"); \
    STEP8(TT,((SL)+2)%NS8,((SL)+1)%NS8,xa0,xa1,ya0,ya1,S0,S1,T0,T1,vx0,vx1,vy0,vy1); \
    glds16(dsrc,D0); glds16(dsrc+8192,D1); dsrc+=16384; \
    STEP8((TT)+1,((SL)+3)%NS8,((SL)+2)%NS8,ya0,ya1,xa0,xa1,T0,T1,S0,S1,vy0,vy1,vx0,vx1); }while(0)
  static_assert(NT==128,"the peeled tail below is written for 128 tiles");
  #pragma unroll 1
  for(int t=0;t<120;t+=8){ PAIR8(t,0,dA0,dA1); PAIR8(t+2,2,dB0,dB1); PAIR8(t+4,4,dC0,dC1); PAIR8(t+6,6,dD0,dD1); }
  #undef PAIR8
  #define PAIR8T(TT,SL,WAITS,ISSUE) do{ asm volatile(WAITS "\n\ts_barrier":::"memory"); \
    STEP8(TT,((SL)+2)%NS8,((SL)+1)%NS8,xa0,xa1,ya0,ya1,S0,S1,T0,T1,vx0,vx1,vy0,vy1); \
    ISSUE; \
    STEP8((TT)+1,((SL)+3)%NS8,((SL)+2)%NS8,ya0,ya1,xa0,xa1,T0,T1,S0,S1,vy0,vy1,vx0,vx1); }while(0)
  PAIR8T(120,0,"s_waitcnt vmcnt(3)",{ glds16(dsrc,dA0); if(!kw){ glds16(dsrc+8192,dA1); } });
  PAIR8T(122,2,"s_waitcnt vmcnt(2)",{});
  PAIR8T(124,4,"s_waitcnt vmcnt(0)",{});
  PAIR8T(126,6,"s_waitcnt vmcnt(0)",{});
  #undef PAIR8T
  #undef STEP8
  #undef KFRAG
  #undef VFRAG
  asm volatile("s_nop 15\n\ts_nop 15\n\ts_nop 15":"+v"(o[0]),"+v"(o[1]),"+v"(lsum));
  float*wsf=(float*)(shm+L8_WS)+wid*64;
  if((lane&7)==0){
    #pragma unroll
    for(int v=0;v<4;++v)wsf[32+4*(lane>>4)+v+((lane&8)?16:0)]=lsum[v]; }
  asm volatile("s_waitcnt lgkmcnt(0)":::"memory");
  float rli[16];
  #pragma unroll
  for(int r=0;r<16;++r)rli[r]=__builtin_amdgcn_rcpf(wsf[32+crow(r,hi)]);
  bf16*Ow=O+(rowbase+q0+wid*QBLK)*QP+h*D;
  { bf16*stg=(bf16*)(shm+L8_OST)+wid*2048;
    #pragma unroll
    for(int r=0;r<16;++r){const int orow=crow(r,hi);
      #pragma unroll
      for(int d0=0;d0<2;++d0)stg[orow*64+d0*32+r32]=__float2bfloat16(o[d0][r]*rli[r]);}
    asm volatile("s_waitcnt lgkmcnt(0)":::"memory");
    #pragma unroll
    for(int i=0;i<4;++i){const int row=i*8+(lane>>3),chn=lane&7; const u32x4 v=*(const u32x4*)(stg+row*64+chn*8); ATTN_STORE16(Ow+(long)row*QP+chn*8,v);} }
  asm volatile("s_waitcnt lgkmcnt(0)\n\ts_barrier":::"memory");
  #undef DMA8
}
struct AttnTensors8 { const unsigned char* Q8; const unsigned char* K8; const unsigned char* VT8; bf16* O; float m0; };
template<class Sched> __device__ __forceinline__ void attn_phase8(char*lds,const AttnTensors8&T,const Sched&S){
  AttnUnit u;
  for(int i=0;S.next(i,u);++i){ attn_unit8(u.bh/NHEAD,u.bh%NHEAD,u.qb,T.Q8,T.K8,T.VT8,T.O,lds,T.m0); }
}
#undef MFMA8_NEW
#undef MFMA8_ACC
template<class Sched,int THRL=8> __device__ __forceinline__ void attn_phase(char*lds,const AttnTensors&T,const Sched&S){
  AttnUnit u;
  for(int i=0;S.next(i,u);++i){ S.a_ready(u); attn_unit<THRL>(u.bh/NHEAD,u.bh%NHEAD,u.qb,T.Q,T.K,T.V,T.O,lds,T.mref); S.done(u); }
}
#undef SBAR
#undef WAIT_BAR
}
#define GAS __attribute__((address_space(1)))
#define LAS __attribute__((address_space(3)))
typedef unsigned short bf16;
typedef unsigned v4u __attribute__((ext_vector_type(4)));
typedef float f32x4 __attribute__((ext_vector_type(4)));
typedef short bf16x8 __attribute__((ext_vector_type(8)));
typedef GAS unsigned gu32;
typedef GAS unsigned long long gu64;
#define RLX_AGENT __ATOMIC_RELAXED, __HIP_MEMORY_SCOPE_AGENT
#define LDS_WAIT() asm volatile("s_waitcnt lgkmcnt(0)" ::: "memory")
#define VM_WAIT() asm volatile("s_waitcnt vmcnt(0)" ::: "memory")
__device__ __forceinline__ unsigned long long rt() { return __builtin_amdgcn_s_memrealtime(); }

#define XB_TMO      128
#define XB_XCNT(j)  (256  + 64 * (j))
#define XB_XSUB(j)  (1280 + 64 * (j))
#define XB_XGEN(j)  (2304 + 64 * (j))
#define XB_TOP      3328
#define XB_TOPGEN   3392
#define XCD_BAR_WORDS 3456
#define XB_SPIN_CAP (1u << 18)

__device__ __forceinline__ unsigned xb_ld(unsigned* p)              { return __hip_atomic_load(p, __ATOMIC_RELAXED, __HIP_MEMORY_SCOPE_AGENT); }
__device__ __forceinline__ unsigned xb_add(unsigned* p, unsigned v) { return __hip_atomic_fetch_add(p, v, __ATOMIC_RELAXED, __HIP_MEMORY_SCOPE_AGENT); }
__device__ __forceinline__ unsigned xb_xcc_id() { return (unsigned)__builtin_amdgcn_s_getreg((3 << 11) | 20) & 0xFu; }
#define XB_SPIN(cond, bar) do { unsigned _sp = 0; while (cond) { __builtin_amdgcn_s_sleep(1); \
    if ((++_sp & 255u) == 0u) { if (xb_ld(&(bar)[XB_TMO])) break; if (_sp > XB_SPIN_CAP) { atomicAdd(&(bar)[XB_TMO], 1u); break; } } } } while (0)

struct XcdBarrier {
    unsigned* bar; unsigned x;
    volatile LAS unsigned* st;
};

__device__ __forceinline__ XcdBarrier xcd_barrier_post(unsigned* bar, volatile LAS unsigned* st) {
    XcdBarrier b; b.bar = bar; b.x = xb_xcc_id(); b.st = st;
    if (threadIdx.x == 0) (void)xb_add(&bar[XB_XCNT(b.x)], 1u);
    return b;
}
__device__ __forceinline__ void xcd_barrier_complete(unsigned* bar, unsigned x, unsigned& nloc, unsigned& nx) {
    const unsigned G = gridDim.x * gridDim.y * gridDim.z;
    unsigned sum, cnt, mine, sp = 0u;
    for (;;) {
        sum = 0u; cnt = 0u; mine = 0u;
#pragma unroll
        for (unsigned j = 0; j < 16; ++j) { const unsigned c = xb_ld(&bar[XB_XCNT(j)]); sum += c; cnt += (c > 0u) ? 1u : 0u; mine = (j == x) ? c : mine; }
        if (sum == G) break;
        __builtin_amdgcn_s_sleep(1);
        if ((++sp & 255u) == 0u) { if (xb_ld(&bar[XB_TMO])) break; if (sp > XB_SPIN_CAP) { atomicAdd(&bar[XB_TMO], 1u); break; } }
    }
    nloc = mine > 0u ? mine : 1u; nx = cnt > 0u ? cnt : 1u;
}

__device__ __forceinline__ void xcd_barrier(const XcdBarrier& b) {
    asm volatile("s_waitcnt vmcnt(0)" ::: "memory");
    __syncthreads();
    if (threadIdx.x == 0) {
        unsigned* bar = b.bar;
        __builtin_amdgcn_s_waitcnt(0);
        unsigned nloc = b.st[0], nx = b.st[1];
        if (nloc == 0u) { xcd_barrier_complete(bar, b.x, nloc, nx); b.st[0] = nloc; b.st[1] = nx; }
        const unsigned old = xb_add(&bar[XB_XSUB(b.x)], 1u);
        const unsigned gen = old / nloc;
        if (old + 1u == (gen + 1u) * nloc) {
            __builtin_amdgcn_fence(__ATOMIC_RELEASE, "agent");
            asm volatile("s_waitcnt vmcnt(0)" ::: "memory");
            const unsigned og = xb_add(&bar[XB_TOP], 1u);
            const unsigned tg = og / nx;
            if (og + 1u == (tg + 1u) * nx) xb_add(&bar[XB_TOPGEN], 1u);
            else XB_SPIN(xb_ld(&bar[XB_TOPGEN]) == tg, bar);
            __builtin_amdgcn_fence(__ATOMIC_ACQUIRE, "agent");
            xb_add(&bar[XB_XGEN(b.x)], 1u);
            asm volatile("s_waitcnt vmcnt(0)" ::: "memory");
        } else {
            XB_SPIN(xb_ld(&bar[XB_XGEN(b.x)]) == gen, bar);
            __builtin_amdgcn_fence(__ATOMIC_ACQUIRE, "agent");
            asm volatile("s_waitcnt vmcnt(0)" ::: "memory");
        }
    }
    __syncthreads();
}
#define HD __device__ __forceinline__
#define FFT_ASM_CMUL 1
#define FFT_DEVICE 1
#define OPAQUE(x) asm volatile("" : "+v"(x))
typedef _Float16 hc __attribute__((ext_vector_type(2)));
typedef float cf __attribute__((ext_vector_type(2)));
HD int fft_pad(int i) { return i + ((i >> 6) << 2); }
constexpr int FFT_N = 16384;
constexpr int FFT_LDS_ELEMS = FFT_N + (FFT_N >> 6) * 4;
constexpr int TW_A = 0, TW_B = 16384, TW_C = 16384 + 1024, TW_ELEMS = 16384 + 1024 + 64;
#ifdef FFT_ASM_CMUL
HD hc hmul(hc a, hc b) { hc t, r;
    asm("v_pk_mul_f16 %0, %1, %2 op_sel:[0,0] op_sel_hi:[0,1]" : "=v"(t) : "v"(a), "v"(b));
    asm("v_pk_fma_f16 %0, %1, %2, %3 op_sel:[1,1,0] op_sel_hi:[1,0,1] neg_lo:[1,0,0] neg_hi:[0,0,0]" : "=v"(r) : "v"(a), "v"(b), "v"(t));
    return r; }
HD hc hmulc(hc a, hc b) { hc t, r;
    asm("v_pk_mul_f16 %0, %1, %2 op_sel:[0,0] op_sel_hi:[0,1] neg_lo:[0,0] neg_hi:[0,1]" : "=v"(t) : "v"(a), "v"(b));
    asm("v_pk_fma_f16 %0, %1, %2, %3 op_sel:[1,1,0] op_sel_hi:[1,0,1] neg_lo:[0,0,0] neg_hi:[0,0,0]" : "=v"(r) : "v"(a), "v"(b), "v"(t));
    return r; }
HD hc add_mi(hc a, hc b) { hc r; asm("v_pk_add_f16 %0, %1, %2 op_sel:[0,1] op_sel_hi:[1,0] neg_lo:[0,0] neg_hi:[0,1]" : "=v"(r) : "v"(a), "v"(b)); return r; }
HD hc sub_mi(hc a, hc b) { hc r; asm("v_pk_add_f16 %0, %1, %2 op_sel:[0,1] op_sel_hi:[1,0] neg_lo:[0,1] neg_hi:[0,0]" : "=v"(r) : "v"(a), "v"(b)); return r; }
#else
HD hc hmul(hc a, hc b) { const hc t = hc{(_Float16)(a.x * b.x), (_Float16)(a.x * b.y)}; return hc{(_Float16)(-a.y * b.y + t.x), (_Float16)(a.y * b.x + t.y)}; }
HD hc hmulc(hc a, hc b) { const hc t = hc{(_Float16)(a.x * b.x), (_Float16)(-(a.x * b.y))}; return hc{(_Float16)(a.y * b.y + t.x), (_Float16)(a.y * b.x + t.y)}; }
HD hc add_mi(hc a, hc b) { return hc{(_Float16)(a.x + b.y), (_Float16)(a.y - b.x)}; }
HD hc sub_mi(hc a, hc b) { return hc{(_Float16)(a.x - b.y), (_Float16)(a.y + b.x)}; }
#endif
typedef _Float16 hc2v __attribute__((ext_vector_type(4)));
#ifdef FFT_DEVICE
HD __attribute__((address_space(3))) hc2v* zb2(__attribute__((address_space(3))) hc* p) { return (__attribute__((address_space(3))) hc2v*)p; }
#else
inline hc2v* zb2(hc* p) { return (hc2v*)p; }
#endif
template <bool INV> HD void dft4(hc& a0, hc& a1, hc& a2, hc& a3) {
    const hc t0 = a0 + a2, t1 = a0 - a2, t2 = a1 + a3, t3 = a1 - a3;
    a0 = t0 + t2; a2 = t0 - t2;
    if (!INV) { a1 = add_mi(t1, t3); a3 = sub_mi(t1, t3); } else { a1 = sub_mi(t1, t3); a3 = add_mi(t1, t3); }
}
template <bool INV> HD void dft16(hc (&x)[16]) {
#pragma unroll
    for (int m0 = 0; m0 < 4; ++m0) dft4<INV>(x[m0], x[4 + m0], x[8 + m0], x[12 + m0]);
    const float C1 = 0.92387953251128674f, S1 = 0.38268343236508977f, R2 = 0.70710678118654752f;
#define TW(r, c, s) { const hc w = hc{(_Float16)(c), (_Float16)(-(s))}; x[r] = INV ? hmulc(x[r], w) : hmul(x[r], w); }
    TW(5, C1, S1) TW(6, R2, R2) TW(7, S1, C1) TW(9, R2, R2) TW(10, 0.f, 1.f) TW(11, -R2, R2) TW(13, S1, C1) TW(14, -R2, R2) TW(15, -C1, -S1)
#undef TW
#pragma unroll
    for (int q1 = 0; q1 < 4; ++q1) dft4<INV>(x[4 * q1], x[4 * q1 + 1], x[4 * q1 + 2], x[4 * q1 + 3]);
}
template <int ST, int TS, class Z, class TT> HD void r16_fwd2(Z zb, TT tw) {
    hc x0[16], x1[16];
#pragma unroll
    for (int m = 0; m < 16; ++m) { const hc2v v = *zb2(zb + ST * m); x0[m] = hc{v.x, v.y}; x1[m] = hc{v.z, v.w}; }
    dft16<false>(x0); dft16<false>(x1);
    const hc sc = hc{(_Float16)0.0625f, (_Float16)0.0625f};
#pragma unroll
    for (int r = 0; r < 16; ++r) { const int q = (r >> 2) + 4 * (r & 3); hc y0, y1;
        if (q == 0) { y0 = x0[r] * sc; y1 = x1[r] * sc; }
        else { const hc2v t = *zb2(tw + TS * q); y0 = hmul(x0[r], hc{t.x, t.y}); y1 = hmul(x1[r], hc{t.z, t.w}); }
        *zb2(zb + ST * q) = hc2v{y0.x, y0.y, y1.x, y1.y}; }
}
template <int ST, int TS, class Z, class TT> HD void r16_inv2(Z zb, TT tw) {
    hc x0[16], x1[16];
    const hc sc = hc{(_Float16)0.0625f, (_Float16)0.0625f};
#pragma unroll
    for (int q = 0; q < 16; ++q) { const hc2v v = *zb2(zb + ST * q); const hc v0 = hc{v.x, v.y}, v1 = hc{v.z, v.w};
        if (q == 0) { x0[q] = v0 * sc; x1[q] = v1 * sc; }
        else { const hc2v t = *zb2(tw + TS * q); x0[q] = hmulc(v0, hc{t.x, t.y}); x1[q] = hmulc(v1, hc{t.z, t.w}); } }
    dft16<true>(x0); dft16<true>(x1);
#pragma unroll
    for (int r = 0; r < 16; ++r) { const int m = (r >> 2) + 4 * (r & 3); *zb2(zb + ST * m) = hc2v{x0[r].x, x0[r].y, x1[r].x, x1[r].y}; }
}
template <class Z, class TT> HD void fft_pass_fwd(Z z, TT tw, int tid, int stage) {
    OPAQUE(tid);
    const int bid = 2 * tid;
    if (stage == 0) r16_fwd2<1088, 1024>(z + fft_pad(bid), tw + TW_A + bid);
    else if (stage == 1) r16_fwd2<68, 64>(z + fft_pad((bid >> 6) * 1024 + (bid & 63)), tw + TW_B + (bid & 63));
    else r16_fwd2<4, 4>(z + fft_pad((bid >> 2) * 64 + (bid & 3)), tw + TW_C + (bid & 3));
}
template <class Z, class TT> HD void fft_pass_inv(Z z, TT tw, int tid, int stage) {
    OPAQUE(tid);
    const int bid = 2 * tid;
    if (stage == 0) r16_inv2<1088, 1024>(z + fft_pad(bid), tw + TW_A + bid);
    else if (stage == 1) r16_inv2<68, 64>(z + fft_pad((bid >> 6) * 1024 + (bid & 63)), tw + TW_B + (bid & 63));
    else r16_inv2<4, 4>(z + fft_pad((bid >> 2) * 64 + (bid & 3)), tw + TW_C + (bid & 3));
}
template <class Z> HD void fft_pass_d_fwd(Z z, int tid) {
    OPAQUE(tid);
    const hc q4 = hc{(_Float16)0.25f, (_Float16)0.25f};
#pragma unroll 1
    for (int r = 0; r < 8; ++r) { const int pb = fft_pad(4 * (tid + 512 * r));
        hc a0 = z[pb], a1 = z[pb + 1], a2 = z[pb + 2], a3 = z[pb + 3]; dft4<false>(a0, a1, a2, a3); z[pb] = a0 * q4; z[pb + 1] = a1 * q4; z[pb + 2] = a2 * q4; z[pb + 3] = a3 * q4; }
}
struct KPre { hc k[8][4]; };
HD void fft_dkd_prefetch(KPre& kp, const hc* K, int tid) {
#pragma unroll
    for (int r = 0; r < 8; ++r) { const int b4 = 4 * (tid + 512 * r);
#pragma unroll
        for (int i = 0; i < 4; ++i) kp.k[r][i] = K[b4 + i]; }
}
template <class Z> HD void fft_pass_dkd(Z z, const KPre& kp, int tid) {
    OPAQUE(tid);
#pragma unroll
    for (int r = 0; r < 8; ++r) { const int b4 = 4 * (tid + 512 * r); const int pb = fft_pad(b4);
        hc a0 = z[pb], a1 = z[pb + 1], a2 = z[pb + 2], a3 = z[pb + 3]; dft4<false>(a0, a1, a2, a3);
        a0 = hmul(a0, kp.k[r][0]); a1 = hmul(a1, kp.k[r][1]); a2 = hmul(a2, kp.k[r][2]); a3 = hmul(a3, kp.k[r][3]);
        dft4<true>(a0, a1, a2, a3); z[pb] = a0; z[pb + 1] = a1; z[pb + 2] = a2; z[pb + 3] = a3; }
}
constexpr int NWAVES = 8;
#ifndef MK_N_LAUNCHES
#define MK_N_LAUNCHES 1
#endif
constexpr int N_PHASES = 11;
constexpr int N_LAUNCHES = MK_N_LAUNCHES;

constexpr int NB = 4, T = 8192, D = 1024, M = NB * T;
constexpr int HW = 512, AW = 512, KVW = 128;
constexpr int INC = 4352, NHY = 1536, NREST = INC - NHY;
constexpr int PR_Q = 0, PR_K = 512, PR_V = 640, PR_GH = 768, PR_GA = 1792;
constexpr int NE = 32, TOPK = 4, FF = 1024, RB_MAX = 544, P_MAX = RB_MAX * 256;
constexpr float EPS = 1e-6f;
constexpr int TPB = 128;

constexpr size_t MiB = 1u << 20;
constexpr size_t WS_CTL = 0, CTL_ZERO_BYTES = 1 * MiB;
constexpr size_t WS_WIN = 1 * MiB;
constexpr size_t WS_WHU = 10 * MiB, WS_WAU = 11 * MiB, WS_WOUT = 12 * MiB;
constexpr size_t WS_WRT = 14 * MiB;
constexpr size_t WS_TOKROWS = 14 * MiB + 512 * 1024;
constexpr size_t WS_ROWGATE = 15 * MiB;
constexpr size_t WS_ENT = 16 * MiB;
constexpr size_t WS_SRC = 18 * MiB;
constexpr size_t WS_W1 = 19 * MiB;
constexpr size_t WS_W2 = 147 * MiB;
constexpr size_t WS_XN = 211 * MiB;
constexpr size_t WS_EARLY = 275 * MiB;
constexpr size_t WS_ZT = WS_EARLY;
constexpr size_t WS_PR = WS_ZT + 96 * MiB;
constexpr size_t WS_QO = WS_PR + 176 * MiB;
constexpr size_t WS_KB = WS_QO + 32 * MiB, WS_VB = WS_KB + 8 * MiB;
constexpr size_t WS_HT = WS_VB + 8 * MiB;
constexpr size_t WS_KSP = WS_HT + 64 * MiB;
constexpr size_t WS_Y1S = WS_KSP + 64 * MiB;
constexpr size_t WS_YHT = WS_Y1S + 16 * MiB;
constexpr size_t WS_YH = WS_YHT + 32 * MiB;
constexpr size_t WS_MG = WS_YH + 32 * MiB;
constexpr size_t WS_EARLY_END = WS_MG + 64 * MiB;
constexpr size_t WS_AO = WS_EARLY_END;
constexpr size_t WS_HB = WS_AO + 32 * MiB;
static_assert(WS_HB + 64 * MiB <= 1024 * MiB, "d_ws map");
constexpr size_t WS_XG = WS_EARLY;
constexpr size_t WS_H1 = WS_XG + 272 * MiB;
constexpr size_t WS_END = 1024 * MiB;
static_assert(WS_EARLY_END <= WS_END && WS_H1 + 272 * MiB <= WS_END && WS_H1 >= WS_PR + 176 * MiB, "d_ws map");
constexpr int CW_CNT = 64;
constexpr int CW_BAR = 4096;

constexpr int RING_OFF = 0, RING_BYTES = 139520;
constexpr int FFT_TW_OFF = 69632;
constexpr int LX_MISC = RING_BYTES;
constexpr int LX_RBE = LX_MISC + 256;
constexpr int LX_CNT = LX_RBE + 2304;
constexpr int LX_ENT = LX_CNT + 512;
constexpr int LX_RED = LX_ENT + TPB * 4 * 16;
constexpr int LX_GIDX = LX_RED + 256;
constexpr int GIDX_UNITS = 17;
constexpr int LDS_BYTES = LX_GIDX + GIDX_UNITS * 512;
static_assert(LDS_BYTES <= 163840, "LDS map");

struct Frame {
    LAS unsigned char* lds;
    volatile LAS unsigned* MISC;
    gu32* ctl;
    int tid, lane, wave, vcu, G;
    unsigned char* ws;
    const float* in[26]; float* out;
};
__device__ __forceinline__ float wave_sum(float v) {
#pragma unroll
    for (int o = 1; o < 64; o <<= 1) v += __shfl_xor(v, o);
    return v;
}
__device__ __forceinline__ unsigned pk2(float lo, float hi) { return pg8::cvt_pk_bf16(lo, hi); }
__device__ __forceinline__ float bflo(unsigned w) { return __uint_as_float(w << 16); }
__device__ __forceinline__ float bfhi(unsigned w) { return __uint_as_float(w & 0xffff0000u); }
__device__ __forceinline__ float bf1(unsigned short h) { return __uint_as_float((unsigned)h << 16); }
__device__ __forceinline__ float sin_rev(float r) { return __builtin_amdgcn_sinf(r); }
__device__ __forceinline__ float cos_rev(float r) { return __builtin_amdgcn_cosf(r); }

struct P0Item { const float* W; bf16* WT; int K, N, item, mode; };
__device__ __forceinline__ void p0_item_load(const P0Item& it, f32x4 (&v)[8], int lane) {
    const int nblk = it.N / 32, kb = it.item / nblk, nb = it.item % nblk, k0 = 64 * kb, n0 = 32 * nb;
    const float* src = it.W + (size_t)(k0 + 8 * (lane >> 3)) * it.N + n0 + 4 * (lane & 7);
#pragma unroll
    for (int i = 0; i < 8; ++i) v[i] = *(const GAS f32x4*)(src + (size_t)i * it.N);
}
template <int NOST>
__device__ __forceinline__ void p0_item_store(const P0Item& it, const f32x4 (&v)[8], int lane) {
    const int nblk = it.N / 32, kb = it.item / nblk, nb = it.item % nblk, k0 = 64 * kb, n0 = 32 * nb;
#pragma unroll
    for (int nn = 0; nn < 4; ++nn) { const int n = n0 + 4 * (lane & 7) + nn;
        v4u o; o.x = pk2(v[0][nn], v[1][nn]); o.y = pk2(v[2][nn], v[3][nn]); o.z = pk2(v[4][nn], v[5][nn]); o.w = pk2(v[6][nn], v[7][nn]);
        int dr;
        if (it.mode == 0) dr = n;
        else { const int jj = n >> 1; dr = (jj >> 7) * 256 + (n & 1) * 128 + (jj & 127); }
        if (!NOST) *(GAS v4u*)(it.WT + (size_t)dr * it.K + k0 + 8 * (lane >> 3)) = o; else asm volatile("" :: "v"(o), "v"(dr)); }
}
__device__ __forceinline__ unsigned cvt4_fp8(float a, float b, float c, float d) { int w = 0; w = __builtin_amdgcn_cvt_pk_fp8_f32(a, b, w, false); w = __builtin_amdgcn_cvt_pk_fp8_f32(c, d, w, true); return (unsigned)w; }
constexpr float WSCALE = 32.0f, ASCALE = 8.0f, HSCALE = 4.0f, YSCALE = 16.0f;
__device__ __forceinline__ void p0_item8_load(const P0Item& it, f32x4 (&v)[16], int lane) {
    const int nblk = it.N / 32, kb = it.item / nblk, nb = it.item % nblk, k0 = 128 * kb, n0 = 32 * nb;
    const float* src = it.W + (size_t)(k0 + 16 * (lane >> 3)) * it.N + n0 + 4 * (lane & 7);
#pragma unroll
    for (int i = 0; i < 16; ++i) v[i] = *(const GAS f32x4*)(src + (size_t)i * it.N);
}
__device__ __forceinline__ void p0_item8_store(const P0Item& it, const f32x4 (&v)[16], int lane) {
    const int nblk = it.N / 32, kb = it.item / nblk, nb = it.item % nblk, k0 = 128 * kb, n0 = 32 * nb;
    unsigned char* WT8 = (unsigned char*)it.WT;
#pragma unroll
    for (int nn = 0; nn < 4; ++nn) { const int n = n0 + 4 * (lane & 7) + nn;
        v4u o;
#pragma unroll
        for (int w = 0; w < 4; ++w) o[w] = cvt4_fp8(v[4 * w][nn] * WSCALE, v[4 * w + 1][nn] * WSCALE, v[4 * w + 2][nn] * WSCALE, v[4 * w + 3][nn] * WSCALE);
        int dr;
        if (it.mode == 0) dr = n;
        else { const int jj = n >> 1; dr = (jj >> 7) * 256 + (n & 1) * 128 + (jj & 127); }
        *(GAS v4u*)(WT8 + (size_t)dr * it.K + k0 + 16 * (lane >> 3)) = o; }
}
template <int NR>
__device__ __forceinline__ void rms_rows_to_bf16(const float* x, const float* g, bf16* o, int m, int rs, int lane) {
    f32x4 v[NR][4];
#pragma unroll
    for (int r = 0; r < NR; ++r) { const GAS f32x4* xr = (const GAS f32x4*)(x + (size_t)(m + r * rs) * D) + lane;
#pragma unroll
        for (int j = 0; j < 4; ++j) v[r][j] = xr[64 * j]; }
    const GAS f32x4* gr = (const GAS f32x4*)g + lane; f32x4 gg[4];
#pragma unroll
    for (int j = 0; j < 4; ++j) gg[j] = gr[64 * j];
#pragma unroll
    for (int r = 0; r < NR; ++r) { float s = 0.f;
#pragma unroll
        for (int j = 0; j < 4; ++j) s += (v[r][j].x * v[r][j].x + v[r][j].y * v[r][j].y) + (v[r][j].z * v[r][j].z + v[r][j].w * v[r][j].w);
        const float rstd = 1.f / sqrtf(wave_sum(s) * (1.f / D) + EPS);
        GAS unsigned long long* o8 = (GAS unsigned long long*)(o + (size_t)(m + r * rs) * D) + lane;
#pragma unroll
        for (int j = 0; j < 4; ++j) o8[64 * j] = (unsigned long long)pk2(v[r][j].x * rstd * gg[j].x, v[r][j].y * rstd * gg[j].y) | ((unsigned long long)pk2(v[r][j].z * rstd * gg[j].z, v[r][j].w * rstd * gg[j].w) << 32); }
}
__device__ __forceinline__ void p0_filter_tile(Frame& F, int tile) {
    LAS float* feats = (LAS float*)(F.lds + RING_OFF);
    LAS float* h1 = feats + 32 * 36;
    LAS float* h2 = h1 + 32 * 64;
    LAS float* w1s = h2 + 32 * 64;
    LAS float* w2s = w1s + 33 * 64;
    const float *fw1 = F.in[5], *fb1 = F.in[6], *ff1 = F.in[7], *fw2 = F.in[8], *fb2 = F.in[9], *ff2 = F.in[10], *fw3 = F.in[11], *fb3 = F.in[12];
    float* HT = (float*)(F.ws + WS_HT);
    const int tid = F.tid;
    for (int i = tid; i < 33 * 64; i += NWAVES * 64) w1s[i] = fw1[i];
    for (int i = tid; i < 64 * 64; i += NWAVES * 64) w2s[i] = fw2[i];
    for (int i = tid; i < 32 * 33; i += NWAVES * 64) { const int r = i / 33, f = i % 33, t = tile * 32 + r; float val;
        if (f == 0) val = (float)t * (1.0f / 8191.0f);
        else { const int bi = (f - 1) & 15; const float fr = 1e-4f + (float)bi * ((15.0f - 1e-4f) / 15.0f); float rev = (float)t * fr * (1.0f / 8192.0f); rev -= floorf(rev);
               val = (f <= 16) ? cos_rev(rev) : -sin_rev(rev); }
        feats[r * 36 + f] = val; }
    __syncthreads();
#pragma unroll 1
    for (int k = 0; k < 4; ++k) { const int i = tid + 512 * k, r = i >> 6, n = i & 63; float a = fb1[n];
#pragma unroll 11
        for (int f = 0; f < 33; ++f) a += feats[r * 36 + f] * w1s[f * 64 + n];
        float rev = ff1[n] * a * 0.15915494309189535f; rev -= rintf(rev); h1[r * 64 + n] = sin_rev(rev); }
    __syncthreads();
#pragma unroll 1
    for (int k = 0; k < 4; ++k) { const int i = tid + 512 * k, r = i >> 6, n = i & 63; float a = fb2[n];
#pragma unroll 16
        for (int f = 0; f < 64; ++f) a += h1[r * 64 + f] * w2s[f * 64 + n];
        float rev = ff2[n] * a * 0.15915494309189535f; rev -= rintf(rev); h2[r * 64 + n] = sin_rev(rev); }
    __syncthreads();
    { typedef float f32x16 __attribute__((ext_vector_type(16)));
      const int lane = F.lane, r32 = lane & 31, hi = lane >> 5;
      float a[32];
#pragma unroll
      for (int s = 0; s < 32; ++s) a[s] = h2[r32 * 64 + 2 * s + hi];
#pragma unroll 1
      for (int i = 0; i < 8; ++i) { const int col = 32 * (F.wave + 8 * i) + r32; float bq[32];
#pragma unroll
          for (int s = 0; s < 32; ++s) bq[s] = fw3[(2 * s + hi) * 2048 + col];
          f32x16 acc = {};
#pragma unroll
          for (int s = 0; s < 32; ++s) acc = __builtin_amdgcn_mfma_f32_32x32x2f32(a[s], bq[s], acc, 0, 0, 0);
          const float bias = fb3[col]; const int c = col & 511;
          const float delta = 3.0701134573253945f + (float)c * ((15.350567286626973f - 3.0701134573253945f) / 511.0f);
          float* dst = HT + (size_t)col * T + tile * 32 + 4 * hi;
#pragma unroll
          for (int g = 0; g < 4; ++g) { f32x4 o;
#pragma unroll
              for (int q = 0; q < 4; ++q) { const float tl = (float)(tile * 32 + 8 * g + 4 * hi + q) * (1.0f / 8191.0f); o[q] = (acc[4 * g + q] + bias) * __expf(-tl * delta); }
              *(f32x4*)(dst + 8 * g) = o; } } }
    __syncthreads();
}
__device__ __forceinline__ P0Item p0_item(Frame& F, int r) {
    constexpr int I_IN = (D / 64) * (INC / 32), I_UP = (512 / 64) * (D / 32);
    if (r < I_IN) return P0Item{F.in[2], (bf16*)(F.ws + WS_WIN), D, INC, r, 0}; r -= I_IN;
    if (r < I_UP) return P0Item{F.in[16], (bf16*)(F.ws + WS_WHU), 512, D, r, 0}; r -= I_UP;
    if (r < I_UP) return P0Item{F.in[17], (bf16*)(F.ws + WS_WAU), 512, D, r, 0}; r -= I_UP;
    return P0Item{F.in[18], (bf16*)(F.ws + WS_WOUT), D, D, r, 0};
}
__device__ __forceinline__ P0Item p0_item8(Frame& F, int r) {
    constexpr int I_W1 = (D / 128) * (2 * FF / 32), I_W2 = (FF / 128) * (D / 32);
    if (r < NE * I_W1) { const int e = r / I_W1; return P0Item{F.in[22] + (size_t)e * D * 2 * FF, (bf16*)(F.ws + WS_W1 + (size_t)e * 2 * FF * D), D, 2 * FF, r % I_W1, 1}; } r -= NE * I_W1;
    { const int e = r / I_W2; return P0Item{F.in[24] + (size_t)e * FF * D, (bf16*)(F.ws + WS_W2 + (size_t)e * D * FF), FF, D, r % I_W2, 0}; }
}
#ifndef PROBE_SUB
#define PROBE_SUB 0
#endif
__device__ __forceinline__ void p0_xn(Frame& F) {
    const int gw = F.vcu * NWAVES + F.wave, NGW = F.G * NWAVES;
    bf16* XN = (bf16*)(F.ws + WS_XN);
    for (int m = gw; m < M; m += 4 * NGW) rms_rows_to_bf16<4>(F.in[0], F.in[1], XN, m, NGW, F.lane);
}
template <int NOST>
__device__ __forceinline__ void p0_transposes(Frame& F) {
    const int gw = F.vcu * NWAVES + F.wave, NGW = F.G * NWAVES;
    constexpr int NITEMS = (D / 64) * (INC / 32) + 2 * (512 / 64) * (D / 32) + (D / 64) * (D / 32);
    static_assert(NITEMS % 4 == 0, "items are taken four at a time");
    for (int it = 4 * gw; it < NITEMS; it += 4 * NGW) {
        const P0Item a = p0_item(F, it), b = p0_item(F, it + 1), c = p0_item(F, it + 2), d = p0_item(F, it + 3);
        f32x4 va[8], vb[8], vc[8], vd[8];
        p0_item_load(a, va, F.lane); p0_item_load(b, vb, F.lane); p0_item_load(c, vc, F.lane); p0_item_load(d, vd, F.lane);
        p0_item_store<NOST>(a, va, F.lane); p0_item_store<NOST>(b, vb, F.lane); p0_item_store<NOST>(c, vc, F.lane); p0_item_store<NOST>(d, vd, F.lane);
    }
    constexpr int NITEMS8 = NE * ((D / 128) * (2 * FF / 32) + (FF / 128) * (D / 32));
    static_assert(NITEMS8 % 2 == 0, "expert items are taken two at a time");
    for (int it = 2 * gw; it < NITEMS8; it += 2 * NGW) {
        const P0Item a = p0_item8(F, it), b = p0_item8(F, it + 1);
        f32x4 va[16], vb[16];
        p0_item8_load(a, va, F.lane); p0_item8_load(b, vb, F.lane);
        p0_item8_store(a, va, F.lane); p0_item8_store(b, vb, F.lane);
    }
}
__device__ __forceinline__ void p0_prologue(Frame& F) {
    p0_xn(F); if (PROBE_SUB & 1) p0_xn(F);
    for (int tile = F.vcu; tile < T / 32; tile += F.G) p0_filter_tile(F, tile);
    if (PROBE_SUB & 2) for (int tile = F.vcu; tile < T / 32; tile += F.G) p0_filter_tile(F, tile);
    p0_transposes<0>(F); if (PROBE_SUB & 4) p0_transposes<0>(F); if (PROBE_SUB & 512) p0_transposes<1>(F);
    float* wrt = (float*)(F.ws + WS_WRT);
    for (int i = F.vcu * NWAVES * 64 + F.tid; i < NE * D; i += F.G * NWAVES * 64) { const int e = i >> 10, d = i & 1023; wrt[i] = F.in[20][d * NE + e]; }
}

__device__ __forceinline__ void rope8f(const v4u raw, float rms, const float* g, int d0, int trow, int tcol, float scale, float (&o)[8]) {
    float x[8];
#pragma unroll
    for (int i = 0; i < 4; ++i) { x[2 * i] = bflo(raw[i]) * rms * g[d0 + 2 * i]; x[2 * i + 1] = bfhi(raw[i]) * rms * g[d0 + 2 * i + 1]; }
#pragma unroll
    for (int i = 0; i < 4; ++i) { const int pi = (d0 >> 1) + i;
        const float freq = __builtin_amdgcn_exp2f(-(float)(pi & 15) * (13.287712379549449f / 16.0f));
        float rev = (float)(pi < 16 ? trow : tcol) * freq * 0.15915494309189535f; rev -= floorf(rev);
        const float c = cos_rev(rev), sn = sin_rev(rev);
        o[2 * i] = (x[2 * i] * c - x[2 * i + 1] * sn) * scale; o[2 * i + 1] = (x[2 * i] * sn + x[2 * i + 1] * c) * scale; }
}
constexpr float QSCALE8 = 8.0f, VSCALE8 = 4.0f;
__device__ __forceinline__ void p2_qkprep(Frame& F) {
    const bf16* PR = (const bf16*)(F.ws + WS_PR); unsigned char* Q8 = (unsigned char*)(F.ws + WS_QO); unsigned char* K8 = (unsigned char*)(F.ws + WS_KB);
    const float* qg = F.in[14]; const float* kg = F.in[15];
    const int gw = F.vcu * NWAVES + F.wave, NGW = F.G * NWAVES, lane = F.lane;
    typedef unsigned u32x2v __attribute__((ext_vector_type(2)));
    for (int m = gw; m < M; m += NGW) {
        const int t = m & (T - 1), trow = t >> 6, tcol = t & 63;
        const bf16* pr = PR + (size_t)m * NREST;
        { const v4u raw = *(const GAS v4u*)(pr + PR_Q + 8 * lane); float ss = 0.f;
#pragma unroll
          for (int i = 0; i < 4; ++i) { const float a = bflo(raw[i]), b = bfhi(raw[i]); ss += a * a + b * b; }
          ss += __shfl_xor(ss, 1); ss += __shfl_xor(ss, 2); ss += __shfl_xor(ss, 4);
          const float rms = 1.f / sqrtf(ss * (1.f / 64.f) + EPS); float o[8];
          rope8f(raw, rms, qg, 8 * (lane & 7), trow, tcol, 0.125f * 1.4426950408889634f * QSCALE8, o);
          u32x2v w; w.x = cvt4_fp8(o[0], o[1], o[2], o[3]); w.y = cvt4_fp8(o[4], o[5], o[6], o[7]);
          *(GAS u32x2v*)(Q8 + (size_t)m * AW + 8 * lane) = w; }
    }
    for (int j = 0; gw + j * NGW < M; j += 4) {
        const int m = gw + (j + (lane >> 4)) * NGW; if (m >= M) continue;
        const int t = m & (T - 1), trow = t >> 6, tcol = t & 63, l2 = lane & 15;
        const v4u raw = *(const GAS v4u*)(PR + (size_t)m * NREST + PR_K + 8 * l2); float ss = 0.f;
#pragma unroll
        for (int i = 0; i < 4; ++i) { const float a = bflo(raw[i]), b = bfhi(raw[i]); ss += a * a + b * b; }
        ss += __shfl_xor(ss, 1); ss += __shfl_xor(ss, 2); ss += __shfl_xor(ss, 4);
        const float rms = 1.f / sqrtf(ss * (1.f / 64.f) + EPS); float o[8];
        rope8f(raw, rms, kg, 8 * (lane & 7), trow, tcol, 1.0f, o);
        u32x2v w; w.x = cvt4_fp8(o[0], o[1], o[2], o[3]); w.y = cvt4_fp8(o[4], o[5], o[6], o[7]);
        *(GAS u32x2v*)(K8 + (size_t)m * KVW + 8 * l2) = w;
    }
    unsigned char* VT8 = (unsigned char*)(F.ws + WS_VB);
    for (int it = gw; it < (M / 64) * 2; it += NGW) { const int tile = it >> 1, kvh = it & 1;
        const unsigned short* vp = (const unsigned short*)(PR + (size_t)tile * 64 * NREST + PR_V + kvh * 64 + lane);
        unsigned wv[2][8];
#pragma unroll
        for (int hh = 0; hh < 2; ++hh)
#pragma unroll
            for (int w = 0; w < 8; ++w) wv[hh][w] = 0u;
#pragma unroll
        for (int kp = 0; kp < 64; kp += 2) {
            const float a = __builtin_amdgcn_fmed3f(bf1(vp[(size_t)kp * NREST]) * VSCALE8, -448.f, 448.f), b = __builtin_amdgcn_fmed3f(bf1(vp[(size_t)(kp + 1) * NREST]) * VSCALE8, -448.f, 448.f);
            const int k5 = kp & 31, hh = (k5 >> 2) & 1, r = (k5 & 3) + 4 * (k5 >> 3), byte = r + 16 * (kp >> 5);
            if ((byte >> 1) & 1) wv[hh][byte >> 2] = (unsigned)__builtin_amdgcn_cvt_pk_fp8_f32(a, b, (int)wv[hh][byte >> 2], true); else wv[hh][byte >> 2] = (unsigned)__builtin_amdgcn_cvt_pk_fp8_f32(a, b, (int)wv[hh][byte >> 2], false); }
        unsigned char* dst = VT8 + (size_t)it * 4096 + lane * 32;
#pragma unroll
        for (int hh = 0; hh < 2; ++hh) { *(GAS v4u*)(dst + hh * 2048) = (v4u){wv[hh][0], wv[hh][1], wv[hh][2], wv[hh][3]}; *(GAS v4u*)(dst + hh * 2048 + 16) = (v4u){wv[hh][4], wv[hh][5], wv[hh][6], wv[hh][7]}; } }
}
typedef LAS hc* zptr;
#define FSYNC() __syncthreads()
#define LSYNC() asm volatile("s_waitcnt lgkmcnt(0)\n\ts_barrier" ::: "memory")
__device__ __forceinline__ float block_sum(Frame& F, float v) {
    LAS float* red = (LAS float*)(F.lds + LX_RED);
    v = wave_sum(v); if (F.lane == 0) red[F.wave] = v; __syncthreads();
    float s = 0.f;
#pragma unroll
    for (int w = 0; w < NWAVES; ++w) s += red[w];
    __syncthreads(); return s;
}
__device__ __forceinline__ hc f2h(float a, float b) { return __builtin_convertvector((cf){a, b}, hc); }
__device__ __forceinline__ void fft_tables(Frame& F) {
    zptr tw = (zptr)(F.lds + FFT_TW_OFF);
    for (int i = F.tid; i < TW_ELEMS; i += NWAVES * 64) { int jq, ls;
        if (i < TW_B) { jq = (i & 1023) * (i >> 10); ls = 16384; } else if (i < TW_C) { const int k = i - TW_B; jq = (k & 63) * (k >> 6); ls = 1024; } else { const int k = i - TW_C; jq = (k & 3) * (k >> 2); ls = 64; }
        const float rev = (float)(jq & (ls - 1)) / (float)ls;
        tw[i] = f2h(0.0625f * cos_rev(rev), -0.0625f * sin_rev(rev)); }
    __syncthreads();
}
struct Raw8 { v4u c; unsigned p, n; };
__device__ __forceinline__ Raw8 sc8_load(const bf16* row, int t0) { Raw8 r; r.c = *(const GAS v4u*)(row + t0); r.p = t0 > 0 ? (unsigned)row[t0 - 1] : 0u; r.n = t0 + 8 < T ? (unsigned)row[t0 + 8] : 0u; return r; }
__device__ __forceinline__ void sc8_eval(const Raw8& r, float w0, float w1, float w2, float b, float (&o)[8]) {
    float z[10]; z[0] = __uint_as_float(r.p << 16); z[9] = __uint_as_float(r.n << 16);
#pragma unroll
    for (int i = 0; i < 4; ++i) { z[1 + 2 * i] = bflo(r.c[i]); z[2 + 2 * i] = bfhi(r.c[i]); }
#pragma unroll
    for (int i = 0; i < 8; ++i) o[i] = b + w0 * z[i] + w1 * z[i + 1] + w2 * z[i + 2];
}
__device__ __forceinline__ void fft_fwd3(zptr Z, zptr tw, int tid) { fft_pass_fwd(Z, tw, tid, 0); LSYNC(); fft_pass_fwd(Z, tw, tid, 1); LSYNC(); fft_pass_fwd(Z, tw, tid, 2); LSYNC(); }
__device__ __forceinline__ void fft_inv3(zptr Z, zptr tw, int tid) { fft_pass_inv(Z, tw, tid, 2); LSYNC(); fft_pass_inv(Z, tw, tid, 1); LSYNC(); fft_pass_inv(Z, tw, tid, 0); LSYNC(); }
__device__ __forceinline__ void hyena_channel(Frame& F, int c) {
    zptr Z = (zptr)(F.lds + RING_OFF); zptr tw = (zptr)(F.lds + FFT_TW_OFF);
    const int tid = F.tid;
    hc* Ksp = (hc*)(F.ws + WS_KSP) + (size_t)blockIdx.x * 2 * FFT_N;
    const float* HT = (const float*)(F.ws + WS_HT);
    const bf16* ZT = (const bf16*)(F.ws + WS_ZT); bf16* YHT = (bf16*)(F.ws + WS_YHT);
    const float* cw = F.in[3]; const float* cb = F.in[4]; const float* hd = F.in[13];
    const hc hzero = f2h(0.f, 0.f);
    {
        const float* f0 = HT + (size_t)c * T; const float* b0 = HT + (size_t)(512 + c) * T; const float* f1 = HT + (size_t)(1024 + c) * T; const float* b1 = HT + (size_t)(1536 + c) * T;
        float as0 = 0.f, as1 = 0.f;
#pragma unroll
        for (int r = 0; r < 2; ++r) { int tl_ = tid; OPAQUE(tl_); const int t0 = 8 * (tl_ + 512 * r);
#pragma unroll
            for (int h = 0; h < 2; ++h) { const f32x4 fa = *(const GAS f32x4*)(f0 + t0 + 4 * h), ba = *(const GAS f32x4*)(b0 + t0 + 4 * h), fb = *(const GAS f32x4*)(f1 + t0 + 4 * h), bb = *(const GAS f32x4*)(b1 + t0 + 4 * h);
#pragma unroll
                for (int i = 0; i < 4; ++i) { const int t = t0 + 4 * h + i; Z[fft_pad(t)] = f2h(fa[i], fb[i]); as0 += fabsf(fa[i]); as1 += fabsf(fb[i]);
                    if (t >= 1) { Z[fft_pad(FFT_N - t)] = f2h(ba[i], bb[i]); as0 += fabsf(ba[i]); as1 += fabsf(bb[i]); } else Z[fft_pad(T)] = hzero; } } }
        const float S0 = block_sum(F, as0), S1 = block_sum(F, as1);
        fft_fwd3(Z, tw, tid); fft_pass_d_fwd(Z, tid); FSYNC();
        const float sc0 = 0.5f * 16384.0f * 1024.0f / S0, sc1 = 0.5f * 16384.0f * 1024.0f / S1;
#pragma unroll 2
        for (int r = 0; r < 8; ++r) { int tl_ = tid; OPAQUE(tl_); const int p0 = 4 * (tl_ + 512 * r); v4u w0, w1;
#pragma unroll
            for (int i = 0; i < 4; ++i) { const int p = p0 + i;
                const int k = (p >> 10) + 16 * ((p >> 6) & 15) + 256 * ((p >> 2) & 15) + 4096 * (p & 3), kn = (FFT_N - k) & (FFT_N - 1);
                const int pn = 1024 * (kn & 15) + 64 * ((kn >> 4) & 15) + 4 * ((kn >> 8) & 15) + (kn >> 12);
                const cf a = __builtin_convertvector(Z[fft_pad(p)], cf), b = __builtin_convertvector(Z[fft_pad(pn)], cf);
                w0[i] = __builtin_bit_cast(unsigned, f2h((a.x + b.x) * sc0, (a.y - b.y) * sc0));
                w1[i] = __builtin_bit_cast(unsigned, f2h((a.y + b.y) * sc1, (b.x - a.x) * sc1)); }
            *(GAS v4u*)(Ksp + p0) = w0; *(GAS v4u*)(Ksp + FFT_N + p0) = w1; }
        FSYNC();
    }
    const float wv0 = cw[c], wv1 = cw[NHY + c], wv2 = cw[2 * NHY + c], bv = cb[c];
    const float wa0 = cw[512 + c], wa1 = cw[NHY + 512 + c], wa2 = cw[2 * NHY + 512 + c], ba = cb[512 + c];
    const float wb0 = cw[1024 + c], wb1 = cw[NHY + 1024 + c], wb2 = cw[2 * NHY + 1024 + c], bb = cb[1024 + c];
    const float d0 = hd[c], d1 = hd[HW + c];
    const int tq0 = 8 * tid, tq1 = 8 * (tid + 512);
    Raw8 rv[2][2];
    { const bf16* v0 = ZT + (size_t)c * M; rv[0][0] = sc8_load(v0, tq0); rv[0][1] = sc8_load(v0, tq1); rv[1][0] = sc8_load(v0 + T, tq0); rv[1][1] = sc8_load(v0 + T, tq1); }
    for (int pair_ = 0; pair_ < ((PROBE_SUB & 32) ? 4 : 2); ++pair_) { const int pair = pair_ & 1;
        const bf16* a0 = ZT + (size_t)(512 + c) * M + (size_t)(2 * pair) * T;  const bf16* a1 = a0 + T;
        const bf16* b0 = ZT + (size_t)(1024 + c) * M + (size_t)(2 * pair) * T; const bf16* b1 = b0 + T;
        float x[2][2][8];
#pragma unroll
        for (int r = 0; r < 2; ++r) { const int t0 = r ? tq1 : tq0; sc8_eval(rv[0][r], wv0, wv1, wv2, bv, x[0][r]); sc8_eval(rv[1][r], wv0, wv1, wv2, bv, x[1][r]);
#pragma unroll
            for (int i = 0; i < 8; ++i) { Z[fft_pad(t0 + i)] = f2h(x[0][r][i], x[1][r][i]); Z[fft_pad(T + t0 + i)] = hzero; } }
        KPre kp; fft_dkd_prefetch(kp, (const hc*)Ksp, tid);
        Raw8 rg[2][2]; rg[0][0] = sc8_load(a0, tq0); rg[0][1] = sc8_load(a0, tq1); rg[1][0] = sc8_load(a1, tq0); rg[1][1] = sc8_load(a1, tq1);
        LSYNC();
        fft_fwd3(Z, tw, tid); fft_pass_dkd(Z, kp, tid); LSYNC();
        fft_dkd_prefetch(kp, (const hc*)(Ksp + FFT_N), tid);
        fft_inv3(Z, tw, tid);
        float y[2][2][8];
#pragma unroll
        for (int r = 0; r < 2; ++r) { const int t0 = r ? tq1 : tq0; float g0[8], g1[8]; sc8_eval(rg[0][r], wa0, wa1, wa2, ba, g0); sc8_eval(rg[1][r], wa0, wa1, wa2, ba, g1);
#pragma unroll
            for (int i = 0; i < 8; ++i) { const cf cv = __builtin_convertvector(Z[fft_pad(t0 + i)], cf); y[0][r][i] = g0[i] * (cv.x + x[0][r][i] * d0); y[1][r][i] = g1[i] * (cv.y + x[1][r][i] * d0);
                Z[fft_pad(t0 + i)] = f2h(y[0][r][i], y[1][r][i]); Z[fft_pad(T + t0 + i)] = hzero; } }
        rg[0][0] = sc8_load(b0, tq0); rg[0][1] = sc8_load(b0, tq1); rg[1][0] = sc8_load(b1, tq0); rg[1][1] = sc8_load(b1, tq1);
        { const bf16* v0 = ZT + (size_t)c * M + (size_t)(2 * ((pair + 1) & 1)) * T; rv[0][0] = sc8_load(v0, tq0); rv[0][1] = sc8_load(v0, tq1); rv[1][0] = sc8_load(v0 + T, tq0); rv[1][1] = sc8_load(v0 + T, tq1); }
        LSYNC();
        fft_fwd3(Z, tw, tid); fft_pass_dkd(Z, kp, tid); LSYNC(); fft_inv3(Z, tw, tid);
#pragma unroll
        for (int r = 0; r < 2; ++r) { const int t0 = r ? tq1 : tq0; float g0[8], g1[8]; sc8_eval(rg[0][r], wb0, wb1, wb2, bb, g0); sc8_eval(rg[1][r], wb0, wb1, wb2, bb, g1);
            float y0[8], y1[8];
#pragma unroll
            for (int i = 0; i < 8; ++i) { const cf cv = __builtin_convertvector(Z[fft_pad(t0 + i)], cf); y0[i] = g0[i] * (cv.x + y[0][r][i] * d1); y1[i] = g1[i] * (cv.y + y[1][r][i] * d1); }
            v4u w0, w1;
#pragma unroll
            for (int i = 0; i < 4; ++i) { w0[i] = pk2(y0[2 * i], y0[2 * i + 1]); w1[i] = pk2(y1[2 * i], y1[2 * i + 1]); }
            *(GAS v4u*)(YHT + (size_t)c * M + (size_t)(2 * pair) * T + t0) = w0; *(GAS v4u*)(YHT + (size_t)c * M + (size_t)(2 * pair + 1) * T + t0) = w1; }
        LSYNC();
    }
}
__device__ __forceinline__ void p3_transpose(Frame& F) {
    const unsigned short* YHT = (const unsigned short*)(F.ws + WS_YHT); unsigned short* YH = (unsigned short*)(F.ws + WS_YH);
    const int gw = F.vcu * NWAVES + F.wave, NGW = F.G * NWAVES, lane = F.lane, cb8 = lane >> 3, mb8 = lane & 7;
    for (int it = gw; it < (HW / 64) * (M / 64); it += NGW) { const int cb = it & 7, mb = it >> 3, c0 = cb * 64 + 8 * cb8, m0 = mb * 64 + 8 * mb8;
        const unsigned short* src = YHT + (size_t)c0 * M + m0;
        v4u R[8];
#pragma unroll
        for (int r = 0; r < 8; ++r) R[r] = *(const GAS v4u*)(src + (size_t)r * M);
#pragma unroll
        for (int j = 0; j < 8; ++j) { v4u o;
#pragma unroll
            for (int w = 0; w < 4; ++w) o[w] = __builtin_amdgcn_perm(R[2 * w + 1][j >> 1], R[2 * w][j >> 1], (j & 1) ? 0x07060302u : 0x05040100u);
            *(GAS v4u*)(YH + (size_t)(m0 + j) * HW + c0) = o; } }
}
typedef int RouteEnt __attribute__((ext_vector_type(4)));
__device__ __forceinline__ void top4_insert(float (&tv)[4], int (&te)[4], float v, int e) {
    if (v > tv[3]) { tv[3] = v; te[3] = e;
        if (tv[3] > tv[2]) { const float a = tv[2]; const int b = te[2]; tv[2] = tv[3]; te[2] = te[3]; tv[3] = a; te[3] = b;
            if (tv[2] > tv[1]) { const float a2 = tv[1]; const int b2 = te[1]; tv[1] = tv[2]; te[1] = te[2]; tv[2] = a2; te[2] = b2;
                if (tv[1] > tv[0]) { const float a3 = tv[0]; const int b3 = te[0]; tv[0] = tv[1]; te[0] = te[1]; tv[1] = a3; te[1] = b3; } } } }
}
__device__ __forceinline__ bool top4_before(float va, int ea, float vb, int eb) { return va > vb || (va == vb && ea < eb); }
template <int DRY>
__device__ __forceinline__ void p6_route(Frame& F) {
    typedef float f32x16 __attribute__((ext_vector_type(16)));
    constexpr int WP = 1028;
    LAS float* W = (LAS float*)(F.lds + RING_OFF);
    LAS float* rstab = (LAS float*)(F.lds + RING_OFF + 32 * WP * 4);
    LAS int* lcnt = (LAS int*)(F.lds + LX_CNT); LAS int* lbase = lcnt + 32;
    LAS RouteEnt* ent = (LAS RouteEnt*)(F.lds + LX_ENT);
    const float* wrt = (const float*)(F.ws + WS_WRT); const float* g2 = F.in[19]; const float* rb = F.in[21];
    const bf16* h = (const bf16*)(F.ws + WS_HB); bf16* HN = (bf16*)(F.ws + WS_XN);
    const int tid = F.tid, lane = F.lane;
    for (int i = tid; i < NE * D / 4; i += NWAVES * 64) { const int e = i >> 8, k4 = (i & 255) * 4; const f32x4 w = ((const GAS f32x4*)wrt)[i], g = *(const GAS f32x4*)(g2 + k4); *(LAS f32x4*)(W + e * WP + k4) = w * g; }
    if (tid < 32) lcnt[tid] = 0;
    __syncthreads();
    const int m0 = blockIdx.x * TPB;
    f32x16 acc = {};
    if (F.wave >= 4) {
        f32x4 gg[4];
#pragma unroll
        for (int j = 0; j < 4; ++j) gg[j] = ((const GAS f32x4*)g2)[lane + 64 * j];
        unsigned long long nx[4];
        { const GAS unsigned long long* xr = (const GAS unsigned long long*)(h + (size_t)(m0 + F.wave - 4) * D) + lane;
#pragma unroll
          for (int j = 0; j < 4; ++j) nx[j] = xr[64 * j]; }
        for (int lt = F.wave - 4; lt < TPB; lt += 4) { const int m = m0 + lt;
            f32x4 v[4]; float ss = 0.f;
#pragma unroll
            for (int j = 0; j < 4; ++j) { const unsigned lo = (unsigned)nx[j], hi = (unsigned)(nx[j] >> 32); v[j] = (f32x4){bflo(lo), bfhi(lo), bflo(hi), bfhi(hi)}; ss += (v[j].x * v[j].x + v[j].y * v[j].y) + (v[j].z * v[j].z + v[j].w * v[j].w); }
            if (lt + 4 < TPB) { const GAS unsigned long long* xr = (const GAS unsigned long long*)(h + (size_t)(m + 4) * D) + lane;
#pragma unroll
                for (int j = 0; j < 4; ++j) nx[j] = xr[64 * j]; }
            const float rstd = 1.f / sqrtf(wave_sum(ss) * (1.f / D) + EPS);
            if (lane == 0) rstab[lt] = rstd;
            GAS unsigned* o4 = (GAS unsigned*)((unsigned char*)HN + (size_t)m * D) + lane;
#pragma unroll
            for (int j = 0; j < 4; ++j) { v[j] = v[j] * (rstd * ASCALE) * gg[j]; o4[64 * j] = cvt4_fp8(fminf(fmaxf(v[j].x, -448.f), 448.f), fminf(fmaxf(v[j].y, -448.f), 448.f), fminf(fmaxf(v[j].z, -448.f), 448.f), fminf(fmaxf(v[j].w, -448.f), 448.f)); } }
    } else {
        const int tok = lane & 31, kh = lane >> 5;
        const GAS v4u* hp = (const GAS v4u*)(h + (size_t)(m0 + 32 * F.wave + tok) * D + 8 * kh);
        const LAS float* wp = W + tok * WP + 8 * kh;
        v4u hb[2]; hb[0] = hp[0]; hb[1] = hp[2];
#pragma unroll 2
        for (int S = 0; S < 64; ++S) { const v4u raw = hb[S & 1]; if (S + 2 < 64) hb[S & 1] = hp[2 * (S + 2)];
            const f32x4 w0 = *(const LAS f32x4*)(wp + 16 * S), w1 = *(const LAS f32x4*)(wp + 16 * S + 4);
            const float b[8] = {bflo(raw.x), bfhi(raw.x), bflo(raw.y), bfhi(raw.y), bflo(raw.z), bfhi(raw.z), bflo(raw.w), bfhi(raw.w)};
            const float a[8] = {w0.x, w0.y, w0.z, w0.w, w1.x, w1.y, w1.z, w1.w};
#pragma unroll
            for (int i = 0; i < 8; ++i) acc = __builtin_amdgcn_mfma_f32_32x32x2f32(a[i], b[i], acc, 0, 0, 0); }
    }
    __syncthreads();
    if (F.wave < 4) {
        const int tok = lane & 31, hh = lane >> 5, lt = 32 * F.wave + tok;
        const float rstd = rstab[lt];
        float tv[4] = {-INFINITY, -INFINITY, -INFINITY, -INFINITY}; int te[4] = {0, 0, 0, 0};
#pragma unroll
        for (int i = 0; i < 16; ++i) { const int e = (i & 3) + 8 * (i >> 2) + 4 * hh; top4_insert(tv, te, acc[i] * rstd + rb[e], e); }
        float pv[4]; int pe[4];
#pragma unroll
        for (int k = 0; k < 4; ++k) { pv[k] = __shfl_xor(tv[k], 32); pe[k] = __shfl_xor(te[k], 32); }
        float mv[4]; int me[4]; int ia = 0, ib = 0;
#pragma unroll
        for (int k = 0; k < 4; ++k) {
            const float va = ia == 0 ? tv[0] : ia == 1 ? tv[1] : ia == 2 ? tv[2] : tv[3]; const int ea = ia == 0 ? te[0] : ia == 1 ? te[1] : ia == 2 ? te[2] : te[3];
            const float vb = ib == 0 ? pv[0] : ib == 1 ? pv[1] : ib == 2 ? pv[2] : pv[3]; const int eb = ib == 0 ? pe[0] : ib == 1 ? pe[1] : ib == 2 ? pe[2] : pe[3];
            const bool ta = top4_before(va, ea, vb, eb); mv[k] = ta ? va : vb; me[k] = ta ? ea : eb; ia += ta ? 1 : 0; ib += ta ? 0 : 1; }
        const float e1 = __expf(mv[1] - mv[0]), e2 = __expf(mv[2] - mv[0]), e3 = __expf(mv[3] - mv[0]); const float inv = 1.0f / (1.0f + e1 + e2 + e3);
        if (hh == 0) { const float gt[4] = {inv, e1 * inv, e2 * inv, e3 * inv};
#pragma unroll
            for (int k = 0; k < 4; ++k) { const int lp = atomicAdd((int*)(lcnt + me[k]), 1); ent[lt * 4 + k] = (RouteEnt){me[k], lp, (int)__float_as_uint(gt[k]), 0}; } }
    }
    __syncthreads();
    if (DRY) return;
    if (tid < 32) lbase[tid] = (int)__hip_atomic_fetch_add(F.ctl + CW_CNT + tid, (unsigned)lcnt[tid], __ATOMIC_RELAXED, __HIP_MEMORY_SCOPE_AGENT);
    __syncthreads();
    { RouteEnt en = ent[tid]; en.y += lbase[en.x]; ((GAS RouteEnt*)(F.ws + WS_ENT))[(size_t)m0 * 4 + tid] = en; }
}
__device__ __forceinline__ void build_layout(Frame& F) {
    LAS int* pstart = (LAS int*)(F.lds + LX_CNT) + 64; LAS int* rbe = (LAS int*)(F.lds + LX_RBE); LAS int* gcnt = (LAS int*)(F.lds + LX_RED);
    __syncthreads();
    if (F.tid < 32) gcnt[F.tid] = (int)__hip_atomic_load(F.ctl + CW_CNT + F.tid, __ATOMIC_RELAXED, __HIP_MEMORY_SCOPE_AGENT);
    __syncthreads();
    if (F.tid == 0) { int rb = 0;
        for (int e = 0; e < NE; ++e) { pstart[e] = rb * 256; const int nb = (gcnt[e] + 255) >> 8; for (int b = 0; b < nb && rb < RB_MAX; ++b) rbe[rb++] = e; }
        pstart[NE] = rb * 256; F.MISC[16] = (unsigned)rb; }
    __syncthreads();
}
__device__ __forceinline__ void p7_layout(Frame& F) {
    build_layout(F);
    LAS int* pstart = (LAS int*)(F.lds + LX_CNT) + 64; LAS int* gcnt = (LAS int*)(F.lds + LX_RED);
    int* tokrows = (int*)(F.ws + WS_TOKROWS); float* rowgate = (float*)(F.ws + WS_ROWGATE); int* srctok = (int*)(F.ws + WS_SRC);
    const int m0 = blockIdx.x * TPB;
    { const int m = m0 + (F.tid >> 2), k = F.tid & 3;
      const RouteEnt en = ((const GAS RouteEnt*)(F.ws + WS_ENT))[(size_t)m * 4 + k]; const int row = pstart[en.x] + en.y;
      tokrows[m * 4 + k] = row; rowgate[row] = __uint_as_float((unsigned)en.z); srctok[row] = m; }
    if (blockIdx.x < NE) { const int e = blockIdx.x, r0 = pstart[e] + gcnt[e], r1 = pstart[e + 1];
        for (int row = r0 + F.tid; row < r1; row += NWAVES * 64) { srctok[row] = 0; rowgate[row] = 0.f; } }
}
__device__ __forceinline__ void p10_combine(Frame& F) {
    const unsigned char* Y2 = (const unsigned char*)(F.ws + WS_XG); const bf16* HB = (const bf16*)(F.ws + WS_HB); const int* tokrows = (const int*)(F.ws + WS_TOKROWS); float* out = F.out;
    const int gw = F.vcu * NWAVES + F.wave, NGW = F.G * NWAVES, lane = F.lane;
    typedef float f32x2v __attribute__((ext_vector_type(2))); typedef unsigned u32x2c __attribute__((ext_vector_type(2)));
#pragma unroll 1
    for (int mm = gw; mm < M; mm += 2 * NGW) {
        int rr[2][4];
#pragma unroll
        for (int u = 0; u < 2; ++u) { const RouteEnt t4 = *(const GAS RouteEnt*)(tokrows + (size_t)(mm + u * NGW) * 4); rr[u][0] = t4.x; rr[u][1] = t4.y; rr[u][2] = t4.z; rr[u][3] = t4.w; }
        u32x2c hb[2][4]; unsigned yw[2][4][4];
#pragma unroll
        for (int u = 0; u < 2; ++u) { const int m = mm + u * NGW;
#pragma unroll
            for (int i = 0; i < 4; ++i) { const int col = 256 * i + 4 * lane; hb[u][i] = *(const GAS u32x2c*)(HB + (size_t)m * D + col);
#pragma unroll
                for (int k = 0; k < 4; ++k) yw[u][k][i] = *(const GAS unsigned*)(Y2 + (size_t)rr[u][k] * D + col); } }
#pragma unroll
        for (int u = 0; u < 2; ++u) { const int m = mm + u * NGW;
#pragma unroll
            for (int i = 0; i < 4; ++i) { f32x2v s0 = {0.f, 0.f}, s1 = {0.f, 0.f};
#pragma unroll
                for (int k = 0; k < 4; ++k) { s0 += __builtin_amdgcn_cvt_pk_f32_fp8((int)yw[u][k][i], false); s1 += __builtin_amdgcn_cvt_pk_f32_fp8((int)yw[u][k][i], true); }
                f32x4 o; o[0] = bflo(hb[u][i][0]) + s0.x * (1.0f / YSCALE); o[1] = bfhi(hb[u][i][0]) + s0.y * (1.0f / YSCALE); o[2] = bflo(hb[u][i][1]) + s1.x * (1.0f / YSCALE); o[3] = bfhi(hb[u][i][1]) + s1.y * (1.0f / YSCALE);
                *(GAS f32x4*)(out + (size_t)m * D + 256 * i + 4 * lane) = o; } } }
}
template <int NOSTORE = 0> __device__ __forceinline__ void ph1(Frame& F) {
    bf16* const XN = (bf16*)(F.ws + WS_XN);
    { pg8::Gemm g{(const bf16*)(F.ws + WS_WIN), XN, NHY, M, D}; pg8::StaticOrder S; S.init(NHY, M, F.G, (int)blockIdx.x);
      pg8::EpiBf16Plain E{(bf16*)(F.ws + WS_ZT), M};
      pg8::gemm_phase<pg8::EpiBf16Plain, pg8::StaticOrder, true, true>(F.lds + RING_OFF, g, S, E); }
    { pg8::Gemm g{XN, (const bf16*)(F.ws + WS_WIN) + (size_t)NHY * D, M, NREST, D}; pg8::StaticOrder S; S.init(M, NREST, F.G, (int)blockIdx.x);
      pg8::EpiBf16Plain E{(bf16*)(F.ws + WS_PR), NREST};
      pg8::gemm_phase<pg8::EpiBf16Plain, pg8::StaticOrder, true, true>(F.lds + RING_OFF, g, S, E); }
}
__device__ __forceinline__ void ph2(Frame& F) {
    p2_qkprep(F); if (PROBE_SUB & 8) p2_qkprep(F);
    __syncthreads(); fft_tables(F);
    for (int c = F.vcu; c < HW; c += F.G) hyena_channel(F, c);
}
__device__ __forceinline__ void ph3(Frame& F, unsigned char* lds) {
    p3_transpose(F);
    __syncthreads();
    static_assert(attn_body::L8_BYTES <= RING_BYTES, "attention LDS");
    float gq = fabsf(F.in[14][F.lane]), gk = fabsf(F.in[15][F.lane]);
#pragma unroll
    for (int o = 1; o < 64; o <<= 1) { gq = fmaxf(gq, __shfl_xor(gq, o)); gk = fmaxf(gk, __shfl_xor(gk, o)); }
    const float mref = 64.0f * 0.125f * 1.4426950408889634f * gq * gk;
    const attn_body::AttnTensors8 AT{(const unsigned char*)(F.ws + WS_QO), (const unsigned char*)(F.ws + WS_KB), (const unsigned char*)(F.ws + WS_VB), (attn_body::bf16*)(F.ws + WS_AO), mref - 7.0f};
    const attn_body::StaticOrder S((int)F.G, F.vcu);
    attn_body::attn_phase8<attn_body::StaticOrder>((char*)lds + RING_OFF, AT, S);
}
__device__ __forceinline__ void ph4(Frame& F) {
    const bf16* PR = (const bf16*)(F.ws + WS_PR); bf16* MG = (bf16*)(F.ws + WS_MG);
    pg8::Gemm g{(const bf16*)(F.ws + WS_YH), (const bf16*)(F.ws + WS_WHU), M, D, 512, nullptr, (const bf16*)(F.ws + WS_AO), (const bf16*)(F.ws + WS_WAU)};
    pg8::ChainOrder S; S.base.init(M, D, F.G, (int)blockIdx.x);
    pg8::EpiGateChain E{MG, D, PR + PR_GH, PR + PR_GA, NREST};
    pg8::gemm_phase<pg8::EpiGateChain, pg8::ChainOrder, true, true>(F.lds + RING_OFF, g, S, E);
}
__device__ __forceinline__ void ph5(Frame& F) {
    pg8::Gemm g{(const bf16*)(F.ws + WS_MG), (const bf16*)(F.ws + WS_WOUT), M, D, D}; pg8::StaticOrder S; S.init(M, D, F.G, (int)blockIdx.x);
    pg8::EpiResBf16 E{F.in[0], (bf16*)(F.ws + WS_HB), D};
    pg8::gemm_phase<pg8::EpiResBf16, pg8::StaticOrder, true, true>(F.lds + RING_OFF, g, S, E);
}
__device__ __forceinline__ void ph8(Frame& F) {
    build_layout(F); const int nrb = (int)F.MISC[16];
    pg8::MoeOrder S; S.init(nrb, 8, F.G, (int)blockIdx.x, (const LAS int*)(F.lds + LX_RBE));
    LAS unsigned short* lidx = (LAS unsigned short*)(F.lds + LX_GIDX); const int* srctok = (const int*)(F.ws + WS_SRC);
    { pg8::Unit u; for (int i = 0; i < GIDX_UNITS && S.next(i, u); ++i) if (F.tid < 256) lidx[i * 256 + F.tid] = (unsigned short)srctok[u.pm * 256 + F.tid]; }
    __syncthreads();
    pg8::Gemm g{(const bf16*)(F.ws + WS_XN), (const bf16*)(F.ws + WS_W1), nrb * 256, 2 * FF, D / 2, lidx};
    pg8::EpiSwiglu E{(bf16*)(F.ws + WS_H1), F.in[23], 1.0f / (ASCALE * WSCALE), HSCALE};
    pg8::gemm_phase<pg8::EpiSwiglu, pg8::MoeOrder, true, true, true, true>(F.lds + RING_OFF, g, S, E);
}
template <int NOSTORE>
__device__ __forceinline__ void ph9(Frame& F) {
    build_layout(F); const int nrb = (int)F.MISC[16];
    pg8::Gemm g{(const bf16*)(F.ws + WS_H1), (const bf16*)(F.ws + WS_W2), nrb * 256, D, FF / 2}; pg8::MoeOrder S; S.init(nrb, 4, F.G, (int)blockIdx.x, (const LAS int*)(F.lds + LX_RBE)); if (PROBE_SUB & 2048) S.dup = 1;
    pg8::EpiMoe2 E{(bf16*)(F.ws + WS_XG), F.in[25], (const float*)(F.ws + WS_ROWGATE), NOSTORE, 1.0f / (HSCALE * WSCALE), YSCALE};
    pg8::gemm_phase<pg8::EpiMoe2, pg8::MoeOrder, true, true, false, true>(F.lds + RING_OFF, g, S, E);
}
struct Args { const float* in[26]; float* out; unsigned char* ws; int ph_lo, ph_hi; };
__global__ void __launch_bounds__(NWAVES * 64, 2) hybrid_fwd(Args args) {
    extern __shared__ __attribute__((aligned(16))) unsigned char lds[];
    Frame F;
    F.lds = (LAS unsigned char*)lds;
    F.MISC = (volatile LAS unsigned*)(F.lds + LX_MISC);
    F.tid = threadIdx.x; F.lane = F.tid & 63; F.wave = __builtin_amdgcn_readfirstlane(F.tid >> 6);
    F.G = gridDim.x; { const int bx = blockIdx.x; F.vcu = (F.G % 8 == 0) ? (bx % 8) * (F.G / 8) + bx / 8 : bx; }
    F.ws = args.ws; F.ctl = (gu32*)(args.ws + WS_CTL); F.out = args.out;
#pragma unroll
    for (int i = 0; i < 26; ++i) F.in[i] = args.in[i];
    if (F.tid < 64) F.MISC[F.tid] = 0u;
    __syncthreads();
    XcdBarrier bar; bar.bar = (unsigned*)(F.ctl + CW_BAR); bar.x = 0; bar.st = nullptr;
    if (N_LAUNCHES == 1) bar = xcd_barrier_post((unsigned*)(F.ctl + CW_BAR), F.MISC + 8);
#define GRID_BAR() do { if (N_LAUNCHES == 1) xcd_barrier(bar); } while (0)
    const int lo = args.ph_lo, hi = args.ph_hi;
#ifndef ONLYP
#define ONLYP -1
#endif
#define IN(k) (lo <= (k) && (k) < hi && (ONLYP < 0 || ONLYP == (k)))
#ifndef PROBE_DUP
#define PROBE_DUP 0
#endif
#define DUP(k) (((PROBE_DUP) >> (k)) & 1)
#define FRESH() do { int t_ = threadIdx.x; asm volatile("" : "+v"(t_)); F.tid = t_; F.lane = t_ & 63; } while (0)
    if (IN(0)) { FRESH(); p0_prologue(F); if (DUP(0)) { __syncthreads(); p0_prologue(F); } GRID_BAR(); }
    if (IN(1)) { FRESH(); ph1(F); if (DUP(1)) ph1(F); GRID_BAR(); }
    if (IN(2)) { FRESH(); ph2(F); if (DUP(2)) ph2(F); GRID_BAR(); }
    if (IN(3)) { FRESH(); ph3(F, lds); if (DUP(3)) { __syncthreads(); ph3(F, lds); } GRID_BAR(); }
    if (IN(4)) { FRESH(); ph4(F); if (DUP(4)) ph4(F); GRID_BAR(); }
    if (IN(5)) { FRESH(); ph5(F); if (DUP(5)) ph5(F); GRID_BAR(); }
    if (IN(6)) { FRESH(); if (PROBE_SUB & 128) { p6_route<1>(F); __syncthreads(); } p6_route<0>(F); GRID_BAR(); if (PROBE_SUB & 256) { for (int i = 0; i < 10; ++i) GRID_BAR(); } }
    if (IN(7)) { FRESH(); p7_layout(F); if (DUP(7)) p7_layout(F); GRID_BAR(); }
    if (IN(8)) { FRESH(); ph8(F); if (DUP(8)) ph8(F); GRID_BAR(); }
    if (IN(9)) { FRESH(); ph9<0>(F); if (DUP(9)) ph9<0>(F); if (PROBE_SUB & 64) ph9<1>(F); GRID_BAR(); }
    if (IN(10)) { FRESH(); p10_combine(F); if (DUP(10)) p10_combine(F); }
#undef IN
}

extern "C" void kernel_launch(void* const* d_in, const int* in_sizes, int n_in, void* d_out, int out_size, void* d_ws, size_t ws_size, hipStream_t stream) {
    static int grid = 0;
    if (grid == 0) {
        if (n_in != 26 || in_sizes[0] != M * D || out_size != M * D || ws_size < WS_END) { fprintf(stderr, "kernel_launch: unexpected shapes (n_in %d, in0 %d, out %d, ws %zu); nothing launched\n", n_in, n_in > 0 ? in_sizes[0] : -1, out_size, ws_size); grid = -1; return; }
        int dev = 0, cus = 0, per_cu = 0;
        if (hipGetDevice(&dev) != hipSuccess || hipDeviceGetAttribute(&cus, hipDeviceAttributeMultiprocessorCount, dev) != hipSuccess) { grid = -1; return; }
        if (hipFuncSetAttribute((const void*)hybrid_fwd, hipFuncAttributeMaxDynamicSharedMemorySize, LDS_BYTES) != hipSuccess) { fprintf(stderr, "kernel_launch: hipFuncSetAttribute failed\n"); grid = -1; return; }
        if (hipOccupancyMaxActiveBlocksPerMultiprocessor(&per_cu, (const void*)hybrid_fwd, NWAVES * 64, LDS_BYTES) != hipSuccess || per_cu < 1) fprintf(stderr, "kernel_launch: occupancy query reports %d\n", per_cu);
        (void)hipGetLastError();
        grid = cus;
        if (grid != 256) { fprintf(stderr, "kernel_launch: built for 256 CUs, device has %d\n", grid); grid = -1; return; }
    }
    if (grid < 0) return;
    if (hipMemsetAsync((char*)d_ws + WS_CTL, 0, CTL_ZERO_BYTES, stream) != hipSuccess) return;
    Args a{};
    for (int i = 0; i < 26; ++i) a.in[i] = (const float*)d_in[i];
    a.out = (float*)d_out; a.ws = (unsigned char*)d_ws;
    if (N_LAUNCHES == 1) { a.ph_lo = 0; a.ph_hi = N_PHASES; hipLaunchKernelGGL(hybrid_fwd, dim3(grid), dim3(NWAVES * 64), LDS_BYTES, stream, a); }
    else for (int p = 0; p < N_PHASES; ++p) { a.ph_lo = p; a.ph_hi = p + 1; hipLaunchKernelGGL(hybrid_fwd, dim3(grid), dim3(NWAVES * 64), LDS_BYTES, stream, a); }
}
```

```cpp
#include <hip/hip_runtime.h>
#include <cstdio>
#include <cstdint>
namespace pg8 {
#define PG8_LAS __attribute__((address_space(3)))
typedef unsigned short bf16_t;
typedef short bf16x8 __attribute__((ext_vector_type(8)));
typedef float f32x4 __attribute__((ext_vector_type(4)));
typedef unsigned u32x4 __attribute__((ext_vector_type(4)));
typedef int i32x4 __attribute__((ext_vector_type(4)));
constexpr int BM = 256, BK = 64, HALF = 128, HTB = HALF * BK * 2  , STAGE_BYTES = 8 * HTB, NXCD = 8, WGM = 8;

__host__ __device__ __forceinline__ int lds_byte(int r, int c) { const int st = (r >> 4) * 2 + (c >> 5), rr = r & 15, cc = c & 31, ob = rr * 64 + cc * 2; return st * 1024 + (ob ^ (((ob >> 9) & 1) << 5)); }
__host__ __device__ __forceinline__ void stage_rc(int b, int& R, int& C) { const int st = b / 1024, sb = b % 1024, swz = sb ^ (((sb >> 9) & 1) << 5); R = (st >> 1) * 16 + swz / 64; C = (st & 1) * 32 + (swz % 64) / 2; }
__host__ __device__ __forceinline__ int perm32(int rho) { const int n = rho >> 4, i = rho & 15; return 8 * (i >> 2) + 4 * n + (i & 3); }

struct Unit { int pm, pn, pb, sel; };
struct Gemm { const bf16_t* A; const bf16_t* Bt; int M, N, K; const PG8_LAS unsigned short* lidx; const bf16_t* A2; const bf16_t* Bt2; };

struct StaticOrder {
    int nM, nN, nwg, G, c;
    __host__ __device__ void init(int M, int N, int G_, int c_) { nM = M / BM; nN = N / BM; nwg = nM * nN; G = G_; c = c_; }
    __host__ __device__ bool next(int i, Unit& u) const {
        const long L = (long)i * G + c; if (L >= nwg) return false;
        int wgid = (int)L; { const int q = nwg / NXCD, r = nwg % NXCD, xcd = wgid % NXCD, off = wgid / NXCD; wgid = (xcd < r ? xcd * (q + 1) : r * (q + 1) + (xcd - r) * q) + off; }
        const int nig = WGM * nN, gid = wgid / nig, fm = gid * WGM, gsz = (nM - fm) < WGM ? (nM - fm) : WGM;
        u.pm = fm + ((wgid % nig) % gsz); u.pn = (wgid % nig) / gsz; u.pb = u.pn; u.sel = 0; return true;
    }
    __device__ __forceinline__ void a_ready(const Unit&) const {}
    __device__ __forceinline__ void done(const Unit&) const {}
};

__device__ __forceinline__ unsigned cvt_pk_bf16(float lo, float hi) { unsigned r; asm volatile("v_cvt_pk_bf16_f32 %0, %1, %2" : "=v"(r) : "v"(lo), "v"(hi)); return r; }
typedef float f32x2 __attribute__((ext_vector_type(2)));
template <int ACT  > struct EpiBf16 {
    static constexpr bool PERM = true, AFTER_DRAIN = false, CHAIN = false; static_assert(ACT == 0, "EpiBf16: ACT is 0 (none)");
    struct Pre {}; __device__ __forceinline__ Pre pre(const Unit&, int, int, int, int) const { return Pre{}; }
    bf16_t* O; int ldc; const float* bias; int split_cols; size_t split_stride; float scale0;
    __device__ __forceinline__ void operator()(const f32x4 (&acc)[2][2][4][2], const Unit& u, int wr, int wc, int fr, int fq, const Pre&) const {
        const int row0 = u.pm * BM + wr * 64 + fr; int colt = u.pn * BM; bf16_t* base = O;
        float sc = 1.f; if (split_cols) { const int t = colt / split_cols; base += (size_t)t * split_stride; colt -= t * split_cols; if (t == 0) sc = scale0; }
        const int col0 = colt + wc * 32 + 8 * fq, bcol0 = u.pn * BM + wc * 32 + 8 * fq;
        f32x4 bv[2][2];
#pragma unroll
        for (int bj = 0; bj < 2; ++bj)
#pragma unroll
            for (int n = 0; n < 2; ++n) bv[bj][n] = bias ? *(const f32x4*)(bias + bcol0 + bj * HALF + 4 * n) : (f32x4){0.f, 0.f, 0.f, 0.f};
#pragma unroll
        for (int ai = 0; ai < 2; ++ai)
#pragma unroll
            for (int m = 0; m < 4; ++m) { bf16_t* rowp = base + (size_t)(row0 + ai * HALF + m * 16) * ldc + col0;
#pragma unroll
                for (int bj = 0; bj < 2; ++bj) { f32x4 v0 = acc[ai][bj][m][0] + bv[bj][0], v1 = acc[ai][bj][m][1] + bv[bj][1];
                    v0 = v0 * sc; v1 = v1 * sc; u32x4 w; w.x = cvt_pk_bf16(v0[0], v0[1]); w.y = cvt_pk_bf16(v0[2], v0[3]); w.z = cvt_pk_bf16(v1[0], v1[1]); w.w = cvt_pk_bf16(v1[2], v1[3]);
                    *(u32x4*)(rowp + bj * HALF) = w; } }
    }
};
struct EpiBf16Plain {
    static constexpr bool PERM = true, AFTER_DRAIN = false, CHAIN = false; static constexpr int PERM2 = 3;
    struct Pre {}; __device__ __forceinline__ Pre pre(const Unit&, int, int, int, int) const { return Pre{}; }
    bf16_t* O; int ldc;
    __device__ __forceinline__ void operator()(const f32x4 (&acc)[2][2][4][2], const Unit& u, int wr, int wc, int fr, int fq, const Pre&) const {
        const bool lo = fr < 8;
        const int row0 = u.pm * BM + wr * 64 + (fr & 7), col0 = u.pn * BM + wc * 64 + 8 * fq + (lo ? 0 : 32);
#pragma unroll
        for (int ai = 0; ai < 2; ++ai)
#pragma unroll
            for (int m = 0; m < 4; ++m) { bf16_t* rowp = O + (size_t)(row0 + ai * HALF + m * 16) * ldc + col0;
                u32x4 w[2];
#pragma unroll
                for (int bj = 0; bj < 2; ++bj) { const f32x4 v0 = acc[ai][bj][m][0], v1 = acc[ai][bj][m][1];
                    w[bj].x = cvt_pk_bf16(v0[0], v0[1]); w[bj].y = cvt_pk_bf16(v0[2], v0[3]); w[bj].z = cvt_pk_bf16(v1[0], v1[1]); w[bj].w = cvt_pk_bf16(v1[2], v1[3]); }
                u32x4 xa, xb;
#pragma unroll
                for (int i = 0; i < 4; ++i) { const unsigned give = lo ? w[1][i] : w[0][i], recv = (unsigned)__shfl_xor((int)give, 8, 64);
                    xa[i] = lo ? w[0][i] : recv; xb[i] = lo ? recv : w[1][i]; }
                *(u32x4*)rowp = xa; *(u32x4*)(rowp + (size_t)8 * ldc) = xb; }
    }
};
__device__ __forceinline__ float bf_lo(unsigned w) { return __uint_as_float(w << 16); }
__device__ __forceinline__ float bf_hi(unsigned w) { return __uint_as_float(w & 0xffff0000u); }
__device__ __forceinline__ float sigmoid_f(float x) { return __builtin_amdgcn_rcpf(1.f + __builtin_amdgcn_exp2f(-1.4426950408889634f * x)); }
struct MoeOrder {
    int nM, nN, nwg, G, c; const PG8_LAS int* rbe;
    __device__ void init(int nM_, int nN_, int G_, int c_, const PG8_LAS int* rbe_) { nM = nM_; nN = nN_; nwg = nM * nN; G = G_; c = c_; rbe = rbe_; dup = 0; }
    int dup;
    __device__ bool next(int i, Unit& u) const {
        const long L = (long)(i >> dup) * G + c; if (L >= nwg) return false;
        int wgid = (int)L; { const int q = nwg / NXCD, r = nwg % NXCD, xcd = wgid % NXCD, off = wgid / NXCD; wgid = (xcd < r ? xcd * (q + 1) : r * (q + 1) + (xcd - r) * q) + off; }
        const int nig = WGM * nN, gid = wgid / nig, fm = gid * WGM, gsz = (nM - fm) < WGM ? (nM - fm) : WGM;
        u.pm = fm + ((wgid % nig) % gsz); u.pn = (wgid % nig) / gsz; u.pb = rbe[u.pm] * nN + u.pn; u.sel = dup ? (i & 1) : 0; return true;
    }
    __device__ __forceinline__ void a_ready(const Unit&) const {}
    __device__ __forceinline__ void done(const Unit&) const {}
};
template <int PASS> struct EpiGate {
    static constexpr bool PERM = true, AFTER_DRAIN = false, CHAIN = false;
    struct Pre {}; __device__ __forceinline__ Pre pre(const Unit&, int, int, int, int) const { return Pre{}; }
    bf16_t* O; int ldc; const bf16_t* G; int ldg;
    __device__ __forceinline__ void operator()(const f32x4 (&acc)[2][2][4][2], const Unit& u, int wr, int wc, int fr, int fq, const Pre&) const {
        const int row0 = u.pm * BM + wr * 64 + fr, col0 = u.pn * BM + wc * 32 + 8 * fq;
#pragma unroll
        for (int ai = 0; ai < 2; ++ai)
#pragma unroll
            for (int m = 0; m < 4; ++m) { const size_t row = (size_t)(row0 + ai * HALF + m * 16);
#pragma unroll
                for (int bj = 0; bj < 2; ++bj) { const int col = col0 + bj * HALF;
                    const u32x4 gw = *(const u32x4*)(G + row * ldg + col);
                    float v[8];
#pragma unroll
                    for (int i = 0; i < 4; ++i) { v[2 * i] = sigmoid_f(bf_lo(gw[i])) * acc[ai][bj][m][i >> 1][(2 * i) & 3]; v[2 * i + 1] = sigmoid_f(bf_hi(gw[i])) * acc[ai][bj][m][i >> 1][(2 * i + 1) & 3]; }
                    bf16_t* op = O + row * ldc + col;
                    if (PASS == 1) { const u32x4 tw = *(const u32x4*)op;
#pragma unroll
                        for (int i = 0; i < 4; ++i) { v[2 * i] += bf_lo(tw[i]); v[2 * i + 1] += bf_hi(tw[i]); } }
                    u32x4 w; w.x = cvt_pk_bf16(v[0], v[1]); w.y = cvt_pk_bf16(v[2], v[3]); w.z = cvt_pk_bf16(v[4], v[5]); w.w = cvt_pk_bf16(v[6], v[7]);
                    *(u32x4*)op = w; } }
    }
};
struct EpiResF32 {
    static constexpr bool PERM = false, AFTER_DRAIN = false, CHAIN = false;
    struct Pre {}; __device__ __forceinline__ Pre pre(const Unit&, int, int, int, int) const { return Pre{}; }
    const float* X; float* out; int ldc;
    __device__ __forceinline__ void operator()(const f32x4 (&acc)[2][2][4][2], const Unit& u, int wr, int wc, int fr, int fq, const Pre&) const {
        const int row0 = u.pm * BM + wr * 64 + fr, col0 = u.pn * BM + wc * 32 + 4 * fq;
#pragma unroll
        for (int ai = 0; ai < 2; ++ai)
#pragma unroll
            for (int m = 0; m < 4; ++m) { const size_t off = (size_t)(row0 + ai * HALF + m * 16) * ldc + col0;
#pragma unroll
                for (int bj = 0; bj < 2; ++bj)
#pragma unroll
                    for (int n = 0; n < 2; ++n) { const f32x4 xv = *(const f32x4*)(X + off + bj * HALF + n * 16); *(f32x4*)(out + off + bj * HALF + n * 16) = xv + acc[ai][bj][m][n]; } }
    }
};
struct EpiResBf16 {
    static constexpr bool PERM = true, AFTER_DRAIN = false, CHAIN = false;
    struct Pre {}; __device__ __forceinline__ Pre pre(const Unit&, int, int, int, int) const { return Pre{}; }
    const float* X; bf16_t* out; int ldc;
    __device__ __forceinline__ void operator()(const f32x4 (&acc)[2][2][4][2], const Unit& u, int wr, int wc, int fr, int fq, const Pre&) const {
        const int row0 = u.pm * BM + wr * 64 + fr, col0 = u.pn * BM + wc * 32 + 8 * fq;
#pragma unroll
        for (int ai = 0; ai < 2; ++ai)
#pragma unroll
            for (int m = 0; m < 4; ++m) { const size_t off = (size_t)(row0 + ai * HALF + m * 16) * ldc + col0;
#pragma unroll
                for (int bj = 0; bj < 2; ++bj) { const f32x4 v0 = *(const f32x4*)(X + off + bj * HALF) + acc[ai][bj][m][0], v1 = *(const f32x4*)(X + off + bj * HALF + 4) + acc[ai][bj][m][1];
                    u32x4 w; w.x = cvt_pk_bf16(v0[0], v0[1]); w.y = cvt_pk_bf16(v0[2], v0[3]); w.z = cvt_pk_bf16(v1[0], v1[1]); w.w = cvt_pk_bf16(v1[2], v1[3]);
                    *(u32x4*)(out + off + bj * HALF) = w; } }
    }
};
typedef unsigned u32x2 __attribute__((ext_vector_type(2)));
__device__ __forceinline__ unsigned pack4_fp8(float a, float b, float c, float d) { int w = 0; w = __builtin_amdgcn_cvt_pk_fp8_f32(a, b, w, false); w = __builtin_amdgcn_cvt_pk_fp8_f32(c, d, w, true); return (unsigned)w; }
__device__ __forceinline__ float clamp8(float x) { return __builtin_amdgcn_fmed3f(x, -448.0f, 448.0f); }
struct EpiSwiglu {
    static constexpr bool PERM = true, AFTER_DRAIN = false, CHAIN = false, C0START = true;
    bf16_t* H; const float* b1; float ascale, hscale;
    struct Pre { f32x4 t[4]; };
    __device__ __forceinline__ Pre pre(const Unit& u, int wr, int wc, int fr, int fq) const {
        const int e = u.pb >> 3, j0 = u.pn * HALF + wc * 32 + 8 * fq; const float* bp = b1 + (size_t)e * 2048 + 2 * j0; Pre p;
#pragma unroll
        for (int i = 0; i < 4; ++i) p.t[i] = *(const f32x4*)(bp + 4 * i);
        return p; }
    __device__ __forceinline__ void operator()(const f32x4 (&acc)[2][2][4][2], const Unit& u, int wr, int wc, int fr, int fq, const Pre& pr) const {
#if defined(PROBE_EPI) && PROBE_EPI == 1
        if (u.sel) {
#pragma unroll
            for (int ai = 0; ai < 2; ++ai)
#pragma unroll
                for (int bj = 0; bj < 2; ++bj)
#pragma unroll
                    for (int m = 0; m < 4; ++m) { asm volatile("" :: "v"(acc[ai][bj][m][0]), "v"(acc[ai][bj][m][1])); }
            return; }
#endif
        const int row0 = u.pm * BM + wr * 64 + fr, j0 = u.pn * HALF + wc * 32 + 8 * fq;
        typedef float f32x2 __attribute__((ext_vector_type(2)));
        f32x2 bg[4], bl[4];
#pragma unroll
        for (int i = 0; i < 4; ++i) { const f32x4 t = pr.t[i]; bg[i] = (f32x2){t[0], t[2]}; bl[i] = (f32x2){t[1], t[3]}; }
        const f32x2 as2 = {ascale, ascale}, hs2 = {hscale, hscale}, one2 = {1.0f, 1.0f};
        const f32x2 c1 = {-1.702f * 1.4426950408889634f * 8388608.0f, -1.702f * 1.4426950408889634f * 8388608.0f}, c0 = {1064986823.0f, 1064986823.0f};
#pragma unroll
        for (int ai = 0; ai < 2; ++ai)
#pragma unroll
            for (int mp = 0; mp < 2; ++mp) { u32x2 wm[2];
#pragma unroll
                for (int mi = 0; mi < 2; ++mi) { const int m = 2 * mp + mi; f32x2 o[4];
#pragma unroll
                for (int i = 0; i < 4; ++i) { const f32x4 ag = acc[ai][0][m][i >> 1], al = acc[ai][1][m][i >> 1];
                    f32x2 g = (i & 1) ? (f32x2){ag[2], ag[3]} : (f32x2){ag[0], ag[1]}, l = (i & 1) ? (f32x2){al[2], al[3]} : (f32x2){al[0], al[1]};
                    g = g * as2 + bg[i]; l = l * as2 + bl[i];
                    g[0] = __builtin_amdgcn_fmed3f(g[0], -30.0f, 7.0f); g[1] = __builtin_amdgcn_fmed3f(g[1], -30.0f, 7.0f);
                    l[0] = __builtin_amdgcn_fmed3f(l[0], -7.0f, 7.0f); l[1] = __builtin_amdgcn_fmed3f(l[1], -7.0f, 7.0f);
                    const f32x2 ex = g * c1 + c0; f32x2 e2; e2[0] = __int_as_float((int)ex[0]); e2[1] = __int_as_float((int)ex[1]);
                    const f32x2 den = e2 + one2; f32x2 r; r[0] = __builtin_amdgcn_rcpf(den[0]); r[1] = __builtin_amdgcn_rcpf(den[1]);
                    o[i] = (g * r) * (l * hs2 + hs2); }
                    wm[mi].x = pack4_fp8(o[0][0], o[0][1], o[1][0], o[1][1]); wm[mi].y = pack4_fp8(o[2][0], o[2][1], o[3][0], o[3][1]); }
                const auto s0 = __builtin_amdgcn_permlane16_swap(wm[0].x, wm[1].x, false, false), s1 = __builtin_amdgcn_permlane16_swap(wm[0].y, wm[1].y, false, false);
                u32x4 w; w.x = s0[0]; w.y = s1[0]; w.z = s0[1]; w.w = s1[1];
                const size_t row = (size_t)(row0 + ai * HALF + (2 * mp + (fq & 1)) * 16);
                *(u32x4*)((unsigned char*)H + row * 1024 + (j0 - 8 * (fq & 1))) = w; }
    }
};
struct EpiMoe2 {
    static constexpr bool PERM = true, AFTER_DRAIN = false, CHAIN = false; static constexpr int PERM2 = 2;
    bf16_t* Y; const float* b2; const float* gate; int nostore; float ascale, yscale;
    struct Pre { f32x4 bv[4]; float gt[2][4]; };
    __device__ __forceinline__ Pre pre(const Unit& u, int wr, int wc, int fr, int fq) const {
        const int row0 = u.pm * BM + wr * 64 + fr, e = u.pb >> 2, col0 = u.pn * BM + wc * 64 + 16 * fq; Pre p;
#pragma unroll
        for (int q = 0; q < 4; ++q) p.bv[q] = *(const f32x4*)(b2 + (size_t)e * 1024 + col0 + 4 * q);
#pragma unroll
        for (int ai = 0; ai < 2; ++ai)
#pragma unroll
            for (int m = 0; m < 4; ++m) p.gt[ai][m] = gate[row0 + ai * HALF + m * 16];
        return p; }
    __device__ __forceinline__ void operator()(const f32x4 (&acc)[2][2][4][2], const Unit& u, int wr, int wc, int fr, int fq, const Pre& pr) const {
#if defined(PROBE_EPI) && PROBE_EPI == 1
        if (u.sel) {
#pragma unroll
            for (int ai = 0; ai < 2; ++ai)
#pragma unroll
                for (int bj = 0; bj < 2; ++bj)
#pragma unroll
                    for (int m = 0; m < 4; ++m) { asm volatile("" :: "v"(acc[ai][bj][m][0]), "v"(acc[ai][bj][m][1])); }
            return; }
#endif
        const int row0 = u.pm * BM + wr * 64 + fr, col0 = u.pn * BM + wc * 64 + 16 * fq;
#pragma unroll
        for (int ai = 0; ai < 2; ++ai)
#pragma unroll
            for (int m = 0; m < 4; ++m) { const size_t row = (size_t)(row0 + ai * HALF + m * 16); const float gs = pr.gt[ai][m] * yscale, a2 = ascale * gs; u32x4 w;
#pragma unroll
                for (int q = 0; q < 4; ++q) { const f32x4 v = acc[ai][q >> 1][m][q & 1] * a2 + pr.bv[q] * gs;
                    w[q] = pack4_fp8(clamp8(v[0]), clamp8(v[1]), clamp8(v[2]), clamp8(v[3])); }
#if defined(PROBE_EPI) && PROBE_EPI == 2
                if (u.sel) { asm volatile("" :: "v"(w)); continue; }
#endif
                if (!nostore) *(u32x4*)((unsigned char*)Y + row * 1024 + col0) = w; else asm volatile("" :: "v"(w)); }
    }
};
struct ChainOrder {
    StaticOrder base;
    __device__ bool next(int i, Unit& u) const { if (!base.next(i >> 1, u)) return false; u.sel = i & 1; return true; }
    __device__ __forceinline__ void a_ready(const Unit&) const {}
    __device__ __forceinline__ void done(const Unit&) const {}
};
struct EpiGateChain {
    static constexpr bool PERM = true, AFTER_DRAIN = false, CHAIN = true;
    struct Pre {}; __device__ __forceinline__ Pre pre(const Unit&, int, int, int, int) const { return Pre{}; }
    bf16_t* O; int ldc; const bf16_t* GH; const bf16_t* GA; int ldg;
    __device__ __forceinline__ static float eneg(float x) { return __builtin_amdgcn_exp2f(-1.4426950408889634f * fminf(fmaxf(x, -30.f), 30.f)); }
    typedef float f32x2g __attribute__((ext_vector_type(2)));
    __device__ __forceinline__ static f32x2g en2(unsigned w) {
        f32x2g x = {__builtin_amdgcn_fmed3f(bf_lo(w), -30.f, 30.f), __builtin_amdgcn_fmed3f(bf_hi(w), -30.f, 30.f)};
        x = x * (f32x2g){-1.4426950408889634f, -1.4426950408889634f};
        return (f32x2g){__builtin_amdgcn_exp2f(x[0]), __builtin_amdgcn_exp2f(x[1])}; }
    __device__ __forceinline__ void mid(f32x4 (&acc)[2][2][4][2], const Unit& u, int wr, int wc, int fr, int fq) const {
        const int row0 = u.pm * BM + wr * 64 + fr, col0 = u.pn * BM + wc * 32 + 8 * fq; const f32x2g one2 = {1.f, 1.f};
#pragma unroll
        for (int ai = 0; ai < 2; ++ai)
#pragma unroll
            for (int m = 0; m < 4; ++m) { const size_t row = (size_t)(row0 + ai * HALF + m * 16);
#pragma unroll
                for (int bj = 0; bj < 2; ++bj) { const int col = col0 + bj * HALF;
                    const u32x4 hw = *(const u32x4*)(GH + row * ldg + col), aw = *(const u32x4*)(GA + row * ldg + col);
#pragma unroll
                    for (int i = 0; i < 4; ++i) { const f32x2g na = en2(aw[i]) + one2, nh = en2(hw[i]) + one2;
                        const f32x2g r = na * (f32x2g){__builtin_amdgcn_rcpf(nh[0]), __builtin_amdgcn_rcpf(nh[1])};
                        acc[ai][bj][m][i >> 1][(2 * i) & 3] *= r[0]; acc[ai][bj][m][i >> 1][(2 * i + 1) & 3] *= r[1]; } } }
    }
    __device__ __forceinline__ void operator()(const f32x4 (&acc)[2][2][4][2], const Unit& u, int wr, int wc, int fr, int fq, const Pre&) const {
        const int row0 = u.pm * BM + wr * 64 + fr, col0 = u.pn * BM + wc * 32 + 8 * fq; const f32x2g one2 = {1.f, 1.f};
#pragma unroll
        for (int ai = 0; ai < 2; ++ai)
#pragma unroll
            for (int m = 0; m < 4; ++m) { const size_t row = (size_t)(row0 + ai * HALF + m * 16);
#pragma unroll
                for (int bj = 0; bj < 2; ++bj) { const int col = col0 + bj * HALF;
                    const u32x4 aw = *(const u32x4*)(GA + row * ldg + col); float v[8];
#pragma unroll
                    for (int i = 0; i < 4; ++i) { const f32x2g na = en2(aw[i]) + one2;
                        v[2 * i] = acc[ai][bj][m][i >> 1][(2 * i) & 3] * __builtin_amdgcn_rcpf(na[0]); v[2 * i + 1] = acc[ai][bj][m][i >> 1][(2 * i + 1) & 3] * __builtin_amdgcn_rcpf(na[1]); }
                    u32x4 w; w.x = cvt_pk_bf16(v[0], v[1]); w.y = cvt_pk_bf16(v[2], v[3]); w.z = cvt_pk_bf16(v[4], v[5]); w.w = cvt_pk_bf16(v[6], v[7]);
                    *(u32x4*)(O + row * ldc + col) = w; } }
    }
};
template <class E, class = void> struct C0Of { static constexpr bool v = false; };
template <class E> struct C0Of<E, decltype((void)E::C0START)> { static constexpr bool v = E::C0START; };
template <class E, class = void> struct Perm2Of { static constexpr int v = 0; };
template <class E> struct Perm2Of<E, decltype((void)E::PERM2)> { static constexpr int v = (int)E::PERM2; };
template <class Epi, class Sched, bool ALIGN_EPI = false, bool SP2 = false, bool GATHER = false, bool FP8 = false, bool ATILE = false>
__device__ __forceinline__ void gemm_phase(PG8_LAS unsigned char* lds, const Gemm g, const Sched& S, const Epi& E) {
    const int tid = threadIdx.x, wid = __builtin_amdgcn_readfirstlane(tid >> 6), lane = tid & 63, wr = wid >> 2, wc = wid & 3, fr = lane & 15, fq = lane >> 4;
    const int K = g.K, nt = K / BK;
    constexpr int PERM2 = Perm2Of<Epi>::v;
    unsigned voffA[2], voffB[2], voffB1[2];
#pragma unroll
    for (int i = 0; i < 2; ++i) { int R, C; stage_rc(tid * 16 + i * 8192, R, C); const int Rb = Epi::PERM ? ((R & ~31) + perm32(R & 31)) : R;
        const int R2 = (R >> 5) * 64 + ((R >> 2) & 3) * (PERM2 == 3 ? 8 : 16) + ((R >> 4) & 1) * 4 + (R & 3);
        voffA[i] = ATILE ? (unsigned)((R >> 2) * 4096 + (R & 3) * 32 + ((2 * C) >> 5) * 128 + ((2 * C) & 31)) : (unsigned)(R * K + C) * 2u; voffB[i] = (unsigned)((PERM2 ? R2 : Rb) * K + C) * 2u; voffB1[i] = (unsigned)((R2 + (PERM2 == 3 ? 32 : 8)) * K + C) * 2u; }
    unsigned goffC[2][2] = {{0u, 0u}, {0u, 0u}}, goffN[2][2] = {{0u, 0u}, {0u, 0u}}; int gR[2], gC[2];
#pragma unroll
    for (int i = 0; i < 2; ++i) stage_rc(tid * 16 + i * 8192, gR[i], gC[i]);
    const size_t kstep = (size_t)(BK * 2);
    const size_t kstepA = ATILE ? (size_t)(BK * 2) * 4 : kstep;
    static_assert(!ATILE || !GATHER, "ATILE: dense A only");
    const size_t hstep = (size_t)HALF * K * 2;
    const size_t tstep = 2 * hstep;
    const unsigned ldsw = (unsigned)wid * 1024u;
    const int aoff = FP8 ? lds_byte(wr * 64 + fr, 16 * (fq & 1)) + (fq >> 1) * 1024 : lds_byte(wr * 64 + fr, fq * 8), boff = FP8 ? lds_byte(wc * 32 + fr, 16 * (fq & 1)) + (fq >> 1) * 1024 : lds_byte(wc * 32 + fr, fq * 8);

#define PG8_SA(b, h) (((b) * 2 + (h)) * HTB)
#define PG8_SB(b, h) ((4 + (b) * 2 + (h)) * HTB)
#define PG8_STAGE(bufoff, gbase, voff) do { _Pragma("unroll") for (int _i = 0; _i < 2; ++_i) \
        __builtin_amdgcn_global_load_lds((const unsigned*)((const char*)(gbase) + (voff)[_i]), (PG8_LAS unsigned*)(lds + (bufoff) + ldsw + _i * 8192), 16, 0, 0); } while (0)
#define PG8_STAGE_B(bufoff, gbase, h) do { if constexpr (PERM2) { if (h) PG8_STAGE(bufoff, gbase, voffB1); else PG8_STAGE(bufoff, gbase, voffB); } else PG8_STAGE(bufoff, (gbase) + ((h) ? hstep : 0), voffB); } while (0)
#define PG8_GOFF(dst, u_) do { if constexpr (GATHER) { _Pragma("unroll") for (int h_ = 0; h_ < 2; ++h_) _Pragma("unroll") for (int i_ = 0; i_ < 2; ++i_) \
        dst[h_][i_] = ((unsigned)g.lidx[(u_) * BM + h_ * HALF + gR[i_]] * (unsigned)K + (unsigned)gC[i_]) * 2u; } } while (0)
#define PG8_STAGE_A(bufoff, gbase, h, nx) do { if constexpr (GATHER) { unsigned vo_[2] = { (nx) ? goffN[h][0] : goffC[h][0], (nx) ? goffN[h][1] : goffC[h][1] }; PG8_STAGE(bufoff, gbase, vo_); } \
        else { PG8_STAGE(bufoff, (gbase) + ((h) ? hstep : 0), voffA); } } while (0)
#define PG8_LDA(dst, b, h) do { _Pragma("unroll") for (int m = 0; m < 4; ++m) _Pragma("unroll") for (int k = 0; k < 2; ++k) { if constexpr (FP8) { if (k == 0) dst##8[m] = PG8_CAT2(*(const PG8_LAS i32x4*)(lds + PG8_SA(b, h) + aoff + m * 2048), *(const PG8_LAS i32x4*)(lds + PG8_SA(b, h) + aoff + m * 2048 + 16)); } else dst[m][k] = *(const PG8_LAS bf16x8*)(lds + PG8_SA(b, h) + aoff + m * 2048 + k * 1024); } } while (0)
#define PG8_LDB(dst, b, h) do { _Pragma("unroll") for (int n = 0; n < 2; ++n) _Pragma("unroll") for (int k = 0; k < 2; ++k) { if constexpr (FP8) { if (k == 0) dst##8[n] = PG8_CAT2(*(const PG8_LAS i32x4*)(lds + PG8_SB(b, h) + boff + n * 2048), *(const PG8_LAS i32x4*)(lds + PG8_SB(b, h) + boff + n * 2048 + 16)); } else dst[n][k] = *(const PG8_LAS bf16x8*)(lds + PG8_SB(b, h) + boff + n * 2048 + k * 1024); } } while (0)
#define PG8_CAT2(lo_, hi_) __builtin_shufflevector(lo_, hi_, 0, 1, 2, 3, 4, 5, 6, 7)
#define PG8_MMA(ai, bj, At, Bt) do { __builtin_amdgcn_s_setprio(1); _Pragma("unroll") for (int m = 0; m < 4; ++m) _Pragma("unroll") for (int n = 0; n < 2; ++n) { \
        if constexpr (FP8) asm volatile("v_mfma_scale_f32_16x16x128_f8f6f4 %0, %1, %2, %0, %3, %3 op_sel_hi:[0,0,0]" : "+v"(acc[ai][bj][m][n]) : "v"(Bt##8[n]), "v"(At##8[m]), "v"(mxone));     \
        else { _Pragma("unroll") for (int k = 0; k < 2; ++k) acc[ai][bj][m][n] = __builtin_amdgcn_mfma_f32_16x16x32_bf16(Bt[n][k], At[m][k], acc[ai][bj][m][n], 0, 0, 0); } } __builtin_amdgcn_s_setprio(0); } while (0)
#define PG8_MF_(d, a, b, c) "v_mfma_scale_f32_16x16x128_f8f6f4 " d ", " b ", " a ", " c ", %14, %14 op_sel_hi:[0,0,0]\n\t"
#define PG8_MMA0(ai, bj, At, Bt, first) do { if constexpr (C0) { __builtin_amdgcn_s_setprio(1); asm volatile("s_cmp_eq_u32 %15, 0\n\ts_cbranch_scc1 .Lma_%=\n\t" \
        PG8_MF_("%0", "%8", "%12", "0") PG8_MF_("%1", "%8", "%13", "0") PG8_MF_("%2", "%9", "%12", "0") PG8_MF_("%3", "%9", "%13", "0") \
        PG8_MF_("%4", "%10", "%12", "0") PG8_MF_("%5", "%10", "%13", "0") PG8_MF_("%6", "%11", "%12", "0") PG8_MF_("%7", "%11", "%13", "0") \
        "s_branch .Lmd_%=\n.Lma_%=:\n\t" \
        PG8_MF_("%0", "%8", "%12", "%0") PG8_MF_("%1", "%8", "%13", "%1") PG8_MF_("%2", "%9", "%12", "%2") PG8_MF_("%3", "%9", "%13", "%3") \
        PG8_MF_("%4", "%10", "%12", "%4") PG8_MF_("%5", "%10", "%13", "%5") PG8_MF_("%6", "%11", "%12", "%6") PG8_MF_("%7", "%11", "%13", "%7") \
        ".Lmd_%=:" \
        : "+v"(acc[ai][bj][0][0]), "+v"(acc[ai][bj][0][1]), "+v"(acc[ai][bj][1][0]), "+v"(acc[ai][bj][1][1]), "+v"(acc[ai][bj][2][0]), "+v"(acc[ai][bj][2][1]), "+v"(acc[ai][bj][3][0]), "+v"(acc[ai][bj][3][1]) \
        : "v"(At##8[0]), "v"(At##8[1]), "v"(At##8[2]), "v"(At##8[3]), "v"(Bt##8[0]), "v"(Bt##8[1]), "v"(mxone), "s"(first) : "scc"); __builtin_amdgcn_s_setprio(0); } else PG8_MMA(ai, bj, At, Bt); } while (0)
#define PG8_WAIT_V(n) asm volatile("s_waitcnt vmcnt(" #n ")" ::: "memory")
#define PG8_WAIT_L(n) asm volatile("s_waitcnt lgkmcnt(" #n ")" ::: "memory")
#define PG8_BAR __builtin_amdgcn_s_barrier()
#define PG8_SCHED __builtin_amdgcn_sched_barrier(0)
    Unit cur, nxt; int ui = 0;
    if (!S.next(0, cur)) return;
    constexpr bool C0 = FP8 && C0Of<Epi>::v; static_assert(!C0 || (SP2 && !Epi::CHAIN), "C0START: the SP2 loop starts the accumulators itself (no zeroing), no chaining");
    f32x4 acc[2][2][4][2];
    if constexpr (!C0) {
#pragma unroll
    for (int a = 0; a < 2; ++a)
#pragma unroll
        for (int b = 0; b < 2; ++b)
#pragma unroll
            for (int m = 0; m < 4; ++m)
#pragma unroll
                for (int n = 0; n < 2; ++n) acc[a][b][m][n] = (f32x4){0.f, 0.f, 0.f, 0.f}; }
    bf16x8 At[4][2], B0[2][2], B1[2][2];
    typedef int i32x8 __attribute__((ext_vector_type(8)));
    i32x8 At8[4], B08[2], B18[2];
    const int mxone = 0x7f7f7f7f;
    const char* cA = (const char*)((Epi::CHAIN && cur.sel) ? g.A2 : g.A) + (GATHER ? (size_t)0 : (size_t)cur.pm * tstep); PG8_GOFF(goffC, 0); const char* cB = (const char*)((Epi::CHAIN && cur.sel) ? g.Bt2 : g.Bt) + (size_t)cur.pb * tstep;
    S.a_ready(cur);
    if constexpr (SP2) {
        PG8_STAGE_B(PG8_SB(0, 0), cB, 0); PG8_STAGE_B(PG8_SB(0, 1), cB, 1); PG8_STAGE_A(PG8_SA(0, 0), cA, 0, false); PG8_STAGE_A(PG8_SA(0, 1), cA, 1, false);
        if (wr == 1) PG8_BAR;
        PG8_WAIT_V(2); PG8_BAR;
        PG8_STAGE_B(PG8_SB(1, 0), cB + kstep, 0); PG8_STAGE_A(PG8_SA(1, 0), cA + kstepA, 0, false); PG8_STAGE_B(PG8_SB(1, 1), cB + kstep, 1);
        PG8_WAIT_V(6); PG8_BAR;
    } else {
        PG8_STAGE_B(PG8_SB(0, 0), cB, 0); PG8_STAGE(PG8_SA(0, 0), cA, voffA); PG8_STAGE_B(PG8_SB(0, 1), cB, 1); PG8_STAGE(PG8_SA(0, 1), cA + hstep, voffA);
        if (wr == 1) PG8_BAR;
        PG8_WAIT_V(4); PG8_BAR;
        PG8_STAGE_B(PG8_SB(1, 0), cB + kstep, 0); PG8_STAGE(PG8_SA(1, 0), cA + kstepA, voffA); PG8_STAGE_B(PG8_SB(1, 1), cB + kstep, 1);
        PG8_WAIT_V(6); PG8_BAR;
    }
    for (;;) {
        const typename Epi::Pre pre = E.pre(cur, wr, wc, fr, fq);
        const bool has_next = S.next(ui + 1, nxt);
        if (has_next) PG8_GOFF(goffN, ui + 1); else { _Pragma("unroll") for (int h_ = 0; h_ < 2; ++h_) _Pragma("unroll") for (int i_ = 0; i_ < 2; ++i_) goffN[h_][i_] = goffC[h_][i_]; }
        const char* nA = (has_next && !GATHER) ? (const char*)((Epi::CHAIN && nxt.sel) ? g.A2 : g.A) + (size_t)nxt.pm * tstep : cA; const char* nB = has_next ? (const char*)((Epi::CHAIN && nxt.sel) ? g.Bt2 : g.Bt) + (size_t)nxt.pb * tstep : cB;
        for (int t = 0; t < nt; t += 2) {
            const bool last = (t == nt - 2); const int first = __builtin_amdgcn_readfirstlane(t == 0 ? 1 : 0);
            const char* a1 = cA + (size_t)(t + 1) * kstepA;
            const char* a2 = last ? nA : cA + (size_t)(t + 2) * kstepA; const char* b2 = last ? nB : cB + (size_t)(t + 2) * kstep;
            const char* a3 = a2 + kstepA; const char* b3 = b2 + kstep;
            if (last && has_next) S.a_ready(nxt);
            if constexpr (SP2) {
            PG8_LDB(B0, 0, 0); PG8_LDB(B1, 0, 1); PG8_SCHED; PG8_LDA(At, 0, 0); PG8_STAGE_A(PG8_SA(1, 1), a1, 1, false);
            PG8_WAIT_V(8); PG8_WAIT_L(0); PG8_BAR; PG8_MMA0(0, 0, At, B0, first); PG8_MMA0(0, 1, At, B1, first); PG8_BAR; PG8_SCHED;
            PG8_LDA(At, 0, 1); PG8_STAGE_B(PG8_SB(0, 0), b2, 0); PG8_STAGE_B(PG8_SB(0, 1), b2, 1); PG8_STAGE_A(PG8_SA(0, 0), a2, 0, last);
            PG8_WAIT_V(8); PG8_WAIT_L(0); PG8_BAR; PG8_MMA0(1, 0, At, B0, first); PG8_MMA0(1, 1, At, B1, first); PG8_BAR; PG8_SCHED;
            PG8_LDB(B0, 1, 0); PG8_LDB(B1, 1, 1); PG8_SCHED; PG8_LDA(At, 1, 0); PG8_STAGE_A(PG8_SA(0, 1), a2, 1, last);
            PG8_WAIT_V(8); PG8_WAIT_L(0); PG8_BAR; PG8_MMA(0, 0, At, B0); PG8_MMA(0, 1, At, B1); PG8_BAR; PG8_SCHED;
            PG8_LDA(At, 1, 1); PG8_STAGE_B(PG8_SB(1, 0), b3, 0); PG8_STAGE_B(PG8_SB(1, 1), b3, 1); PG8_STAGE_A(PG8_SA(1, 0), a3, 0, last);
            PG8_WAIT_V(8); PG8_WAIT_L(0); PG8_BAR; PG8_MMA(1, 0, At, B0); PG8_MMA(1, 1, At, B1); PG8_BAR; PG8_SCHED;
            } else {
            PG8_LDB(B0, 0, 0); PG8_SCHED; PG8_LDA(At, 0, 0); PG8_STAGE(PG8_SA(1, 1), a1 + hstep, voffA);
            PG8_WAIT_L(8); PG8_BAR; PG8_WAIT_L(0); PG8_MMA(0, 0, At, B0); PG8_BAR; PG8_SCHED;
            PG8_LDB(B1, 0, 1); PG8_STAGE_B(PG8_SB(0, 0), b2, 0);
            PG8_BAR; PG8_WAIT_L(0); PG8_MMA(0, 1, At, B1); PG8_BAR;
            PG8_LDA(At, 0, 1); PG8_STAGE(PG8_SA(0, 0), a2, voffA);
            PG8_BAR; PG8_WAIT_L(0); PG8_MMA(1, 0, At, B0); PG8_BAR; PG8_SCHED;
            PG8_STAGE_B(PG8_SB(0, 1), b2, 1);
            PG8_WAIT_V(6); PG8_BAR; PG8_MMA(1, 1, At, B1); PG8_BAR;
            PG8_LDB(B0, 1, 0); PG8_SCHED; PG8_LDA(At, 1, 0); PG8_STAGE(PG8_SA(0, 1), a2 + hstep, voffA);
            PG8_WAIT_L(8); PG8_BAR; PG8_WAIT_L(0); PG8_MMA(0, 0, At, B0); PG8_BAR; PG8_SCHED;
            PG8_LDB(B1, 1, 1); PG8_STAGE_B(PG8_SB(1, 0), b3, 0);
            PG8_BAR; PG8_WAIT_L(0); PG8_MMA(0, 1, At, B1); PG8_BAR;
            PG8_LDA(At, 1, 1); PG8_STAGE(PG8_SA(1, 0), a3, voffA);
            PG8_BAR; PG8_WAIT_L(0); PG8_MMA(1, 0, At, B0); PG8_BAR; PG8_SCHED;
            PG8_STAGE_B(PG8_SB(1, 1), b3, 1);
            PG8_WAIT_V(6); PG8_BAR; PG8_MMA(1, 1, At, B1); PG8_BAR;
            }
        }
        if constexpr (FP8) asm volatile("s_nop 15\n\ts_nop 15" ::: "memory");
        if constexpr (ALIGN_EPI) { if (wr == 0) PG8_BAR; }
        bool keep_acc = false;
        if constexpr (Epi::CHAIN) { if (cur.sel == 0) { E.mid(acc, cur, wr, wc, fr, fq); keep_acc = true; } else E(acc, cur, wr, wc, fr, fq, pre); S.done(cur); }
        else if constexpr (!Epi::AFTER_DRAIN) { E(acc, cur, wr, wc, fr, fq, pre); S.done(cur); }
        if (!has_next) break;
        if (!keep_acc && !C0) {
#pragma unroll
        for (int a = 0; a < 2; ++a)
#pragma unroll
            for (int b = 0; b < 2; ++b)
#pragma unroll
                for (int m = 0; m < 4; ++m)
#pragma unroll
                    for (int n = 0; n < 2; ++n) acc[a][b][m][n] = (f32x4){0.f, 0.f, 0.f, 0.f};
        }
        cur = nxt; cA = nA; cB = nB; ++ui;
#pragma unroll
        for (int h_ = 0; h_ < 2; ++h_)
#pragma unroll
            for (int i_ = 0; i_ < 2; ++i_) goffC[h_][i_] = goffN[h_][i_];
        if constexpr (ALIGN_EPI) { if (wr == 1) PG8_BAR; }
    }
    PG8_WAIT_V(0);
    if constexpr (!ALIGN_EPI) { if (wr == 0) PG8_BAR; }
    PG8_BAR;
    if constexpr (Epi::AFTER_DRAIN) { E.fused(acc, cur, wr, wc, fr, fq, lds, wid, lane); S.done(cur); }
#undef PG8_SA
#undef PG8_SB
#undef PG8_STAGE
#undef PG8_GOFF
#undef PG8_STAGE_A
#undef PG8_STAGE_B
#undef PG8_CAT2
#undef PG8_LDA
#undef PG8_LDB
#undef PG8_MMA
#undef PG8_MMA0
#undef PG8_MF_
#undef PG8_WAIT_V
#undef PG8_WAIT_L
#undef PG8_BAR
#undef PG8_SCHED
}
}
#include <hip/hip_bf16.h>
#include <cmath>
namespace attn_body {
using bf16=__hip_bfloat16;
using bf16x8=__attribute__((ext_vector_type(8)))short;
using s16x4=__attribute__((ext_vector_type(4)))short;
using f32x16=__attribute__((ext_vector_type(16)))float;
using u32x4=__attribute__((ext_vector_type(4)))unsigned;
constexpr int BATCH=4,NHEAD=8,NKVH=2,SEQ=8192,D=64,QP=NHEAD*D,KP=NKVH*D;
constexpr int NW=8,QBLK=32,QB=QBLK*NW,KVBLK=64,NQB=SEQ/QB;
constexpr int ATTN_UNIT_ROWS=QB;
__device__ __forceinline__ int crow(int r,int hi){return (r&3)+8*(r>>2)+4*hi;}
#define SBAR() __builtin_amdgcn_sched_barrier(0)
constexpr int NSLOT=3, SLOTB=8192;
constexpr int LDS_K=0, LDS_V=NSLOT*SLOTB, LDS_WS=2*NSLOT*SLOTB, LDS_OST=LDS_WS+NW*64*4, LDS_BYTES=LDS_OST+NW*4096;
constexpr float C2=0.125f*1.4426950408889634f;
__device__ __forceinline__ void glds16(const void*gsrc,unsigned lds_dst){unsigned keep;
  asm volatile("s_mov_b32 %0, m0\n\ts_mov_b32 m0, %2\n\ts_nop 0\n\tglobal_load_lds_dwordx4 %1, off\n\ts_mov_b32 m0, %0":"=&s"(keep):"v"(gsrc),"s"(lds_dst):"memory");}
__device__ __forceinline__ float max3f(float a,float b,float c){float r;asm("v_max3_f32 %0, %1, %2, %3":"=v"(r):"v"(a),"v"(b),"v"(c));return r;}
__device__ __forceinline__ float max2f(float a,float b){float r;asm("v_max_f32_e32 %0, %1, %2":"=v"(r):"v"(a),"v"(b));return r;}
__device__ __forceinline__ float fadd_s(float a,float b){float r;asm("v_add_f32_e32 %0, %1, %2":"=v"(r):"v"(a),"v"(b));return r;}
__device__ __forceinline__ float fsub_s(float a,float b){float r;asm("v_sub_f32_e32 %0, %1, %2":"=v"(r):"v"(a),"v"(b));return r;}
typedef float f32x2_t __attribute__((ext_vector_type(2))); typedef __bf16 bf16x2_t __attribute__((ext_vector_type(2)));
__device__ __forceinline__ unsigned cvtpk_s(float lo,float hi){f32x2_t v={lo,hi};bf16x2_t b=__builtin_convertvector(v,bf16x2_t);return __builtin_bit_cast(unsigned,b);}
#define WAIT_BAR(N) asm volatile("s_waitcnt vmcnt(" #N ") lgkmcnt(0)\n\ts_barrier":::"memory")

__device__ __forceinline__ void qkt(f32x16&p0,f32x16&p1,const char*Kslot,const bf16x8*qr,const f32x16&negm,int r32,int hi){
  const char*kb=Kslot+hi*1024+r32*16;
  #pragma unroll
  for(int d0=0;d0<4;++d0){
    const bf16x8 b0=*reinterpret_cast<const bf16x8*>(kb+d0*2048);
    const bf16x8 b1=*reinterpret_cast<const bf16x8*>(kb+d0*2048+512);
    if(d0==0){p0=__builtin_amdgcn_mfma_f32_32x32x16_bf16(b0,qr[0],negm,0,0,0);p1=__builtin_amdgcn_mfma_f32_32x32x16_bf16(b1,qr[0],negm,0,0,0);}
    else{p0=__builtin_amdgcn_mfma_f32_32x32x16_bf16(b0,qr[d0],p0,0,0,0);p1=__builtin_amdgcn_mfma_f32_32x32x16_bf16(b1,qr[d0],p1,0,0,0);}}
}
typedef __attribute__((address_space(3))) const char* lds_cptr;
typedef short v4i16_t __attribute__((ext_vector_type(4)));
__device__ __forceinline__ void kload8(bf16x8*kf,lds_cptr kp){
  kf[0]=*(const __attribute__((address_space(3))) bf16x8*)(kp);      kf[1]=*(const __attribute__((address_space(3))) bf16x8*)(kp+512);
  kf[2]=*(const __attribute__((address_space(3))) bf16x8*)(kp+2048); kf[3]=*(const __attribute__((address_space(3))) bf16x8*)(kp+2560);
  kf[4]=*(const __attribute__((address_space(3))) bf16x8*)(kp+4096); kf[5]=*(const __attribute__((address_space(3))) bf16x8*)(kp+4608);
  kf[6]=*(const __attribute__((address_space(3))) bf16x8*)(kp+6144); kf[7]=*(const __attribute__((address_space(3))) bf16x8*)(kp+6656);
}
__device__ __forceinline__ void kload2(bf16x8*kf,lds_cptr kp,int j){ kf[2*j]=*(const __attribute__((address_space(3))) bf16x8*)(kp+j*2048); kf[2*j+1]=*(const __attribute__((address_space(3))) bf16x8*)(kp+j*2048+512); }
__device__ __forceinline__ s16x4 vtr(lds_cptr p){ return __builtin_bit_cast(s16x4,__builtin_amdgcn_ds_read_tr16_b64_v4i16((__attribute__((address_space(3))) v4i16_t*)p)); }
__device__ __forceinline__ float rowmax(const f32x16&p0,const f32x16&p1){
  float a=max3f(p0[0],p0[1],p1[0]),b=max3f(p0[2],p0[3],p1[1]);a=max3f(a,p1[2],p1[3]);
  #pragma unroll
  for(int r=4;r<16;r+=4){a=max3f(a,p0[r],p0[r+1]);b=max3f(b,p0[r+2],p0[r+3]);a=max3f(a,p1[r],p1[r+1]);b=max3f(b,p1[r+2],p1[r+3]);}
  const float m=max2f(a,b);
  auto rr=__builtin_amdgcn_permlane32_swap(__float_as_uint(m),__float_as_uint(m),false,false);
  return max2f(__uint_as_float(rr[0]),__uint_as_float(rr[1]));
}
__device__ __forceinline__ void pv(f32x16*o,int vb,bf16x8 pa0,bf16x8 pa1,bf16x8 pa2,bf16x8 pa3){
  #pragma unroll
  for(int d0=0;d0<2;++d0){s16x4 lo[4],hi[4];
    #pragma unroll
    for(int ks=0;ks<4;++ks){
      asm volatile("ds_read_b64_tr_b16 %0,%1 offset:%c2":"=&v"(lo[ks]):"v"(vb),"i"(d0*4096+ks*1024):"memory");
      asm volatile("ds_read_b64_tr_b16 %0,%1 offset:%c2":"=&v"(hi[ks]):"v"(vb),"i"(d0*4096+ks*1024+512):"memory");}
    asm volatile("s_waitcnt lgkmcnt(0)":::"memory");SBAR();
    #define PK(k) (bf16x8){lo[k][0],lo[k][1],lo[k][2],lo[k][3],hi[k][0],hi[k][1],hi[k][2],hi[k][3]}
    o[d0]=__builtin_amdgcn_mfma_f32_32x32x16_bf16(pa0,PK(0),o[d0],0,0,0);
    o[d0]=__builtin_amdgcn_mfma_f32_32x32x16_bf16(pa1,PK(1),o[d0],0,0,0);
    o[d0]=__builtin_amdgcn_mfma_f32_32x32x16_bf16(pa2,PK(2),o[d0],0,0,0);
    o[d0]=__builtin_amdgcn_mfma_f32_32x32x16_bf16(pa3,PK(3),o[d0],0,0,0);
    #undef PK
  }
}

#ifndef ATTN_STORE16
#define ATTN_STORE16(p,v) (*(u32x4*)(p)=(v))
#endif
template<int THRL> __device__ __forceinline__ void attn_unit(int b,int h,int qb,const bf16*Q,const bf16*__restrict__ K,const bf16*__restrict__ V,bf16*O,char*shm,const float mref){
  const int tid=threadIdx.x,lane=tid&63,r32=lane&31,hi=lane>>5; const int wid=__builtin_amdgcn_readfirstlane(tid>>6);
  const long rowbase=(long)b*SEQ; const int q0=qb*QB;
  const bf16*Qw=Q+(rowbase+q0+wid*QBLK)*QP+h*D;
  const int hk=h/(NHEAD/NKVH); const bf16*Kh=K+rowbase*KP+hk*D,*Vh=V+rowbase*KP+hk*D;
  const unsigned lds0=(unsigned)(uintptr_t)shm;
  float*wsf=(float*)(shm+LDS_WS)+wid*64;
  const bf16*ksrc=Kh+(long)lane*KP+wid*8;
  const bf16*vsrc=Vh+(long)(16*(wid&3)+(lane>>2))*KP+(wid>>2)*32+(lane&3)*8;
  const unsigned kdst=lds0+LDS_K+wid*1024, vdst=lds0+LDS_V+wid*1024;
  #define DMA_K(t,slot) glds16(ksrc+(long)(t)*KVBLK*KP,(unsigned)__builtin_amdgcn_readfirstlane(kdst+(slot)))
  #define DMA_V(t,slot) glds16(vsrc+(long)(t)*KVBLK*KP,(unsigned)__builtin_amdgcn_readfirstlane(vdst+(slot)))
  const int vb0=(int)(lds0+LDS_V)+((lane>>4)&1)*32+(lane&3)*8+(4*hi+((lane&15)>>2))*64;
  const char*Kbase=shm+LDS_K; bf16x8 kf[8];
  const lds_cptr shm3=(lds_cptr)shm; const lds_cptr kp0=shm3+LDS_K+hi*1024+r32*16; const lds_cptr vp0=shm3+LDS_V+((lane>>4)&1)*32+(lane&3)*8+(4*hi+((lane&15)>>2))*64;
  constexpr int NT=SEQ/KVBLK;
  DMA_K(0,0);DMA_V(0,0);DMA_K(1,SLOTB);
  bf16x8 qr[4];
  #pragma unroll
  for(int d0=0;d0<4;++d0)qr[d0]=*reinterpret_cast<const bf16x8*>(&Qw[(long)r32*QP+d0*16+hi*8]);
  float mhat=0.f,l_reg=0.f;f32x16 o[2];o[0]=f32x16{};o[1]=f32x16{};f32x16 negm=f32x16{};asm volatile("":"+v"(negm));
    #define CMASK(P0,P1,t) do{}while(0)
  bool resc=false;
  #define START(P0,P1) do{ resc=false; \
    { const float dl=mref; mhat=fadd_s(mhat,dl); \
      _Pragma("unroll") for(int r=0;r<16;++r){P0[r]=fsub_s(P0[r],dl);P1[r]=fsub_s(P1[r],dl);} \
      _Pragma("unroll") for(int r=0;r<16;++r)negm[r]=-mhat; asm volatile("":"+v"(negm)); } \
    _Pragma("unroll") for(int r=0;r<16;++r)P0[r]=__builtin_amdgcn_exp2f(P0[r]); }while(0)
  #define RESC() do{ if(resc){ asm volatile("s_waitcnt lgkmcnt(0)":::"memory"); \
      _Pragma("unroll") for(int d_=0;d_<2;++d_) _Pragma("unroll") for(int r=0;r<16;++r)o[d_][r]*=wsf[crow(r,hi)]; } }while(0)
  f32x16 pA0,pA1,pB0,pB1;
  int sl_prev=0,sl_cur=0,sl_next=SLOTB;
  #define ROT() do{sl_prev=sl_cur;sl_cur=sl_next;sl_next=(sl_next==(NSLOT-1)*SLOTB)?0:sl_next+SLOTB;}while(0)
  DMA_K(2,2*SLOTB);
  WAIT_BAR(3);
  qkt(pA0,pA1,Kbase,qr,negm,r32,hi);asm volatile("s_nop 15\n\ts_nop 7":"+v"(pA0),"+v"(pA1));CMASK(pA0,pA1,0);
  START(pA0,pA1);
  _Pragma("unroll") for(int r=0;r<16;++r)pA1[r]=__builtin_amdgcn_exp2f(pA1[r]);
  WAIT_BAR(0);
  DMA_K(3,0);DMA_V(1,SLOTB);
  ROT();
  kload8(kf,kp0+sl_cur);
  WAIT_BAR(2);
  s16x4 vlo[8],vhi[8]; u32x4 pw0,pw1,pw2,pw3;
  #define PKW(P,B) cvtpk_s(P[B],P[B+1])
  #define PAF(k) __builtin_bit_cast(bf16x8,pw##k)
  #define VFR(i) (bf16x8){vlo[i][0],vlo[i][1],vlo[i][2],vlo[i][3],vhi[i][0],vhi[i][1],vhi[i][2],vhi[i][3]}
  #define PIN(x) asm volatile("":"+v"(x))
  #define MX3(a,b,c) __builtin_fmaxf(__builtin_fmaxf((a),(b)),(c))
  #define GAPA(MF,A0,A1,A2,A3,W0,W1,PW) do{ MF; sacc+=A0; sacc+=A1; sacc+=A2; sacc+=A3; PIN(sacc); W0; W1; PIN(PW); SBAR(); }while(0)
  #define EX(v) __builtin_amdgcn_exp2f(v)
  #define GAPB(MF,X,B) do{ MF; X[B]=EX(X[B]); X[B+1]=EX(X[B+1]); X[B+2]=EX(X[B+2]); X[B+3]=EX(X[B+3]); PIN(X); SBAR(); }while(0)
  #define VRD(i) do{ vlo[i]=vtr(vp_+(((i)>>2)*4096+((i)&3)*1024)); vhi[i]=vtr(vp_+(((i)>>2)*4096+((i)&3)*1024+512)); }while(0)
  #define KRD(G,j) do{ if(G){ kload2(kf,kp0+sl_next,j); SBAR(); } }while(0)
  #define STEP(C0,C1,P0,P1,t,GK,GV,GL) do{ SBAR(); \
    const lds_cptr vp_=vp0+sl_prev; \
    VRD(0); SBAR(); float sacc=(P0[0]+P0[1]); \
    GAPA(C0=__builtin_amdgcn_mfma_f32_32x32x16_bf16(kf[0],qr[0],negm,0,0,0), P0[2],P0[3],P0[4],P0[5],     pw0[0]=PKW(P0,0), pw0[1]=PKW(P0,2), pw0); \
    VRD(4); SBAR(); GAPA(C1=__builtin_amdgcn_mfma_f32_32x32x16_bf16(kf[1],qr[0],negm,0,0,0), P0[6],P0[7],P0[8],P0[9],     pw0[2]=PKW(P0,4), pw0[3]=PKW(P0,6), pw0); \
    VRD(1); SBAR(); GAPA(C0=__builtin_amdgcn_mfma_f32_32x32x16_bf16(kf[2],qr[1],C0,0,0,0),   P0[10],P0[11],P0[12],P0[13], pw1[0]=PKW(P0,8), pw1[1]=PKW(P0,10), pw1); \
    VRD(5); SBAR(); GAPA(C1=__builtin_amdgcn_mfma_f32_32x32x16_bf16(kf[3],qr[1],C1,0,0,0),   P0[14],P0[15],P1[0],P1[1],   pw1[2]=PKW(P0,12),pw1[3]=PKW(P0,14), pw1); \
    VRD(2); SBAR(); GAPA(C0=__builtin_amdgcn_mfma_f32_32x32x16_bf16(kf[4],qr[2],C0,0,0,0),   P1[2],P1[3],P1[4],P1[5],     pw2[0]=PKW(P1,0), pw2[1]=PKW(P1,2), pw2); \
    VRD(6); SBAR(); GAPA(C1=__builtin_amdgcn_mfma_f32_32x32x16_bf16(kf[5],qr[2],C1,0,0,0),   P1[6],P1[7],P1[8],P1[9],     pw2[2]=PKW(P1,4), pw2[3]=PKW(P1,6), pw2); \
    VRD(3); SBAR(); GAPA(C0=__builtin_amdgcn_mfma_f32_32x32x16_bf16(kf[6],qr[3],C0,0,0,0),   P1[10],P1[11],P1[12],P1[13], pw3[0]=PKW(P1,8), pw3[1]=PKW(P1,10), pw3); \
    VRD(7); SBAR(); GAPA(C1=__builtin_amdgcn_mfma_f32_32x32x16_bf16(kf[7],qr[3],C1,0,0,0),   P1[14],P1[15],0.f,0.f,       pw3[2]=PKW(P1,12),pw3[3]=PKW(P1,14), pw3); \
    l_reg+=sacc; \
    if(GK){DMA_K((t)+3,sl_cur);} if(GV){DMA_V((t)+1,sl_next);} \
    CMASK(C0,C1,t); \
    resc=false;   \
    SBAR(); \
    GAPB(o[0]=__builtin_amdgcn_mfma_f32_32x32x16_bf16(PAF(0),VFR(0),o[0],0,0,0), C0,0); \
    GAPB(o[1]=__builtin_amdgcn_mfma_f32_32x32x16_bf16(PAF(0),VFR(4),o[1],0,0,0), C0,4); \
    KRD(GL,0); GAPB(o[0]=__builtin_amdgcn_mfma_f32_32x32x16_bf16(PAF(1),VFR(1),o[0],0,0,0), C0,8); \
    KRD(GL,1); GAPB(o[1]=__builtin_amdgcn_mfma_f32_32x32x16_bf16(PAF(1),VFR(5),o[1],0,0,0), C0,12); \
    KRD(GL,2); GAPB(o[0]=__builtin_amdgcn_mfma_f32_32x32x16_bf16(PAF(2),VFR(2),o[0],0,0,0), C1,0); \
    KRD(GL,3); GAPB(o[1]=__builtin_amdgcn_mfma_f32_32x32x16_bf16(PAF(2),VFR(6),o[1],0,0,0), C1,4); \
    GAPB(o[0]=__builtin_amdgcn_mfma_f32_32x32x16_bf16(PAF(3),VFR(3),o[0],0,0,0), C1,8); \
    GAPB(o[1]=__builtin_amdgcn_mfma_f32_32x32x16_bf16(PAF(3),VFR(7),o[1],0,0,0), C1,12); \
    }while(0)
  int t=1;
  #undef CMASK
  #define CMASK(P0,P1,t) do{}while(0)
  for(;t+5<NT;t+=2){
    STEP(pB0,pB1,pA0,pA1,t,true,true,true);     WAIT_BAR(2); RESC(); ROT();
    STEP(pA0,pA1,pB0,pB1,t+1,true,true,true);   WAIT_BAR(2); RESC(); ROT();
  }
  #undef CMASK
  #define CMASK(P0,P1,t) do{}while(0)
  #define ENDW(tt) do{ if((tt)+3<NT){WAIT_BAR(2);} else if((tt)+2<NT){WAIT_BAR(1);} else {WAIT_BAR(0);} }while(0)
  for(;t+1<NT;t+=2){
    STEP(pB0,pB1,pA0,pA1,t,(t+3<NT),(t+1<NT),(t+1<NT));       ENDW(t);   RESC(); ROT();
    STEP(pA0,pA1,pB0,pB1,t+1,(t+4<NT),(t+2<NT),(t+2<NT));     ENDW(t+1); RESC(); ROT();
  }
  STEP(pB0,pB1,pA0,pA1,NT-1,false,false,false); RESC();
  { float sacc=pB0[0]+pB0[1]; _Pragma("unroll") for(int r=2;r<16;++r)sacc+=pB0[r]; _Pragma("unroll") for(int r=0;r<16;++r)sacc+=pB1[r]; l_reg+=sacc;
    pw0=(u32x4){PKW(pB0,0),PKW(pB0,2),PKW(pB0,4),PKW(pB0,6)};pw1=(u32x4){PKW(pB0,8),PKW(pB0,10),PKW(pB0,12),PKW(pB0,14)};pw2=(u32x4){PKW(pB1,0),PKW(pB1,2),PKW(pB1,4),PKW(pB1,6)};pw3=(u32x4){PKW(pB1,8),PKW(pB1,10),PKW(pB1,12),PKW(pB1,14)};
    SBAR(); pv(o,vb0+sl_cur,PAF(0),PAF(1),PAF(2),PAF(3)); }
  #undef PKW
  #undef PAF
  #undef VFR
  #undef PIN
  #undef MX3
  #undef GAPA
  #undef GAPB
  #undef EX
  #undef VRD
  #undef KRD
  #undef STEP
  #undef ENDW
  {auto rr=__builtin_amdgcn_permlane32_swap(__float_as_uint(l_reg),__float_as_uint(l_reg),false,false);l_reg=__uint_as_float(rr[0])+__uint_as_float(rr[1]);}
  if(hi==0)wsf[32+r32]=l_reg;asm volatile("s_waitcnt lgkmcnt(0)":::"memory");
  float rli[16];
  #pragma unroll
  for(int r=0;r<16;++r)rli[r]=__builtin_amdgcn_rcpf(wsf[32+crow(r,hi)]);
  bf16*Ow=O+(rowbase+q0+wid*QBLK)*QP+h*D;
  { bf16*stg=(bf16*)(shm+LDS_OST)+wid*2048;
    #pragma unroll
    for(int r=0;r<16;++r){const int orow=crow(r,hi);
      #pragma unroll
      for(int d0=0;d0<2;++d0)stg[orow*64+d0*32+r32]=__float2bfloat16(o[d0][r]*rli[r]);}
    asm volatile("s_waitcnt lgkmcnt(0)":::"memory");
    #pragma unroll
    for(int i=0;i<4;++i){const int row=i*8+(lane>>3),ch=lane&7; const u32x4 v=*(const u32x4*)(stg+row*64+ch*8); ATTN_STORE16(Ow+(long)row*QP+ch*8,v);} }
  asm volatile("s_waitcnt lgkmcnt(0)\n\ts_barrier":::"memory");
  #undef DMA_K
  #undef DMA_V
  #undef CMASK
  #undef START
  #undef RESC
  #undef ROT
}
constexpr int ATTN_LDS_BYTES=LDS_BYTES;
struct AttnTensors { const bf16* Q; const bf16* K; const bf16* V; bf16* O; float mref; };
struct AttnUnit { int bh; int qb; };
struct StaticOrder {
  int vcu,per;
  __device__ __forceinline__ explicit StaticOrder(int grid,int vcu_):vcu(vcu_),per((BATCH*NHEAD*NQB+grid-1)/grid){}
  __device__ __forceinline__ bool next(int i,AttnUnit&u)const{ if(i>=per)return false; const int U=vcu*per+i; if(U>=BATCH*NHEAD*NQB)return false; u.bh=U/NQB; u.qb=U%NQB; return true; }
  __device__ __forceinline__ void a_ready(const AttnUnit&)const{}
  __device__ __forceinline__ void done(const AttnUnit&)const{}
};
typedef int i32x8v __attribute__((ext_vector_type(8)));
typedef int i32x4v __attribute__((ext_vector_type(4)));
constexpr int S8=4096, NS8=8, L8_K=0, L8_V=NS8*S8, L8_WS=2*NS8*S8, L8_OST=L8_WS+NW*64*4, L8_BYTES=L8_OST+NW*4096;
__device__ __forceinline__ unsigned pknorm16(float a,float b){ typedef unsigned short u16x2 __attribute__((ext_vector_type(2))); const u16x2 r=__builtin_amdgcn_cvt_pknorm_u16(a,b); return (unsigned)r[0]|((unsigned)r[1]<<16); }
__device__ __forceinline__ int pk4_fp8_over(int w,float a,float b,float c,float d){w=__builtin_amdgcn_cvt_pk_fp8_f32(a,b,w,false);w=__builtin_amdgcn_cvt_pk_fp8_f32(c,d,w,true);return w;}
__device__ __forceinline__ unsigned pk4_fp8(float a,float b,float c,float d){int w=0;w=__builtin_amdgcn_cvt_pk_fp8_f32(a,b,w,false);w=__builtin_amdgcn_cvt_pk_fp8_f32(c,d,w,true);return (unsigned)w;}
#define MFMA8_NEW(D_,A_,B_,C_,SA_,SB_) asm volatile("v_mfma_scale_f32_32x32x64_f8f6f4 %0, %1, %2, %3, %4, %5 op_sel_hi:[0,0,0]":"=&v"(D_):"v"(A_),"v"(B_),"v"(C_),"v"(SA_),"v"(SB_))
#define MFMA8_ACC(D_,A_,B_,SA_,SB_) asm volatile("v_mfma_scale_f32_32x32x64_f8f6f4 %0, %1, %2, %0, %3, %4 op_sel_hi:[0,0,0]":"+v"(D_):"v"(A_),"v"(B_),"v"(SA_),"v"(SB_))
__device__ __forceinline__ void attn_unit8(int b,int h,int qb,const unsigned char*Q8,const unsigned char*K8,const unsigned char*VT8,bf16*O,char*shm,const float m0){
  int tid_=threadIdx.x; asm volatile("":"+v"(tid_));
  const int tid=tid_,lane=tid&63,r32=lane&31,hi=lane>>5; const int wid=__builtin_amdgcn_readfirstlane(tid>>6);
  const long rowbase=(long)b*SEQ; const int q0=qb*QB; const int hk=h/(NHEAD/NKVH);
  constexpr int NT=SEQ/KVBLK;
  const unsigned lds0=(unsigned)(uintptr_t)shm;

  const unsigned char*qp=Q8+(size_t)(rowbase+q0+wid*QBLK+r32)*QP+h*D+32*hi;
  const i32x4v qlo=*(const i32x4v*)qp, qhi=*(const i32x4v*)(qp+16);
  i32x8v qf=__builtin_shufflevector(qlo,qhi,0,1,2,3,4,5,6,7);
  asm volatile("":"+v"(qf));
  const int pc=wid&3, hip=pc>>1, ch=pc&1;
  const unsigned char*ksrc=K8+(size_t)(rowbase+lane)*KP+hk*D+32*hip+16*ch;
  const unsigned char*vsrc=VT8+((size_t)(b*NT)*NKVH+hk)*4096+(size_t)(hip*64+lane)*32+16*ch;
  const unsigned mydst=lds0+(wid<4?L8_K:L8_V)+pc*1024;
  #define DMA8(t,slot) do{ if(wid<4) glds16(ksrc+(size_t)(t)*KVBLK*KP,(unsigned)__builtin_amdgcn_readfirstlane(mydst+(slot)*S8)); \
                           else glds16(vsrc+(size_t)(t)*NKVH*4096,(unsigned)__builtin_amdgcn_readfirstlane(mydst+(slot)*S8)); }while(0)
  const lds_cptr shm3=(lds_cptr)shm;
  const lds_cptr kfp=shm3+L8_K+hi*2048+r32*16;
  const lds_cptr vfp=shm3+L8_V+hi*2048+r32*16;
  f32x16 negm;
  #pragma unroll
  for(int r=0;r<16;++r)negm[r]=(-8.0f*m0+56.16f)*(1.0f/256.0f);
  const int sV=0x7d7d7d7d, s1=0x7f7f7f7f, sK=0x77777777;
  i32x8v ones; { const int onev=(((lane>>4)&1)==((lane>>3)&1))?0x38383838:0;
  #pragma unroll
  for(int i=0;i<8;++i)ones[i]=onev; }
  asm volatile("":"+v"(ones));
  typedef float f32x4s __attribute__((ext_vector_type(4)));
  f32x4s lsum=f32x4s{}; f32x16 o[2]; o[0]=f32x16{}; o[1]=f32x16{};
  #define KFRAG(A0,A1,SLOT) do{ const lds_cptr kp_=kfp+(SLOT)*S8; \
      const i32x4v x0=*(const __attribute__((address_space(3))) i32x4v*)(kp_), x1=*(const __attribute__((address_space(3))) i32x4v*)(kp_+1024); A0=__builtin_shufflevector(x0,x1,0,1,2,3,4,5,6,7); \
      const i32x4v y0=*(const __attribute__((address_space(3))) i32x4v*)(kp_+512), y1=*(const __attribute__((address_space(3))) i32x4v*)(kp_+1536); A1=__builtin_shufflevector(y0,y1,0,1,2,3,4,5,6,7); }while(0)
  #define VFRAG(A0,A1,SLOT) do{ const lds_cptr vp_=vfp+(SLOT)*S8; \
      const i32x4v x0=*(const __attribute__((address_space(3))) i32x4v*)(vp_), x1=*(const __attribute__((address_space(3))) i32x4v*)(vp_+1024); A0=__builtin_shufflevector(x0,x1,0,1,2,3,4,5,6,7); \
      const i32x4v y0=*(const __attribute__((address_space(3))) i32x4v*)(vp_+512), y1=*(const __attribute__((address_space(3))) i32x4v*)(vp_+1536); A1=__builtin_shufflevector(y0,y1,0,1,2,3,4,5,6,7); }while(0)
  #define STEP8(TT,KS2,VS1,UA0,UA1,LA0,LA1,S0,S1,N0,N1,v0,v1,W0,W1) do{ \
    if((TT)+1<NT){ MFMA8_NEW(N0,UA0,qf,negm,sK,s1); MFMA8_NEW(N1,UA1,qf,negm,sK,s1); } \
    if((TT)+2<NT){ KFRAG(LA0,LA1,KS2); }                                                     \
    if((TT)+1<NT){ VFRAG(W0,W1,VS1); }                                                      \
      \
    _Pragma("unroll") for(int w=0;w<4;++w){ \
      const unsigned a0=pknorm16(S0[4*w],S0[4*w+1]), a1=pknorm16(S0[4*w+2],S0[4*w+3]), b0=pknorm16(S1[4*w],S1[4*w+1]), b1=pknorm16(S1[4*w+2],S1[4*w+3]); \
      P8[w]=(int)__builtin_amdgcn_perm(a1,a0,0x07050301u); P8[4+w]=(int)__builtin_amdgcn_perm(b1,b0,0x07050301u); } \
    asm volatile("s_nop 3":"+v"(P8)); \
    MFMA8_ACC(o[0],P8,v0,s1,sV); MFMA8_ACC(o[1],P8,v1,s1,sV); asm volatile("v_mfma_scale_f32_16x16x128_f8f6f4 %0, %1, %2, %0, %3, %3 op_sel_hi:[0,0,0]":"+v"(lsum):"v"(P8),"v"(ones),"v"(s1)); \
    if((TT)+1<NT){ asm volatile("":"+v"(N0),"+v"(N1)); } }while(0)
  if(wid<4){ DMA8(0,0); DMA8(1,1); DMA8(2,2); DMA8(3,3); DMA8(4,4); DMA8(5,5); DMA8(6,6); } else { DMA8(0,0); DMA8(1,1); DMA8(2,2); DMA8(3,3); DMA8(4,4); DMA8(5,5); }
  asm volatile("s_waitcnt vmcnt(5) lgkmcnt(0)\n\ts_barrier":::"memory");
  f32x16 S0,S1,T0,T1; i32x8v xa0,xa1,ya0,ya1; i32x8v P8={};
  { KFRAG(ya0,ya1,0); MFMA8_NEW(S0,ya0,qf,negm,sK,s1); MFMA8_NEW(S1,ya1,qf,negm,sK,s1); }
  KFRAG(xa0,xa1,1);
  i32x8v vx0,vx1,vy0,vy1; VFRAG(vx0,vx1,0);
  asm volatile("s_nop 15\n\ts_nop 15\n\ts_nop 15":"+v"(S0),"+v"(S1));
  const bool kw=wid<4;
  const unsigned char*dsrc=kw?(ksrc+(size_t)7*KVBLK*KP):(vsrc+(size_t)6*NKVH*4096);
  static_assert(KVBLK*KP==8192&&NKVH*4096==8192,"K and V streams advance by the same 8 KiB per tile");
  static_assert(NS8==8,"slot constants below are for 8-slot rings");
  #define DSLOT(a_,b_) (unsigned)__builtin_amdgcn_readfirstlane(mydst+(kw?(a_):(b_))*S8)
  const unsigned dA0=DSLOT(7,6), dA1=DSLOT(0,7);
  const unsigned dB0=DSLOT(1,0), dB1=DSLOT(2,1);
  const unsigned dC0=DSLOT(3,2), dC1=DSLOT(4,3);
  const unsigned dD0=DSLOT(5,4), dD1=DSLOT(6,5);
  #undef DSLOT
  #define PAIR8(TT,SL,D0,D1) do{ asm volatile("s_waitcnt vmcnt(3)\n\ts_barrier":::"memory"); \
    STEP8(TT,((SL)+2)%NS8,((SL)+1)%NS8,xa0,xa1,ya0,ya1,S0,S1,T0,T1,vx0,vx1,vy0,vy1); \
    glds16(dsrc,D0); glds16(dsrc+8192,D1); dsrc+=16384; \
    STEP8((TT)+1,((SL)+3)%NS8,((SL)+2)%NS8,ya0,ya1,xa0,xa1,T0,T1,S0,S1,vy0,vy1,vx0,vx1); }while(0)
  static_assert(NT==128,"the peeled tail below is written for 128 tiles");
  #pragma unroll 1
  for(int t=0;t<120;t+=8){ PAIR8(t,0,dA0,dA1); PAIR8(t+2,2,dB0,dB1); PAIR8(t+4,4,dC0,dC1); PAIR8(t+6,6,dD0,dD1); }
  #undef PAIR8
  #define PAIR8T(TT,SL,WAITS,ISSUE) do{ asm volatile(WAITS "\n\ts_barrier":::"memory"); \
    STEP8(TT,((SL)+2)%NS8,((SL)+1)%NS8,xa0,xa1,ya0,ya1,S0,S1,T0,T1,vx0,vx1,vy0,vy1); \
    ISSUE; \
    STEP8((TT)+1,((SL)+3)%NS8,((SL)+2)%NS8,ya0,ya1,xa0,xa1,T0,T1,S0,S1,vy0,vy1,vx0,vx1); }while(0)
  PAIR8T(120,0,"s_waitcnt vmcnt(3)",{ glds16(dsrc,dA0); if(!kw){ glds16(dsrc+8192,dA1); } });
  PAIR8T(122,2,"s_waitcnt vmcnt(2)",{});
  PAIR8T(124,4,"s_waitcnt vmcnt(0)",{});
  PAIR8T(126,6,"s_waitcnt vmcnt(0)",{});
  #undef PAIR8T
  #undef STEP8
  #undef KFRAG
  #undef VFRAG
  asm volatile("s_nop 15\n\ts_nop 15\n\ts_nop 15":"+v"(o[0]),"+v"(o[1]),"+v"(lsum));
  float*wsf=(float*)(shm+L8_WS)+wid*64;
  if((lane&7)==0){
    #pragma unroll
    for(int v=0;v<4;++v)wsf[32+4*(lane>>4)+v+((lane&8)?16:0)]=lsum[v]; }
  asm volatile("s_waitcnt lgkmcnt(0)":::"memory");
  float rli[16];
  #pragma unroll
  for(int r=0;r<16;++r)rli[r]=__builtin_amdgcn_rcpf(wsf[32+crow(r,hi)]);
  bf16*Ow=O+(rowbase+q0+wid*QBLK)*QP+h*D;
  { bf16*stg=(bf16*)(shm+L8_OST)+wid*2048;
    #pragma unroll
    for(int r=0;r<16;++r){const int orow=crow(r,hi);
      #pragma unroll
      for(int d0=0;d0<2;++d0)stg[orow*64+d0*32+r32]=__float2bfloat16(o[d0][r]*rli[r]);}
    asm volatile("s_waitcnt lgkmcnt(0)":::"memory");
    #pragma unroll
    for(int i=0;i<4;++i){const int row=i*8+(lane>>3),chn=lane&7; const u32x4 v=*(const u32x4*)(stg+row*64+chn*8); ATTN_STORE16(Ow+(long)row*QP+chn*8,v);} }
  asm volatile("s_waitcnt lgkmcnt(0)\n\ts_barrier":::"memory");
  #undef DMA8
}
struct AttnTensors8 { const unsigned char* Q8; const unsigned char* K8; const unsigned char* VT8; bf16* O; float m0; };
template<class Sched> __device__ __forceinline__ void attn_phase8(char*lds,const AttnTensors8&T,const Sched&S){
  AttnUnit u;
  for(int i=0;S.next(i,u);++i){ attn_unit8(u.bh/NHEAD,u.bh%NHEAD,u.qb,T.Q8,T.K8,T.VT8,T.O,lds,T.m0); }
}
#undef MFMA8_NEW
#undef MFMA8_ACC
template<class Sched,int THRL=8> __device__ __forceinline__ void attn_phase(char*lds,const AttnTensors&T,const Sched&S){
  AttnUnit u;
  for(int i=0;S.next(i,u);++i){ S.a_ready(u); attn_unit<THRL>(u.bh/NHEAD,u.bh%NHEAD,u.qb,T.Q,T.K,T.V,T.O,lds,T.mref); S.done(u); }
}
#undef SBAR
#undef WAIT_BAR
}
#define GAS __attribute__((address_space(1)))
#define LAS __attribute__((address_space(3)))
typedef unsigned short bf16;
typedef unsigned v4u __attribute__((ext_vector_type(4)));
typedef float f32x4 __attribute__((ext_vector_type(4)));
typedef short bf16x8 __attribute__((ext_vector_type(8)));
typedef GAS unsigned gu32;
typedef GAS unsigned long long gu64;
#define RLX_AGENT __ATOMIC_RELAXED, __HIP_MEMORY_SCOPE_AGENT
#define LDS_WAIT() asm volatile("s_waitcnt lgkmcnt(0)" ::: "memory")
#define VM_WAIT() asm volatile("s_waitcnt vmcnt(0)" ::: "memory")
__device__ __forceinline__ unsigned long long rt() { return __builtin_amdgcn_s_memrealtime(); }

#define XB_TMO      128
#define XB_XCNT(j)  (256  + 64 * (j))
#define XB_XSUB(j)  (1280 + 64 * (j))
#define XB_XGEN(j)  (2304 + 64 * (j))
#define XB_TOP      3328
#define XB_TOPGEN   3392
#define XCD_BAR_WORDS 3456
#define XB_SPIN_CAP (1u << 18)

__device__ __forceinline__ unsigned xb_ld(unsigned* p)              { return __hip_atomic_load(p, __ATOMIC_RELAXED, __HIP_MEMORY_SCOPE_AGENT); }
__device__ __forceinline__ unsigned xb_add(unsigned* p, unsigned v) { return __hip_atomic_fetch_add(p, v, __ATOMIC_RELAXED, __HIP_MEMORY_SCOPE_AGENT); }
__device__ __forceinline__ unsigned xb_xcc_id() { return (unsigned)__builtin_amdgcn_s_getreg((3 << 11) | 20) & 0xFu; }
#define XB_SPIN(cond, bar) do { unsigned _sp = 0; while (cond) { __builtin_amdgcn_s_sleep(1); \
    if ((++_sp & 255u) == 0u) { if (xb_ld(&(bar)[XB_TMO])) break; if (_sp > XB_SPIN_CAP) { atomicAdd(&(bar)[XB_TMO], 1u); break; } } } } while (0)

struct XcdBarrier {
    unsigned* bar; unsigned x;
    volatile LAS unsigned* st;
};

__device__ __forceinline__ XcdBarrier xcd_barrier_post(unsigned* bar, volatile LAS unsigned* st) {
    XcdBarrier b; b.bar = bar; b.x = xb_xcc_id(); b.st = st;
    if (threadIdx.x == 0) (void)xb_add(&bar[XB_XCNT(b.x)], 1u);
    return b;
}
__device__ __forceinline__ void xcd_barrier_complete(unsigned* bar, unsigned x, unsigned& nloc, unsigned& nx) {
    const unsigned G = gridDim.x * gridDim.y * gridDim.z;
    unsigned sum, cnt, mine, sp = 0u;
    for (;;) {
        sum = 0u; cnt = 0u; mine = 0u;
#pragma unroll
        for (unsigned j = 0; j < 16; ++j) { const unsigned c = xb_ld(&bar[XB_XCNT(j)]); sum += c; cnt += (c > 0u) ? 1u : 0u; mine = (j == x) ? c : mine; }
        if (sum == G) break;
        __builtin_amdgcn_s_sleep(1);
        if ((++sp & 255u) == 0u) { if (xb_ld(&bar[XB_TMO])) break; if (sp > XB_SPIN_CAP) { atomicAdd(&bar[XB_TMO], 1u); break; } }
    }
    nloc = mine > 0u ? mine : 1u; nx = cnt > 0u ? cnt : 1u;
}

__device__ __forceinline__ void xcd_barrier(const XcdBarrier& b) {
    asm volatile("s_waitcnt vmcnt(0)" ::: "memory");
    __syncthreads();
    if (threadIdx.x == 0) {
        unsigned* bar = b.bar;
        __builtin_amdgcn_s_waitcnt(0);
        unsigned nloc = b.st[0], nx = b.st[1];
        if (nloc == 0u) { xcd_barrier_complete(bar, b.x, nloc, nx); b.st[0] = nloc; b.st[1] = nx; }
        const unsigned old = xb_add(&bar[XB_XSUB(b.x)], 1u);
        const unsigned gen = old / nloc;
        if (old + 1u == (gen + 1u) * nloc) {
            __builtin_amdgcn_fence(__ATOMIC_RELEASE, "agent");
            asm volatile("s_waitcnt vmcnt(0)" ::: "memory");
            const unsigned og = xb_add(&bar[XB_TOP], 1u);
            const unsigned tg = og / nx;
            if (og + 1u == (tg + 1u) * nx) xb_add(&bar[XB_TOPGEN], 1u);
            else XB_SPIN(xb_ld(&bar[XB_TOPGEN]) == tg, bar);
            __builtin_amdgcn_fence(__ATOMIC_ACQUIRE, "agent");
            xb_add(&bar[XB_XGEN(b.x)], 1u);
            asm volatile("s_waitcnt vmcnt(0)" ::: "memory");
        } else {
            XB_SPIN(xb_ld(&bar[XB_XGEN(b.x)]) == gen, bar);
            __builtin_amdgcn_fence(__ATOMIC_ACQUIRE, "agent");
            asm volatile("s_waitcnt vmcnt(0)" ::: "memory");
        }
    }
    __syncthreads();
}
#define HD __device__ __forceinline__
#define FFT_ASM_CMUL 1
#define FFT_DEVICE 1
#define OPAQUE(x) asm volatile("" : "+v"(x))
typedef _Float16 hc __attribute__((ext_vector_type(2)));
typedef float cf __attribute__((ext_vector_type(2)));
HD int fft_pad(int i) { return i + ((i >> 6) << 2); }
constexpr int FFT_N = 16384;
constexpr int FFT_LDS_ELEMS = FFT_N + (FFT_N >> 6) * 4;
constexpr int TW_A = 0, TW_B = 16384, TW_C = 16384 + 1024, TW_ELEMS = 16384 + 1024 + 64;
#ifdef FFT_ASM_CMUL
HD hc hmul(hc a, hc b) { hc t, r;
    asm("v_pk_mul_f16 %0, %1, %2 op_sel:[0,0] op_sel_hi:[0,1]" : "=v"(t) : "v"(a), "v"(b));
    asm("v_pk_fma_f16 %0, %1, %2, %3 op_sel:[1,1,0] op_sel_hi:[1,0,1] neg_lo:[1,0,0] neg_hi:[0,0,0]" : "=v"(r) : "v"(a), "v"(b), "v"(t));
    return r; }
HD hc hmulc(hc a, hc b) { hc t, r;
    asm("v_pk_mul_f16 %0, %1, %2 op_sel:[0,0] op_sel_hi:[0,1] neg_lo:[0,0] neg_hi:[0,1]" : "=v"(t) : "v"(a), "v"(b));
    asm("v_pk_fma_f16 %0, %1, %2, %3 op_sel:[1,1,0] op_sel_hi:[1,0,1] neg_lo:[0,0,0] neg_hi:[0,0,0]" : "=v"(r) : "v"(a), "v"(b), "v"(t));
    return r; }
HD hc add_mi(hc a, hc b) { hc r; asm("v_pk_add_f16 %0, %1, %2 op_sel:[0,1] op_sel_hi:[1,0] neg_lo:[0,0] neg_hi:[0,1]" : "=v"(r) : "v"(a), "v"(b)); return r; }
HD hc sub_mi(hc a, hc b) { hc r; asm("v_pk_add_f16 %0, %1, %2 op_sel:[0,1] op_sel_hi:[1,0] neg_lo:[0,1] neg_hi:[0,0]" : "=v"(r) : "v"(a), "v"(b)); return r; }
#else
HD hc hmul(hc a, hc b) { const hc t = hc{(_Float16)(a.x * b.x), (_Float16)(a.x * b.y)}; return hc{(_Float16)(-a.y * b.y + t.x), (_Float16)(a.y * b.x + t.y)}; }
HD hc hmulc(hc a, hc b) { const hc t = hc{(_Float16)(a.x * b.x), (_Float16)(-(a.x * b.y))}; return hc{(_Float16)(a.y * b.y + t.x), (_Float16)(a.y * b.x + t.y)}; }
HD hc add_mi(hc a, hc b) { return hc{(_Float16)(a.x + b.y), (_Float16)(a.y - b.x)}; }
HD hc sub_mi(hc a, hc b) { return hc{(_Float16)(a.x - b.y), (_Float16)(a.y + b.x)}; }
#endif
typedef _Float16 hc2v __attribute__((ext_vector_type(4)));
#ifdef FFT_DEVICE
HD __attribute__((address_space(3))) hc2v* zb2(__attribute__((address_space(3))) hc* p) { return (__attribute__((address_space(3))) hc2v*)p; }
#else
inline hc2v* zb2(hc* p) { return (hc2v*)p; }
#endif
template <bool INV> HD void dft4(hc& a0, hc& a1, hc& a2, hc& a3) {
    const hc t0 = a0 + a2, t1 = a0 - a2, t2 = a1 + a3, t3 = a1 - a3;
    a0 = t0 + t2; a2 = t0 - t2;
    if (!INV) { a1 = add_mi(t1, t3); a3 = sub_mi(t1, t3); } else { a1 = sub_mi(t1, t3); a3 = add_mi(t1, t3); }
}
template <bool INV> HD void dft16(hc (&x)[16]) {
#pragma unroll
    for (int m0 = 0; m0 < 4; ++m0) dft4<INV>(x[m0], x[4 + m0], x[8 + m0], x[12 + m0]);
    const float C1 = 0.92387953251128674f, S1 = 0.38268343236508977f, R2 = 0.70710678118654752f;
#define TW(r, c, s) { const hc w = hc{(_Float16)(c), (_Float16)(-(s))}; x[r] = INV ? hmulc(x[r], w) : hmul(x[r], w); }
    TW(5, C1, S1) TW(6, R2, R2) TW(7, S1, C1) TW(9, R2, R2) TW(10, 0.f, 1.f) TW(11, -R2, R2) TW(13, S1, C1) TW(14, -R2, R2) TW(15, -C1, -S1)
#undef TW
#pragma unroll
    for (int q1 = 0; q1 < 4; ++q1) dft4<INV>(x[4 * q1], x[4 * q1 + 1], x[4 * q1 + 2], x[4 * q1 + 3]);
}
template <int ST, int TS, class Z, class TT> HD void r16_fwd2(Z zb, TT tw) {
    hc x0[16], x1[16];
#pragma unroll
    for (int m = 0; m < 16; ++m) { const hc2v v = *zb2(zb + ST * m); x0[m] = hc{v.x, v.y}; x1[m] = hc{v.z, v.w}; }
    dft16<false>(x0); dft16<false>(x1);
    const hc sc = hc{(_Float16)0.0625f, (_Float16)0.0625f};
#pragma unroll
    for (int r = 0; r < 16; ++r) { const int q = (r >> 2) + 4 * (r & 3); hc y0, y1;
        if (q == 0) { y0 = x0[r] * sc; y1 = x1[r] * sc; }
        else { const hc2v t = *zb2(tw + TS * q); y0 = hmul(x0[r], hc{t.x, t.y}); y1 = hmul(x1[r], hc{t.z, t.w}); }
        *zb2(zb + ST * q) = hc2v{y0.x, y0.y, y1.x, y1.y}; }
}
template <int ST, int TS, class Z, class TT> HD void r16_inv2(Z zb, TT tw) {
    hc x0[16], x1[16];
    const hc sc = hc{(_Float16)0.0625f, (_Float16)0.0625f};
#pragma unroll
    for (int q = 0; q < 16; ++q) { const hc2v v = *zb2(zb + ST * q); const hc v0 = hc{v.x, v.y}, v1 = hc{v.z, v.w};
        if (q == 0) { x0[q] = v0 * sc; x1[q] = v1 * sc; }
        else { const hc2v t = *zb2(tw + TS * q); x0[q] = hmulc(v0, hc{t.x, t.y}); x1[q] = hmulc(v1, hc{t.z, t.w}); } }
    dft16<true>(x0); dft16<true>(x1);
#pragma unroll
    for (int r = 0; r < 16; ++r) { const int m = (r >> 2) + 4 * (r & 3); *zb2(zb + ST * m) = hc2v{x0[r].x, x0[r].y, x1[r].x, x1[r].y}; }
}
template <class Z, class TT> HD void fft_pass_fwd(Z z, TT tw, int tid, int stage) {
    OPAQUE(tid);
    const int bid = 2 * tid;
    if (stage == 0) r16_fwd2<1088, 1024>(z + fft_pad(bid), tw + TW_A + bid);
    else if (stage == 1) r16_fwd2<68, 64>(z + fft_pad((bid >> 6) * 1024 + (bid & 63)), tw + TW_B + (bid & 63));
    else r16_fwd2<4, 4>(z + fft_pad((bid >> 2) * 64 + (bid & 3)), tw + TW_C + (bid & 3));
}
template <class Z, class TT> HD void fft_pass_inv(Z z, TT tw, int tid, int stage) {
    OPAQUE(tid);
    const int bid = 2 * tid;
    if (stage == 0) r16_inv2<1088, 1024>(z + fft_pad(bid), tw + TW_A + bid);
    else if (stage == 1) r16_inv2<68, 64>(z + fft_pad((bid >> 6) * 1024 + (bid & 63)), tw + TW_B + (bid & 63));
    else r16_inv2<4, 4>(z + fft_pad((bid >> 2) * 64 + (bid & 3)), tw + TW_C + (bid & 3));
}
template <class Z> HD void fft_pass_d_fwd(Z z, int tid) {
    OPAQUE(tid);
    const hc q4 = hc{(_Float16)0.25f, (_Float16)0.25f};
#pragma unroll 1
    for (int r = 0; r < 8; ++r) { const int pb = fft_pad(4 * (tid + 512 * r));
        hc a0 = z[pb], a1 = z[pb + 1], a2 = z[pb + 2], a3 = z[pb + 3]; dft4<false>(a0, a1, a2, a3); z[pb] = a0 * q4; z[pb + 1] = a1 * q4; z[pb + 2] = a2 * q4; z[pb + 3] = a3 * q4; }
}
struct KPre { hc k[8][4]; };
HD void fft_dkd_prefetch(KPre& kp, const hc* K, int tid) {
#pragma unroll
    for (int r = 0; r < 8; ++r) { const int b4 = 4 * (tid + 512 * r);
#pragma unroll
        for (int i = 0; i < 4; ++i) kp.k[r][i] = K[b4 + i]; }
}
template <class Z> HD void fft_pass_dkd(Z z, const KPre& kp, int tid) {
    OPAQUE(tid);
#pragma unroll
    for (int r = 0; r < 8; ++r) { const int b4 = 4 * (tid + 512 * r); const int pb = fft_pad(b4);
        hc a0 = z[pb], a1 = z[pb + 1], a2 = z[pb + 2], a3 = z[pb + 3]; dft4<false>(a0, a1, a2, a3);
        a0 = hmul(a0, kp.k[r][0]); a1 = hmul(a1, kp.k[r][1]); a2 = hmul(a2, kp.k[r][2]); a3 = hmul(a3, kp.k[r][3]);
        dft4<true>(a0, a1, a2, a3); z[pb] = a0; z[pb + 1] = a1; z[pb + 2] = a2; z[pb + 3] = a3; }
}
constexpr int NWAVES = 8;
#ifndef MK_N_LAUNCHES
#define MK_N_LAUNCHES 1
#endif
constexpr int N_PHASES = 11;
constexpr int N_LAUNCHES = MK_N_LAUNCHES;

constexpr int NB = 4, T = 8192, D = 1024, M = NB * T;
constexpr int HW = 512, AW = 512, KVW = 128;
constexpr int INC = 4352, NHY = 1536, NREST = INC - NHY;
constexpr int PR_Q = 0, PR_K = 512, PR_V = 640, PR_GH = 768, PR_GA = 1792;
constexpr int NE = 32, TOPK = 4, FF = 1024, RB_MAX = 544, P_MAX = RB_MAX * 256;
constexpr float EPS = 1e-6f;
constexpr int TPB = 128;

constexpr size_t MiB = 1u << 20;
constexpr size_t WS_CTL = 0, CTL_ZERO_BYTES = 1 * MiB;
constexpr size_t WS_WIN = 1 * MiB;
constexpr size_t WS_WHU = 10 * MiB, WS_WAU = 11 * MiB, WS_WOUT = 12 * MiB;
constexpr size_t WS_WRT = 14 * MiB;
constexpr size_t WS_TOKROWS = 14 * MiB + 512 * 1024;
constexpr size_t WS_ROWGATE = 15 * MiB;
constexpr size_t WS_ENT = 16 * MiB;
constexpr size_t WS_SRC = 18 * MiB;
constexpr size_t WS_W1 = 19 * MiB;
constexpr size_t WS_W2 = 147 * MiB;
constexpr size_t WS_XN = 211 * MiB;
constexpr size_t WS_EARLY = 275 * MiB;
constexpr size_t WS_ZT = WS_EARLY;
constexpr size_t WS_PR = WS_ZT + 96 * MiB;
constexpr size_t WS_QO = WS_PR + 176 * MiB;
constexpr size_t WS_KB = WS_QO + 32 * MiB, WS_VB = WS_KB + 8 * MiB;
constexpr size_t WS_HT = WS_VB + 8 * MiB;
constexpr size_t WS_KSP = WS_HT + 64 * MiB;
constexpr size_t WS_Y1S = WS_KSP + 64 * MiB;
constexpr size_t WS_YHT = WS_Y1S + 16 * MiB;
constexpr size_t WS_YH = WS_YHT + 32 * MiB;
constexpr size_t WS_MG = WS_YH + 32 * MiB;
constexpr size_t WS_EARLY_END = WS_MG + 64 * MiB;
constexpr size_t WS_AO = WS_EARLY_END;
constexpr size_t WS_HB = WS_AO + 32 * MiB;
static_assert(WS_HB + 64 * MiB <= 1024 * MiB, "d_ws map");
constexpr size_t WS_XG = WS_EARLY;
constexpr size_t WS_H1 = WS_XG + 272 * MiB;
constexpr size_t WS_END = 1024 * MiB;
static_assert(WS_EARLY_END <= WS_END && WS_H1 + 272 * MiB <= WS_END && WS_H1 >= WS_PR + 176 * MiB, "d_ws map");
constexpr int CW_CNT = 64;
constexpr int CW_BAR = 4096;

constexpr int RING_OFF = 0, RING_BYTES = 139520;
constexpr int FFT_TW_OFF = 69632;
constexpr int LX_MISC = RING_BYTES;
constexpr int LX_RBE = LX_MISC + 256;
constexpr int LX_CNT = LX_RBE + 2304;
constexpr int LX_ENT = LX_CNT + 512;
constexpr int LX_RED = LX_ENT + TPB * 4 * 16;
constexpr int LX_GIDX = LX_RED + 256;
constexpr int GIDX_UNITS = 17;
constexpr int LDS_BYTES = LX_GIDX + GIDX_UNITS * 512;
static_assert(LDS_BYTES <= 163840, "LDS map");

struct Frame {
    LAS unsigned char* lds;
    volatile LAS unsigned* MISC;
    gu32* ctl;
    int tid, lane, wave, vcu, G;
    unsigned char* ws;
    const float* in[26]; float* out;
};
__device__ __forceinline__ float wave_sum(float v) {
#pragma unroll
    for (int o = 1; o < 64; o <<= 1) v += __shfl_xor(v, o);
    return v;
}
__device__ __forceinline__ unsigned pk2(float lo, float hi) { return pg8::cvt_pk_bf16(lo, hi); }
__device__ __forceinline__ float bflo(unsigned w) { return __uint_as_float(w << 16); }
__device__ __forceinline__ float bfhi(unsigned w) { return __uint_as_float(w & 0xffff0000u); }
__device__ __forceinline__ float bf1(unsigned short h) { return __uint_as_float((unsigned)h << 16); }
__device__ __forceinline__ float sin_rev(float r) { return __builtin_amdgcn_sinf(r); }
__device__ __forceinline__ float cos_rev(float r) { return __builtin_amdgcn_cosf(r); }

struct P0Item { const float* W; bf16* WT; int K, N, item, mode; };
__device__ __forceinline__ void p0_item_load(const P0Item& it, f32x4 (&v)[8], int lane) {
    const int nblk = it.N / 32, kb = it.item / nblk, nb = it.item % nblk, k0 = 64 * kb, n0 = 32 * nb;
    const float* src = it.W + (size_t)(k0 + 8 * (lane >> 3)) * it.N + n0 + 4 * (lane & 7);
#pragma unroll
    for (int i = 0; i < 8; ++i) v[i] = *(const GAS f32x4*)(src + (size_t)i * it.N);
}
template <int NOST>
__device__ __forceinline__ void p0_item_store(const P0Item& it, const f32x4 (&v)[8], int lane) {
    const int nblk = it.N / 32, kb = it.item / nblk, nb = it.item % nblk, k0 = 64 * kb, n0 = 32 * nb;
#pragma unroll
    for (int nn = 0; nn < 4; ++nn) { const int n = n0 + 4 * (lane & 7) + nn;
        v4u o; o.x = pk2(v[0][nn], v[1][nn]); o.y = pk2(v[2][nn], v[3][nn]); o.z = pk2(v[4][nn], v[5][nn]); o.w = pk2(v[6][nn], v[7][nn]);
        int dr;
        if (it.mode == 0) dr = n;
        else { const int jj = n >> 1; dr = (jj >> 7) * 256 + (n & 1) * 128 + (jj & 127); }
        if (!NOST) *(GAS v4u*)(it.WT + (size_t)dr * it.K + k0 + 8 * (lane >> 3)) = o; else asm volatile("" :: "v"(o), "v"(dr)); }
}
__device__ __forceinline__ unsigned cvt4_fp8(float a, float b, float c, float d) { int w = 0; w = __builtin_amdgcn_cvt_pk_fp8_f32(a, b, w, false); w = __builtin_amdgcn_cvt_pk_fp8_f32(c, d, w, true); return (unsigned)w; }
constexpr float WSCALE = 32.0f, ASCALE = 8.0f, HSCALE = 4.0f, YSCALE = 16.0f;
__device__ __forceinline__ void p0_item8_load(const P0Item& it, f32x4 (&v)[16], int lane) {
    const int nblk = it.N / 32, kb = it.item / nblk, nb = it.item % nblk, k0 = 128 * kb, n0 = 32 * nb;
    const float* src = it.W + (size_t)(k0 + 16 * (lane >> 3)) * it.N + n0 + 4 * (lane & 7);
#pragma unroll
    for (int i = 0; i < 16; ++i) v[i] = *(const GAS f32x4*)(src + (size_t)i * it.N);
}
__device__ __forceinline__ void p0_item8_store(const P0Item& it, const f32x4 (&v)[16], int lane) {
    const int nblk = it.N / 32, kb = it.item / nblk, nb = it.item % nblk, k0 = 128 * kb, n0 = 32 * nb;
    unsigned char* WT8 = (unsigned char*)it.WT;
#pragma unroll
    for (int nn = 0; nn < 4; ++nn) { const int n = n0 + 4 * (lane & 7) + nn;
        v4u o;
#pragma unroll
        for (int w = 0; w < 4; ++w) o[w] = cvt4_fp8(v[4 * w][nn] * WSCALE, v[4 * w + 1][nn] * WSCALE, v[4 * w + 2][nn] * WSCALE, v[4 * w + 3][nn] * WSCALE);
        int dr;
        if (it.mode == 0) dr = n;
        else { const int jj = n >> 1; dr = (jj >> 7) * 256 + (n & 1) * 128 + (jj & 127); }
        *(GAS v4u*)(WT8 + (size_t)dr * it.K + k0 + 16 * (lane >> 3)) = o; }
}
template <int NR>
__device__ __forceinline__ void rms_rows_to_bf16(const float* x, const float* g, bf16* o, int m, int rs, int lane) {
    f32x4 v[NR][4];
#pragma unroll
    for (int r = 0; r < NR; ++r) { const GAS f32x4* xr = (const GAS f32x4*)(x + (size_t)(m + r * rs) * D) + lane;
#pragma unroll
        for (int j = 0; j < 4; ++j) v[r][j] = xr[64 * j]; }
    const GAS f32x4* gr = (const GAS f32x4*)g + lane; f32x4 gg[4];
#pragma unroll
    for (int j = 0; j < 4; ++j) gg[j] = gr[64 * j];
#pragma unroll
    for (int r = 0; r < NR; ++r) { float s = 0.f;
#pragma unroll
        for (int j = 0; j < 4; ++j) s += (v[r][j].x * v[r][j].x + v[r][j].y * v[r][j].y) + (v[r][j].z * v[r][j].z + v[r][j].w * v[r][j].w);
        const float rstd = 1.f / sqrtf(wave_sum(s) * (1.f / D) + EPS);
        GAS unsigned long long* o8 = (GAS unsigned long long*)(o + (size_t)(m + r * rs) * D) + lane;
#pragma unroll
        for (int j = 0; j < 4; ++j) o8[64 * j] = (unsigned long long)pk2(v[r][j].x * rstd * gg[j].x, v[r][j].y * rstd * gg[j].y) | ((unsigned long long)pk2(v[r][j].z * rstd * gg[j].z, v[r][j].w * rstd * gg[j].w) << 32); }
}
__device__ __forceinline__ void p0_filter_tile(Frame& F, int tile) {
    LAS float* feats = (LAS float*)(F.lds + RING_OFF);
    LAS float* h1 = feats + 32 * 36;
    LAS float* h2 = h1 + 32 * 64;
    LAS float* w1s = h2 + 32 * 64;
    LAS float* w2s = w1s + 33 * 64;
    const float *fw1 = F.in[5], *fb1 = F.in[6], *ff1 = F.in[7], *fw2 = F.in[8], *fb2 = F.in[9], *ff2 = F.in[10], *fw3 = F.in[11], *fb3 = F.in[12];
    float* HT = (float*)(F.ws + WS_HT);
    const int tid = F.tid;
    for (int i = tid; i < 33 * 64; i += NWAVES * 64) w1s[i] = fw1[i];
    for (int i = tid; i < 64 * 64; i += NWAVES * 64) w2s[i] = fw2[i];
    for (int i = tid; i < 32 * 33; i += NWAVES * 64) { const int r = i / 33, f = i % 33, t = tile * 32 + r; float val;
        if (f == 0) val = (float)t * (1.0f / 8191.0f);
        else { const int bi = (f - 1) & 15; const float fr = 1e-4f + (float)bi * ((15.0f - 1e-4f) / 15.0f); float rev = (float)t * fr * (1.0f / 8192.0f); rev -= floorf(rev);
               val = (f <= 16) ? cos_rev(rev) : -sin_rev(rev); }
        feats[r * 36 + f] = val; }
    __syncthreads();
#pragma unroll 1
    for (int k = 0; k < 4; ++k) { const int i = tid + 512 * k, r = i >> 6, n = i & 63; float a = fb1[n];
#pragma unroll 11
        for (int f = 0; f < 33; ++f) a += feats[r * 36 + f] * w1s[f * 64 + n];
        float rev = ff1[n] * a * 0.15915494309189535f; rev -= rintf(rev); h1[r * 64 + n] = sin_rev(rev); }
    __syncthreads();
#pragma unroll 1
    for (int k = 0; k < 4; ++k) { const int i = tid + 512 * k, r = i >> 6, n = i & 63; float a = fb2[n];
#pragma unroll 16
        for (int f = 0; f < 64; ++f) a += h1[r * 64 + f] * w2s[f * 64 + n];
        float rev = ff2[n] * a * 0.15915494309189535f; rev -= rintf(rev); h2[r * 64 + n] = sin_rev(rev); }
    __syncthreads();
    { typedef float f32x16 __attribute__((ext_vector_type(16)));
      const int lane = F.lane, r32 = lane & 31, hi = lane >> 5;
      float a[32];
#pragma unroll
      for (int s = 0; s < 32; ++s) a[s] = h2[r32 * 64 + 2 * s + hi];
#pragma unroll 1
      for (int i = 0; i < 8; ++i) { const int col = 32 * (F.wave + 8 * i) + r32; float bq[32];
#pragma unroll
          for (int s = 0; s < 32; ++s) bq[s] = fw3[(2 * s + hi) * 2048 + col];
          f32x16 acc = {};
#pragma unroll
          for (int s = 0; s < 32; ++s) acc = __builtin_amdgcn_mfma_f32_32x32x2f32(a[s], bq[s], acc, 0, 0, 0);
          const float bias = fb3[col]; const int c = col & 511;
          const float delta = 3.0701134573253945f + (float)c * ((15.350567286626973f - 3.0701134573253945f) / 511.0f);
          float* dst = HT + (size_t)col * T + tile * 32 + 4 * hi;
#pragma unroll
          for (int g = 0; g < 4; ++g) { f32x4 o;
#pragma unroll
              for (int q = 0; q < 4; ++q) { const float tl = (float)(tile * 32 + 8 * g + 4 * hi + q) * (1.0f / 8191.0f); o[q] = (acc[4 * g + q] + bias) * __expf(-tl * delta); }
              *(f32x4*)(dst + 8 * g) = o; } } }
    __syncthreads();
}
__device__ __forceinline__ P0Item p0_item(Frame& F, int r) {
    constexpr int I_IN = (D / 64) * (INC / 32), I_UP = (512 / 64) * (D / 32);
    if (r < I_IN) return P0Item{F.in[2], (bf16*)(F.ws + WS_WIN), D, INC, r, 0}; r -= I_IN;
    if (r < I_UP) return P0Item{F.in[16], (bf16*)(F.ws + WS_WHU), 512, D, r, 0}; r -= I_UP;
    if (r < I_UP) return P0Item{F.in[17], (bf16*)(F.ws + WS_WAU), 512, D, r, 0}; r -= I_UP;
    return P0Item{F.in[18], (bf16*)(F.ws + WS_WOUT), D, D, r, 0};
}
__device__ __forceinline__ P0Item p0_item8(Frame& F, int r) {
    constexpr int I_W1 = (D / 128) * (2 * FF / 32), I_W2 = (FF / 128) * (D / 32);
    if (r < NE * I_W1) { const int e = r / I_W1; return P0Item{F.in[22] + (size_t)e * D * 2 * FF, (bf16*)(F.ws + WS_W1 + (size_t)e * 2 * FF * D), D, 2 * FF, r % I_W1, 1}; } r -= NE * I_W1;
    { const int e = r / I_W2; return P0Item{F.in[24] + (size_t)e * FF * D, (bf16*)(F.ws + WS_W2 + (size_t)e * D * FF), FF, D, r % I_W2, 0}; }
}
#ifndef PROBE_SUB
#define PROBE_SUB 0
#endif
__device__ __forceinline__ void p0_xn(Frame& F) {
    const int gw = F.vcu * NWAVES + F.wave, NGW = F.G * NWAVES;
    bf16* XN = (bf16*)(F.ws + WS_XN);
    for (int m = gw; m < M; m += 4 * NGW) rms_rows_to_bf16<4>(F.in[0], F.in[1], XN, m, NGW, F.lane);
}
template <int NOST>
__device__ __forceinline__ void p0_transposes(Frame& F) {
    const int gw = F.vcu * NWAVES + F.wave, NGW = F.G * NWAVES;
    constexpr int NITEMS = (D / 64) * (INC / 32) + 2 * (512 / 64) * (D / 32) + (D / 64) * (D / 32);
    static_assert(NITEMS % 4 == 0, "items are taken four at a time");
    for (int it = 4 * gw; it < NITEMS; it += 4 * NGW) {
        const P0Item a = p0_item(F, it), b = p0_item(F, it + 1), c = p0_item(F, it + 2), d = p0_item(F, it + 3);
        f32x4 va[8], vb[8], vc[8], vd[8];
        p0_item_load(a, va, F.lane); p0_item_load(b, vb, F.lane); p0_item_load(c, vc, F.lane); p0_item_load(d, vd, F.lane);
        p0_item_store<NOST>(a, va, F.lane); p0_item_store<NOST>(b, vb, F.lane); p0_item_store<NOST>(c, vc, F.lane); p0_item_store<NOST>(d, vd, F.lane);
    }
    constexpr int NITEMS8 = NE * ((D / 128) * (2 * FF / 32) + (FF / 128) * (D / 32));
    static_assert(NITEMS8 % 2 == 0, "expert items are taken two at a time");
    for (int it = 2 * gw; it < NITEMS8; it += 2 * NGW) {
        const P0Item a = p0_item8(F, it), b = p0_item8(F, it + 1);
        f32x4 va[16], vb[16];
        p0_item8_load(a, va, F.lane); p0_item8_load(b, vb, F.lane);
        p0_item8_store(a, va, F.lane); p0_item8_store(b, vb, F.lane);
    }
}
__device__ __forceinline__ void p0_prologue(Frame& F) {
    p0_xn(F); if (PROBE_SUB & 1) p0_xn(F);
    for (int tile = F.vcu; tile < T / 32; tile += F.G) p0_filter_tile(F, tile);
    if (PROBE_SUB & 2) for (int tile = F.vcu; tile < T / 32; tile += F.G) p0_filter_tile(F, tile);
    p0_transposes<0>(F); if (PROBE_SUB & 4) p0_transposes<0>(F); if (PROBE_SUB & 512) p0_transposes<1>(F);
    float* wrt = (float*)(F.ws + WS_WRT);
    for (int i = F.vcu * NWAVES * 64 + F.tid; i < NE * D; i += F.G * NWAVES * 64) { const int e = i >> 10, d = i & 1023; wrt[i] = F.in[20][d * NE + e]; }
}

__device__ __forceinline__ void rope8f(const v4u raw, float rms, const float* g, int d0, int trow, int tcol, float scale, float (&o)[8]) {
    float x[8];
#pragma unroll
    for (int i = 0; i < 4; ++i) { x[2 * i] = bflo(raw[i]) * rms * g[d0 + 2 * i]; x[2 * i + 1] = bfhi(raw[i]) * rms * g[d0 + 2 * i + 1]; }
#pragma unroll
    for (int i = 0; i < 4; ++i) { const int pi = (d0 >> 1) + i;
        const float freq = __builtin_amdgcn_exp2f(-(float)(pi & 15) * (13.287712379549449f / 16.0f));
        float rev = (float)(pi < 16 ? trow : tcol) * freq * 0.15915494309189535f; rev -= floorf(rev);
        const float c = cos_rev(rev), sn = sin_rev(rev);
        o[2 * i] = (x[2 * i] * c - x[2 * i + 1] * sn) * scale; o[2 * i + 1] = (x[2 * i] * sn + x[2 * i + 1] * c) * scale; }
}
constexpr float QSCALE8 = 8.0f, VSCALE8 = 4.0f;
__device__ __forceinline__ void p2_qkprep(Frame& F) {
    const bf16* PR = (const bf16*)(F.ws + WS_PR); unsigned char* Q8 = (unsigned char*)(F.ws + WS_QO); unsigned char* K8 = (unsigned char*)(F.ws + WS_KB);
    const float* qg = F.in[14]; const float* kg = F.in[15];
    const int gw = F.vcu * NWAVES + F.wave, NGW = F.G * NWAVES, lane = F.lane;
    typedef unsigned u32x2v __attribute__((ext_vector_type(2)));
    for (int m = gw; m < M; m += NGW) {
        const int t = m & (T - 1), trow = t >> 6, tcol = t & 63;
        const bf16* pr = PR + (size_t)m * NREST;
        { const v4u raw = *(const GAS v4u*)(pr + PR_Q + 8 * lane); float ss = 0.f;
#pragma unroll
          for (int i = 0; i < 4; ++i) { const float a = bflo(raw[i]), b = bfhi(raw[i]); ss += a * a + b * b; }
          ss += __shfl_xor(ss, 1); ss += __shfl_xor(ss, 2); ss += __shfl_xor(ss, 4);
          const float rms = 1.f / sqrtf(ss * (1.f / 64.f) + EPS); float o[8];
          rope8f(raw, rms, qg, 8 * (lane & 7), trow, tcol, 0.125f * 1.4426950408889634f * QSCALE8, o);
          u32x2v w; w.x = cvt4_fp8(o[0], o[1], o[2], o[3]); w.y = cvt4_fp8(o[4], o[5], o[6], o[7]);
          *(GAS u32x2v*)(Q8 + (size_t)m * AW + 8 * lane) = w; }
    }
    for (int j = 0; gw + j * NGW < M; j += 4) {
        const int m = gw + (j + (lane >> 4)) * NGW; if (m >= M) continue;
        const int t = m & (T - 1), trow = t >> 6, tcol = t & 63, l2 = lane & 15;
        const v4u raw = *(const GAS v4u*)(PR + (size_t)m * NREST + PR_K + 8 * l2); float ss = 0.f;
#pragma unroll
        for (int i = 0; i < 4; ++i) { const float a = bflo(raw[i]), b = bfhi(raw[i]); ss += a * a + b * b; }
        ss += __shfl_xor(ss, 1); ss += __shfl_xor(ss, 2); ss += __shfl_xor(ss, 4);
        const float rms = 1.f / sqrtf(ss * (1.f / 64.f) + EPS); float o[8];
        rope8f(raw, rms, kg, 8 * (lane & 7), trow, tcol, 1.0f, o);
        u32x2v w; w.x = cvt4_fp8(o[0], o[1], o[2], o[3]); w.y = cvt4_fp8(o[4], o[5], o[6], o[7]);
        *(GAS u32x2v*)(K8 + (size_t)m * KVW + 8 * l2) = w;
    }
    unsigned char* VT8 = (unsigned char*)(F.ws + WS_VB);
    for (int it = gw; it < (M / 64) * 2; it += NGW) { const int tile = it >> 1, kvh = it & 1;
        const unsigned short* vp = (const unsigned short*)(PR + (size_t)tile * 64 * NREST + PR_V + kvh * 64 + lane);
        unsigned wv[2][8];
#pragma unroll
        for (int hh = 0; hh < 2; ++hh)
#pragma unroll
            for (int w = 0; w < 8; ++w) wv[hh][w] = 0u;
#pragma unroll
        for (int kp = 0; kp < 64; kp += 2) {
            const float a = __builtin_amdgcn_fmed3f(bf1(vp[(size_t)kp * NREST]) * VSCALE8, -448.f, 448.f), b = __builtin_amdgcn_fmed3f(bf1(vp[(size_t)(kp + 1) * NREST]) * VSCALE8, -448.f, 448.f);
            const int k5 = kp & 31, hh = (k5 >> 2) & 1, r = (k5 & 3) + 4 * (k5 >> 3), byte = r + 16 * (kp >> 5);
            if ((byte >> 1) & 1) wv[hh][byte >> 2] = (unsigned)__builtin_amdgcn_cvt_pk_fp8_f32(a, b, (int)wv[hh][byte >> 2], true); else wv[hh][byte >> 2] = (unsigned)__builtin_amdgcn_cvt_pk_fp8_f32(a, b, (int)wv[hh][byte >> 2], false); }
        unsigned char* dst = VT8 + (size_t)it * 4096 + lane * 32;
#pragma unroll
        for (int hh = 0; hh < 2; ++hh) { *(GAS v4u*)(dst + hh * 2048) = (v4u){wv[hh][0], wv[hh][1], wv[hh][2], wv[hh][3]}; *(GAS v4u*)(dst + hh * 2048 + 16) = (v4u){wv[hh][4], wv[hh][5], wv[hh][6], wv[hh][7]}; } }
}
typedef LAS hc* zptr;
#define FSYNC() __syncthreads()
#define LSYNC() asm volatile("s_waitcnt lgkmcnt(0)\n\ts_barrier" ::: "memory")
__device__ __forceinline__ float block_sum(Frame& F, float v) {
    LAS float* red = (LAS float*)(F.lds + LX_RED);
    v = wave_sum(v); if (F.lane == 0) red[F.wave] = v; __syncthreads();
    float s = 0.f;
#pragma unroll
    for (int w = 0; w < NWAVES; ++w) s += red[w];
    __syncthreads(); return s;
}
__device__ __forceinline__ hc f2h(float a, float b) { return __builtin_convertvector((cf){a, b}, hc); }
__device__ __forceinline__ void fft_tables(Frame& F) {
    zptr tw = (zptr)(F.lds + FFT_TW_OFF);
    for (int i = F.tid; i < TW_ELEMS; i += NWAVES * 64) { int jq, ls;
        if (i < TW_B) { jq = (i & 1023) * (i >> 10); ls = 16384; } else if (i < TW_C) { const int k = i - TW_B; jq = (k & 63) * (k >> 6); ls = 1024; } else { const int k = i - TW_C; jq = (k & 3) * (k >> 2); ls = 64; }
        const float rev = (float)(jq & (ls - 1)) / (float)ls;
        tw[i] = f2h(0.0625f * cos_rev(rev), -0.0625f * sin_rev(rev)); }
    __syncthreads();
}
struct Raw8 { v4u c; unsigned p, n; };
__device__ __forceinline__ Raw8 sc8_load(const bf16* row, int t0) { Raw8 r; r.c = *(const GAS v4u*)(row + t0); r.p = t0 > 0 ? (unsigned)row[t0 - 1] : 0u; r.n = t0 + 8 < T ? (unsigned)row[t0 + 8] : 0u; return r; }
__device__ __forceinline__ void sc8_eval(const Raw8& r, float w0, float w1, float w2, float b, float (&o)[8]) {
    float z[10]; z[0] = __uint_as_float(r.p << 16); z[9] = __uint_as_float(r.n << 16);
#pragma unroll
    for (int i = 0; i < 4; ++i) { z[1 + 2 * i] = bflo(r.c[i]); z[2 + 2 * i] = bfhi(r.c[i]); }
#pragma unroll
    for (int i = 0; i < 8; ++i) o[i] = b + w0 * z[i] + w1 * z[i + 1] + w2 * z[i + 2];
}
__device__ __forceinline__ void fft_fwd3(zptr Z, zptr tw, int tid) { fft_pass_fwd(Z, tw, tid, 0); LSYNC(); fft_pass_fwd(Z, tw, tid, 1); LSYNC(); fft_pass_fwd(Z, tw, tid, 2); LSYNC(); }
__device__ __forceinline__ void fft_inv3(zptr Z, zptr tw, int tid) { fft_pass_inv(Z, tw, tid, 2); LSYNC(); fft_pass_inv(Z, tw, tid, 1); LSYNC(); fft_pass_inv(Z, tw, tid, 0); LSYNC(); }
__device__ __forceinline__ void hyena_channel(Frame& F, int c) {
    zptr Z = (zptr)(F.lds + RING_OFF); zptr tw = (zptr)(F.lds + FFT_TW_OFF);
    const int tid = F.tid;
    hc* Ksp = (hc*)(F.ws + WS_KSP) + (size_t)blockIdx.x * 2 * FFT_N;
    const float* HT = (const float*)(F.ws + WS_HT);
    const bf16* ZT = (const bf16*)(F.ws + WS_ZT); bf16* YHT = (bf16*)(F.ws + WS_YHT);
    const float* cw = F.in[3]; const float* cb = F.in[4]; const float* hd = F.in[13];
    const hc hzero = f2h(0.f, 0.f);
    {
        const float* f0 = HT + (size_t)c * T; const float* b0 = HT + (size_t)(512 + c) * T; const float* f1 = HT + (size_t)(1024 + c) * T; const float* b1 = HT + (size_t)(1536 + c) * T;
        float as0 = 0.f, as1 = 0.f;
#pragma unroll
        for (int r = 0; r < 2; ++r) { int tl_ = tid; OPAQUE(tl_); const int t0 = 8 * (tl_ + 512 * r);
#pragma unroll
            for (int h = 0; h < 2; ++h) { const f32x4 fa = *(const GAS f32x4*)(f0 + t0 + 4 * h), ba = *(const GAS f32x4*)(b0 + t0 + 4 * h), fb = *(const GAS f32x4*)(f1 + t0 + 4 * h), bb = *(const GAS f32x4*)(b1 + t0 + 4 * h);
#pragma unroll
                for (int i = 0; i < 4; ++i) { const int t = t0 + 4 * h + i; Z[fft_pad(t)] = f2h(fa[i], fb[i]); as0 += fabsf(fa[i]); as1 += fabsf(fb[i]);
                    if (t >= 1) { Z[fft_pad(FFT_N - t)] = f2h(ba[i], bb[i]); as0 += fabsf(ba[i]); as1 += fabsf(bb[i]); } else Z[fft_pad(T)] = hzero; } } }
        const float S0 = block_sum(F, as0), S1 = block_sum(F, as1);
        fft_fwd3(Z, tw, tid); fft_pass_d_fwd(Z, tid); FSYNC();
        const float sc0 = 0.5f * 16384.0f * 1024.0f / S0, sc1 = 0.5f * 16384.0f * 1024.0f / S1;
#pragma unroll 2
        for (int r = 0; r < 8; ++r) { int tl_ = tid; OPAQUE(tl_); const int p0 = 4 * (tl_ + 512 * r); v4u w0, w1;
#pragma unroll
            for (int i = 0; i < 4; ++i) { const int p = p0 + i;
                const int k = (p >> 10) + 16 * ((p >> 6) & 15) + 256 * ((p >> 2) & 15) + 4096 * (p & 3), kn = (FFT_N - k) & (FFT_N - 1);
                const int pn = 1024 * (kn & 15) + 64 * ((kn >> 4) & 15) + 4 * ((kn >> 8) & 15) + (kn >> 12);
                const cf a = __builtin_convertvector(Z[fft_pad(p)], cf), b = __builtin_convertvector(Z[fft_pad(pn)], cf);
                w0[i] = __builtin_bit_cast(unsigned, f2h((a.x + b.x) * sc0, (a.y - b.y) * sc0));
                w1[i] = __builtin_bit_cast(unsigned, f2h((a.y + b.y) * sc1, (b.x - a.x) * sc1)); }
            *(GAS v4u*)(Ksp + p0) = w0; *(GAS v4u*)(Ksp + FFT_N + p0) = w1; }
        FSYNC();
    }
    const float wv0 = cw[c], wv1 = cw[NHY + c], wv2 = cw[2 * NHY + c], bv = cb[c];
    const float wa0 = cw[512 + c], wa1 = cw[NHY + 512 + c], wa2 = cw[2 * NHY + 512 + c], ba = cb[512 + c];
    const float wb0 = cw[1024 + c], wb1 = cw[NHY + 1024 + c], wb2 = cw[2 * NHY + 1024 + c], bb = cb[1024 + c];
    const float d0 = hd[c], d1 = hd[HW + c];
    const int tq0 = 8 * tid, tq1 = 8 * (tid + 512);
    Raw8 rv[2][2];
    { const bf16* v0 = ZT + (size_t)c * M; rv[0][0] = sc8_load(v0, tq0); rv[0][1] = sc8_load(v0, tq1); rv[1][0] = sc8_load(v0 + T, tq0); rv[1][1] = sc8_load(v0 + T, tq1); }
    for (int pair_ = 0; pair_ < ((PROBE_SUB & 32) ? 4 : 2); ++pair_) { const int pair = pair_ & 1;
        const bf16* a0 = ZT + (size_t)(512 + c) * M + (size_t)(2 * pair) * T;  const bf16* a1 = a0 + T;
        const bf16* b0 = ZT + (size_t)(1024 + c) * M + (size_t)(2 * pair) * T; const bf16* b1 = b0 + T;
        float x[2][2][8];
#pragma unroll
        for (int r = 0; r < 2; ++r) { const int t0 = r ? tq1 : tq0; sc8_eval(rv[0][r], wv0, wv1, wv2, bv, x[0][r]); sc8_eval(rv[1][r], wv0, wv1, wv2, bv, x[1][r]);
#pragma unroll
            for (int i = 0; i < 8; ++i) { Z[fft_pad(t0 + i)] = f2h(x[0][r][i], x[1][r][i]); Z[fft_pad(T + t0 + i)] = hzero; } }
        KPre kp; fft_dkd_prefetch(kp, (const hc*)Ksp, tid);
        Raw8 rg[2][2]; rg[0][0] = sc8_load(a0, tq0); rg[0][1] = sc8_load(a0, tq1); rg[1][0] = sc8_load(a1, tq0); rg[1][1] = sc8_load(a1, tq1);
        LSYNC();
        fft_fwd3(Z, tw, tid); fft_pass_dkd(Z, kp, tid); LSYNC();
        fft_dkd_prefetch(kp, (const hc*)(Ksp + FFT_N), tid);
        fft_inv3(Z, tw, tid);
        float y[2][2][8];
#pragma unroll
        for (int r = 0; r < 2; ++r) { const int t0 = r ? tq1 : tq0; float g0[8], g1[8]; sc8_eval(rg[0][r], wa0, wa1, wa2, ba, g0); sc8_eval(rg[1][r], wa0, wa1, wa2, ba, g1);
#pragma unroll
            for (int i = 0; i < 8; ++i) { const cf cv = __builtin_convertvector(Z[fft_pad(t0 + i)], cf); y[0][r][i] = g0[i] * (cv.x + x[0][r][i] * d0); y[1][r][i] = g1[i] * (cv.y + x[1][r][i] * d0);
                Z[fft_pad(t0 + i)] = f2h(y[0][r][i], y[1][r][i]); Z[fft_pad(T + t0 + i)] = hzero; } }
        rg[0][0] = sc8_load(b0, tq0); rg[0][1] = sc8_load(b0, tq1); rg[1][0] = sc8_load(b1, tq0); rg[1][1] = sc8_load(b1, tq1);
        { const bf16* v0 = ZT + (size_t)c * M + (size_t)(2 * ((pair + 1) & 1)) * T; rv[0][0] = sc8_load(v0, tq0); rv[0][1] = sc8_load(v0, tq1); rv[1][0] = sc8_load(v0 + T, tq0); rv[1][1] = sc8_load(v0 + T, tq1); }
        LSYNC();
        fft_fwd3(Z, tw, tid); fft_pass_dkd(Z, kp, tid); LSYNC(); fft_inv3(Z, tw, tid);
#pragma unroll
        for (int r = 0; r < 2; ++r) { const int t0 = r ? tq1 : tq0; float g0[8], g1[8]; sc8_eval(rg[0][r], wb0, wb1, wb2, bb, g0); sc8_eval(rg[1][r], wb0, wb1, wb2, bb, g1);
            float y0[8], y1[8];
#pragma unroll
            for (int i = 0; i < 8; ++i) { const cf cv = __builtin_convertvector(Z[fft_pad(t0 + i)], cf); y0[i] = g0[i] * (cv.x + y[0][r][i] * d1); y1[i] = g1[i] * (cv.y + y[1][r][i] * d1); }
            v4u w0, w1;
#pragma unroll
            for (int i = 0; i < 4; ++i) { w0[i] = pk2(y0[2 * i], y0[2 * i + 1]); w1[i] = pk2(y1[2 * i], y1[2 * i + 1]); }
            *(GAS v4u*)(YHT + (size_t)c * M + (size_t)(2 * pair) * T + t0) = w0; *(GAS v4u*)(YHT + (size_t)c * M + (size_t)(2 * pair + 1) * T + t0) = w1; }
        LSYNC();
    }
}
__device__ __forceinline__ void p3_transpose(Frame& F) {
    const unsigned short* YHT = (const unsigned short*)(F.ws + WS_YHT); unsigned short* YH = (unsigned short*)(F.ws + WS_YH);
    const int gw = F.vcu * NWAVES + F.wave, NGW = F.G * NWAVES, lane = F.lane, cb8 = lane >> 3, mb8 = lane & 7;
    for (int it = gw; it < (HW / 64) * (M / 64); it += NGW) { const int cb = it & 7, mb = it >> 3, c0 = cb * 64 + 8 * cb8, m0 = mb * 64 + 8 * mb8;
        const unsigned short* src = YHT + (size_t)c0 * M + m0;
        v4u R[8];
#pragma unroll
        for (int r = 0; r < 8; ++r) R[r] = *(const GAS v4u*)(src + (size_t)r * M);
#pragma unroll
        for (int j = 0; j < 8; ++j) { v4u o;
#pragma unroll
            for (int w = 0; w < 4; ++w) o[w] = __builtin_amdgcn_perm(R[2 * w + 1][j >> 1], R[2 * w][j >> 1], (j & 1) ? 0x07060302u : 0x05040100u);
            *(GAS v4u*)(YH + (size_t)(m0 + j) * HW + c0) = o; } }
}
typedef int RouteEnt __attribute__((ext_vector_type(4)));
__device__ __forceinline__ void top4_insert(float (&tv)[4], int (&te)[4], float v, int e) {
    if (v > tv[3]) { tv[3] = v; te[3] = e;
        if (tv[3] > tv[2]) { const float a = tv[2]; const int b = te[2]; tv[2] = tv[3]; te[2] = te[3]; tv[3] = a; te[3] = b;
            if (tv[2] > tv[1]) { const float a2 = tv[1]; const int b2 = te[1]; tv[1] = tv[2]; te[1] = te[2]; tv[2] = a2; te[2] = b2;
                if (tv[1] > tv[0]) { const float a3 = tv[0]; const int b3 = te[0]; tv[0] = tv[1]; te[0] = te[1]; tv[1] = a3; te[1] = b3; } } } }
}
__device__ __forceinline__ bool top4_before(float va, int ea, float vb, int eb) { return va > vb || (va == vb && ea < eb); }
template <int DRY>
__device__ __forceinline__ void p6_route(Frame& F) {
    typedef float f32x16 __attribute__((ext_vector_type(16)));
    constexpr int WP = 1028;
    LAS float* W = (LAS float*)(F.lds + RING_OFF);
    LAS float* rstab = (LAS float*)(F.lds + RING_OFF + 32 * WP * 4);
    LAS int* lcnt = (LAS int*)(F.lds + LX_CNT); LAS int* lbase = lcnt + 32;
    LAS RouteEnt* ent = (LAS RouteEnt*)(F.lds + LX_ENT);
    const float* wrt = (const float*)(F.ws + WS_WRT); const float* g2 = F.in[19]; const float* rb = F.in[21];
    const bf16* h = (const bf16*)(F.ws + WS_HB); bf16* HN = (bf16*)(F.ws + WS_XN);
    const int tid = F.tid, lane = F.lane;
    for (int i = tid; i < NE * D / 4; i += NWAVES * 64) { const int e = i >> 8, k4 = (i & 255) * 4; const f32x4 w = ((const GAS f32x4*)wrt)[i], g = *(const GAS f32x4*)(g2 + k4); *(LAS f32x4*)(W + e * WP + k4) = w * g; }
    if (tid < 32) lcnt[tid] = 0;
    __syncthreads();
    const int m0 = blockIdx.x * TPB;
    f32x16 acc = {};
    if (F.wave >= 4) {
        f32x4 gg[4];
#pragma unroll
        for (int j = 0; j < 4; ++j) gg[j] = ((const GAS f32x4*)g2)[lane + 64 * j];
        unsigned long long nx[4];
        { const GAS unsigned long long* xr = (const GAS unsigned long long*)(h + (size_t)(m0 + F.wave - 4) * D) + lane;
#pragma unroll
          for (int j = 0; j < 4; ++j) nx[j] = xr[64 * j]; }
        for (int lt = F.wave - 4; lt < TPB; lt += 4) { const int m = m0 + lt;
            f32x4 v[4]; float ss = 0.f;
#pragma unroll
            for (int j = 0; j < 4; ++j) { const unsigned lo = (unsigned)nx[j], hi = (unsigned)(nx[j] >> 32); v[j] = (f32x4){bflo(lo), bfhi(lo), bflo(hi), bfhi(hi)}; ss += (v[j].x * v[j].x + v[j].y * v[j].y) + (v[j].z * v[j].z + v[j].w * v[j].w); }
            if (lt + 4 < TPB) { const GAS unsigned long long* xr = (const GAS unsigned long long*)(h + (size_t)(m + 4) * D) + lane;
#pragma unroll
                for (int j = 0; j < 4; ++j) nx[j] = xr[64 * j]; }
            const float rstd = 1.f / sqrtf(wave_sum(ss) * (1.f / D) + EPS);
            if (lane == 0) rstab[lt] = rstd;
            GAS unsigned* o4 = (GAS unsigned*)((unsigned char*)HN + (size_t)m * D) + lane;
#pragma unroll
            for (int j = 0; j < 4; ++j) { v[j] = v[j] * (rstd * ASCALE) * gg[j]; o4[64 * j] = cvt4_fp8(fminf(fmaxf(v[j].x, -448.f), 448.f), fminf(fmaxf(v[j].y, -448.f), 448.f), fminf(fmaxf(v[j].z, -448.f), 448.f), fminf(fmaxf(v[j].w, -448.f), 448.f)); } }
    } else {
        const int tok = lane & 31, kh = lane >> 5;
        const GAS v4u* hp = (const GAS v4u*)(h + (size_t)(m0 + 32 * F.wave + tok) * D + 8 * kh);
        const LAS float* wp = W + tok * WP + 8 * kh;
        v4u hb[2]; hb[0] = hp[0]; hb[1] = hp[2];
#pragma unroll 2
        for (int S = 0; S < 64; ++S) { const v4u raw = hb[S & 1]; if (S + 2 < 64) hb[S & 1] = hp[2 * (S + 2)];
            const f32x4 w0 = *(const LAS f32x4*)(wp + 16 * S), w1 = *(const LAS f32x4*)(wp + 16 * S + 4);
            const float b[8] = {bflo(raw.x), bfhi(raw.x), bflo(raw.y), bfhi(raw.y), bflo(raw.z), bfhi(raw.z), bflo(raw.w), bfhi(raw.w)};
            const float a[8] = {w0.x, w0.y, w0.z, w0.w, w1.x, w1.y, w1.z, w1.w};
#pragma unroll
            for (int i = 0; i < 8; ++i) acc = __builtin_amdgcn_mfma_f32_32x32x2f32(a[i], b[i], acc, 0, 0, 0); }
    }
    __syncthreads();
    if (F.wave < 4) {
        const int tok = lane & 31, hh = lane >> 5, lt = 32 * F.wave + tok;
        const float rstd = rstab[lt];
        float tv[4] = {-INFINITY, -INFINITY, -INFINITY, -INFINITY}; int te[4] = {0, 0, 0, 0};
#pragma unroll
        for (int i = 0; i < 16; ++i) { const int e = (i & 3) + 8 * (i >> 2) + 4 * hh; top4_insert(tv, te, acc[i] * rstd + rb[e], e); }
        float pv[4]; int pe[4];
#pragma unroll
        for (int k = 0; k < 4; ++k) { pv[k] = __shfl_xor(tv[k], 32); pe[k] = __shfl_xor(te[k], 32); }
        float mv[4]; int me[4]; int ia = 0, ib = 0;
#pragma unroll
        for (int k = 0; k < 4; ++k) {
            const float va = ia == 0 ? tv[0] : ia == 1 ? tv[1] : ia == 2 ? tv[2] : tv[3]; const int ea = ia == 0 ? te[0] : ia == 1 ? te[1] : ia == 2 ? te[2] : te[3];
            const float vb = ib == 0 ? pv[0] : ib == 1 ? pv[1] : ib == 2 ? pv[2] : pv[3]; const int eb = ib == 0 ? pe[0] : ib == 1 ? pe[1] : ib == 2 ? pe[2] : pe[3];
            const bool ta = top4_before(va, ea, vb, eb); mv[k] = ta ? va : vb; me[k] = ta ? ea : eb; ia += ta ? 1 : 0; ib += ta ? 0 : 1; }
        const float e1 = __expf(mv[1] - mv[0]), e2 = __expf(mv[2] - mv[0]), e3 = __expf(mv[3] - mv[0]); const float inv = 1.0f / (1.0f + e1 + e2 + e3);
        if (hh == 0) { const float gt[4] = {inv, e1 * inv, e2 * inv, e3 * inv};
#pragma unroll
            for (int k = 0; k < 4; ++k) { const int lp = atomicAdd((int*)(lcnt + me[k]), 1); ent[lt * 4 + k] = (RouteEnt){me[k], lp, (int)__float_as_uint(gt[k]), 0}; } }
    }
    __syncthreads();
    if (DRY) return;
    if (tid < 32) lbase[tid] = (int)__hip_atomic_fetch_add(F.ctl + CW_CNT + tid, (unsigned)lcnt[tid], __ATOMIC_RELAXED, __HIP_MEMORY_SCOPE_AGENT);
    __syncthreads();
    { RouteEnt en = ent[tid]; en.y += lbase[en.x]; ((GAS RouteEnt*)(F.ws + WS_ENT))[(size_t)m0 * 4 + tid] = en; }
}
__device__ __forceinline__ void build_layout(Frame& F) {
    LAS int* pstart = (LAS int*)(F.lds + LX_CNT) + 64; LAS int* rbe = (LAS int*)(F.lds + LX_RBE); LAS int* gcnt = (LAS int*)(F.lds + LX_RED);
    __syncthreads();
    if (F.tid < 32) gcnt[F.tid] = (int)__hip_atomic_load(F.ctl + CW_CNT + F.tid, __ATOMIC_RELAXED, __HIP_MEMORY_SCOPE_AGENT);
    __syncthreads();
    if (F.tid == 0) { int rb = 0;
        for (int e = 0; e < NE; ++e) { pstart[e] = rb * 256; const int nb = (gcnt[e] + 255) >> 8; for (int b = 0; b < nb && rb < RB_MAX; ++b) rbe[rb++] = e; }
        pstart[NE] = rb * 256; F.MISC[16] = (unsigned)rb; }
    __syncthreads();
}
__device__ __forceinline__ void p7_layout(Frame& F) {
    build_layout(F);
    LAS int* pstart = (LAS int*)(F.lds + LX_CNT) + 64; LAS int* gcnt = (LAS int*)(F.lds + LX_RED);
    int* tokrows = (int*)(F.ws + WS_TOKROWS); float* rowgate = (float*)(F.ws + WS_ROWGATE); int* srctok = (int*)(F.ws + WS_SRC);
    const int m0 = blockIdx.x * TPB;
    { const int m = m0 + (F.tid >> 2), k = F.tid & 3;
      const RouteEnt en = ((const GAS RouteEnt*)(F.ws + WS_ENT))[(size_t)m * 4 + k]; const int row = pstart[en.x] + en.y;
      tokrows[m * 4 + k] = row; rowgate[row] = __uint_as_float((unsigned)en.z); srctok[row] = m; }
    if (blockIdx.x < NE) { const int e = blockIdx.x, r0 = pstart[e] + gcnt[e], r1 = pstart[e + 1];
        for (int row = r0 + F.tid; row < r1; row += NWAVES * 64) { srctok[row] = 0; rowgate[row] = 0.f; } }
}
__device__ __forceinline__ void p10_combine(Frame& F) {
    const unsigned char* Y2 = (const unsigned char*)(F.ws + WS_XG); const bf16* HB = (const bf16*)(F.ws + WS_HB); const int* tokrows = (const int*)(F.ws + WS_TOKROWS); float* out = F.out;
    const int gw = F.vcu * NWAVES + F.wave, NGW = F.G * NWAVES, lane = F.lane;
    typedef float f32x2v __attribute__((ext_vector_type(2))); typedef unsigned u32x2c __attribute__((ext_vector_type(2)));
#pragma unroll 1
    for (int mm = gw; mm < M; mm += 2 * NGW) {
        int rr[2][4];
#pragma unroll
        for (int u = 0; u < 2; ++u) { const RouteEnt t4 = *(const GAS RouteEnt*)(tokrows + (size_t)(mm + u * NGW) * 4); rr[u][0] = t4.x; rr[u][1] = t4.y; rr[u][2] = t4.z; rr[u][3] = t4.w; }
        u32x2c hb[2][4]; unsigned yw[2][4][4];
#pragma unroll
        for (int u = 0; u < 2; ++u) { const int m = mm + u * NGW;
#pragma unroll
            for (int i = 0; i < 4; ++i) { const int col = 256 * i + 4 * lane; hb[u][i] = *(const GAS u32x2c*)(HB + (size_t)m * D + col);
#pragma unroll
                for (int k = 0; k < 4; ++k) yw[u][k][i] = *(const GAS unsigned*)(Y2 + (size_t)rr[u][k] * D + col); } }
#pragma unroll
        for (int u = 0; u < 2; ++u) { const int m = mm + u * NGW;
#pragma unroll
            for (int i = 0; i < 4; ++i) { f32x2v s0 = {0.f, 0.f}, s1 = {0.f, 0.f};
#pragma unroll
                for (int k = 0; k < 4; ++k) { s0 += __builtin_amdgcn_cvt_pk_f32_fp8((int)yw[u][k][i], false); s1 += __builtin_amdgcn_cvt_pk_f32_fp8((int)yw[u][k][i], true); }
                f32x4 o; o[0] = bflo(hb[u][i][0]) + s0.x * (1.0f / YSCALE); o[1] = bfhi(hb[u][i][0]) + s0.y * (1.0f / YSCALE); o[2] = bflo(hb[u][i][1]) + s1.x * (1.0f / YSCALE); o[3] = bfhi(hb[u][i][1]) + s1.y * (1.0f / YSCALE);
                *(GAS f32x4*)(out + (size_t)m * D + 256 * i + 4 * lane) = o; } } }
}
template <int NOSTORE = 0> __device__ __forceinline__ void ph1(Frame& F) {
    bf16* const XN = (bf16*)(F.ws + WS_XN);
    { pg8::Gemm g{(const bf16*)(F.ws + WS_WIN), XN, NHY, M, D}; pg8::StaticOrder S; S.init(NHY, M, F.G, (int)blockIdx.x);
      pg8::EpiBf16Plain E{(bf16*)(F.ws + WS_ZT), M};
      pg8::gemm_phase<pg8::EpiBf16Plain, pg8::StaticOrder, true, true>(F.lds + RING_OFF, g, S, E); }
    { pg8::Gemm g{XN, (const bf16*)(F.ws + WS_WIN) + (size_t)NHY * D, M, NREST, D}; pg8::StaticOrder S; S.init(M, NREST, F.G, (int)blockIdx.x);
      pg8::EpiBf16Plain E{(bf16*)(F.ws + WS_PR), NREST};
      pg8::gemm_phase<pg8::EpiBf16Plain, pg8::StaticOrder, true, true>(F.lds + RING_OFF, g, S, E); }
}
__device__ __forceinline__ void ph2(Frame& F) {
    p2_qkprep(F); if (PROBE_SUB & 8) p2_qkprep(F);
    __syncthreads(); fft_tables(F);
    for (int c = F.vcu; c < HW; c += F.G) hyena_channel(F, c);
}
__device__ __forceinline__ void ph3(Frame& F, unsigned char* lds) {
    p3_transpose(F);
    __syncthreads();
    static_assert(attn_body::L8_BYTES <= RING_BYTES, "attention LDS");
    float gq = fabsf(F.in[14][F.lane]), gk = fabsf(F.in[15][F.lane]);
#pragma unroll
    for (int o = 1; o < 64; o <<= 1) { gq = fmaxf(gq, __shfl_xor(gq, o)); gk = fmaxf(gk, __shfl_xor(gk, o)); }
    const float mref = 64.0f * 0.125f * 1.4426950408889634f * gq * gk;
    const attn_body::AttnTensors8 AT{(const unsigned char*)(F.ws + WS_QO), (const unsigned char*)(F.ws + WS_KB), (const unsigned char*)(F.ws + WS_VB), (attn_body::bf16*)(F.ws + WS_AO), mref - 7.0f};
    const attn_body::StaticOrder S((int)F.G, F.vcu);
    attn_body::attn_phase8<attn_body::StaticOrder>((char*)lds + RING_OFF, AT, S);
}
__device__ __forceinline__ void ph4(Frame& F) {
    const bf16* PR = (const bf16*)(F.ws + WS_PR); bf16* MG = (bf16*)(F.ws + WS_MG);
    pg8::Gemm g{(const bf16*)(F.ws + WS_YH), (const bf16*)(F.ws + WS_WHU), M, D, 512, nullptr, (const bf16*)(F.ws + WS_AO), (const bf16*)(F.ws + WS_WAU)};
    pg8::ChainOrder S; S.base.init(M, D, F.G, (int)blockIdx.x);
    pg8::EpiGateChain E{MG, D, PR + PR_GH, PR + PR_GA, NREST};
    pg8::gemm_phase<pg8::EpiGateChain, pg8::ChainOrder, true, true>(F.lds + RING_OFF, g, S, E);
}
__device__ __forceinline__ void ph5(Frame& F) {
    pg8::Gemm g{(const bf16*)(F.ws + WS_MG), (const bf16*)(F.ws + WS_WOUT), M, D, D}; pg8::StaticOrder S; S.init(M, D, F.G, (int)blockIdx.x);
    pg8::EpiResBf16 E{F.in[0], (bf16*)(F.ws + WS_HB), D};
    pg8::gemm_phase<pg8::EpiResBf16, pg8::StaticOrder, true, true>(F.lds + RING_OFF, g, S, E);
}
__device__ __forceinline__ void ph8(Frame& F) {
    build_layout(F); const int nrb = (int)F.MISC[16];
    pg8::MoeOrder S; S.init(nrb, 8, F.G, (int)blockIdx.x, (const LAS int*)(F.lds + LX_RBE));
    LAS unsigned short* lidx = (LAS unsigned short*)(F.lds + LX_GIDX); const int* srctok = (const int*)(F.ws + WS_SRC);
    { pg8::Unit u; for (int i = 0; i < GIDX_UNITS && S.next(i, u); ++i) if (F.tid < 256) lidx[i * 256 + F.tid] = (unsigned short)srctok[u.pm * 256 + F.tid]; }
    __syncthreads();
    pg8::Gemm g{(const bf16*)(F.ws + WS_XN), (const bf16*)(F.ws + WS_W1), nrb * 256, 2 * FF, D / 2, lidx};
    pg8::EpiSwiglu E{(bf16*)(F.ws + WS_H1), F.in[23], 1.0f / (ASCALE * WSCALE), HSCALE};
    pg8::gemm_phase<pg8::EpiSwiglu, pg8::MoeOrder, true, true, true, true>(F.lds + RING_OFF, g, S, E);
}
template <int NOSTORE>
__device__ __forceinline__ void ph9(Frame& F) {
    build_layout(F); const int nrb = (int)F.MISC[16];
    pg8::Gemm g{(const bf16*)(F.ws + WS_H1), (const bf16*)(F.ws + WS_W2), nrb * 256, D, FF / 2}; pg8::MoeOrder S; S.init(nrb, 4, F.G, (int)blockIdx.x, (const LAS int*)(F.lds + LX_RBE)); if (PROBE_SUB & 2048) S.dup = 1;
    pg8::EpiMoe2 E{(bf16*)(F.ws + WS_XG), F.in[25], (const float*)(F.ws + WS_ROWGATE), NOSTORE, 1.0f / (HSCALE * WSCALE), YSCALE};
    pg8::gemm_phase<pg8::EpiMoe2, pg8::MoeOrder, true, true, false, true>(F.lds + RING_OFF, g, S, E);
}
struct Args { const float* in[26]; float* out; unsigned char* ws; int ph_lo, ph_hi; };
__global__ void __launch_bounds__(NWAVES * 64, 2) hybrid_fwd(Args args) {
    extern __shared__ __attribute__((aligned(16))) unsigned char lds[];
    Frame F;
    F.lds = (LAS unsigned char*)lds;
    F.MISC = (volatile LAS unsigned*)(F.lds + LX_MISC);
    F.tid = threadIdx.x; F.lane = F.tid & 63; F.wave = __builtin_amdgcn_readfirstlane(F.tid >> 6);
    F.G = gridDim.x; { const int bx = blockIdx.x; F.vcu = (F.G % 8 == 0) ? (bx % 8) * (F.G / 8) + bx / 8 : bx; }
    F.ws = args.ws; F.ctl = (gu32*)(args.ws + WS_CTL); F.out = args.out;
#pragma unroll
    for (int i = 0; i < 26; ++i) F.in[i] = args.in[i];
    if (F.tid < 64) F.MISC[F.tid] = 0u;
    __syncthreads();
    XcdBarrier bar; bar.bar = (unsigned*)(F.ctl + CW_BAR); bar.x = 0; bar.st = nullptr;
    if (N_LAUNCHES == 1) bar = xcd_barrier_post((unsigned*)(F.ctl + CW_BAR), F.MISC + 8);
#define GRID_BAR() do { if (N_LAUNCHES == 1) xcd_barrier(bar); } while (0)
    const int lo = args.ph_lo, hi = args.ph_hi;
#ifndef ONLYP
#define ONLYP -1
#endif
#define IN(k) (lo <= (k) && (k) < hi && (ONLYP < 0 || ONLYP == (k)))
#ifndef PROBE_DUP
#define PROBE_DUP 0
#endif
#define DUP(k) (((PROBE_DUP) >> (k)) & 1)
#define FRESH() do { int t_ = threadIdx.x; asm volatile("" : "+v"(t_)); F.tid = t_; F.lane = t_ & 63; } while (0)
    if (IN(0)) { FRESH(); p0_prologue(F); if (DUP(0)) { __syncthreads(); p0_prologue(F); } GRID_BAR(); }
    if (IN(1)) { FRESH(); ph1(F); if (DUP(1)) ph1(F); GRID_BAR(); }
    if (IN(2)) { FRESH(); ph2(F); if (DUP(2)) ph2(F); GRID_BAR(); }
    if (IN(3)) { FRESH(); ph3(F, lds); if (DUP(3)) { __syncthreads(); ph3(F, lds); } GRID_BAR(); }
    if (IN(4)) { FRESH(); ph4(F); if (DUP(4)) ph4(F); GRID_BAR(); }
    if (IN(5)) { FRESH(); ph5(F); if (DUP(5)) ph5(F); GRID_BAR(); }
    if (IN(6)) { FRESH(); if (PROBE_SUB & 128) { p6_route<1>(F); __syncthreads(); } p6_route<0>(F); GRID_BAR(); if (PROBE_SUB & 256) { for (int i = 0; i < 10; ++i) GRID_BAR(); } }
    if (IN(7)) { FRESH(); p7_layout(F); if (DUP(7)) p7_layout(F); GRID_BAR(); }
    if (IN(8)) { FRESH(); ph8(F); if (DUP(8)) ph8(F); GRID_BAR(); }
    if (IN(9)) { FRESH(); ph9<0>(F); if (DUP(9)) ph9<0>(F); if (PROBE_SUB & 64) ph9<1>(F); GRID_BAR(); }
    if (IN(10)) { FRESH(); p10_combine(F); if (DUP(10)) p10_combine(F); }
#undef IN
}

extern "C" void kernel_launch(void* const* d_in, const int* in_sizes, int n_in, void* d_out, int out_size, void* d_ws, size_t ws_size, hipStream_t stream) {
    static int grid = 0;
    if (grid == 0) {
        if (n_in != 26 || in_sizes[0] != M * D || out_size != M * D || ws_size < WS_END) { fprintf(stderr, "kernel_launch: unexpected shapes (n_in %d, in0 %d, out %d, ws %zu); nothing launched\n", n_in, n_in > 0 ? in_sizes[0] : -1, out_size, ws_size); grid = -1; return; }
        int dev = 0, cus = 0, per_cu = 0;
        if (hipGetDevice(&dev) != hipSuccess || hipDeviceGetAttribute(&cus, hipDeviceAttributeMultiprocessorCount, dev) != hipSuccess) { grid = -1; return; }
        if (hipFuncSetAttribute((const void*)hybrid_fwd, hipFuncAttributeMaxDynamicSharedMemorySize, LDS_BYTES) != hipSuccess) { fprintf(stderr, "kernel_launch: hipFuncSetAttribute failed\n"); grid = -1; return; }
        if (hipOccupancyMaxActiveBlocksPerMultiprocessor(&per_cu, (const void*)hybrid_fwd, NWAVES * 64, LDS_BYTES) != hipSuccess || per_cu < 1) fprintf(stderr, "kernel_launch: occupancy query reports %d\n", per_cu);
        (void)hipGetLastError();
        grid = cus;
        if (grid != 256) { fprintf(stderr, "kernel_launch: built for 256 CUs, device has %d\n", grid); grid = -1; return; }
    }
    if (grid < 0) return;
    if (hipMemsetAsync((char*)d_ws + WS_CTL, 0, CTL_ZERO_BYTES, stream) != hipSuccess) return;
    Args a{};
    for (int i = 0; i < 26; ++i) a.in[i] = (const float*)d_in[i];
    a.out = (float*)d_out; a.ws = (unsigned char*)d_ws;
    if (N_LAUNCHES == 1) { a.ph_lo = 0; a.ph_hi = N_PHASES; hipLaunchKernelGGL(hybrid_fwd, dim3(grid), dim3(NWAVES * 64), LDS_BYTES, stream, a); }
    else for (int p = 0; p < N_PHASES; ++p) { a.ph_lo = p; a.ph_hi = p + 1; hipLaunchKernelGGL(hybrid_fwd, dim3(grid), dim3(NWAVES * 64), LDS_BYTES, stream, a); }
}
```

```cpp
#include <hip/hip_runtime.h>
#include <cstdio>
#include <cstdint>
namespace pg8 {
#define PG8_LAS __attribute__((address_space(3)))
typedef unsigned short bf16_t;
typedef short bf16x8 __attribute__((ext_vector_type(8)));
typedef float f32x4 __attribute__((ext_vector_type(4)));
typedef unsigned u32x4 __attribute__((ext_vector_type(4)));
typedef int i32x4 __attribute__((ext_vector_type(4)));
constexpr int BM = 256, BK = 64, HALF = 128, HTB = HALF * BK * 2  , STAGE_BYTES = 8 * HTB, NXCD = 8, WGM = 8;

__host__ __device__ __forceinline__ int lds_byte(int r, int c) { const int st = (r >> 4) * 2 + (c >> 5), rr = r & 15, cc = c & 31, ob = rr * 64 + cc * 2; return st * 1024 + (ob ^ (((ob >> 9) & 1) << 5)); }
__host__ __device__ __forceinline__ void stage_rc(int b, int& R, int& C) { const int st = b / 1024, sb = b % 1024, swz = sb ^ (((sb >> 9) & 1) << 5); R = (st >> 1) * 16 + swz / 64; C = (st & 1) * 32 + (swz % 64) / 2; }
__host__ __device__ __forceinline__ int perm32(int rho) { const int n = rho >> 4, i = rho & 15; return 8 * (i >> 2) + 4 * n + (i & 3); }

struct Unit { int pm, pn, pb, sel; };
struct Gemm { const bf16_t* A; const bf16_t* Bt; int M, N, K; const PG8_LAS unsigned short* lidx; const bf16_t* A2; const bf16_t* Bt2; };

struct StaticOrder {
    int nM, nN, nwg, G, c;
    __host__ __device__ void init(int M, int N, int G_, int c_) { nM = M / BM; nN = N / BM; nwg = nM * nN; G = G_; c = c_; }
    __host__ __device__ bool next(int i, Unit& u) const {
        const long L = (long)i * G + c; if (L >= nwg) return false;
        int wgid = (int)L; { const int q = nwg / NXCD, r = nwg % NXCD, xcd = wgid % NXCD, off = wgid / NXCD; wgid = (xcd < r ? xcd * (q + 1) : r * (q + 1) + (xcd - r) * q) + off; }
        const int nig = WGM * nN, gid = wgid / nig, fm = gid * WGM, gsz = (nM - fm) < WGM ? (nM - fm) : WGM;
        u.pm = fm + ((wgid % nig) % gsz); u.pn = (wgid % nig) / gsz; u.pb = u.pn; u.sel = 0; return true;
    }
    __device__ __forceinline__ void a_ready(const Unit&) const {}
    __device__ __forceinline__ void done(const Unit&) const {}
};

__device__ __forceinline__ unsigned cvt_pk_bf16(float lo, float hi) { unsigned r; asm volatile("v_cvt_pk_bf16_f32 %0, %1, %2" : "=v"(r) : "v"(lo), "v"(hi)); return r; }
typedef float f32x2 __attribute__((ext_vector_type(2)));
template <int ACT  > struct EpiBf16 {
    static constexpr bool PERM = true, AFTER_DRAIN = false, CHAIN = false; static_assert(ACT == 0, "EpiBf16: ACT is 0 (none)");
    struct Pre {}; __device__ __forceinline__ Pre pre(const Unit&, int, int, int, int) const { return Pre{}; }
    bf16_t* O; int ldc; const float* bias; int split_cols; size_t split_stride; float scale0;
    __device__ __forceinline__ void operator()(const f32x4 (&acc)[2][2][4][2], const Unit& u, int wr, int wc, int fr, int fq, const Pre&) const {
        const int row0 = u.pm * BM + wr * 64 + fr; int colt = u.pn * BM; bf16_t* base = O;
        float sc = 1.f; if (split_cols) { const int t = colt / split_cols; base += (size_t)t * split_stride; colt -= t * split_cols; if (t == 0) sc = scale0; }
        const int col0 = colt + wc * 32 + 8 * fq, bcol0 = u.pn * BM + wc * 32 + 8 * fq;
        f32x4 bv[2][2];
#pragma unroll
        for (int bj = 0; bj < 2; ++bj)
#pragma unroll
            for (int n = 0; n < 2; ++n) bv[bj][n] = bias ? *(const f32x4*)(bias + bcol0 + bj * HALF + 4 * n) : (f32x4){0.f, 0.f, 0.f, 0.f};
#pragma unroll
        for (int ai = 0; ai < 2; ++ai)
#pragma unroll
            for (int m = 0; m < 4; ++m) { bf16_t* rowp = base + (size_t)(row0 + ai * HALF + m * 16) * ldc + col0;
#pragma unroll
                for (int bj = 0; bj < 2; ++bj) { f32x4 v0 = acc[ai][bj][m][0] + bv[bj][0], v1 = acc[ai][bj][m][1] + bv[bj][1];
                    v0 = v0 * sc; v1 = v1 * sc; u32x4 w; w.x = cvt_pk_bf16(v0[0], v0[1]); w.y = cvt_pk_bf16(v0[2], v0[3]); w.z = cvt_pk_bf16(v1[0], v1[1]); w.w = cvt_pk_bf16(v1[2], v1[3]);
                    *(u32x4*)(rowp + bj * HALF) = w; } }
    }
};
struct EpiBf16Plain {
    static constexpr bool PERM = true, AFTER_DRAIN = false, CHAIN = false; static constexpr int PERM2 = 3;
    struct Pre {}; __device__ __forceinline__ Pre pre(const Unit&, int, int, int, int) const { return Pre{}; }
    bf16_t* O; int ldc;
    __device__ __forceinline__ void operator()(const f32x4 (&acc)[2][2][4][2], const Unit& u, int wr, int wc, int fr, int fq, const Pre&) const {
        const bool lo = fr < 8;
        const int row0 = u.pm * BM + wr * 64 + (fr & 7), col0 = u.pn * BM + wc * 64 + 8 * fq + (lo ? 0 : 32);
#pragma unroll
        for (int ai = 0; ai < 2; ++ai)
#pragma unroll
            for (int m = 0; m < 4; ++m) { bf16_t* rowp = O + (size_t)(row0 + ai * HALF + m * 16) * ldc + col0;
                u32x4 w[2];
#pragma unroll
                for (int bj = 0; bj < 2; ++bj) { const f32x4 v0 = acc[ai][bj][m][0], v1 = acc[ai][bj][m][1];
                    w[bj].x = cvt_pk_bf16(v0[0], v0[1]); w[bj].y = cvt_pk_bf16(v0[2], v0[3]); w[bj].z = cvt_pk_bf16(v1[0], v1[1]); w[bj].w = cvt_pk_bf16(v1[2], v1[3]); }
                u32x4 xa, xb;
#pragma unroll
                for (int i = 0; i < 4; ++i) { const unsigned give = lo ? w[1][i] : w[0][i], recv = (unsigned)__shfl_xor((int)give, 8, 64);
                    xa[i] = lo ? w[0][i] : recv; xb[i] = lo ? recv : w[1][i]; }
                *(u32x4*)rowp = xa; *(u32x4*)(rowp + (size_t)8 * ldc) = xb; }
    }
};
__device__ __forceinline__ float bf_lo(unsigned w) { return __uint_as_float(w << 16); }
__device__ __forceinline__ float bf_hi(unsigned w) { return __uint_as_float(w & 0xffff0000u); }
__device__ __forceinline__ float sigmoid_f(float x) { return __builtin_amdgcn_rcpf(1.f + __builtin_amdgcn_exp2f(-1.4426950408889634f * x)); }
struct MoeOrder {
    int nM, nN, nwg, G, c; const PG8_LAS int* rbe;
    __device__ void init(int nM_, int nN_, int G_, int c_, const PG8_LAS int* rbe_) { nM = nM_; nN = nN_; nwg = nM * nN; G = G_; c = c_; rbe = rbe_; dup = 0; }
    int dup;
    __device__ bool next(int i, Unit& u) const {
        const long L = (long)(i >> dup) * G + c; if (L >= nwg) return false;
        int wgid = (int)L; { const int q = nwg / NXCD, r = nwg % NXCD, xcd = wgid % NXCD, off = wgid / NXCD; wgid = (xcd < r ? xcd * (q + 1) : r * (q + 1) + (xcd - r) * q) + off; }
        const int nig = WGM * nN, gid = wgid / nig, fm = gid * WGM, gsz = (nM - fm) < WGM ? (nM - fm) : WGM;
        u.pm = fm + ((wgid % nig) % gsz); u.pn = (wgid % nig) / gsz; u.pb = rbe[u.pm] * nN + u.pn; u.sel = dup ? (i & 1) : 0; return true;
    }
    __device__ __forceinline__ void a_ready(const Unit&) const {}
    __device__ __forceinline__ void done(const Unit&) const {}
};
template <int PASS> struct EpiGate {
    static constexpr bool PERM = true, AFTER_DRAIN = false, CHAIN = false;
    struct Pre {}; __device__ __forceinline__ Pre pre(const Unit&, int, int, int, int) const { return Pre{}; }
    bf16_t* O; int ldc; const bf16_t* G; int ldg;
    __device__ __forceinline__ void operator()(const f32x4 (&acc)[2][2][4][2], const Unit& u, int wr, int wc, int fr, int fq, const Pre&) const {
        const int row0 = u.pm * BM + wr * 64 + fr, col0 = u.pn * BM + wc * 32 + 8 * fq;
#pragma unroll
        for (int ai = 0; ai < 2; ++ai)
#pragma unroll
            for (int m = 0; m < 4; ++m) { const size_t row = (size_t)(row0 + ai * HALF + m * 16);
#pragma unroll
                for (int bj = 0; bj < 2; ++bj) { const int col = col0 + bj * HALF;
                    const u32x4 gw = *(const u32x4*)(G + row * ldg + col);
                    float v[8];
#pragma unroll
                    for (int i = 0; i < 4; ++i) { v[2 * i] = sigmoid_f(bf_lo(gw[i])) * acc[ai][bj][m][i >> 1][(2 * i) & 3]; v[2 * i + 1] = sigmoid_f(bf_hi(gw[i])) * acc[ai][bj][m][i >> 1][(2 * i + 1) & 3]; }
                    bf16_t* op = O + row * ldc + col;
                    if (PASS == 1) { const u32x4 tw = *(const u32x4*)op;
#pragma unroll
                        for (int i = 0; i < 4; ++i) { v[2 * i] += bf_lo(tw[i]); v[2 * i + 1] += bf_hi(tw[i]); } }
                    u32x4 w; w.x = cvt_pk_bf16(v[0], v[1]); w.y = cvt_pk_bf16(v[2], v[3]); w.z = cvt_pk_bf16(v[4], v[5]); w.w = cvt_pk_bf16(v[6], v[7]);
                    *(u32x4*)op = w; } }
    }
};
struct EpiResF32 {
    static constexpr bool PERM = false, AFTER_DRAIN = false, CHAIN = false;
    struct Pre {}; __device__ __forceinline__ Pre pre(const Unit&, int, int, int, int) const { return Pre{}; }
    const float* X; float* out; int ldc;
    __device__ __forceinline__ void operator()(const f32x4 (&acc)[2][2][4][2], const Unit& u, int wr, int wc, int fr, int fq, const Pre&) const {
        const int row0 = u.pm * BM + wr * 64 + fr, col0 = u.pn * BM + wc * 32 + 4 * fq;
#pragma unroll
        for (int ai = 0; ai < 2; ++ai)
#pragma unroll
            for (int m = 0; m < 4; ++m) { const size_t off = (size_t)(row0 + ai * HALF + m * 16) * ldc + col0;
#pragma unroll
                for (int bj = 0; bj < 2; ++bj)
#pragma unroll
                    for (int n = 0; n < 2; ++n) { const f32x4 xv = *(const f32x4*)(X + off + bj * HALF + n * 16); *(f32x4*)(out + off + bj * HALF + n * 16) = xv + acc[ai][bj][m][n]; } }
    }
};
struct EpiResBf16 {
    static constexpr bool PERM = true, AFTER_DRAIN = false, CHAIN = false; static constexpr int PERM2 = 3;
    struct Pre {}; __device__ __forceinline__ Pre pre(const Unit&, int, int, int, int) const { return Pre{}; }
    const float* X; bf16_t* out; int ldc;
    __device__ __forceinline__ void operator()(const f32x4 (&acc)[2][2][4][2], const Unit& u, int wr, int wc, int fr, int fq, const Pre&) const {
        const bool lo = fr < 8;
        const int row0 = u.pm * BM + wr * 64, colx = u.pn * BM + wc * 64 + 8 * fq;
        const int cols = colx + (lo ? 0 : 32);
#pragma unroll
        for (int ai = 0; ai < 2; ++ai) {
            f32x4 xv[4][2][2];
#pragma unroll
            for (int m = 0; m < 4; ++m) { const size_t off = ((size_t)(row0 + ai * HALF + m * 16) + fr) * ldc + colx;
#pragma unroll
                for (int bj = 0; bj < 2; ++bj) { xv[m][bj][0] = *(const f32x4*)(X + off + bj * 32); xv[m][bj][1] = *(const f32x4*)(X + off + bj * 32 + 4); } }
            asm volatile("" ::: "memory");
#pragma unroll
            for (int m = 0; m < 4; ++m) { const size_t rb = (size_t)(row0 + ai * HALF + m * 16);
                u32x4 w[2];
#pragma unroll
                for (int bj = 0; bj < 2; ++bj) { const f32x4 v0 = xv[m][bj][0] + acc[ai][bj][m][0], v1 = xv[m][bj][1] + acc[ai][bj][m][1];
                    w[bj].x = cvt_pk_bf16(v0[0], v0[1]); w[bj].y = cvt_pk_bf16(v0[2], v0[3]); w[bj].z = cvt_pk_bf16(v1[0], v1[1]); w[bj].w = cvt_pk_bf16(v1[2], v1[3]); }
                u32x4 xa, xb;
#pragma unroll
                for (int i = 0; i < 4; ++i) { const unsigned give = lo ? w[1][i] : w[0][i], recv = (unsigned)__shfl_xor((int)give, 8, 64);
                    xa[i] = lo ? w[0][i] : recv; xb[i] = lo ? recv : w[1][i]; }
                bf16_t* rowp = out + (rb + (fr & 7)) * ldc + cols;
                *(u32x4*)rowp = xa; *(u32x4*)(rowp + (size_t)8 * ldc) = xb; } }
    }
};
typedef unsigned u32x2 __attribute__((ext_vector_type(2)));
__device__ __forceinline__ unsigned pack4_fp8(float a, float b, float c, float d) { int w = 0; w = __builtin_amdgcn_cvt_pk_fp8_f32(a, b, w, false); w = __builtin_amdgcn_cvt_pk_fp8_f32(c, d, w, true); return (unsigned)w; }
__device__ __forceinline__ float clamp8(float x) { return __builtin_amdgcn_fmed3f(x, -448.0f, 448.0f); }
struct EpiSwiglu {
    static constexpr bool PERM = true, AFTER_DRAIN = false, CHAIN = false, C0START = true;
    bf16_t* H; const float* b1; float ascale, hscale;
    struct Pre { f32x4 t[4]; };
    __device__ __forceinline__ Pre pre(const Unit& u, int wr, int wc, int fr, int fq) const {
        const int e = u.pb >> 3, j0 = u.pn * HALF + wc * 32 + 8 * fq; const float* bp = b1 + (size_t)e * 2048 + 2 * j0; Pre p;
#pragma unroll
        for (int i = 0; i < 4; ++i) p.t[i] = *(const f32x4*)(bp + 4 * i);
        return p; }
    __device__ __forceinline__ void operator()(const f32x4 (&acc)[2][2][4][2], const Unit& u, int wr, int wc, int fr, int fq, const Pre& pr) const {
#if defined(PROBE_EPI) && PROBE_EPI == 1
        if (u.sel) {
#pragma unroll
            for (int ai = 0; ai < 2; ++ai)
#pragma unroll
                for (int bj = 0; bj < 2; ++bj)
#pragma unroll
                    for (int m = 0; m < 4; ++m) { asm volatile("" :: "v"(acc[ai][bj][m][0]), "v"(acc[ai][bj][m][1])); }
            return; }
#endif
        const int row0 = u.pm * BM + wr * 64 + fr, j0 = u.pn * HALF + wc * 32 + 8 * fq;
        typedef float f32x2 __attribute__((ext_vector_type(2)));
        f32x2 bg[4], bl[4];
#pragma unroll
        for (int i = 0; i < 4; ++i) { const f32x4 t = pr.t[i]; bg[i] = (f32x2){t[0], t[2]}; bl[i] = (f32x2){t[1], t[3]}; }
        const f32x2 as2 = {ascale, ascale}, hs2 = {hscale, hscale}, one2 = {1.0f, 1.0f};
        const f32x2 c1 = {-1.702f * 1.4426950408889634f * 8388608.0f, -1.702f * 1.4426950408889634f * 8388608.0f}, c0 = {1064986823.0f, 1064986823.0f};
#pragma unroll
        for (int ai = 0; ai < 2; ++ai)
#pragma unroll
            for (int mp = 0; mp < 2; ++mp) { u32x2 wm[2];
#pragma unroll
                for (int mi = 0; mi < 2; ++mi) { const int m = 2 * mp + mi; f32x2 o[4];
#pragma unroll
                for (int i = 0; i < 4; ++i) { const f32x4 ag = acc[ai][0][m][i >> 1], al = acc[ai][1][m][i >> 1];
                    f32x2 g = (i & 1) ? (f32x2){ag[2], ag[3]} : (f32x2){ag[0], ag[1]}, l = (i & 1) ? (f32x2){al[2], al[3]} : (f32x2){al[0], al[1]};
                    g = g * as2 + bg[i]; l = l * as2 + bl[i];
                    g[0] = __builtin_amdgcn_fmed3f(g[0], -30.0f, 7.0f); g[1] = __builtin_amdgcn_fmed3f(g[1], -30.0f, 7.0f);
                    l[0] = __builtin_amdgcn_fmed3f(l[0], -7.0f, 7.0f); l[1] = __builtin_amdgcn_fmed3f(l[1], -7.0f, 7.0f);
                    const f32x2 ex = g * c1 + c0; f32x2 e2; e2[0] = __int_as_float((int)ex[0]); e2[1] = __int_as_float((int)ex[1]);
                    const f32x2 den = e2 + one2; f32x2 r; r[0] = __builtin_amdgcn_rcpf(den[0]); r[1] = __builtin_amdgcn_rcpf(den[1]);
                    o[i] = (g * r) * (l * hs2 + hs2); }
                    wm[mi].x = pack4_fp8(o[0][0], o[0][1], o[1][0], o[1][1]); wm[mi].y = pack4_fp8(o[2][0], o[2][1], o[3][0], o[3][1]); }
                const auto s0 = __builtin_amdgcn_permlane16_swap(wm[0].x, wm[1].x, false, false), s1 = __builtin_amdgcn_permlane16_swap(wm[0].y, wm[1].y, false, false);
                u32x4 w; w.x = s0[0]; w.y = s1[0]; w.z = s0[1]; w.w = s1[1];
                const size_t row = (size_t)(row0 + ai * HALF + (2 * mp + (fq & 1)) * 16);
                *(u32x4*)((unsigned char*)H + row * 1024 + (j0 - 8 * (fq & 1))) = w; }
    }
};
struct EpiMoe2 {
    static constexpr bool PERM = true, AFTER_DRAIN = false, CHAIN = false, C0START = true; static constexpr int PERM2 = 2;
    bf16_t* Y; const float* b2; const float* gate; int nostore; float ascale, yscale;
    struct Pre { f32x4 bv[4]; float gt[2][4]; };
    __device__ __forceinline__ Pre pre(const Unit& u, int wr, int wc, int fr, int fq) const {
        const int row0 = u.pm * BM + wr * 64 + fr, e = u.pb >> 2, col0 = u.pn * BM + wc * 64 + 16 * fq; Pre p;
#pragma unroll
        for (int q = 0; q < 4; ++q) p.bv[q] = *(const f32x4*)(b2 + (size_t)e * 1024 + col0 + 4 * q);
#pragma unroll
        for (int ai = 0; ai < 2; ++ai)
#pragma unroll
            for (int m = 0; m < 4; ++m) p.gt[ai][m] = gate[row0 + ai * HALF + m * 16];
        return p; }
    __device__ __forceinline__ void operator()(const f32x4 (&acc)[2][2][4][2], const Unit& u, int wr, int wc, int fr, int fq, const Pre& pr) const {
#if defined(PROBE_EPI) && PROBE_EPI == 1
        if (u.sel) {
#pragma unroll
            for (int ai = 0; ai < 2; ++ai)
#pragma unroll
                for (int bj = 0; bj < 2; ++bj)
#pragma unroll
                    for (int m = 0; m < 4; ++m) { asm volatile("" :: "v"(acc[ai][bj][m][0]), "v"(acc[ai][bj][m][1])); }
            return; }
#endif
        const int row0 = u.pm * BM + wr * 64 + fr, col0 = u.pn * BM + wc * 64 + 16 * fq;
#pragma unroll
        for (int ai = 0; ai < 2; ++ai)
#pragma unroll
            for (int m = 0; m < 4; ++m) { const size_t row = (size_t)(row0 + ai * HALF + m * 16); const float gs = pr.gt[ai][m] * yscale, a2 = ascale * gs; u32x4 w;
#pragma unroll
                for (int q = 0; q < 4; ++q) { const f32x4 v = acc[ai][q >> 1][m][q & 1] * a2 + pr.bv[q] * gs;
                    w[q] = pack4_fp8(clamp8(v[0]), clamp8(v[1]), clamp8(v[2]), clamp8(v[3])); }
#if defined(PROBE_EPI) && PROBE_EPI == 2
                if (u.sel) { asm volatile("" :: "v"(w)); continue; }
#endif
                if (!nostore) *(u32x4*)((unsigned char*)Y + row * 1024 + col0) = w; else asm volatile("" :: "v"(w)); }
    }
};
struct ChainOrder {
    StaticOrder base;
    __device__ bool next(int i, Unit& u) const { if (!base.next(i >> 1, u)) return false; u.sel = i & 1; return true; }
    __device__ __forceinline__ void a_ready(const Unit&) const {}
    __device__ __forceinline__ void done(const Unit&) const {}
};
struct EpiGateChain {
    static constexpr bool PERM = true, AFTER_DRAIN = false, CHAIN = true;
    struct Pre {}; __device__ __forceinline__ Pre pre(const Unit&, int, int, int, int) const { return Pre{}; }
    bf16_t* O; int ldc; const bf16_t* GH; const bf16_t* GA; int ldg;
    __device__ __forceinline__ static float eneg(float x) { return __builtin_amdgcn_exp2f(-1.4426950408889634f * fminf(fmaxf(x, -30.f), 30.f)); }
    typedef float f32x2g __attribute__((ext_vector_type(2)));
    __device__ __forceinline__ static f32x2g en2(unsigned w) {
        f32x2g x = {__builtin_amdgcn_fmed3f(bf_lo(w), -30.f, 30.f), __builtin_amdgcn_fmed3f(bf_hi(w), -30.f, 30.f)};
        x = x * (f32x2g){-1.4426950408889634f, -1.4426950408889634f};
        return (f32x2g){__builtin_amdgcn_exp2f(x[0]), __builtin_amdgcn_exp2f(x[1])}; }
    __device__ __forceinline__ void mid(f32x4 (&acc)[2][2][4][2], const Unit& u, int wr, int wc, int fr, int fq) const {
        const int row0 = u.pm * BM + wr * 64 + fr, col0 = u.pn * BM + wc * 32 + 8 * fq; const f32x2g one2 = {1.f, 1.f};
#pragma unroll
        for (int ai = 0; ai < 2; ++ai) {
            u32x4 hw[4][2], aw[4][2];
#pragma unroll
            for (int m = 0; m < 4; ++m) { const size_t row = (size_t)(row0 + ai * HALF + m * 16);
#pragma unroll
                for (int bj = 0; bj < 2; ++bj) { const int col = col0 + bj * HALF; hw[m][bj] = *(const u32x4*)(GH + row * ldg + col); aw[m][bj] = *(const u32x4*)(GA + row * ldg + col); } }
            asm volatile("" ::: "memory");
#pragma unroll
            for (int m = 0; m < 4; ++m)
#pragma unroll
                for (int bj = 0; bj < 2; ++bj)
#pragma unroll
                    for (int i = 0; i < 4; ++i) { const f32x2g na = en2(aw[m][bj][i]) + one2, nh = en2(hw[m][bj][i]) + one2;
                        const f32x2g r = na * (f32x2g){__builtin_amdgcn_rcpf(nh[0]), __builtin_amdgcn_rcpf(nh[1])};
                        acc[ai][bj][m][i >> 1][(2 * i) & 3] *= r[0]; acc[ai][bj][m][i >> 1][(2 * i + 1) & 3] *= r[1]; } }
    }
    __device__ __forceinline__ void operator()(const f32x4 (&acc)[2][2][4][2], const Unit& u, int wr, int wc, int fr, int fq, const Pre&) const {
        const int row0 = u.pm * BM + wr * 64 + fr, col0 = u.pn * BM + wc * 32 + 8 * fq; const f32x2g one2 = {1.f, 1.f};
#pragma unroll
        for (int ai = 0; ai < 2; ++ai)
#pragma unroll
            for (int m = 0; m < 4; ++m) { const size_t row = (size_t)(row0 + ai * HALF + m * 16);
#pragma unroll
                for (int bj = 0; bj < 2; ++bj) { const int col = col0 + bj * HALF;
                    const u32x4 aw = *(const u32x4*)(GA + row * ldg + col); float v[8];
#pragma unroll
                    for (int i = 0; i < 4; ++i) { const f32x2g na = en2(aw[i]) + one2;
                        v[2 * i] = acc[ai][bj][m][i >> 1][(2 * i) & 3] * __builtin_amdgcn_rcpf(na[0]); v[2 * i + 1] = acc[ai][bj][m][i >> 1][(2 * i + 1) & 3] * __builtin_amdgcn_rcpf(na[1]); }
                    u32x4 w; w.x = cvt_pk_bf16(v[0], v[1]); w.y = cvt_pk_bf16(v[2], v[3]); w.z = cvt_pk_bf16(v[4], v[5]); w.w = cvt_pk_bf16(v[6], v[7]);
                    *(u32x4*)(O + row * ldc + col) = w; } }
    }
};
template <class E, class = void> struct C0Of { static constexpr bool v = false; };
template <class E> struct C0Of<E, decltype((void)E::C0START)> { static constexpr bool v = E::C0START; };
template <class E, class = void> struct Perm2Of { static constexpr int v = 0; };
template <class E> struct Perm2Of<E, decltype((void)E::PERM2)> { static constexpr int v = (int)E::PERM2; };
template <class Epi, class Sched, bool ALIGN_EPI = false, bool SP2 = false, bool GATHER = false, bool FP8 = false, bool ATILE = false>
__device__ __forceinline__ void gemm_phase(PG8_LAS unsigned char* lds, const Gemm g, const Sched& S, const Epi& E) {
    const int tid = threadIdx.x, wid = __builtin_amdgcn_readfirstlane(tid >> 6), lane = tid & 63, wr = wid >> 2, wc = wid & 3, fr = lane & 15, fq = lane >> 4;
    const int K = g.K, nt = K / BK;
    constexpr int PERM2 = Perm2Of<Epi>::v;
    unsigned voffA[2], voffB[2];
#pragma unroll
    for (int i = 0; i < 2; ++i) { int R, C; stage_rc(tid * 16 + i * 8192, R, C); const int Rb = Epi::PERM ? ((R & ~31) + perm32(R & 31)) : R;
        const int R2 = (R >> 5) * 64 + ((R >> 2) & 3) * (PERM2 == 3 ? 8 : 16) + ((R >> 4) & 1) * 4 + (R & 3);
        voffA[i] = ATILE ? (unsigned)((R >> 2) * 4096 + (R & 3) * 32 + ((2 * C) >> 5) * 128 + ((2 * C) & 31)) : (unsigned)(R * K + C) * 2u; voffB[i] = (unsigned)((PERM2 ? R2 : Rb) * K + C) * 2u; }
    unsigned goffC[2][2] = {{0u, 0u}, {0u, 0u}}, goffN[2][2] = {{0u, 0u}, {0u, 0u}}; int gR[2], gC[2];
#pragma unroll
    for (int i = 0; i < 2; ++i) stage_rc(tid * 16 + i * 8192, gR[i], gC[i]);
    const size_t kstep = (size_t)(BK * 2);
    const size_t kstepA = ATILE ? (size_t)(BK * 2) * 4 : kstep;
    static_assert(!ATILE || !GATHER, "ATILE: dense A only");
    const size_t hstep = (size_t)HALF * K * 2;
    const size_t tstep = 2 * hstep;
    const unsigned ldsw = (unsigned)wid * 1024u;
    const int aoff = FP8 ? lds_byte(wr * 64 + fr, 16 * (fq & 1)) + (fq >> 1) * 1024 : lds_byte(wr * 64 + fr, fq * 8), boff = FP8 ? lds_byte(wc * 32 + fr, 16 * (fq & 1)) + (fq >> 1) * 1024 : lds_byte(wc * 32 + fr, fq * 8);

#define PG8_SA(b, h) (((b) * 2 + (h)) * HTB)
#define PG8_SB(b, h) ((4 + (b) * 2 + (h)) * HTB)
#define PG8_STAGE(bufoff, gbase, voff) do { _Pragma("unroll") for (int _i = 0; _i < 2; ++_i) \
        __builtin_amdgcn_global_load_lds((const unsigned*)((const char*)(gbase) + (voff)[_i]), (PG8_LAS unsigned*)(lds + (bufoff) + ldsw + _i * 8192), 16, 0, 0); } while (0)
#define PG8_STAGE_B(bufoff, gbase, h) do { if constexpr (PERM2) { if (h) PG8_STAGE(bufoff, (gbase) + (size_t)(PERM2 == 3 ? 32 : 8) * K * 2, voffB); else PG8_STAGE(bufoff, gbase, voffB); }     else PG8_STAGE(bufoff, (gbase) + ((h) ? hstep : 0), voffB); } while (0)
#define PG8_GOFF(dst, u_) do { if constexpr (GATHER) { _Pragma("unroll") for (int h_ = 0; h_ < 2; ++h_) _Pragma("unroll") for (int i_ = 0; i_ < 2; ++i_) \
        dst[h_][i_] = ((unsigned)g.lidx[(u_) * BM + h_ * HALF + gR[i_]] * (unsigned)K + (unsigned)gC[i_]) * 2u; } } while (0)
#define PG8_STAGE_A(bufoff, gbase, h, nx) do { if constexpr (GATHER) { unsigned vo_[2] = { (nx) ? goffN[h][0] : goffC[h][0], (nx) ? goffN[h][1] : goffC[h][1] }; PG8_STAGE(bufoff, gbase, vo_); } \
        else { PG8_STAGE(bufoff, (gbase) + ((h) ? hstep : 0), voffA); } } while (0)
#define PG8_LDA(dst, b, h) do { _Pragma("unroll") for (int m = 0; m < 4; ++m) _Pragma("unroll") for (int k = 0; k < 2; ++k) { if constexpr (FP8) { if (k == 0) dst##8[m] = PG8_CAT2(*(const PG8_LAS i32x4*)(lds + PG8_SA(b, h) + aoff + m * 2048), *(const PG8_LAS i32x4*)(lds + PG8_SA(b, h) + aoff + m * 2048 + 16)); } else dst[m][k] = *(const PG8_LAS bf16x8*)(lds + PG8_SA(b, h) + aoff + m * 2048 + k * 1024); } } while (0)
#define PG8_LDB(dst, b, h) do { _Pragma("unroll") for (int n = 0; n < 2; ++n) _Pragma("unroll") for (int k = 0; k < 2; ++k) { if constexpr (FP8) { if (k == 0) dst##8[n] = PG8_CAT2(*(const PG8_LAS i32x4*)(lds + PG8_SB(b, h) + boff + n * 2048), *(const PG8_LAS i32x4*)(lds + PG8_SB(b, h) + boff + n * 2048 + 16)); } else dst[n][k] = *(const PG8_LAS bf16x8*)(lds + PG8_SB(b, h) + boff + n * 2048 + k * 1024); } } while (0)
#define PG8_CAT2(lo_, hi_) __builtin_shufflevector(lo_, hi_, 0, 1, 2, 3, 4, 5, 6, 7)
#define PG8_MMA(ai, bj, At, Bt) do { __builtin_amdgcn_s_setprio(1); _Pragma("unroll") for (int m = 0; m < 4; ++m) _Pragma("unroll") for (int n = 0; n < 2; ++n) { \
        if constexpr (FP8) asm volatile("v_mfma_scale_f32_16x16x128_f8f6f4 %0, %1, %2, %0, %3, %3 op_sel_hi:[0,0,0]" : "+v"(acc[ai][bj][m][n]) : "v"(Bt##8[n]), "v"(At##8[m]), "v"(mxone));     \
        else { _Pragma("unroll") for (int k = 0; k < 2; ++k) acc[ai][bj][m][n] = __builtin_amdgcn_mfma_f32_16x16x32_bf16(Bt[n][k], At[m][k], acc[ai][bj][m][n], 0, 0, 0); } } __builtin_amdgcn_s_setprio(0); } while (0)
#define PG8_MF_(d, a, b, c) "v_mfma_scale_f32_16x16x128_f8f6f4 " d ", " b ", " a ", " c ", %14, %14 op_sel_hi:[0,0,0]\n\t"
#define PG8_MMA0(ai, bj, At, Bt, first) do { if constexpr (C0) { __builtin_amdgcn_s_setprio(1); asm volatile("s_cmp_eq_u32 %15, 0\n\ts_cbranch_scc1 .Lma_%=\n\t" \
        PG8_MF_("%0", "%8", "%12", "0") PG8_MF_("%1", "%8", "%13", "0") PG8_MF_("%2", "%9", "%12", "0") PG8_MF_("%3", "%9", "%13", "0") \
        PG8_MF_("%4", "%10", "%12", "0") PG8_MF_("%5", "%10", "%13", "0") PG8_MF_("%6", "%11", "%12", "0") PG8_MF_("%7", "%11", "%13", "0") \
        "s_branch .Lmd_%=\n.Lma_%=:\n\t" \
        PG8_MF_("%0", "%8", "%12", "%0") PG8_MF_("%1", "%8", "%13", "%1") PG8_MF_("%2", "%9", "%12", "%2") PG8_MF_("%3", "%9", "%13", "%3") \
        PG8_MF_("%4", "%10", "%12", "%4") PG8_MF_("%5", "%10", "%13", "%5") PG8_MF_("%6", "%11", "%12", "%6") PG8_MF_("%7", "%11", "%13", "%7") \
        ".Lmd_%=:" \
        : "+v"(acc[ai][bj][0][0]), "+v"(acc[ai][bj][0][1]), "+v"(acc[ai][bj][1][0]), "+v"(acc[ai][bj][1][1]), "+v"(acc[ai][bj][2][0]), "+v"(acc[ai][bj][2][1]), "+v"(acc[ai][bj][3][0]), "+v"(acc[ai][bj][3][1]) \
        : "v"(At##8[0]), "v"(At##8[1]), "v"(At##8[2]), "v"(At##8[3]), "v"(Bt##8[0]), "v"(Bt##8[1]), "v"(mxone), "s"(first) : "scc"); __builtin_amdgcn_s_setprio(0); } else PG8_MMA(ai, bj, At, Bt); } while (0)
#define PG8_WAIT_V(n) asm volatile("s_waitcnt vmcnt(" #n ")" ::: "memory")
#define PG8_WAIT_L(n) asm volatile("s_waitcnt lgkmcnt(" #n ")" ::: "memory")
#define PG8_BAR __builtin_amdgcn_s_barrier()
#define PG8_SCHED __builtin_amdgcn_sched_barrier(0)
    Unit cur, nxt; int ui = 0;
    if (!S.next(0, cur)) return;
    constexpr bool C0 = FP8 && C0Of<Epi>::v; static_assert(!C0 || (SP2 && !Epi::CHAIN), "C0START: the SP2 loop starts the accumulators itself (no zeroing), no chaining");
    f32x4 acc[2][2][4][2];
    if constexpr (!C0) {
#pragma unroll
    for (int a = 0; a < 2; ++a)
#pragma unroll
        for (int b = 0; b < 2; ++b)
#pragma unroll
            for (int m = 0; m < 4; ++m)
#pragma unroll
                for (int n = 0; n < 2; ++n) acc[a][b][m][n] = (f32x4){0.f, 0.f, 0.f, 0.f}; }
    bf16x8 At[4][2], B0[2][2], B1[2][2];
    typedef int i32x8 __attribute__((ext_vector_type(8)));
    i32x8 At8[4], B08[2], B18[2];
    const int mxone = 0x7f7f7f7f;
    const char* cA = (const char*)((Epi::CHAIN && cur.sel) ? g.A2 : g.A) + (GATHER ? (size_t)0 : (size_t)cur.pm * tstep); PG8_GOFF(goffC, 0); const char* cB = (const char*)((Epi::CHAIN && cur.sel) ? g.Bt2 : g.Bt) + (size_t)cur.pb * tstep;
    S.a_ready(cur);
    if constexpr (SP2) {
        PG8_STAGE_B(PG8_SB(0, 0), cB, 0); PG8_STAGE_B(PG8_SB(0, 1), cB, 1); PG8_STAGE_A(PG8_SA(0, 0), cA, 0, false); PG8_STAGE_A(PG8_SA(0, 1), cA, 1, false);
        if (wr == 1) PG8_BAR;
        PG8_WAIT_V(2); PG8_BAR;
        PG8_STAGE_B(PG8_SB(1, 0), cB + kstep, 0); PG8_STAGE_A(PG8_SA(1, 0), cA + kstepA, 0, false); PG8_STAGE_B(PG8_SB(1, 1), cB + kstep, 1);
        PG8_WAIT_V(6); PG8_BAR;
    } else {
        PG8_STAGE_B(PG8_SB(0, 0), cB, 0); PG8_STAGE(PG8_SA(0, 0), cA, voffA); PG8_STAGE_B(PG8_SB(0, 1), cB, 1); PG8_STAGE(PG8_SA(0, 1), cA + hstep, voffA);
        if (wr == 1) PG8_BAR;
        PG8_WAIT_V(4); PG8_BAR;
        PG8_STAGE_B(PG8_SB(1, 0), cB + kstep, 0); PG8_STAGE(PG8_SA(1, 0), cA + kstepA, voffA); PG8_STAGE_B(PG8_SB(1, 1), cB + kstep, 1);
        PG8_WAIT_V(6); PG8_BAR;
    }
    for (;;) {
        const typename Epi::Pre pre = E.pre(cur, wr, wc, fr, fq);
        const bool has_next = S.next(ui + 1, nxt);
        if (has_next) PG8_GOFF(goffN, ui + 1); else { _Pragma("unroll") for (int h_ = 0; h_ < 2; ++h_) _Pragma("unroll") for (int i_ = 0; i_ < 2; ++i_) goffN[h_][i_] = goffC[h_][i_]; }
        const char* nA = (has_next && !GATHER) ? (const char*)((Epi::CHAIN && nxt.sel) ? g.A2 : g.A) + (size_t)nxt.pm * tstep : cA; const char* nB = has_next ? (const char*)((Epi::CHAIN && nxt.sel) ? g.Bt2 : g.Bt) + (size_t)nxt.pb * tstep : cB;
        for (int t = 0; t < nt; t += 2) {
            const bool last = (t == nt - 2); const int first = __builtin_amdgcn_readfirstlane(t == 0 ? 1 : 0);
            const char* a1 = cA + (size_t)(t + 1) * kstepA;
            const char* a2 = last ? nA : cA + (size_t)(t + 2) * kstepA; const char* b2 = last ? nB : cB + (size_t)(t + 2) * kstep;
            const char* a3 = a2 + kstepA; const char* b3 = b2 + kstep;
            if (last && has_next) S.a_ready(nxt);
            if constexpr (SP2) {
            PG8_LDB(B0, 0, 0); PG8_LDB(B1, 0, 1); PG8_SCHED; PG8_LDA(At, 0, 0); PG8_STAGE_A(PG8_SA(1, 1), a1, 1, false);
            PG8_WAIT_V(8); PG8_WAIT_L(0); PG8_BAR; PG8_MMA0(0, 0, At, B0, first); PG8_MMA0(0, 1, At, B1, first); PG8_BAR; PG8_SCHED;
            PG8_LDA(At, 0, 1); PG8_STAGE_B(PG8_SB(0, 0), b2, 0); PG8_STAGE_B(PG8_SB(0, 1), b2, 1); PG8_STAGE_A(PG8_SA(0, 0), a2, 0, last);
            PG8_WAIT_V(8); PG8_WAIT_L(0); PG8_BAR; PG8_MMA0(1, 0, At, B0, first); PG8_MMA0(1, 1, At, B1, first); PG8_BAR; PG8_SCHED;
            PG8_LDB(B0, 1, 0); PG8_LDB(B1, 1, 1); PG8_SCHED; PG8_LDA(At, 1, 0); PG8_STAGE_A(PG8_SA(0, 1), a2, 1, last);
            PG8_WAIT_V(8); PG8_WAIT_L(0); PG8_BAR; PG8_MMA(0, 0, At, B0); PG8_MMA(0, 1, At, B1); PG8_BAR; PG8_SCHED;
            PG8_LDA(At, 1, 1); PG8_STAGE_B(PG8_SB(1, 0), b3, 0); PG8_STAGE_B(PG8_SB(1, 1), b3, 1); PG8_STAGE_A(PG8_SA(1, 0), a3, 0, last);
            PG8_WAIT_V(8); PG8_WAIT_L(0); PG8_BAR; PG8_MMA(1, 0, At, B0); PG8_MMA(1, 1, At, B1); PG8_BAR; PG8_SCHED;
            } else {
            PG8_LDB(B0, 0, 0); PG8_SCHED; PG8_LDA(At, 0, 0); PG8_STAGE(PG8_SA(1, 1), a1 + hstep, voffA);
            PG8_WAIT_L(8); PG8_BAR; PG8_WAIT_L(0); PG8_MMA(0, 0, At, B0); PG8_BAR; PG8_SCHED;
            PG8_LDB(B1, 0, 1); PG8_STAGE_B(PG8_SB(0, 0), b2, 0);
            PG8_BAR; PG8_WAIT_L(0); PG8_MMA(0, 1, At, B1); PG8_BAR;
            PG8_LDA(At, 0, 1); PG8_STAGE(PG8_SA(0, 0), a2, voffA);
            PG8_BAR; PG8_WAIT_L(0); PG8_MMA(1, 0, At, B0); PG8_BAR; PG8_SCHED;
            PG8_STAGE_B(PG8_SB(0, 1), b2, 1);
            PG8_WAIT_V(6); PG8_BAR; PG8_MMA(1, 1, At, B1); PG8_BAR;
            PG8_LDB(B0, 1, 0); PG8_SCHED; PG8_LDA(At, 1, 0); PG8_STAGE(PG8_SA(0, 1), a2 + hstep, voffA);
            PG8_WAIT_L(8); PG8_BAR; PG8_WAIT_L(0); PG8_MMA(0, 0, At, B0); PG8_BAR; PG8_SCHED;
            PG8_LDB(B1, 1, 1); PG8_STAGE_B(PG8_SB(1, 0), b3, 0);
            PG8_BAR; PG8_WAIT_L(0); PG8_MMA(0, 1, At, B1); PG8_BAR;
            PG8_LDA(At, 1, 1); PG8_STAGE(PG8_SA(1, 0), a3, voffA);
            PG8_BAR; PG8_WAIT_L(0); PG8_MMA(1, 0, At, B0); PG8_BAR; PG8_SCHED;
            PG8_STAGE_B(PG8_SB(1, 1), b3, 1);
            PG8_WAIT_V(6); PG8_BAR; PG8_MMA(1, 1, At, B1); PG8_BAR;
            }
        }
        if constexpr (FP8) asm volatile("s_nop 15\n\ts_nop 15" ::: "memory");
        if constexpr (ALIGN_EPI) { if (wr == 0) PG8_BAR; }
        bool keep_acc = false;
        if constexpr (Epi::CHAIN) { if (cur.sel == 0) { E.mid(acc, cur, wr, wc, fr, fq); keep_acc = true; } else E(acc, cur, wr, wc, fr, fq, pre); S.done(cur); }
        else if constexpr (!Epi::AFTER_DRAIN) { E(acc, cur, wr, wc, fr, fq, pre); S.done(cur); }
        if (!has_next) break;
        if (!keep_acc && !C0) {
#pragma unroll
        for (int a = 0; a < 2; ++a)
#pragma unroll
            for (int b = 0; b < 2; ++b)
#pragma unroll
                for (int m = 0; m < 4; ++m)
#pragma unroll
                    for (int n = 0; n < 2; ++n) acc[a][b][m][n] = (f32x4){0.f, 0.f, 0.f, 0.f};
        }
        cur = nxt; cA = nA; cB = nB; ++ui;
#pragma unroll
        for (int h_ = 0; h_ < 2; ++h_)
#pragma unroll
            for (int i_ = 0; i_ < 2; ++i_) goffC[h_][i_] = goffN[h_][i_];
        if constexpr (ALIGN_EPI) { if (wr == 1) PG8_BAR; }
    }
    PG8_WAIT_V(0);
    if constexpr (!ALIGN_EPI) { if (wr == 0) PG8_BAR; }
    PG8_BAR;
    if constexpr (Epi::AFTER_DRAIN) { E.fused(acc, cur, wr, wc, fr, fq, lds, wid, lane); S.done(cur); }
#undef PG8_SA
#undef PG8_SB
#undef PG8_STAGE
#undef PG8_GOFF
#undef PG8_STAGE_A
#undef PG8_STAGE_B
#undef PG8_CAT2
#undef PG8_LDA
#undef PG8_LDB
#undef PG8_MMA
#undef PG8_MMA0
#undef PG8_MF_
#undef PG8_WAIT_V
#undef PG8_WAIT_L
#undef PG8_BAR
#undef PG8_SCHED
}
}
#include <hip/hip_bf16.h>
#include <cmath>
namespace attn_body {
using bf16=__hip_bfloat16;
using bf16x8=__attribute__((ext_vector_type(8)))short;
using s16x4=__attribute__((ext_vector_type(4)))short;
using f32x16=__attribute__((ext_vector_type(16)))float;
using u32x4=__attribute__((ext_vector_type(4)))unsigned;
constexpr int BATCH=4,NHEAD=8,NKVH=2,SEQ=8192,D=64,QP=NHEAD*D,KP=NKVH*D;
constexpr int NW=8,QBLK=32,QB=QBLK*NW,KVBLK=64,NQB=SEQ/QB;
constexpr int ATTN_UNIT_ROWS=QB;
__device__ __forceinline__ int crow(int r,int hi){return (r&3)+8*(r>>2)+4*hi;}
#define SBAR() __builtin_amdgcn_sched_barrier(0)
constexpr int NSLOT=3, SLOTB=8192;
constexpr int LDS_K=0, LDS_V=NSLOT*SLOTB, LDS_WS=2*NSLOT*SLOTB, LDS_OST=LDS_WS+NW*64*4, LDS_BYTES=LDS_OST+NW*4096;
constexpr float C2=0.125f*1.4426950408889634f;
__device__ __forceinline__ void glds16(const void*gsrc,unsigned lds_dst){unsigned keep;
  asm volatile("s_mov_b32 %0, m0\n\ts_mov_b32 m0, %2\n\ts_nop 0\n\tglobal_load_lds_dwordx4 %1, off\n\ts_mov_b32 m0, %0":"=&s"(keep):"v"(gsrc),"s"(lds_dst):"memory");}
__device__ __forceinline__ float max3f(float a,float b,float c){float r;asm("v_max3_f32 %0, %1, %2, %3":"=v"(r):"v"(a),"v"(b),"v"(c));return r;}
__device__ __forceinline__ float max2f(float a,float b){float r;asm("v_max_f32_e32 %0, %1, %2":"=v"(r):"v"(a),"v"(b));return r;}
__device__ __forceinline__ float fadd_s(float a,float b){float r;asm("v_add_f32_e32 %0, %1, %2":"=v"(r):"v"(a),"v"(b));return r;}
__device__ __forceinline__ float fsub_s(float a,float b){float r;asm("v_sub_f32_e32 %0, %1, %2":"=v"(r):"v"(a),"v"(b));return r;}
typedef float f32x2_t __attribute__((ext_vector_type(2))); typedef __bf16 bf16x2_t __attribute__((ext_vector_type(2)));
__device__ __forceinline__ unsigned cvtpk_s(float lo,float hi){f32x2_t v={lo,hi};bf16x2_t b=__builtin_convertvector(v,bf16x2_t);return __builtin_bit_cast(unsigned,b);}
#define WAIT_BAR(N) asm volatile("s_waitcnt vmcnt(" #N ") lgkmcnt(0)\n\ts_barrier":::"memory")

__device__ __forceinline__ void qkt(f32x16&p0,f32x16&p1,const char*Kslot,const bf16x8*qr,const f32x16&negm,int r32,int hi){
  const char*kb=Kslot+hi*1024+r32*16;
  #pragma unroll
  for(int d0=0;d0<4;++d0){
    const bf16x8 b0=*reinterpret_cast<const bf16x8*>(kb+d0*2048);
    const bf16x8 b1=*reinterpret_cast<const bf16x8*>(kb+d0*2048+512);
    if(d0==0){p0=__builtin_amdgcn_mfma_f32_32x32x16_bf16(b0,qr[0],negm,0,0,0);p1=__builtin_amdgcn_mfma_f32_32x32x16_bf16(b1,qr[0],negm,0,0,0);}
    else{p0=__builtin_amdgcn_mfma_f32_32x32x16_bf16(b0,qr[d0],p0,0,0,0);p1=__builtin_amdgcn_mfma_f32_32x32x16_bf16(b1,qr[d0],p1,0,0,0);}}
}
typedef __attribute__((address_space(3))) const char* lds_cptr;
typedef short v4i16_t __attribute__((ext_vector_type(4)));
__device__ __forceinline__ void kload8(bf16x8*kf,lds_cptr kp){
  kf[0]=*(const __attribute__((address_space(3))) bf16x8*)(kp);      kf[1]=*(const __attribute__((address_space(3))) bf16x8*)(kp+512);
  kf[2]=*(const __attribute__((address_space(3))) bf16x8*)(kp+2048); kf[3]=*(const __attribute__((address_space(3))) bf16x8*)(kp+2560);
  kf[4]=*(const __attribute__((address_space(3))) bf16x8*)(kp+4096); kf[5]=*(const __attribute__((address_space(3))) bf16x8*)(kp+4608);
  kf[6]=*(const __attribute__((address_space(3))) bf16x8*)(kp+6144); kf[7]=*(const __attribute__((address_space(3))) bf16x8*)(kp+6656);
}
__device__ __forceinline__ void kload2(bf16x8*kf,lds_cptr kp,int j){ kf[2*j]=*(const __attribute__((address_space(3))) bf16x8*)(kp+j*2048); kf[2*j+1]=*(const __attribute__((address_space(3))) bf16x8*)(kp+j*2048+512); }
__device__ __forceinline__ s16x4 vtr(lds_cptr p){ return __builtin_bit_cast(s16x4,__builtin_amdgcn_ds_read_tr16_b64_v4i16((__attribute__((address_space(3))) v4i16_t*)p)); }
__device__ __forceinline__ float rowmax(const f32x16&p0,const f32x16&p1){
  float a=max3f(p0[0],p0[1],p1[0]),b=max3f(p0[2],p0[3],p1[1]);a=max3f(a,p1[2],p1[3]);
  #pragma unroll
  for(int r=4;r<16;r+=4){a=max3f(a,p0[r],p0[r+1]);b=max3f(b,p0[r+2],p0[r+3]);a=max3f(a,p1[r],p1[r+1]);b=max3f(b,p1[r+2],p1[r+3]);}
  const float m=max2f(a,b);
  auto rr=__builtin_amdgcn_permlane32_swap(__float_as_uint(m),__float_as_uint(m),false,false);
  return max2f(__uint_as_float(rr[0]),__uint_as_float(rr[1]));
}
__device__ __forceinline__ void pv(f32x16*o,int vb,bf16x8 pa0,bf16x8 pa1,bf16x8 pa2,bf16x8 pa3){
  #pragma unroll
  for(int d0=0;d0<2;++d0){s16x4 lo[4],hi[4];
    #pragma unroll
    for(int ks=0;ks<4;++ks){
      asm volatile("ds_read_b64_tr_b16 %0,%1 offset:%c2":"=&v"(lo[ks]):"v"(vb),"i"(d0*4096+ks*1024):"memory");
      asm volatile("ds_read_b64_tr_b16 %0,%1 offset:%c2":"=&v"(hi[ks]):"v"(vb),"i"(d0*4096+ks*1024+512):"memory");}
    asm volatile("s_waitcnt lgkmcnt(0)":::"memory");SBAR();
    #define PK(k) (bf16x8){lo[k][0],lo[k][1],lo[k][2],lo[k][3],hi[k][0],hi[k][1],hi[k][2],hi[k][3]}
    o[d0]=__builtin_amdgcn_mfma_f32_32x32x16_bf16(pa0,PK(0),o[d0],0,0,0);
    o[d0]=__builtin_amdgcn_mfma_f32_32x32x16_bf16(pa1,PK(1),o[d0],0,0,0);
    o[d0]=__builtin_amdgcn_mfma_f32_32x32x16_bf16(pa2,PK(2),o[d0],0,0,0);
    o[d0]=__builtin_amdgcn_mfma_f32_32x32x16_bf16(pa3,PK(3),o[d0],0,0,0);
    #undef PK
  }
}

#ifndef ATTN_STORE16
#define ATTN_STORE16(p,v) (*(u32x4*)(p)=(v))
#endif
template<int THRL> __device__ __forceinline__ void attn_unit(int b,int h,int qb,const bf16*Q,const bf16*__restrict__ K,const bf16*__restrict__ V,bf16*O,char*shm,const float mref){
  const int tid=threadIdx.x,lane=tid&63,r32=lane&31,hi=lane>>5; const int wid=__builtin_amdgcn_readfirstlane(tid>>6);
  const long rowbase=(long)b*SEQ; const int q0=qb*QB;
  const bf16*Qw=Q+(rowbase+q0+wid*QBLK)*QP+h*D;
  const int hk=h/(NHEAD/NKVH); const bf16*Kh=K+rowbase*KP+hk*D,*Vh=V+rowbase*KP+hk*D;
  const unsigned lds0=(unsigned)(uintptr_t)shm;
  float*wsf=(float*)(shm+LDS_WS)+wid*64;
  const bf16*ksrc=Kh+(long)lane*KP+wid*8;
  const bf16*vsrc=Vh+(long)(16*(wid&3)+(lane>>2))*KP+(wid>>2)*32+(lane&3)*8;
  const unsigned kdst=lds0+LDS_K+wid*1024, vdst=lds0+LDS_V+wid*1024;
  #define DMA_K(t,slot) glds16(ksrc+(long)(t)*KVBLK*KP,(unsigned)__builtin_amdgcn_readfirstlane(kdst+(slot)))
  #define DMA_V(t,slot) glds16(vsrc+(long)(t)*KVBLK*KP,(unsigned)__builtin_amdgcn_readfirstlane(vdst+(slot)))
  const int vb0=(int)(lds0+LDS_V)+((lane>>4)&1)*32+(lane&3)*8+(4*hi+((lane&15)>>2))*64;
  const char*Kbase=shm+LDS_K; bf16x8 kf[8];
  const lds_cptr shm3=(lds_cptr)shm; const lds_cptr kp0=shm3+LDS_K+hi*1024+r32*16; const lds_cptr vp0=shm3+LDS_V+((lane>>4)&1)*32+(lane&3)*8+(4*hi+((lane&15)>>2))*64;
  constexpr int NT=SEQ/KVBLK;
  DMA_K(0,0);DMA_V(0,0);DMA_K(1,SLOTB);
  bf16x8 qr[4];
  #pragma unroll
  for(int d0=0;d0<4;++d0)qr[d0]=*reinterpret_cast<const bf16x8*>(&Qw[(long)r32*QP+d0*16+hi*8]);
  float mhat=0.f,l_reg=0.f;f32x16 o[2];o[0]=f32x16{};o[1]=f32x16{};f32x16 negm=f32x16{};asm volatile("":"+v"(negm));
    #define CMASK(P0,P1,t) do{}while(0)
  bool resc=false;
  #define START(P0,P1) do{ resc=false; \
    { const float dl=mref; mhat=fadd_s(mhat,dl); \
      _Pragma("unroll") for(int r=0;r<16;++r){P0[r]=fsub_s(P0[r],dl);P1[r]=fsub_s(P1[r],dl);} \
      _Pragma("unroll") for(int r=0;r<16;++r)negm[r]=-mhat; asm volatile("":"+v"(negm)); } \
    _Pragma("unroll") for(int r=0;r<16;++r)P0[r]=__builtin_amdgcn_exp2f(P0[r]); }while(0)
  #define RESC() do{ if(resc){ asm volatile("s_waitcnt lgkmcnt(0)":::"memory"); \
      _Pragma("unroll") for(int d_=0;d_<2;++d_) _Pragma("unroll") for(int r=0;r<16;++r)o[d_][r]*=wsf[crow(r,hi)]; } }while(0)
  f32x16 pA0,pA1,pB0,pB1;
  int sl_prev=0,sl_cur=0,sl_next=SLOTB;
  #define ROT() do{sl_prev=sl_cur;sl_cur=sl_next;sl_next=(sl_next==(NSLOT-1)*SLOTB)?0:sl_next+SLOTB;}while(0)
  DMA_K(2,2*SLOTB);
  WAIT_BAR(3);
  qkt(pA0,pA1,Kbase,qr,negm,r32,hi);asm volatile("s_nop 15\n\ts_nop 7":"+v"(pA0),"+v"(pA1));CMASK(pA0,pA1,0);
  START(pA0,pA1);
  _Pragma("unroll") for(int r=0;r<16;++r)pA1[r]=__builtin_amdgcn_exp2f(pA1[r]);
  WAIT_BAR(0);
  DMA_K(3,0);DMA_V(1,SLOTB);
  ROT();
  kload8(kf,kp0+sl_cur);
  WAIT_BAR(2);
  s16x4 vlo[8],vhi[8]; u32x4 pw0,pw1,pw2,pw3;
  #define PKW(P,B) cvtpk_s(P[B],P[B+1])
  #define PAF(k) __builtin_bit_cast(bf16x8,pw##k)
  #define VFR(i) (bf16x8){vlo[i][0],vlo[i][1],vlo[i][2],vlo[i][3],vhi[i][0],vhi[i][1],vhi[i][2],vhi[i][3]}
  #define PIN(x) asm volatile("":"+v"(x))
  #define MX3(a,b,c) __builtin_fmaxf(__builtin_fmaxf((a),(b)),(c))
  #define GAPA(MF,A0,A1,A2,A3,W0,W1,PW) do{ MF; sacc+=A0; sacc+=A1; sacc+=A2; sacc+=A3; PIN(sacc); W0; W1; PIN(PW); SBAR(); }while(0)
  #define EX(v) __builtin_amdgcn_exp2f(v)
  #define GAPB(MF,X,B) do{ MF; X[B]=EX(X[B]); X[B+1]=EX(X[B+1]); X[B+2]=EX(X[B+2]); X[B+3]=EX(X[B+3]); PIN(X); SBAR(); }while(0)
  #define VRD(i) do{ vlo[i]=vtr(vp_+(((i)>>2)*4096+((i)&3)*1024)); vhi[i]=vtr(vp_+(((i)>>2)*4096+((i)&3)*1024+512)); }while(0)
  #define KRD(G,j) do{ if(G){ kload2(kf,kp0+sl_next,j); SBAR(); } }while(0)
  #define STEP(C0,C1,P0,P1,t,GK,GV,GL) do{ SBAR(); \
    const lds_cptr vp_=vp0+sl_prev; \
    VRD(0); SBAR(); float sacc=(P0[0]+P0[1]); \
    GAPA(C0=__builtin_amdgcn_mfma_f32_32x32x16_bf16(kf[0],qr[0],negm,0,0,0), P0[2],P0[3],P0[4],P0[5],     pw0[0]=PKW(P0,0), pw0[1]=PKW(P0,2), pw0); \
    VRD(4); SBAR(); GAPA(C1=__builtin_amdgcn_mfma_f32_32x32x16_bf16(kf[1],qr[0],negm,0,0,0), P0[6],P0[7],P0[8],P0[9],     pw0[2]=PKW(P0,4), pw0[3]=PKW(P0,6), pw0); \
    VRD(1); SBAR(); GAPA(C0=__builtin_amdgcn_mfma_f32_32x32x16_bf16(kf[2],qr[1],C0,0,0,0),   P0[10],P0[11],P0[12],P0[13], pw1[0]=PKW(P0,8), pw1[1]=PKW(P0,10), pw1); \
    VRD(5); SBAR(); GAPA(C1=__builtin_amdgcn_mfma_f32_32x32x16_bf16(kf[3],qr[1],C1,0,0,0),   P0[14],P0[15],P1[0],P1[1],   pw1[2]=PKW(P0,12),pw1[3]=PKW(P0,14), pw1); \
    VRD(2); SBAR(); GAPA(C0=__builtin_amdgcn_mfma_f32_32x32x16_bf16(kf[4],qr[2],C0,0,0,0),   P1[2],P1[3],P1[4],P1[5],     pw2[0]=PKW(P1,0), pw2[1]=PKW(P1,2), pw2); \
    VRD(6); SBAR(); GAPA(C1=__builtin_amdgcn_mfma_f32_32x32x16_bf16(kf[5],qr[2],C1,0,0,0),   P1[6],P1[7],P1[8],P1[9],     pw2[2]=PKW(P1,4), pw2[3]=PKW(P1,6), pw2); \
    VRD(3); SBAR(); GAPA(C0=__builtin_amdgcn_mfma_f32_32x32x16_bf16(kf[6],qr[3],C0,0,0,0),   P1[10],P1[11],P1[12],P1[13], pw3[0]=PKW(P1,8), pw3[1]=PKW(P1,10), pw3); \
    VRD(7); SBAR(); GAPA(C1=__builtin_amdgcn_mfma_f32_32x32x16_bf16(kf[7],qr[3],C1,0,0,0),   P1[14],P1[15],0.f,0.f,       pw3[2]=PKW(P1,12),pw3[3]=PKW(P1,14), pw3); \
    l_reg+=sacc; \
    if(GK){DMA_K((t)+3,sl_cur);} if(GV){DMA_V((t)+1,sl_next);} \
    CMASK(C0,C1,t); \
    resc=false;   \
    SBAR(); \
    GAPB(o[0]=__builtin_amdgcn_mfma_f32_32x32x16_bf16(PAF(0),VFR(0),o[0],0,0,0), C0,0); \
    GAPB(o[1]=__builtin_amdgcn_mfma_f32_32x32x16_bf16(PAF(0),VFR(4),o[1],0,0,0), C0,4); \
    KRD(GL,0); GAPB(o[0]=__builtin_amdgcn_mfma_f32_32x32x16_bf16(PAF(1),VFR(1),o[0],0,0,0), C0,8); \
    KRD(GL,1); GAPB(o[1]=__builtin_amdgcn_mfma_f32_32x32x16_bf16(PAF(1),VFR(5),o[1],0,0,0), C0,12); \
    KRD(GL,2); GAPB(o[0]=__builtin_amdgcn_mfma_f32_32x32x16_bf16(PAF(2),VFR(2),o[0],0,0,0), C1,0); \
    KRD(GL,3); GAPB(o[1]=__builtin_amdgcn_mfma_f32_32x32x16_bf16(PAF(2),VFR(6),o[1],0,0,0), C1,4); \
    GAPB(o[0]=__builtin_amdgcn_mfma_f32_32x32x16_bf16(PAF(3),VFR(3),o[0],0,0,0), C1,8); \
    GAPB(o[1]=__builtin_amdgcn_mfma_f32_32x32x16_bf16(PAF(3),VFR(7),o[1],0,0,0), C1,12); \
    }while(0)
  int t=1;
  #undef CMASK
  #define CMASK(P0,P1,t) do{}while(0)
  for(;t+5<NT;t+=2){
    STEP(pB0,pB1,pA0,pA1,t,true,true,true);     WAIT_BAR(2); RESC(); ROT();
    STEP(pA0,pA1,pB0,pB1,t+1,true,true,true);   WAIT_BAR(2); RESC(); ROT();
  }
  #undef CMASK
  #define CMASK(P0,P1,t) do{}while(0)
  #define ENDW(tt) do{ if((tt)+3<NT){WAIT_BAR(2);} else if((tt)+2<NT){WAIT_BAR(1);} else {WAIT_BAR(0);} }while(0)
  for(;t+1<NT;t+=2){
    STEP(pB0,pB1,pA0,pA1,t,(t+3<NT),(t+1<NT),(t+1<NT));       ENDW(t);   RESC(); ROT();
    STEP(pA0,pA1,pB0,pB1,t+1,(t+4<NT),(t+2<NT),(t+2<NT));     ENDW(t+1); RESC(); ROT();
  }
  STEP(pB0,pB1,pA0,pA1,NT-1,false,false,false); RESC();
  { float sacc=pB0[0]+pB0[1]; _Pragma("unroll") for(int r=2;r<16;++r)sacc+=pB0[r]; _Pragma("unroll") for(int r=0;r<16;++r)sacc+=pB1[r]; l_reg+=sacc;
    pw0=(u32x4){PKW(pB0,0),PKW(pB0,2),PKW(pB0,4),PKW(pB0,6)};pw1=(u32x4){PKW(pB0,8),PKW(pB0,10),PKW(pB0,12),PKW(pB0,14)};pw2=(u32x4){PKW(pB1,0),PKW(pB1,2),PKW(pB1,4),PKW(pB1,6)};pw3=(u32x4){PKW(pB1,8),PKW(pB1,10),PKW(pB1,12),PKW(pB1,14)};
    SBAR(); pv(o,vb0+sl_cur,PAF(0),PAF(1),PAF(2),PAF(3)); }
  #undef PKW
  #undef PAF
  #undef VFR
  #undef PIN
  #undef MX3
  #undef GAPA
  #undef GAPB
  #undef EX
  #undef VRD
  #undef KRD
  #undef STEP
  #undef ENDW
  {auto rr=__builtin_amdgcn_permlane32_swap(__float_as_uint(l_reg),__float_as_uint(l_reg),false,false);l_reg=__uint_as_float(rr[0])+__uint_as_float(rr[1]);}
  if(hi==0)wsf[32+r32]=l_reg;asm volatile("s_waitcnt lgkmcnt(0)":::"memory");
  float rli[16];
  #pragma unroll
  for(int r=0;r<16;++r)rli[r]=__builtin_amdgcn_rcpf(wsf[32+crow(r,hi)]);
  bf16*Ow=O+(rowbase+q0+wid*QBLK)*QP+h*D;
  { bf16*stg=(bf16*)(shm+LDS_OST)+wid*2048;
    #pragma unroll
    for(int r=0;r<16;++r){const int orow=crow(r,hi);
      #pragma unroll
      for(int d0=0;d0<2;++d0)stg[orow*64+d0*32+r32]=__float2bfloat16(o[d0][r]*rli[r]);}
    asm volatile("s_waitcnt lgkmcnt(0)":::"memory");
    #pragma unroll
    for(int i=0;i<4;++i){const int row=i*8+(lane>>3),ch=lane&7; const u32x4 v=*(const u32x4*)(stg+row*64+ch*8); ATTN_STORE16(Ow+(long)row*QP+ch*8,v);} }
  asm volatile("s_waitcnt lgkmcnt(0)\n\ts_barrier":::"memory");
  #undef DMA_K
  #undef DMA_V
  #undef CMASK
  #undef START
  #undef RESC
  #undef ROT
}
constexpr int ATTN_LDS_BYTES=LDS_BYTES;
struct AttnTensors { const bf16* Q; const bf16* K; const bf16* V; bf16* O; float mref; };
struct AttnUnit { int bh; int qb; };
struct StaticOrder {
  int vcu,per;
  __device__ __forceinline__ explicit StaticOrder(int grid,int vcu_):vcu(vcu_),per((BATCH*NHEAD*NQB+grid-1)/grid){}
  __device__ __forceinline__ bool next(int i,AttnUnit&u)const{ if(i>=per)return false; const int U=vcu*per+i; if(U>=BATCH*NHEAD*NQB)return false; u.bh=U/NQB; u.qb=U%NQB; return true; }
  __device__ __forceinline__ void a_ready(const AttnUnit&)const{}
  __device__ __forceinline__ void done(const AttnUnit&)const{}
};
typedef int i32x8v __attribute__((ext_vector_type(8)));
typedef int i32x4v __attribute__((ext_vector_type(4)));
constexpr int S8=4096, NS8=8, L8_K=0, L8_V=NS8*S8, L8_WS=2*NS8*S8, L8_OST=L8_WS+NW*64*4, L8_BYTES=L8_OST+NW*4096;
__device__ __forceinline__ unsigned pknorm16(float a,float b){ typedef unsigned short u16x2 __attribute__((ext_vector_type(2))); const u16x2 r=__builtin_amdgcn_cvt_pknorm_u16(a,b); return (unsigned)r[0]|((unsigned)r[1]<<16); }
__device__ __forceinline__ int pk4_fp8_over(int w,float a,float b,float c,float d){w=__builtin_amdgcn_cvt_pk_fp8_f32(a,b,w,false);w=__builtin_amdgcn_cvt_pk_fp8_f32(c,d,w,true);return w;}
__device__ __forceinline__ unsigned pk4_fp8(float a,float b,float c,float d){int w=0;w=__builtin_amdgcn_cvt_pk_fp8_f32(a,b,w,false);w=__builtin_amdgcn_cvt_pk_fp8_f32(c,d,w,true);return (unsigned)w;}
#define MFMA8_NEW(D_,A_,B_,C_,SA_,SB_) asm volatile("v_mfma_scale_f32_32x32x64_f8f6f4 %0, %1, %2, %3, %4, %5 op_sel_hi:[0,0,0]":"=&v"(D_):"v"(A_),"v"(B_),"v"(C_),"v"(SA_),"v"(SB_))
#define MFMA8_ACC(D_,A_,B_,SA_,SB_) asm volatile("v_mfma_scale_f32_32x32x64_f8f6f4 %0, %1, %2, %0, %3, %4 op_sel_hi:[0,0,0]":"+v"(D_):"v"(A_),"v"(B_),"v"(SA_),"v"(SB_))
struct XposeJob { const unsigned short* src; unsigned short* dst; int ld_src, ld_dst, ncb; };
__device__ __forceinline__ void xpose_item(const XposeJob&J,int it,int lane){
  typedef unsigned u32x4x __attribute__((ext_vector_type(4)));
  const int cb=it&(J.ncb-1), mb=it/J.ncb, c0=cb*64+8*(lane>>3), m0=mb*64+8*(lane&7);
  const unsigned short*src=J.src+(size_t)c0*J.ld_src+m0;
  u32x4x R[8];
  #pragma unroll
  for(int r=0;r<8;++r)R[r]=*(const u32x4x*)(src+(size_t)r*J.ld_src);
  #pragma unroll
  for(int j=0;j<8;++j){ u32x4x o;
    #pragma unroll
    for(int w=0;w<4;++w)o[w]=__builtin_amdgcn_perm(R[2*w+1][j>>1],R[2*w][j>>1],(j&1)?0x07060302u:0x05040100u);
    *(u32x4x*)(J.dst+(size_t)(m0+j)*J.ld_dst+c0)=o; }
}
__device__ __forceinline__ void attn_unit8(int b,int h,int qb,const unsigned char*Q8,const unsigned char*K8,const unsigned char*VT8,bf16*O,char*shm,const float m0,const XposeJob&XJ,int xitem){
  int tid_=threadIdx.x; asm volatile("":"+v"(tid_));
  const int tid=tid_,lane=tid&63,r32=lane&31,hi=lane>>5; const int wid=__builtin_amdgcn_readfirstlane(tid>>6);
  const long rowbase=(long)b*SEQ; const int q0=qb*QB; const int hk=h/(NHEAD/NKVH);
  constexpr int NT=SEQ/KVBLK;
  const unsigned lds0=(unsigned)(uintptr_t)shm;

  const unsigned char*qp=Q8+(size_t)(rowbase+q0+wid*QBLK+r32)*QP+h*D+32*hi;
  const i32x4v qlo=*(const i32x4v*)qp, qhi=*(const i32x4v*)(qp+16);
  i32x8v qf=__builtin_shufflevector(qlo,qhi,0,1,2,3,4,5,6,7);
  asm volatile("":"+v"(qf));
  const int pc=wid&3, hip=pc>>1, ch=pc&1;
  const unsigned char*ksrc=K8+(size_t)(rowbase+lane)*KP+hk*D+32*hip+16*ch;
  const unsigned char*vsrc=VT8+((size_t)(b*NT)*NKVH+hk)*4096+(size_t)(hip*64+lane)*32+16*ch;
  const unsigned mydst=lds0+(wid<4?L8_K:L8_V)+pc*1024;
  #define DMA8(t,slot) do{ if(wid<4) glds16(ksrc+(size_t)(t)*KVBLK*KP,(unsigned)__builtin_amdgcn_readfirstlane(mydst+(slot)*S8)); \
                           else glds16(vsrc+(size_t)(t)*NKVH*4096,(unsigned)__builtin_amdgcn_readfirstlane(mydst+(slot)*S8)); }while(0)
  const lds_cptr shm3=(lds_cptr)shm;
  const lds_cptr kfp=shm3+L8_K+hi*2048+r32*16;
  const lds_cptr vfp=shm3+L8_V+hi*2048+r32*16;
  f32x16 negm;
  #pragma unroll
  for(int r=0;r<16;++r)negm[r]=(-8.0f*m0+56.16f)*(1.0f/256.0f);
  const int sV=0x7d7d7d7d, s1=0x7f7f7f7f, sK=0x77777777;
  i32x8v ones; { const int onev=(((lane>>4)&1)==((lane>>3)&1))?0x38383838:0;
  #pragma unroll
  for(int i=0;i<8;++i)ones[i]=onev; }
  asm volatile("":"+v"(ones));
  typedef float f32x4s __attribute__((ext_vector_type(4)));
  f32x4s lsum=f32x4s{}; f32x16 o[2]; o[0]=f32x16{}; o[1]=f32x16{};
  #define KFRAG(A0,A1,SLOT) do{ const lds_cptr kp_=kfp+(SLOT)*S8; \
      const i32x4v x0=*(const __attribute__((address_space(3))) i32x4v*)(kp_), x1=*(const __attribute__((address_space(3))) i32x4v*)(kp_+1024); A0=__builtin_shufflevector(x0,x1,0,1,2,3,4,5,6,7); \
      const i32x4v y0=*(const __attribute__((address_space(3))) i32x4v*)(kp_+512), y1=*(const __attribute__((address_space(3))) i32x4v*)(kp_+1536); A1=__builtin_shufflevector(y0,y1,0,1,2,3,4,5,6,7); }while(0)
  #define VFRAG(A0,A1,SLOT) do{ const lds_cptr vp_=vfp+(SLOT)*S8; \
      const i32x4v x0=*(const __attribute__((address_space(3))) i32x4v*)(vp_), x1=*(const __attribute__((address_space(3))) i32x4v*)(vp_+1024); A0=__builtin_shufflevector(x0,x1,0,1,2,3,4,5,6,7); \
      const i32x4v y0=*(const __attribute__((address_space(3))) i32x4v*)(vp_+512), y1=*(const __attribute__((address_space(3))) i32x4v*)(vp_+1536); A1=__builtin_shufflevector(y0,y1,0,1,2,3,4,5,6,7); }while(0)
  #define CHUNK8(PQ,S_,W0_,H_) do{ { const int w=(H_); \
      const unsigned a0=pknorm16(S_[4*w],S_[4*w+1]), a1=pknorm16(S_[4*w+2],S_[4*w+3]), b0=pknorm16(S_[8+4*w],S_[8+4*w+1]), b1=pknorm16(S_[8+4*w+2],S_[8+4*w+3]); \
      PQ[(W0_)+w]=(int)__builtin_amdgcn_perm(a1,a0,0x07050301u); PQ[(W0_)+2+w]=(int)__builtin_amdgcn_perm(b1,b0,0x07050301u); } __builtin_amdgcn_sched_barrier(0); }while(0)
  #define STEP8(TT,KS2,VS0,UA0,UA1,LA0,LA1,S0,S1,N0,N1,v0,v1,W0,W1,PQ,PP) do{ \
    __builtin_amdgcn_sched_barrier(0); \
    if((TT)+1<NT){ MFMA8_NEW(N0,UA0,qf,negm,sK,s1); } \
    if((TT)+2<NT){ KFRAG(LA0,LA1,KS2); }                                                     \
    VFRAG(W0,W1,VS0);                                                                        \
      \
    asm volatile("":"+v"(S0)); CHUNK8(PQ,S0,0,0);                          \
    if((TT)+1<NT){ MFMA8_NEW(N1,UA1,qf,negm,sK,s1); } \
    asm volatile("":"+v"(S0)); CHUNK8(PQ,S0,0,1); \
    MFMA8_ACC(o[0],PP,v0,s1,sV); \
    asm volatile("":"+v"(S1)); CHUNK8(PQ,S1,4,0); \
    MFMA8_ACC(o[1],PP,v1,s1,sV); \
    asm volatile("":"+v"(S1)); CHUNK8(PQ,S1,4,1); \
    asm volatile("v_mfma_scale_f32_16x16x128_f8f6f4 %0, %1, %2, %0, %3, %3 op_sel_hi:[0,0,0]":"+v"(lsum):"v"(PP),"v"(ones),"v"(s1)); \
    if((TT)+1<NT){ asm volatile("":"+v"(N0),"+v"(N1)); } }while(0)
  if(wid<4){ DMA8(0,0); DMA8(1,1); DMA8(2,2); DMA8(3,3); DMA8(4,4); DMA8(5,5); DMA8(6,6); } else { DMA8(0,0); DMA8(1,1); DMA8(2,2); DMA8(3,3); DMA8(4,4); }
  if(xitem>=0) xpose_item(XJ,xitem,lane);
  asm volatile("s_waitcnt vmcnt(4) lgkmcnt(0)\n\ts_barrier":::"memory");
  f32x16 S0,S1,T0,T1; i32x8v xa0,xa1,ya0,ya1; i32x8v PA8={},PB8={};
  { KFRAG(ya0,ya1,0); MFMA8_NEW(S0,ya0,qf,negm,sK,s1); MFMA8_NEW(S1,ya1,qf,negm,sK,s1); }
  KFRAG(xa0,xa1,1);
  i32x8v vx0,vx1,vy0,vy1; VFRAG(vx0,vx1,0);
  asm volatile("s_nop 15\n\ts_nop 15\n\ts_nop 15":"+v"(S0),"+v"(S1));
  const bool kw=wid<4;
  const unsigned char*dsrc=kw?(ksrc+(size_t)7*KVBLK*KP):(vsrc+(size_t)5*NKVH*4096);
  static_assert(KVBLK*KP==8192&&NKVH*4096==8192,"K and V streams advance by the same 8 KiB per tile");
  static_assert(NS8==8,"slot constants below are for 8-slot rings");
  #define DSLOT(a_,b_) (unsigned)__builtin_amdgcn_readfirstlane(mydst+(kw?(a_):(b_))*S8)
  const unsigned dA0=DSLOT(7,5), dA1=DSLOT(0,6);
  const unsigned dB0=DSLOT(1,7), dB1=DSLOT(2,0);
  const unsigned dC0=DSLOT(3,1), dC1=DSLOT(4,2);
  const unsigned dD0=DSLOT(5,3), dD1=DSLOT(6,4);
  #undef DSLOT
  #define PAIR8(TT,SL,D0,D1) do{ asm volatile("s_waitcnt vmcnt(3)\n\ts_barrier":::"memory"); \
    STEP8(TT,((SL)+2)%NS8,(SL),xa0,xa1,ya0,ya1,S0,S1,T0,T1,vx0,vx1,vy0,vy1,PA8,PB8); \
    glds16(dsrc,D0); glds16(dsrc+8192,D1); dsrc+=16384; \
    STEP8((TT)+1,((SL)+3)%NS8,((SL)+1)%NS8,ya0,ya1,xa0,xa1,T0,T1,S0,S1,vy0,vy1,vx0,vx1,PB8,PA8); }while(0)
  static_assert(NT==128,"the peeled tail below is written for 128 tiles");
  #pragma unroll 1
  for(int t=0;t<120;t+=8){ PAIR8(t,0,dA0,dA1); PAIR8(t+2,2,dB0,dB1); PAIR8(t+4,4,dC0,dC1); PAIR8(t+6,6,dD0,dD1); }
  #undef PAIR8
  #define PAIR8T(TT,SL,WAITS,ISSUE) do{ asm volatile(WAITS "\n\ts_barrier":::"memory"); \
    STEP8(TT,((SL)+2)%NS8,(SL),xa0,xa1,ya0,ya1,S0,S1,T0,T1,vx0,vx1,vy0,vy1,PA8,PB8); \
    ISSUE; \
    STEP8((TT)+1,((SL)+3)%NS8,((SL)+1)%NS8,ya0,ya1,xa0,xa1,T0,T1,S0,S1,vy0,vy1,vx0,vx1,PB8,PA8); }while(0)
  PAIR8T(120,0,"s_waitcnt vmcnt(3)",{ glds16(dsrc,dA0); if(!kw){ glds16(dsrc+8192,dA1); } dsrc+=16384; });
  PAIR8T(122,2,"s_waitcnt vmcnt(2)",{ if(!kw){ glds16(dsrc,dB0); } });
  PAIR8T(124,4,"s_waitcnt vmcnt(0)",{});
  PAIR8T(126,6,"s_waitcnt vmcnt(0)",{});
  __builtin_amdgcn_sched_barrier(0);
  asm volatile("s_nop 3":"+v"(PB8));
  MFMA8_ACC(o[0],PB8,vx0,s1,sV); MFMA8_ACC(o[1],PB8,vx1,s1,sV);
  asm volatile("v_mfma_scale_f32_16x16x128_f8f6f4 %0, %1, %2, %0, %3, %3 op_sel_hi:[0,0,0]":"+v"(lsum):"v"(PB8),"v"(ones),"v"(s1));
  #undef CHUNK8
  #undef PAIR8T
  #undef STEP8
  #undef KFRAG
  #undef VFRAG
  asm volatile("s_nop 15\n\ts_nop 15\n\ts_nop 15":"+v"(o[0]),"+v"(o[1]),"+v"(lsum));
  float*wsf=(float*)(shm+L8_WS)+wid*64;
  if((lane&7)==0){
    #pragma unroll
    for(int v=0;v<4;++v)wsf[32+4*(lane>>4)+v+((lane&8)?16:0)]=lsum[v]; }
  asm volatile("s_waitcnt lgkmcnt(0)":::"memory");
  float rli[16];
  #pragma unroll
  for(int r=0;r<16;++r)rli[r]=__builtin_amdgcn_rcpf(wsf[32+crow(r,hi)]);
  bf16*Ow=O+(rowbase+q0+wid*QBLK)*QP+h*D;
  { bf16*stg=(bf16*)(shm+L8_OST)+wid*2048;
    #pragma unroll
    for(int r=0;r<16;++r){const int orow=crow(r,hi);
      #pragma unroll
      for(int d0=0;d0<2;++d0)stg[orow*64+d0*32+r32]=__float2bfloat16(o[d0][r]*rli[r]);}
    asm volatile("s_waitcnt lgkmcnt(0)":::"memory");
    #pragma unroll
    for(int i=0;i<4;++i){const int row=i*8+(lane>>3),chn=lane&7; const u32x4 v=*(const u32x4*)(stg+row*64+chn*8); ATTN_STORE16(Ow+(long)row*QP+chn*8,v);} }
  asm volatile("s_waitcnt lgkmcnt(0)\n\ts_barrier":::"memory");
  #undef DMA8
}
struct AttnTensors8 { const unsigned char* Q8; const unsigned char* K8; const unsigned char* VT8; bf16* O; float m0; XposeJob xj; int xitems, xwave, xnwaves; };
template<class Sched> __device__ __forceinline__ void attn_phase8(char*lds,const AttnTensors8&T,const Sched&S){
  AttnUnit u; int done=0;
  for(int i=0;S.next(i,u);++i){ const int xi=T.xwave+i*T.xnwaves; attn_unit8(u.bh/NHEAD,u.bh%NHEAD,u.qb,T.Q8,T.K8,T.VT8,T.O,lds,T.m0,T.xj,xi<T.xitems?xi:-1); done=i+1; }
  for(int xi=T.xwave+done*T.xnwaves;xi<T.xitems;xi+=T.xnwaves) xpose_item(T.xj,xi,(int)(threadIdx.x&63));
}
#undef MFMA8_NEW
#undef MFMA8_ACC
template<class Sched,int THRL=8> __device__ __forceinline__ void attn_phase(char*lds,const AttnTensors&T,const Sched&S){
  AttnUnit u;
  for(int i=0;S.next(i,u);++i){ S.a_ready(u); attn_unit<THRL>(u.bh/NHEAD,u.bh%NHEAD,u.qb,T.Q,T.K,T.V,T.O,lds,T.mref); S.done(u); }
}
#undef SBAR
#undef WAIT_BAR
}
#define GAS __attribute__((address_space(1)))
#define LAS __attribute__((address_space(3)))
typedef unsigned short bf16;
typedef unsigned v4u __attribute__((ext_vector_type(4)));
typedef float f32x4 __attribute__((ext_vector_type(4)));
typedef short bf16x8 __attribute__((ext_vector_type(8)));
typedef GAS unsigned gu32;
typedef GAS unsigned long long gu64;
#define RLX_AGENT __ATOMIC_RELAXED, __HIP_MEMORY_SCOPE_AGENT
#define LDS_WAIT() asm volatile("s_waitcnt lgkmcnt(0)" ::: "memory")
#define VM_WAIT() asm volatile("s_waitcnt vmcnt(0)" ::: "memory")
__device__ __forceinline__ unsigned long long rt() { return __builtin_amdgcn_s_memrealtime(); }

#define XB_TMO      128
#define XB_XCNT(j)  (256  + 64 * (j))
#define XB_XSUB(j)  (1280 + 64 * (j))
#define XB_XGEN(j)  (2304 + 64 * (j))
#define XB_TOP      3328
#define XB_TOPGEN   3392
#define XCD_BAR_WORDS 3456
#define XB_SPIN_CAP (1u << 18)

__device__ __forceinline__ unsigned xb_ld(unsigned* p)              { return __hip_atomic_load(p, __ATOMIC_RELAXED, __HIP_MEMORY_SCOPE_AGENT); }
__device__ __forceinline__ unsigned xb_add(unsigned* p, unsigned v) { return __hip_atomic_fetch_add(p, v, __ATOMIC_RELAXED, __HIP_MEMORY_SCOPE_AGENT); }
__device__ __forceinline__ unsigned xb_xcc_id() { return (unsigned)__builtin_amdgcn_s_getreg((3 << 11) | 20) & 0xFu; }
#define XB_SPIN(cond, bar) do { unsigned _sp = 0; while (cond) { __builtin_amdgcn_s_sleep(1); \
    if ((++_sp & 255u) == 0u) { if (xb_ld(&(bar)[XB_TMO])) break; if (_sp > XB_SPIN_CAP) { atomicAdd(&(bar)[XB_TMO], 1u); break; } } } } while (0)

struct XcdBarrier {
    unsigned* bar; unsigned x;
    volatile LAS unsigned* st;
};

__device__ __forceinline__ XcdBarrier xcd_barrier_post(unsigned* bar, volatile LAS unsigned* st) {
    XcdBarrier b; b.bar = bar; b.x = xb_xcc_id(); b.st = st;
    if (threadIdx.x == 0) (void)xb_add(&bar[XB_XCNT(b.x)], 1u);
    return b;
}
__device__ __forceinline__ void xcd_barrier_complete(unsigned* bar, unsigned x, unsigned& nloc, unsigned& nx) {
    const unsigned G = gridDim.x * gridDim.y * gridDim.z;
    unsigned sum, cnt, mine, sp = 0u;
    for (;;) {
        sum = 0u; cnt = 0u; mine = 0u;
#pragma unroll
        for (unsigned j = 0; j < 16; ++j) { const unsigned c = xb_ld(&bar[XB_XCNT(j)]); sum += c; cnt += (c > 0u) ? 1u : 0u; mine = (j == x) ? c : mine; }
        if (sum == G) break;
        __builtin_amdgcn_s_sleep(1);
        if ((++sp & 255u) == 0u) { if (xb_ld(&bar[XB_TMO])) break; if (sp > XB_SPIN_CAP) { atomicAdd(&bar[XB_TMO], 1u); break; } }
    }
    nloc = mine > 0u ? mine : 1u; nx = cnt > 0u ? cnt : 1u;
}

__device__ __forceinline__ void xcd_barrier(const XcdBarrier& b) {
    asm volatile("s_waitcnt vmcnt(0)" ::: "memory");
    __syncthreads();
    if (threadIdx.x == 0) {
        unsigned* bar = b.bar;
        __builtin_amdgcn_s_waitcnt(0);
        unsigned nloc = b.st[0], nx = b.st[1];
        if (nloc == 0u) { xcd_barrier_complete(bar, b.x, nloc, nx); b.st[0] = nloc; b.st[1] = nx; }
        const unsigned old = xb_add(&bar[XB_XSUB(b.x)], 1u);
        const unsigned gen = old / nloc;
        if (old + 1u == (gen + 1u) * nloc) {
            __builtin_amdgcn_fence(__ATOMIC_RELEASE, "agent");
            asm volatile("s_waitcnt vmcnt(0)" ::: "memory");
            const unsigned og = xb_add(&bar[XB_TOP], 1u);
            const unsigned tg = og / nx;
            if (og + 1u == (tg + 1u) * nx) xb_add(&bar[XB_TOPGEN], 1u);
            else XB_SPIN(xb_ld(&bar[XB_TOPGEN]) == tg, bar);
            __builtin_amdgcn_fence(__ATOMIC_ACQUIRE, "agent");
            xb_add(&bar[XB_XGEN(b.x)], 1u);
            asm volatile("s_waitcnt vmcnt(0)" ::: "memory");
        } else {
            XB_SPIN(xb_ld(&bar[XB_XGEN(b.x)]) == gen, bar);
            __builtin_amdgcn_fence(__ATOMIC_ACQUIRE, "agent");
            asm volatile("s_waitcnt vmcnt(0)" ::: "memory");
        }
    }
    __syncthreads();
}
#define HD __device__ __forceinline__
#define FFT_ASM_CMUL 1
#define FFT_DEVICE 1
#define OPAQUE(x) asm volatile("" : "+v"(x))
typedef _Float16 hc __attribute__((ext_vector_type(2)));
typedef float cf __attribute__((ext_vector_type(2)));
HD int fft_pad(int i) { return i + ((i >> 6) << 2); }
constexpr int FFT_N = 16384;
constexpr int FFT_LDS_ELEMS = FFT_N + (FFT_N >> 6) * 4;
constexpr int TW_A = 0, TW_B = 16384, TW_C = 16384 + 1024, TW_ELEMS = 16384 + 1024 + 64;
#ifdef FFT_ASM_CMUL
HD hc hmul(hc a, hc b) { hc t, r;
    asm("v_pk_mul_f16 %0, %1, %2 op_sel:[0,0] op_sel_hi:[0,1]" : "=v"(t) : "v"(a), "v"(b));
    asm("v_pk_fma_f16 %0, %1, %2, %3 op_sel:[1,1,0] op_sel_hi:[1,0,1] neg_lo:[1,0,0] neg_hi:[0,0,0]" : "=v"(r) : "v"(a), "v"(b), "v"(t));
    return r; }
HD hc hmulc(hc a, hc b) { hc t, r;
    asm("v_pk_mul_f16 %0, %1, %2 op_sel:[0,0] op_sel_hi:[0,1] neg_lo:[0,0] neg_hi:[0,1]" : "=v"(t) : "v"(a), "v"(b));
    asm("v_pk_fma_f16 %0, %1, %2, %3 op_sel:[1,1,0] op_sel_hi:[1,0,1] neg_lo:[0,0,0] neg_hi:[0,0,0]" : "=v"(r) : "v"(a), "v"(b), "v"(t));
    return r; }
HD hc add_mi(hc a, hc b) { hc r; asm("v_pk_add_f16 %0, %1, %2 op_sel:[0,1] op_sel_hi:[1,0] neg_lo:[0,0] neg_hi:[0,1]" : "=v"(r) : "v"(a), "v"(b)); return r; }
HD hc sub_mi(hc a, hc b) { hc r; asm("v_pk_add_f16 %0, %1, %2 op_sel:[0,1] op_sel_hi:[1,0] neg_lo:[0,1] neg_hi:[0,0]" : "=v"(r) : "v"(a), "v"(b)); return r; }
#else
HD hc hmul(hc a, hc b) { const hc t = hc{(_Float16)(a.x * b.x), (_Float16)(a.x * b.y)}; return hc{(_Float16)(-a.y * b.y + t.x), (_Float16)(a.y * b.x + t.y)}; }
HD hc hmulc(hc a, hc b) { const hc t = hc{(_Float16)(a.x * b.x), (_Float16)(-(a.x * b.y))}; return hc{(_Float16)(a.y * b.y + t.x), (_Float16)(a.y * b.x + t.y)}; }
HD hc add_mi(hc a, hc b) { return hc{(_Float16)(a.x + b.y), (_Float16)(a.y - b.x)}; }
HD hc sub_mi(hc a, hc b) { return hc{(_Float16)(a.x - b.y), (_Float16)(a.y + b.x)}; }
#endif
typedef _Float16 hc2v __attribute__((ext_vector_type(4)));
#ifdef FFT_DEVICE
HD __attribute__((address_space(3))) hc2v* zb2(__attribute__((address_space(3))) hc* p) { return (__attribute__((address_space(3))) hc2v*)p; }
#else
inline hc2v* zb2(hc* p) { return (hc2v*)p; }
#endif
template <bool INV> HD void dft4(hc& a0, hc& a1, hc& a2, hc& a3) {
    const hc t0 = a0 + a2, t1 = a0 - a2, t2 = a1 + a3, t3 = a1 - a3;
    a0 = t0 + t2; a2 = t0 - t2;
    if (!INV) { a1 = add_mi(t1, t3); a3 = sub_mi(t1, t3); } else { a1 = sub_mi(t1, t3); a3 = add_mi(t1, t3); }
}
template <bool INV> HD void dft16(hc (&x)[16]) {
#pragma unroll
    for (int m0 = 0; m0 < 4; ++m0) dft4<INV>(x[m0], x[4 + m0], x[8 + m0], x[12 + m0]);
    const float C1 = 0.92387953251128674f, S1 = 0.38268343236508977f, R2 = 0.70710678118654752f;
#define TW(r, c, s) { const hc w = hc{(_Float16)(c), (_Float16)(-(s))}; x[r] = INV ? hmulc(x[r], w) : hmul(x[r], w); }
    TW(5, C1, S1) TW(6, R2, R2) TW(7, S1, C1) TW(9, R2, R2) TW(10, 0.f, 1.f) TW(11, -R2, R2) TW(13, S1, C1) TW(14, -R2, R2) TW(15, -C1, -S1)
#undef TW
#pragma unroll
    for (int q1 = 0; q1 < 4; ++q1) dft4<INV>(x[4 * q1], x[4 * q1 + 1], x[4 * q1 + 2], x[4 * q1 + 3]);
}
template <int ST, int TS, class Z, class TT> HD void r16_fwd2(Z zb, TT tw) {
    hc x0[16], x1[16];
#pragma unroll
    for (int m = 0; m < 16; ++m) { const hc2v v = *zb2(zb + ST * m); x0[m] = hc{v.x, v.y}; x1[m] = hc{v.z, v.w}; }
    dft16<false>(x0); dft16<false>(x1);
    const hc sc = hc{(_Float16)0.0625f, (_Float16)0.0625f};
#pragma unroll
    for (int r = 0; r < 16; ++r) { const int q = (r >> 2) + 4 * (r & 3); hc y0, y1;
        if (q == 0) { y0 = x0[r] * sc; y1 = x1[r] * sc; }
        else { const hc2v t = *zb2(tw + TS * q); y0 = hmul(x0[r], hc{t.x, t.y}); y1 = hmul(x1[r], hc{t.z, t.w}); }
        *zb2(zb + ST * q) = hc2v{y0.x, y0.y, y1.x, y1.y}; }
}
template <int ST, int TS, class Z, class TT> HD void r16_inv2(Z zb, TT tw) {
    hc x0[16], x1[16];
    const hc sc = hc{(_Float16)0.0625f, (_Float16)0.0625f};
#pragma unroll
    for (int q = 0; q < 16; ++q) { const hc2v v = *zb2(zb + ST * q); const hc v0 = hc{v.x, v.y}, v1 = hc{v.z, v.w};
        if (q == 0) { x0[q] = v0 * sc; x1[q] = v1 * sc; }
        else { const hc2v t = *zb2(tw + TS * q); x0[q] = hmulc(v0, hc{t.x, t.y}); x1[q] = hmulc(v1, hc{t.z, t.w}); } }
    dft16<true>(x0); dft16<true>(x1);
#pragma unroll
    for (int r = 0; r < 16; ++r) { const int m = (r >> 2) + 4 * (r & 3); *zb2(zb + ST * m) = hc2v{x0[r].x, x0[r].y, x1[r].x, x1[r].y}; }
}
template <class Z, class TT> HD void fft_pass_fwd(Z z, TT tw, int tid, int stage) {
    OPAQUE(tid);
    const int bid = 2 * tid;
    if (stage == 0) r16_fwd2<1088, 1024>(z + fft_pad(bid), tw + TW_A + bid);
    else if (stage == 1) r16_fwd2<68, 64>(z + fft_pad((bid >> 6) * 1024 + (bid & 63)), tw + TW_B + (bid & 63));
    else r16_fwd2<4, 4>(z + fft_pad((bid >> 2) * 64 + (bid & 3)), tw + TW_C + (bid & 3));
}
template <class Z, class TT> HD void fft_pass_inv(Z z, TT tw, int tid, int stage) {
    OPAQUE(tid);
    const int bid = 2 * tid;
    if (stage == 0) r16_inv2<1088, 1024>(z + fft_pad(bid), tw + TW_A + bid);
    else if (stage == 1) r16_inv2<68, 64>(z + fft_pad((bid >> 6) * 1024 + (bid & 63)), tw + TW_B + (bid & 63));
    else r16_inv2<4, 4>(z + fft_pad((bid >> 2) * 64 + (bid & 3)), tw + TW_C + (bid & 3));
}
template <class Z> HD void fft_pass_d_fwd(Z z, int tid) {
    OPAQUE(tid);
    const hc q4 = hc{(_Float16)0.25f, (_Float16)0.25f};
#pragma unroll 1
    for (int r = 0; r < 8; ++r) { const int pb = fft_pad(4 * (tid + 512 * r));
        hc a0 = z[pb], a1 = z[pb + 1], a2 = z[pb + 2], a3 = z[pb + 3]; dft4<false>(a0, a1, a2, a3); z[pb] = a0 * q4; z[pb + 1] = a1 * q4; z[pb + 2] = a2 * q4; z[pb + 3] = a3 * q4; }
}
struct KPre { hc k[8][4]; };
HD void fft_dkd_prefetch(KPre& kp, const hc* K, int tid) {
#pragma unroll
    for (int r = 0; r < 8; ++r) { const int b4 = 4 * (tid + 512 * r);
#pragma unroll
        for (int i = 0; i < 4; ++i) kp.k[r][i] = K[b4 + i]; }
}
template <class Z> HD void fft_pass_dkd(Z z, const KPre& kp, int tid) {
    OPAQUE(tid);
#pragma unroll
    for (int r = 0; r < 8; ++r) { const int b4 = 4 * (tid + 512 * r); const int pb = fft_pad(b4);
        hc a0 = z[pb], a1 = z[pb + 1], a2 = z[pb + 2], a3 = z[pb + 3]; dft4<false>(a0, a1, a2, a3);
        a0 = hmul(a0, kp.k[r][0]); a1 = hmul(a1, kp.k[r][1]); a2 = hmul(a2, kp.k[r][2]); a3 = hmul(a3, kp.k[r][3]);
        dft4<true>(a0, a1, a2, a3); z[pb] = a0; z[pb + 1] = a1; z[pb + 2] = a2; z[pb + 3] = a3; }
}
constexpr int NWAVES = 8;
#ifndef MK_N_LAUNCHES
#define MK_N_LAUNCHES 1
#endif
constexpr int N_PHASES = 11;
constexpr int N_LAUNCHES = MK_N_LAUNCHES;

constexpr int NB = 4, T = 8192, D = 1024, M = NB * T;
constexpr int HW = 512, AW = 512, KVW = 128;
constexpr int INC = 4352, NHY = 1536, NREST = INC - NHY;
constexpr int PR_Q = 0, PR_K = 512, PR_V = 640, PR_GH = 768, PR_GA = 1792;
constexpr int NE = 32, TOPK = 4, FF = 1024, RB_MAX = 544, P_MAX = RB_MAX * 256;
constexpr float EPS = 1e-6f;
constexpr int TPB = 128;

constexpr size_t MiB = 1u << 20;
constexpr size_t WS_CTL = 0, CTL_ZERO_BYTES = 32 * 1024;
constexpr size_t WS_WIN = 1 * MiB;
constexpr size_t WS_WHU = 10 * MiB, WS_WAU = 11 * MiB, WS_WOUT = 12 * MiB;
constexpr size_t WS_WRT = 14 * MiB;
constexpr size_t WS_TOKROWS = 14 * MiB + 512 * 1024;
constexpr size_t WS_ROWGATE = 15 * MiB;
constexpr size_t WS_ENT = 16 * MiB;
constexpr size_t WS_SRC = 18 * MiB;
constexpr size_t WS_W1 = 19 * MiB;
constexpr size_t WS_W2 = 147 * MiB;
constexpr size_t WS_XN = 211 * MiB;
constexpr size_t WS_EARLY = 275 * MiB;
constexpr size_t WS_ZT = WS_EARLY;
constexpr size_t WS_PR = WS_ZT + 96 * MiB;
constexpr size_t WS_QO = WS_PR + 176 * MiB;
constexpr size_t WS_KB = WS_QO + 32 * MiB, WS_VB = WS_KB + 8 * MiB;
constexpr size_t WS_HT = WS_VB + 8 * MiB;
constexpr size_t WS_KSP = WS_HT + 64 * MiB;
constexpr size_t WS_Y1S = WS_KSP + 64 * MiB;
constexpr size_t WS_YHT = WS_Y1S + 16 * MiB;
constexpr size_t WS_YH = WS_YHT + 32 * MiB;
constexpr size_t WS_MG = WS_YH + 32 * MiB;
constexpr size_t WS_EARLY_END = WS_MG + 64 * MiB;
constexpr size_t WS_AO = WS_EARLY_END;
constexpr size_t WS_HB = WS_AO + 32 * MiB;
static_assert(WS_HB + 64 * MiB <= 1024 * MiB, "d_ws map");
constexpr size_t WS_XG = WS_EARLY;
constexpr size_t WS_H1 = WS_XG + 272 * MiB;
constexpr size_t WS_END = 1024 * MiB;
static_assert(WS_EARLY_END <= WS_END && WS_H1 + 272 * MiB <= WS_END && WS_H1 >= WS_PR + 176 * MiB, "d_ws map");
constexpr int CW_CNT = 64;
constexpr int CW_BAR = 4096;

constexpr int RING_OFF = 0, RING_BYTES = 139520;
constexpr int FFT_TW_OFF = 69632;
constexpr int LX_MISC = RING_BYTES;
constexpr int LX_RBE = LX_MISC + 256;
constexpr int LX_CNT = LX_RBE + 2304;
constexpr int LX_ENT = LX_CNT + 512;
constexpr int LX_RED = LX_ENT + TPB * 4 * 16;
constexpr int LX_GIDX = LX_RED + 256;
constexpr int GIDX_UNITS = 17;
constexpr int LDS_BYTES = LX_GIDX + GIDX_UNITS * 512;
static_assert(LDS_BYTES <= 163840, "LDS map");

struct Frame {
    LAS unsigned char* lds;
    volatile LAS unsigned* MISC;
    gu32* ctl;
    int tid, lane, wave, vcu, G;
    unsigned char* ws;
    const float* in[26]; float* out;
};
__device__ __forceinline__ float wave_sum(float v) {
#pragma unroll
    for (int o = 1; o < 64; o <<= 1) v += __shfl_xor(v, o);
    return v;
}
__device__ __forceinline__ unsigned pk2(float lo, float hi) { return pg8::cvt_pk_bf16(lo, hi); }
__device__ __forceinline__ float bflo(unsigned w) { return __uint_as_float(w << 16); }
__device__ __forceinline__ float bfhi(unsigned w) { return __uint_as_float(w & 0xffff0000u); }
__device__ __forceinline__ float bf1(unsigned short h) { return __uint_as_float((unsigned)h << 16); }
__device__ __forceinline__ float sin_rev(float r) { return __builtin_amdgcn_sinf(r); }
__device__ __forceinline__ float cos_rev(float r) { return __builtin_amdgcn_cosf(r); }

struct P0Item { const float* W; bf16* WT; int K, N, item, mode; };
__device__ __forceinline__ void p0_item_load(const P0Item& it, f32x4 (&v)[8], int lane) {
    const int nblk = it.N / 32, kb = it.item / nblk, nb = it.item % nblk, k0 = 64 * kb, n0 = 32 * nb;
    const float* src = it.W + (size_t)(k0 + 8 * (lane >> 3)) * it.N + n0 + 4 * (lane & 7);
#pragma unroll
    for (int i = 0; i < 8; ++i) v[i] = *(const GAS f32x4*)(src + (size_t)i * it.N);
}
template <int NOST>
__device__ __forceinline__ void p0_item_store(const P0Item& it, const f32x4 (&v)[8], int lane) {
    const int nblk = it.N / 32, kb = it.item / nblk, nb = it.item % nblk, k0 = 64 * kb, n0 = 32 * nb;
#pragma unroll
    for (int nn = 0; nn < 4; ++nn) { const int n = n0 + 4 * (lane & 7) + nn;
        v4u o; o.x = pk2(v[0][nn], v[1][nn]); o.y = pk2(v[2][nn], v[3][nn]); o.z = pk2(v[4][nn], v[5][nn]); o.w = pk2(v[6][nn], v[7][nn]);
        int dr;
        if (it.mode == 0) dr = n;
        else { const int jj = n >> 1; dr = (jj >> 7) * 256 + (n & 1) * 128 + (jj & 127); }
        if (!NOST) *(GAS v4u*)(it.WT + (size_t)dr * it.K + k0 + 8 * (lane >> 3)) = o; else asm volatile("" :: "v"(o), "v"(dr)); }
}
__device__ __forceinline__ unsigned cvt4_fp8(float a, float b, float c, float d) { int w = 0; w = __builtin_amdgcn_cvt_pk_fp8_f32(a, b, w, false); w = __builtin_amdgcn_cvt_pk_fp8_f32(c, d, w, true); return (unsigned)w; }
constexpr float WSCALE = 32.0f, ASCALE = 8.0f, HSCALE = 4.0f, YSCALE = 16.0f;
__device__ __forceinline__ void p0_item8_load(const P0Item& it, f32x4 (&v)[16], int lane) {
    const int nblk = it.N / 32, kb = it.item / nblk, nb = it.item % nblk, k0 = 128 * kb, n0 = 32 * nb;
    const float* src = it.W + (size_t)(k0 + 16 * (lane >> 3)) * it.N + n0 + 4 * (lane & 7);
#pragma unroll
    for (int i = 0; i < 16; ++i) v[i] = *(const GAS f32x4*)(src + (size_t)i * it.N);
}
__device__ __forceinline__ void p0_item8_store(const P0Item& it, const f32x4 (&v)[16], int lane) {
    const int nblk = it.N / 32, kb = it.item / nblk, nb = it.item % nblk, k0 = 128 * kb, n0 = 32 * nb;
    unsigned char* WT8 = (unsigned char*)it.WT;
#pragma unroll
    for (int nn = 0; nn < 4; ++nn) { const int n = n0 + 4 * (lane & 7) + nn;
        v4u o;
#pragma unroll
        for (int w = 0; w < 4; ++w) o[w] = cvt4_fp8(v[4 * w][nn] * WSCALE, v[4 * w + 1][nn] * WSCALE, v[4 * w + 2][nn] * WSCALE, v[4 * w + 3][nn] * WSCALE);
        int dr;
        if (it.mode == 0) dr = n;
        else { const int jj = n >> 1; dr = (jj >> 7) * 256 + (n & 1) * 128 + (jj & 127); }
        *(GAS v4u*)(WT8 + (size_t)dr * it.K + k0 + 16 * (lane >> 3)) = o; }
}
template <int NR>
__device__ __forceinline__ void rms_rows_to_bf16(const float* x, const float* g, bf16* o, int m, int rs, int lane) {
    f32x4 v[NR][4];
#pragma unroll
    for (int r = 0; r < NR; ++r) { const GAS f32x4* xr = (const GAS f32x4*)(x + (size_t)(m + r * rs) * D) + lane;
#pragma unroll
        for (int j = 0; j < 4; ++j) v[r][j] = xr[64 * j]; }
    const GAS f32x4* gr = (const GAS f32x4*)g + lane; f32x4 gg[4];
#pragma unroll
    for (int j = 0; j < 4; ++j) gg[j] = gr[64 * j];
#pragma unroll
    for (int r = 0; r < NR; ++r) { float s = 0.f;
#pragma unroll
        for (int j = 0; j < 4; ++j) s += (v[r][j].x * v[r][j].x + v[r][j].y * v[r][j].y) + (v[r][j].z * v[r][j].z + v[r][j].w * v[r][j].w);
        const float rstd = 1.f / sqrtf(wave_sum(s) * (1.f / D) + EPS);
        GAS unsigned long long* o8 = (GAS unsigned long long*)(o + (size_t)(m + r * rs) * D) + lane;
#pragma unroll
        for (int j = 0; j < 4; ++j) o8[64 * j] = (unsigned long long)pk2(v[r][j].x * rstd * gg[j].x, v[r][j].y * rstd * gg[j].y) | ((unsigned long long)pk2(v[r][j].z * rstd * gg[j].z, v[r][j].w * rstd * gg[j].w) << 32); }
}
__device__ __forceinline__ void p0_filter_tile(Frame& F, int tile) {
    LAS float* feats = (LAS float*)(F.lds + RING_OFF);
    LAS float* h1 = feats + 32 * 36;
    LAS float* h2 = h1 + 32 * 64;
    LAS float* w1s = h2 + 32 * 64;
    LAS float* w2s = w1s + 33 * 64;
    const float *fw1 = F.in[5], *fb1 = F.in[6], *ff1 = F.in[7], *fw2 = F.in[8], *fb2 = F.in[9], *ff2 = F.in[10], *fw3 = F.in[11], *fb3 = F.in[12];
    float* HT = (float*)(F.ws + WS_HT);
    const int tid = F.tid;
    for (int i = tid; i < 33 * 64; i += NWAVES * 64) w1s[i] = fw1[i];
    for (int i = tid; i < 64 * 64; i += NWAVES * 64) w2s[i] = fw2[i];
    for (int i = tid; i < 32 * 33; i += NWAVES * 64) { const int r = i / 33, f = i % 33, t = tile * 32 + r; float val;
        if (f == 0) val = (float)t * (1.0f / 8191.0f);
        else { const int bi = (f - 1) & 15; const float fr = 1e-4f + (float)bi * ((15.0f - 1e-4f) / 15.0f); float rev = (float)t * fr * (1.0f / 8192.0f); rev -= floorf(rev);
               val = (f <= 16) ? cos_rev(rev) : -sin_rev(rev); }
        feats[r * 36 + f] = val; }
    __syncthreads();
#pragma unroll 1
    for (int k = 0; k < 4; ++k) { const int i = tid + 512 * k, r = i >> 6, n = i & 63; float a = fb1[n];
#pragma unroll 11
        for (int f = 0; f < 33; ++f) a += feats[r * 36 + f] * w1s[f * 64 + n];
        float rev = ff1[n] * a * 0.15915494309189535f; rev -= rintf(rev); h1[r * 64 + n] = sin_rev(rev); }
    __syncthreads();
#pragma unroll 1
    for (int k = 0; k < 4; ++k) { const int i = tid + 512 * k, r = i >> 6, n = i & 63; float a = fb2[n];
#pragma unroll 16
        for (int f = 0; f < 64; ++f) a += h1[r * 64 + f] * w2s[f * 64 + n];
        float rev = ff2[n] * a * 0.15915494309189535f; rev -= rintf(rev); h2[r * 64 + n] = sin_rev(rev); }
    __syncthreads();
    { typedef float f32x16 __attribute__((ext_vector_type(16)));
      const int lane = F.lane, r32 = lane & 31, hi = lane >> 5;
      float a[32];
#pragma unroll
      for (int s = 0; s < 32; ++s) a[s] = h2[r32 * 64 + 2 * s + hi];
#pragma unroll 1
      for (int i = 0; i < 8; ++i) { const int col = 32 * (F.wave + 8 * i) + r32; float bq[32];
#pragma unroll
          for (int s = 0; s < 32; ++s) bq[s] = fw3[(2 * s + hi) * 2048 + col];
          f32x16 acc = {};
#pragma unroll
          for (int s = 0; s < 32; ++s) acc = __builtin_amdgcn_mfma_f32_32x32x2f32(a[s], bq[s], acc, 0, 0, 0);
          const float bias = fb3[col]; const int c = col & 511;
          const float delta = 3.0701134573253945f + (float)c * ((15.350567286626973f - 3.0701134573253945f) / 511.0f);
          float* dst = HT + (size_t)col * T + tile * 32 + 4 * hi;
#pragma unroll
          for (int g = 0; g < 4; ++g) { f32x4 o;
#pragma unroll
              for (int q = 0; q < 4; ++q) { const float tl = (float)(tile * 32 + 8 * g + 4 * hi + q) * (1.0f / 8191.0f); o[q] = (acc[4 * g + q] + bias) * __expf(-tl * delta); }
              *(f32x4*)(dst + 8 * g) = o; } } }
    __syncthreads();
}
__device__ __forceinline__ P0Item p0_item(Frame& F, int r) {
    constexpr int I_IN = (D / 64) * (INC / 32), I_UP = (512 / 64) * (D / 32);
    if (r < I_IN) return P0Item{F.in[2], (bf16*)(F.ws + WS_WIN), D, INC, r, 0}; r -= I_IN;
    if (r < I_UP) return P0Item{F.in[16], (bf16*)(F.ws + WS_WHU), 512, D, r, 0}; r -= I_UP;
    if (r < I_UP) return P0Item{F.in[17], (bf16*)(F.ws + WS_WAU), 512, D, r, 0}; r -= I_UP;
    return P0Item{F.in[18], (bf16*)(F.ws + WS_WOUT), D, D, r, 0};
}
__device__ __forceinline__ P0Item p0_item8(Frame& F, int r) {
    constexpr int I_W1 = (D / 128) * (2 * FF / 32), I_W2 = (FF / 128) * (D / 32);
    if (r < NE * I_W1) { const int e = r / I_W1; return P0Item{F.in[22] + (size_t)e * D * 2 * FF, (bf16*)(F.ws + WS_W1 + (size_t)e * 2 * FF * D), D, 2 * FF, r % I_W1, 1}; } r -= NE * I_W1;
    { const int e = r / I_W2; return P0Item{F.in[24] + (size_t)e * FF * D, (bf16*)(F.ws + WS_W2 + (size_t)e * D * FF), FF, D, r % I_W2, 0}; }
}
#ifndef PROBE_SUB
#define PROBE_SUB 0
#endif
__device__ __forceinline__ void p0_xn(Frame& F) {
    const int gw = F.vcu * NWAVES + F.wave, NGW = F.G * NWAVES;
    bf16* XN = (bf16*)(F.ws + WS_XN);
    for (int m = gw; m < M; m += 4 * NGW) rms_rows_to_bf16<4>(F.in[0], F.in[1], XN, m, NGW, F.lane);
}
constexpr int P0_TAIL_ITEMS = 128 * NWAVES * 4;
template <int NOST>
__device__ __forceinline__ void p0_transposes(Frame& F, int kf) {
    const int gw = F.vcu * NWAVES + F.wave, NGW = F.G * NWAVES;
    constexpr int NITEMS = (D / 64) * (INC / 32) + 2 * (512 / 64) * (D / 32) + (D / 64) * (D / 32);
    static_assert(NITEMS % 4 == 0, "items are taken four at a time");
    for (int it = 4 * gw; it < NITEMS; it += 4 * NGW) {
        const P0Item a = p0_item(F, it), b = p0_item(F, it + 1), c = p0_item(F, it + 2), d = p0_item(F, it + 3);
        f32x4 va[8], vb[8], vc[8], vd[8];
        p0_item_load(a, va, F.lane); p0_item_load(b, vb, F.lane); p0_item_load(c, vc, F.lane); p0_item_load(d, vd, F.lane);
        p0_item_store<NOST>(a, va, F.lane); p0_item_store<NOST>(b, vb, F.lane); p0_item_store<NOST>(c, vc, F.lane); p0_item_store<NOST>(d, vd, F.lane);
    }
    constexpr int NITEMS8 = NE * ((D / 128) * (2 * FF / 32) + (FF / 128) * (D / 32));
    static_assert((NITEMS8 - P0_TAIL_ITEMS) % 2 == 0 && NITEMS8 > P0_TAIL_ITEMS, "expert items are taken two at a time");
    static_assert((NITEMS8 - P0_TAIL_ITEMS) == 5 * 2 * NWAVES * 256, "five two-item trips per wave (grid 256)");
    int trip = 0;
#pragma unroll 1
    for (int it = 2 * gw; ; it += 2 * NGW, ++trip) {
        if (trip == kf) { for (int tile = F.vcu; tile < T / 32; tile += F.G) p0_filter_tile(F, tile); }
        if (it >= NITEMS8 - P0_TAIL_ITEMS) break;
        const P0Item a = p0_item8(F, it), b = p0_item8(F, it + 1);
        f32x4 va[16], vb[16];
        p0_item8_load(a, va, F.lane); p0_item8_load(b, vb, F.lane);
        p0_item8_store(a, va, F.lane); p0_item8_store(b, vb, F.lane);
    }
}
__device__ __forceinline__ void p0_tail_items(Frame& F) {
    constexpr int NITEMS8 = NE * ((D / 128) * (2 * FF / 32) + (FF / 128) * (D / 32));
    const int tw = ((int)blockIdx.x - 128) * NWAVES + F.wave, NTW = 128 * NWAVES;
    for (int it = NITEMS8 - P0_TAIL_ITEMS + 2 * tw; it < NITEMS8; it += 2 * NTW) {
        const P0Item a = p0_item8(F, it), b = p0_item8(F, it + 1);
        f32x4 va[16], vb[16];
        p0_item8_load(a, va, F.lane); p0_item8_load(b, vb, F.lane);
        p0_item8_store(a, va, F.lane); p0_item8_store(b, vb, F.lane);
    }
}
__device__ __forceinline__ void p0_prologue(Frame& F) {
    p0_xn(F); if (PROBE_SUB & 1) p0_xn(F);
    p0_transposes<0>(F, ((int)blockIdx.x & 1) ? 0 : 5);
    float* wrt = (float*)(F.ws + WS_WRT);
    for (int i = F.vcu * NWAVES * 64 + F.tid; i < NE * D; i += F.G * NWAVES * 64) { const int e = i >> 10, d = i & 1023; wrt[i] = F.in[20][d * NE + e]; }
}

__device__ __forceinline__ void rope8f(const v4u raw, float rms, const float* g, int d0, int trow, int tcol, float scale, float (&o)[8]) {
    float x[8];
#pragma unroll
    for (int i = 0; i < 4; ++i) { x[2 * i] = bflo(raw[i]) * rms * g[d0 + 2 * i]; x[2 * i + 1] = bfhi(raw[i]) * rms * g[d0 + 2 * i + 1]; }
#pragma unroll
    for (int i = 0; i < 4; ++i) { const int pi = (d0 >> 1) + i;
        const float freq = __builtin_amdgcn_exp2f(-(float)(pi & 15) * (13.287712379549449f / 16.0f));
        float rev = (float)(pi < 16 ? trow : tcol) * freq * 0.15915494309189535f; rev -= floorf(rev);
        const float c = cos_rev(rev), sn = sin_rev(rev);
        o[2 * i] = (x[2 * i] * c - x[2 * i + 1] * sn) * scale; o[2 * i + 1] = (x[2 * i] * sn + x[2 * i + 1] * c) * scale; }
}
constexpr float QSCALE8 = 8.0f, VSCALE8 = 4.0f;
__device__ __forceinline__ void p2_qkprep(Frame& F) {
    const bf16* PR = (const bf16*)(F.ws + WS_PR); unsigned char* Q8 = (unsigned char*)(F.ws + WS_QO); unsigned char* K8 = (unsigned char*)(F.ws + WS_KB);
    const float* qg = F.in[14]; const float* kg = F.in[15];
    const int gw = F.vcu * NWAVES + F.wave, NGW = F.G * NWAVES, lane = F.lane;
    typedef unsigned u32x2v __attribute__((ext_vector_type(2)));
    for (int m4 = gw; m4 < M; m4 += 4 * NGW) {
      v4u raw4[4];
#pragma unroll
      for (int q = 0; q < 4; ++q) { const int mq = m4 + q * NGW; raw4[q] = mq < M ? *(const GAS v4u*)(PR + (size_t)mq * NREST + PR_Q + 8 * lane) : (v4u){0u, 0u, 0u, 0u}; }
#pragma unroll
      for (int q = 0; q < 4; ++q) { const int m = m4 + q * NGW; if (m >= M) break;
        const int t = m & (T - 1), trow = t >> 6, tcol = t & 63;
        { const v4u raw = raw4[q]; float ss = 0.f;
#pragma unroll
          for (int i = 0; i < 4; ++i) { const float a = bflo(raw[i]), b = bfhi(raw[i]); ss += a * a + b * b; }
          ss += __shfl_xor(ss, 1); ss += __shfl_xor(ss, 2); ss += __shfl_xor(ss, 4);
          const float rms = 1.f / sqrtf(ss * (1.f / 64.f) + EPS); float o[8];
          rope8f(raw, rms, qg, 8 * (lane & 7), trow, tcol, 0.125f * 1.4426950408889634f * QSCALE8, o);
          u32x2v w; w.x = cvt4_fp8(o[0], o[1], o[2], o[3]); w.y = cvt4_fp8(o[4], o[5], o[6], o[7]);
          *(GAS u32x2v*)(Q8 + (size_t)m * AW + 8 * lane) = w; } }
    }
    static_assert(M % (16 * NWAVES * 256) == 0, "k pass: sixteen tokens per wave (grid 256)");
    { v4u rawk[4];
#pragma unroll
      for (int p = 0; p < 4; ++p) { const int m = gw + (4 * p + (lane >> 4)) * NGW; rawk[p] = m < M ? *(const GAS v4u*)(PR + (size_t)m * NREST + PR_K + 8 * (lane & 15)) : (v4u){0u, 0u, 0u, 0u}; }
#pragma unroll
      for (int p = 0; p < 4; ++p) {
        const int m = gw + (4 * p + (lane >> 4)) * NGW; if (m >= M) continue;
        const int t = m & (T - 1), trow = t >> 6, tcol = t & 63, l2 = lane & 15;
        const v4u raw = rawk[p]; float ss = 0.f;
#pragma unroll
        for (int i = 0; i < 4; ++i) { const float a = bflo(raw[i]), b = bfhi(raw[i]); ss += a * a + b * b; }
        ss += __shfl_xor(ss, 1); ss += __shfl_xor(ss, 2); ss += __shfl_xor(ss, 4);
        const float rms = 1.f / sqrtf(ss * (1.f / 64.f) + EPS); float o[8];
        rope8f(raw, rms, kg, 8 * (lane & 7), trow, tcol, 1.0f, o);
        u32x2v w; w.x = cvt4_fp8(o[0], o[1], o[2], o[3]); w.y = cvt4_fp8(o[4], o[5], o[6], o[7]);
        *(GAS u32x2v*)(K8 + (size_t)m * KVW + 8 * l2) = w;
      } }
    unsigned char* VT8 = (unsigned char*)(F.ws + WS_VB);
    for (int it = gw; it < (M / 64) * 2; it += NGW) { const int tile = it >> 1, kvh = it & 1;
        const unsigned short* vp = (const unsigned short*)(PR + (size_t)tile * 64 * NREST + PR_V + kvh * 64 + lane);
        unsigned wv[2][8];
#pragma unroll
        for (int hh = 0; hh < 2; ++hh)
#pragma unroll
            for (int w = 0; w < 8; ++w) wv[hh][w] = 0u;
#pragma unroll
        for (int kp = 0; kp < 64; kp += 2) {
            const float a = __builtin_amdgcn_fmed3f(bf1(vp[(size_t)kp * NREST]) * VSCALE8, -448.f, 448.f), b = __builtin_amdgcn_fmed3f(bf1(vp[(size_t)(kp + 1) * NREST]) * VSCALE8, -448.f, 448.f);
            const int k5 = kp & 31, hh = (k5 >> 2) & 1, r = (k5 & 3) + 4 * (k5 >> 3), byte = r + 16 * (kp >> 5);
            if ((byte >> 1) & 1) wv[hh][byte >> 2] = (unsigned)__builtin_amdgcn_cvt_pk_fp8_f32(a, b, (int)wv[hh][byte >> 2], true); else wv[hh][byte >> 2] = (unsigned)__builtin_amdgcn_cvt_pk_fp8_f32(a, b, (int)wv[hh][byte >> 2], false); }
        unsigned char* dst = VT8 + (size_t)it * 4096 + lane * 32;
#pragma unroll
        for (int hh = 0; hh < 2; ++hh) { *(GAS v4u*)(dst + hh * 2048) = (v4u){wv[hh][0], wv[hh][1], wv[hh][2], wv[hh][3]}; *(GAS v4u*)(dst + hh * 2048 + 16) = (v4u){wv[hh][4], wv[hh][5], wv[hh][6], wv[hh][7]}; } }
}
typedef LAS hc* zptr;
#define FSYNC() __syncthreads()
#define LSYNC() asm volatile("s_waitcnt lgkmcnt(0)\n\ts_barrier" ::: "memory")
__device__ __forceinline__ float block_sum(Frame& F, float v) {
    LAS float* red = (LAS float*)(F.lds + LX_RED);
    v = wave_sum(v); if (F.lane == 0) red[F.wave] = v; __syncthreads();
    float s = 0.f;
#pragma unroll
    for (int w = 0; w < NWAVES; ++w) s += red[w];
    __syncthreads(); return s;
}
__device__ __forceinline__ hc f2h(float a, float b) { return __builtin_convertvector((cf){a, b}, hc); }
__device__ __forceinline__ void fft_tables(Frame& F) {
    zptr tw = (zptr)(F.lds + FFT_TW_OFF);
    for (int i = F.tid; i < TW_ELEMS; i += NWAVES * 64) { int jq, ls;
        if (i < TW_B) { jq = (i & 1023) * (i >> 10); ls = 16384; } else if (i < TW_C) { const int k = i - TW_B; jq = (k & 63) * (k >> 6); ls = 1024; } else { const int k = i - TW_C; jq = (k & 3) * (k >> 2); ls = 64; }
        const float rev = (float)(jq & (ls - 1)) / (float)ls;
        tw[i] = f2h(0.0625f * cos_rev(rev), -0.0625f * sin_rev(rev)); }
    __syncthreads();
}
struct Raw8 { v4u c; unsigned p, n; };
__device__ __forceinline__ Raw8 sc8_load(const bf16* row, int t0) { Raw8 r; r.c = *(const GAS v4u*)(row + t0); r.p = t0 > 0 ? (unsigned)row[t0 - 1] : 0u; r.n = t0 + 8 < T ? (unsigned)row[t0 + 8] : 0u; return r; }
__device__ __forceinline__ void sc8_eval(const Raw8& r, float w0, float w1, float w2, float b, float (&o)[8]) {
    float z[10]; z[0] = __uint_as_float(r.p << 16); z[9] = __uint_as_float(r.n << 16);
#pragma unroll
    for (int i = 0; i < 4; ++i) { z[1 + 2 * i] = bflo(r.c[i]); z[2 + 2 * i] = bfhi(r.c[i]); }
#pragma unroll
    for (int i = 0; i < 8; ++i) o[i] = b + w0 * z[i] + w1 * z[i + 1] + w2 * z[i + 2];
}
__device__ __forceinline__ void fft_fwd3(zptr Z, zptr tw, int tid) { fft_pass_fwd(Z, tw, tid, 0); LSYNC(); fft_pass_fwd(Z, tw, tid, 1); LSYNC(); fft_pass_fwd(Z, tw, tid, 2); LSYNC(); }
__device__ __forceinline__ void fft_inv3(zptr Z, zptr tw, int tid) { fft_pass_inv(Z, tw, tid, 2); LSYNC(); fft_pass_inv(Z, tw, tid, 1); LSYNC(); fft_pass_inv(Z, tw, tid, 0); LSYNC(); }
__device__ __forceinline__ void z_store8(zptr Z, int t0, const float (&re)[8], const float (&im)[8]) { LAS v4u* p = (LAS v4u*)(Z + fft_pad(t0)); v4u a, b;
#pragma unroll
    for (int i = 0; i < 4; ++i) { a[i] = __builtin_bit_cast(unsigned, f2h(re[i], im[i])); b[i] = __builtin_bit_cast(unsigned, f2h(re[4 + i], im[4 + i])); }
    p[0] = a; p[1] = b; }
__device__ __forceinline__ void z_zero8(zptr Z, int t0) { LAS v4u* p = (LAS v4u*)(Z + fft_pad(t0)); const v4u z = {0u, 0u, 0u, 0u}; p[0] = z; p[1] = z; }
__device__ __forceinline__ void z_load8(zptr Z, int t0, float (&re)[8], float (&im)[8]) { const LAS v4u* p = (const LAS v4u*)(Z + fft_pad(t0)); const v4u a = p[0], b = p[1];
#pragma unroll
    for (int i = 0; i < 4; ++i) { const cf u = __builtin_convertvector(__builtin_bit_cast(hc, a[i]), cf), w = __builtin_convertvector(__builtin_bit_cast(hc, b[i]), cf); re[i] = u.x; im[i] = u.y; re[4 + i] = w.x; im[4 + i] = w.y; } }
__device__ __forceinline__ void hyena_channel(Frame& F, int c) {
    zptr Z = (zptr)(F.lds + RING_OFF); zptr tw = (zptr)(F.lds + FFT_TW_OFF);
    const int tid = F.tid;
    hc* Ksp = (hc*)(F.ws + WS_KSP) + (size_t)blockIdx.x * 2 * FFT_N;
    const float* HT = (const float*)(F.ws + WS_HT);
    const bf16* ZT = (const bf16*)(F.ws + WS_ZT); bf16* YHT = (bf16*)(F.ws + WS_YHT);
    const float* cw = F.in[3]; const float* cb = F.in[4]; const float* hd = F.in[13];
    const hc hzero = f2h(0.f, 0.f);
    {
        const float* f0 = HT + (size_t)c * T; const float* b0 = HT + (size_t)(512 + c) * T; const float* f1 = HT + (size_t)(1024 + c) * T; const float* b1 = HT + (size_t)(1536 + c) * T;
        float as0 = 0.f, as1 = 0.f;
#pragma unroll
        for (int r = 0; r < 2; ++r) { int tl_ = tid; OPAQUE(tl_); const int t0 = 8 * (tl_ + 512 * r);
#pragma unroll
            for (int h = 0; h < 2; ++h) { const f32x4 fa = *(const GAS f32x4*)(f0 + t0 + 4 * h), ba = *(const GAS f32x4*)(b0 + t0 + 4 * h), fb = *(const GAS f32x4*)(f1 + t0 + 4 * h), bb = *(const GAS f32x4*)(b1 + t0 + 4 * h);
#pragma unroll
                for (int i = 0; i < 4; ++i) { const int t = t0 + 4 * h + i; Z[fft_pad(t)] = f2h(fa[i], fb[i]); as0 += fabsf(fa[i]); as1 += fabsf(fb[i]);
                    if (t >= 1) { Z[fft_pad(FFT_N - t)] = f2h(ba[i], bb[i]); as0 += fabsf(ba[i]); as1 += fabsf(bb[i]); } else Z[fft_pad(T)] = hzero; } } }
        const float S0 = block_sum(F, as0), S1 = block_sum(F, as1);
        fft_fwd3(Z, tw, tid); fft_pass_d_fwd(Z, tid); FSYNC();
        const float sc0 = 0.5f * 16384.0f * 1024.0f / S0, sc1 = 0.5f * 16384.0f * 1024.0f / S1;
#pragma unroll 2
        for (int r = 0; r < 8; ++r) { int tl_ = tid; OPAQUE(tl_); const int p0 = 4 * (tl_ + 512 * r); v4u w0, w1;
#pragma unroll
            for (int i = 0; i < 4; ++i) { const int p = p0 + i;
                const int k = (p >> 10) + 16 * ((p >> 6) & 15) + 256 * ((p >> 2) & 15) + 4096 * (p & 3), kn = (FFT_N - k) & (FFT_N - 1);
                const int pn = 1024 * (kn & 15) + 64 * ((kn >> 4) & 15) + 4 * ((kn >> 8) & 15) + (kn >> 12);
                const cf a = __builtin_convertvector(Z[fft_pad(p)], cf), b = __builtin_convertvector(Z[fft_pad(pn)], cf);
                w0[i] = __builtin_bit_cast(unsigned, f2h((a.x + b.x) * sc0, (a.y - b.y) * sc0));
                w1[i] = __builtin_bit_cast(unsigned, f2h((a.y + b.y) * sc1, (b.x - a.x) * sc1)); }
            *(GAS v4u*)(Ksp + p0) = w0; *(GAS v4u*)(Ksp + FFT_N + p0) = w1; }
        FSYNC();
    }
    const float wv0 = cw[c], wv1 = cw[NHY + c], wv2 = cw[2 * NHY + c], bv = cb[c];
    const float wa0 = cw[512 + c], wa1 = cw[NHY + 512 + c], wa2 = cw[2 * NHY + 512 + c], ba = cb[512 + c];
    const float wb0 = cw[1024 + c], wb1 = cw[NHY + 1024 + c], wb2 = cw[2 * NHY + 1024 + c], bb = cb[1024 + c];
    const float d0 = hd[c], d1 = hd[HW + c];
    const int tq0 = 8 * tid, tq1 = 8 * (tid + 512);
    Raw8 rv[2][2];
    { const bf16* v0 = ZT + (size_t)c * M; rv[0][0] = sc8_load(v0, tq0); rv[0][1] = sc8_load(v0, tq1); rv[1][0] = sc8_load(v0 + T, tq0); rv[1][1] = sc8_load(v0 + T, tq1); }
    for (int pair_ = 0; pair_ < ((PROBE_SUB & 32) ? 4 : 2); ++pair_) { const int pair = pair_ & 1;
        const bf16* a0 = ZT + (size_t)(512 + c) * M + (size_t)(2 * pair) * T;  const bf16* a1 = a0 + T;
        const bf16* b0 = ZT + (size_t)(1024 + c) * M + (size_t)(2 * pair) * T; const bf16* b1 = b0 + T;
        float x[2][2][8];
#pragma unroll
        for (int r = 0; r < 2; ++r) { const int t0 = r ? tq1 : tq0; sc8_eval(rv[0][r], wv0, wv1, wv2, bv, x[0][r]); sc8_eval(rv[1][r], wv0, wv1, wv2, bv, x[1][r]);
            z_store8(Z, t0, x[0][r], x[1][r]); z_zero8(Z, T + t0); }
        KPre kp; fft_dkd_prefetch(kp, (const hc*)Ksp, tid);
        Raw8 rg[2][2]; rg[0][0] = sc8_load(a0, tq0); rg[0][1] = sc8_load(a0, tq1); rg[1][0] = sc8_load(a1, tq0); rg[1][1] = sc8_load(a1, tq1);
        LSYNC();
        fft_fwd3(Z, tw, tid); fft_pass_dkd(Z, kp, tid); LSYNC();
        fft_dkd_prefetch(kp, (const hc*)(Ksp + FFT_N), tid);
        fft_inv3(Z, tw, tid);
        float y[2][2][8];
#pragma unroll
        for (int r = 0; r < 2; ++r) { const int t0 = r ? tq1 : tq0; float g0[8], g1[8]; sc8_eval(rg[0][r], wa0, wa1, wa2, ba, g0); sc8_eval(rg[1][r], wa0, wa1, wa2, ba, g1);
            float cr[8], ci[8]; z_load8(Z, t0, cr, ci);
#pragma unroll
            for (int i = 0; i < 8; ++i) { y[0][r][i] = g0[i] * (cr[i] + x[0][r][i] * d0); y[1][r][i] = g1[i] * (ci[i] + x[1][r][i] * d0); }
            z_store8(Z, t0, y[0][r], y[1][r]); z_zero8(Z, T + t0); }
        rg[0][0] = sc8_load(b0, tq0); rg[0][1] = sc8_load(b0, tq1); rg[1][0] = sc8_load(b1, tq0); rg[1][1] = sc8_load(b1, tq1);
        { const bf16* v0 = ZT + (size_t)c * M + (size_t)(2 * ((pair + 1) & 1)) * T; rv[0][0] = sc8_load(v0, tq0); rv[0][1] = sc8_load(v0, tq1); rv[1][0] = sc8_load(v0 + T, tq0); rv[1][1] = sc8_load(v0 + T, tq1); }
        LSYNC();
        fft_fwd3(Z, tw, tid); fft_pass_dkd(Z, kp, tid); LSYNC(); fft_inv3(Z, tw, tid);
#pragma unroll
        for (int r = 0; r < 2; ++r) { const int t0 = r ? tq1 : tq0; float g0[8], g1[8]; sc8_eval(rg[0][r], wb0, wb1, wb2, bb, g0); sc8_eval(rg[1][r], wb0, wb1, wb2, bb, g1);
            float y0[8], y1[8];
            float cr[8], ci[8]; z_load8(Z, t0, cr, ci);
#pragma unroll
            for (int i = 0; i < 8; ++i) { y0[i] = g0[i] * (cr[i] + y[0][r][i] * d1); y1[i] = g1[i] * (ci[i] + y[1][r][i] * d1); }
            v4u w0, w1;
#pragma unroll
            for (int i = 0; i < 4; ++i) { w0[i] = pk2(y0[2 * i], y0[2 * i + 1]); w1[i] = pk2(y1[2 * i], y1[2 * i + 1]); }
            *(GAS v4u*)(YHT + (size_t)c * M + (size_t)(2 * pair) * T + t0) = w0; *(GAS v4u*)(YHT + (size_t)c * M + (size_t)(2 * pair + 1) * T + t0) = w1; }
        LSYNC();
    }
}
__device__ __forceinline__ void p3_transpose(Frame& F) {
    const unsigned short* YHT = (const unsigned short*)(F.ws + WS_YHT); unsigned short* YH = (unsigned short*)(F.ws + WS_YH);
    const int gw = F.vcu * NWAVES + F.wave, NGW = F.G * NWAVES, lane = F.lane, cb8 = lane >> 3, mb8 = lane & 7;
    for (int it = gw; it < (HW / 64) * (M / 64); it += NGW) { const int cb = it & 7, mb = it >> 3, c0 = cb * 64 + 8 * cb8, m0 = mb * 64 + 8 * mb8;
        const unsigned short* src = YHT + (size_t)c0 * M + m0;
        v4u R[8];
#pragma unroll
        for (int r = 0; r < 8; ++r) R[r] = *(const GAS v4u*)(src + (size_t)r * M);
#pragma unroll
        for (int j = 0; j < 8; ++j) { v4u o;
#pragma unroll
            for (int w = 0; w < 4; ++w) o[w] = __builtin_amdgcn_perm(R[2 * w + 1][j >> 1], R[2 * w][j >> 1], (j & 1) ? 0x07060302u : 0x05040100u);
            *(GAS v4u*)(YH + (size_t)(m0 + j) * HW + c0) = o; } }
}
typedef int RouteEnt __attribute__((ext_vector_type(4)));
__device__ __forceinline__ void top4_insert(float (&tv)[4], int (&te)[4], float v, int e) {
    if (v > tv[3]) { tv[3] = v; te[3] = e;
        if (tv[3] > tv[2]) { const float a = tv[2]; const int b = te[2]; tv[2] = tv[3]; te[2] = te[3]; tv[3] = a; te[3] = b;
            if (tv[2] > tv[1]) { const float a2 = tv[1]; const int b2 = te[1]; tv[1] = tv[2]; te[1] = te[2]; tv[2] = a2; te[2] = b2;
                if (tv[1] > tv[0]) { const float a3 = tv[0]; const int b3 = te[0]; tv[0] = tv[1]; te[0] = te[1]; tv[1] = a3; te[1] = b3; } } } }
}
__device__ __forceinline__ bool top4_before(float va, int ea, float vb, int eb) { return va > vb || (va == vb && ea < eb); }
template <int DRY>
__device__ __forceinline__ void p6_route(Frame& F) {
    typedef float f32x16 __attribute__((ext_vector_type(16)));
    constexpr int WPB = 2064;
    LAS unsigned char* Whi = (LAS unsigned char*)(F.lds + RING_OFF);
    LAS unsigned char* Wlo = Whi + 32 * WPB;
    LAS float* rstab = (LAS float*)(F.lds + RING_OFF + 2 * 32 * WPB);
    static_assert(2 * 32 * WPB + TPB * 4 <= RING_BYTES, "router images");
    LAS int* lcnt = (LAS int*)(F.lds + LX_CNT); LAS int* lbase = lcnt + 32;
    LAS RouteEnt* ent = (LAS RouteEnt*)(F.lds + LX_ENT);
    const float* wrt = (const float*)(F.ws + WS_WRT); const float* g2 = F.in[19]; const float* rb = F.in[21];
    const bf16* h = (const bf16*)(F.ws + WS_HB); bf16* HN = (bf16*)(F.ws + WS_XN);
    const int tid = F.tid, lane = F.lane;
    { static_assert(NE * D / 4 == 16 * NWAVES * 64, "router image: sixteen pieces per thread");
      typedef unsigned u32x2w __attribute__((ext_vector_type(2)));
      f32x4 wv[16], gv[16];
#pragma unroll
      for (int j = 0; j < 16; ++j) { const int i = tid + j * NWAVES * 64, k4 = (i & 255) * 4; wv[j] = ((const GAS f32x4*)wrt)[i]; gv[j] = *(const GAS f32x4*)(g2 + k4); }
#pragma unroll
      for (int j = 0; j < 16; ++j) { const int i = tid + j * NWAVES * 64, e = i >> 8, k4 = (i & 255) * 4; const f32x4 w = wv[j] * gv[j];
        u32x2w hi; hi.x = pk2(w[0], w[1]); hi.y = pk2(w[2], w[3]);
        u32x2w lo; lo.x = pk2(w[0] - bflo(hi.x), w[1] - bfhi(hi.x)); lo.y = pk2(w[2] - bflo(hi.y), w[3] - bfhi(hi.y));
        *(LAS u32x2w*)(Whi + e * WPB + k4 * 2) = hi; *(LAS u32x2w*)(Wlo + e * WPB + k4 * 2) = lo; } }
    if (tid < 32) lcnt[tid] = 0;
    __syncthreads();
    const int m0 = blockIdx.x * TPB;
    f32x16 acc = {};
    {
        f32x4 gg[4];
#pragma unroll
        for (int j = 0; j < 4; ++j) gg[j] = ((const GAS f32x4*)g2)[lane + 64 * j];
        unsigned long long nx[4][4];
#pragma unroll
        for (int q = 0; q < 4; ++q) { const GAS unsigned long long* xr = (const GAS unsigned long long*)(h + (size_t)(m0 + F.wave + 8 * q) * D) + lane;
#pragma unroll
          for (int j = 0; j < 4; ++j) nx[q][j] = xr[64 * j]; }
        static_assert(TPB % 32 == 0, "row pass: four buffers x eight waves");
        for (int lt0 = F.wave; lt0 < TPB; lt0 += 32) {
#pragma unroll
          for (int q = 0; q < 4; ++q) { const int lt = lt0 + 8 * q, m = m0 + lt;
            f32x4 v[4]; float ss = 0.f;
#pragma unroll
            for (int j = 0; j < 4; ++j) { const unsigned lo = (unsigned)nx[q][j], hi = (unsigned)(nx[q][j] >> 32); v[j] = (f32x4){bflo(lo), bfhi(lo), bflo(hi), bfhi(hi)}; ss += (v[j].x * v[j].x + v[j].y * v[j].y) + (v[j].z * v[j].z + v[j].w * v[j].w); }
            if (lt + 32 < TPB) { const GAS unsigned long long* xr = (const GAS unsigned long long*)(h + (size_t)(m + 32) * D) + lane;
#pragma unroll
                for (int j = 0; j < 4; ++j) nx[q][j] = xr[64 * j]; }
            const float rstd = 1.f / sqrtf(wave_sum(ss) * (1.f / D) + EPS);
            if (lane == 0) rstab[lt] = rstd;
            GAS unsigned* o4 = (GAS unsigned*)((unsigned char*)HN + (size_t)m * D) + lane;
#pragma unroll
            for (int j = 0; j < 4; ++j) { v[j] = v[j] * (rstd * ASCALE) * gg[j]; o4[64 * j] = cvt4_fp8(fminf(fmaxf(v[j].x, -448.f), 448.f), fminf(fmaxf(v[j].y, -448.f), 448.f), fminf(fmaxf(v[j].z, -448.f), 448.f), fminf(fmaxf(v[j].w, -448.f), 448.f)); } } }
    }
    if (F.wave < 4) {
        const int tok = lane & 31, kh = lane >> 5;
        const GAS v4u* hp = (const GAS v4u*)(h + (size_t)(m0 + 32 * F.wave + tok) * D + 8 * kh);
        const LAS unsigned char* wph = Whi + tok * WPB + 16 * kh;
        const LAS unsigned char* wpl = Wlo + tok * WPB + 16 * kh;
        v4u hb[4];
#pragma unroll
        for (int q = 0; q < 4; ++q) hb[q] = hp[2 * q];
#pragma unroll 4
        for (int S = 0; S < 64; ++S) { const v4u raw = hb[S & 3]; if (S + 4 < 64) hb[S & 3] = hp[2 * (S + 4)];
            const v4u whi = *(const LAS v4u*)(wph + 32 * S), wlo = *(const LAS v4u*)(wpl + 32 * S);
            acc = __builtin_amdgcn_mfma_f32_32x32x16_bf16(__builtin_bit_cast(bf16x8, whi), __builtin_bit_cast(bf16x8, raw), acc, 0, 0, 0);
            acc = __builtin_amdgcn_mfma_f32_32x32x16_bf16(__builtin_bit_cast(bf16x8, wlo), __builtin_bit_cast(bf16x8, raw), acc, 0, 0, 0); }
    }
    __syncthreads();
    if (F.wave < 4) {
        const int tok = lane & 31, hh = lane >> 5, lt = 32 * F.wave + tok;
        const float rstd = rstab[lt];
        float tv[4] = {-INFINITY, -INFINITY, -INFINITY, -INFINITY}; int te[4] = {0, 0, 0, 0};
#pragma unroll
        for (int i = 0; i < 16; ++i) { const int e = (i & 3) + 8 * (i >> 2) + 4 * hh; top4_insert(tv, te, acc[i] * rstd + rb[e], e); }
        float pv[4]; int pe[4];
#pragma unroll
        for (int k = 0; k < 4; ++k) { pv[k] = __shfl_xor(tv[k], 32); pe[k] = __shfl_xor(te[k], 32); }
        float mv[4]; int me[4]; int ia = 0, ib = 0;
#pragma unroll
        for (int k = 0; k < 4; ++k) {
            const float va = ia == 0 ? tv[0] : ia == 1 ? tv[1] : ia == 2 ? tv[2] : tv[3]; const int ea = ia == 0 ? te[0] : ia == 1 ? te[1] : ia == 2 ? te[2] : te[3];
            const float vb = ib == 0 ? pv[0] : ib == 1 ? pv[1] : ib == 2 ? pv[2] : pv[3]; const int eb = ib == 0 ? pe[0] : ib == 1 ? pe[1] : ib == 2 ? pe[2] : pe[3];
            const bool ta = top4_before(va, ea, vb, eb); mv[k] = ta ? va : vb; me[k] = ta ? ea : eb; ia += ta ? 1 : 0; ib += ta ? 0 : 1; }
        const float e1 = __expf(mv[1] - mv[0]), e2 = __expf(mv[2] - mv[0]), e3 = __expf(mv[3] - mv[0]); const float inv = 1.0f / (1.0f + e1 + e2 + e3);
        if (hh == 0) { const float gt[4] = {inv, e1 * inv, e2 * inv, e3 * inv};
#pragma unroll
            for (int k = 0; k < 4; ++k) { const int lp = atomicAdd((int*)(lcnt + me[k]), 1); ent[lt * 4 + k] = (RouteEnt){me[k], lp, (int)__float_as_uint(gt[k]), 0}; } }
    }
    __syncthreads();
    if (DRY) return;
    if (tid < 32) lbase[tid] = (int)__hip_atomic_fetch_add(F.ctl + CW_CNT + tid, (unsigned)lcnt[tid], __ATOMIC_RELAXED, __HIP_MEMORY_SCOPE_AGENT);
    __syncthreads();
    { RouteEnt en = ent[tid]; en.y += lbase[en.x]; ((GAS RouteEnt*)(F.ws + WS_ENT))[(size_t)m0 * 4 + tid] = en; }
}
__device__ __forceinline__ void build_layout(Frame& F) {
    LAS int* pstart = (LAS int*)(F.lds + LX_CNT) + 64; LAS int* rbe = (LAS int*)(F.lds + LX_RBE); LAS int* gcnt = (LAS int*)(F.lds + LX_RED);
    __syncthreads();
    if (F.tid < 32) gcnt[F.tid] = (int)__hip_atomic_load(F.ctl + CW_CNT + F.tid, __ATOMIC_RELAXED, __HIP_MEMORY_SCOPE_AGENT);
    __syncthreads();
    if (F.wave == 0) {
        const int lane = F.lane, e = lane & 31; const int nb = lane < 32 ? (gcnt[e] + 255) >> 8 : 0;
        int incl = nb;
#pragma unroll
        for (int o = 1; o < 32; o <<= 1) { const int t = __shfl_up(incl, o); if (lane >= o) incl += t; }
        const int start = incl - nb, total = __shfl(incl, 31);
        if (lane < 32) { pstart[e] = (start < RB_MAX ? start : RB_MAX) * 256;
            for (int b2 = 0; b2 < nb; ++b2) { const int r = start + b2; if (r < RB_MAX) rbe[r] = e; } }
        if (lane == 0) { const int rb = total < RB_MAX ? total : RB_MAX; pstart[NE] = rb * 256; F.MISC[16] = (unsigned)rb; } }
    __syncthreads();
}
__device__ __forceinline__ void p7_layout(Frame& F) {
    build_layout(F);
    LAS int* pstart = (LAS int*)(F.lds + LX_CNT) + 64; LAS int* gcnt = (LAS int*)(F.lds + LX_RED);
    int* tokrows = (int*)(F.ws + WS_TOKROWS); float* rowgate = (float*)(F.ws + WS_ROWGATE); int* srctok = (int*)(F.ws + WS_SRC);
    const int m0 = blockIdx.x * TPB;
    { const int m = m0 + (F.tid >> 2), k = F.tid & 3;
      const RouteEnt en = ((const GAS RouteEnt*)(F.ws + WS_ENT))[(size_t)m * 4 + k]; const int row = pstart[en.x] + en.y;
      tokrows[m * 4 + k] = row; rowgate[row] = __uint_as_float((unsigned)en.z); srctok[row] = m; }
    if (blockIdx.x < NE) { const int e = blockIdx.x, r0 = pstart[e] + gcnt[e], r1 = pstart[e + 1];
        for (int row = r0 + F.tid; row < r1; row += NWAVES * 64) { srctok[row] = 0; rowgate[row] = 0.f; } }
}
__device__ __forceinline__ void p10_combine(Frame& F) {
    const unsigned char* Y2 = (const unsigned char*)(F.ws + WS_XG); const bf16* HB = (const bf16*)(F.ws + WS_HB); const int* tokrows = (const int*)(F.ws + WS_TOKROWS); float* out = F.out;
    const int gw = F.vcu * NWAVES + F.wave, NGW = F.G * NWAVES, lane = F.lane;
    typedef float f32x2v __attribute__((ext_vector_type(2))); typedef unsigned u32x2c __attribute__((ext_vector_type(2)));
    static_assert(M == 16 * NWAVES * 256, "combine: sixteen tokens per wave (grid 256)");
    const RouteEnt mine = *(const GAS RouteEnt*)(tokrows + (size_t)(gw + (lane & 15) * NGW) * 4);
#pragma unroll 1
    for (int kk = 0; kk < 16; kk += 2) { const int mm = gw + kk * NGW;
        int rr[2][4];
#pragma unroll
        for (int u = 0; u < 2; ++u) { rr[u][0] = __shfl(mine.x, kk + u); rr[u][1] = __shfl(mine.y, kk + u); rr[u][2] = __shfl(mine.z, kk + u); rr[u][3] = __shfl(mine.w, kk + u); }
        u32x2c hb[2][4]; unsigned yw[2][4][4];
#pragma unroll
        for (int u = 0; u < 2; ++u) { const int m = mm + u * NGW;
#pragma unroll
            for (int i = 0; i < 4; ++i) { const int col = 256 * i + 4 * lane; hb[u][i] = *(const GAS u32x2c*)(HB + (size_t)m * D + col);
#pragma unroll
                for (int k = 0; k < 4; ++k) yw[u][k][i] = *(const GAS unsigned*)(Y2 + (size_t)rr[u][k] * D + col); } }
#pragma unroll
        for (int u = 0; u < 2; ++u) { const int m = mm + u * NGW;
#pragma unroll
            for (int i = 0; i < 4; ++i) { f32x2v s0 = {0.f, 0.f}, s1 = {0.f, 0.f};
#pragma unroll
                for (int k = 0; k < 4; ++k) { s0 += __builtin_amdgcn_cvt_pk_f32_fp8((int)yw[u][k][i], false); s1 += __builtin_amdgcn_cvt_pk_f32_fp8((int)yw[u][k][i], true); }
                f32x4 o; o[0] = bflo(hb[u][i][0]) + s0.x * (1.0f / YSCALE); o[1] = bfhi(hb[u][i][0]) + s0.y * (1.0f / YSCALE); o[2] = bflo(hb[u][i][1]) + s1.x * (1.0f / YSCALE); o[3] = bfhi(hb[u][i][1]) + s1.y * (1.0f / YSCALE);
                *(GAS f32x4*)(out + (size_t)m * D + 256 * i + 4 * lane) = o; } } }
}
template <int NOSTORE = 0> __device__ __forceinline__ void ph1(Frame& F) {
    bf16* const XN = (bf16*)(F.ws + WS_XN);
    { pg8::Gemm g{(const bf16*)(F.ws + WS_WIN), XN, NHY, M, D}; pg8::StaticOrder S; S.init(NHY, M, F.G, (int)blockIdx.x);
      pg8::EpiBf16Plain E{(bf16*)(F.ws + WS_ZT), M};
      pg8::gemm_phase<pg8::EpiBf16Plain, pg8::StaticOrder, true, true>(F.lds + RING_OFF, g, S, E); }
    { pg8::Gemm g{XN, (const bf16*)(F.ws + WS_WIN) + (size_t)NHY * D, M, NREST, D}; pg8::StaticOrder S; S.init(M, NREST, F.G, (int)blockIdx.x);
      pg8::EpiBf16Plain E{(bf16*)(F.ws + WS_PR), NREST};
      pg8::gemm_phase<pg8::EpiBf16Plain, pg8::StaticOrder, true, true>(F.lds + RING_OFF, g, S, E); }
    if ((int)blockIdx.x >= 128) p0_tail_items(F);
}
__device__ __forceinline__ void ph2(Frame& F) {
    p2_qkprep(F); if (PROBE_SUB & 8) p2_qkprep(F);
    __syncthreads(); fft_tables(F);
    for (int c = F.vcu; c < HW; c += F.G) hyena_channel(F, c);
}
__device__ __forceinline__ void ph3(Frame& F, unsigned char* lds) {
    static_assert(attn_body::L8_BYTES <= RING_BYTES, "attention LDS");
    float gq = fabsf(F.in[14][F.lane]), gk = fabsf(F.in[15][F.lane]);
#pragma unroll
    for (int o = 1; o < 64; o <<= 1) { gq = fmaxf(gq, __shfl_xor(gq, o)); gk = fmaxf(gk, __shfl_xor(gk, o)); }
    const float mref = 64.0f * 0.125f * 1.4426950408889634f * gq * gk;
    const attn_body::AttnTensors8 AT{(const unsigned char*)(F.ws + WS_QO), (const unsigned char*)(F.ws + WS_KB), (const unsigned char*)(F.ws + WS_VB), (attn_body::bf16*)(F.ws + WS_AO), mref - 7.0f,
        attn_body::XposeJob{(const unsigned short*)(F.ws + WS_YHT), (unsigned short*)(F.ws + WS_YH), M, HW, HW / 64}, (HW / 64) * (M / 64), F.vcu * NWAVES + F.wave, (int)F.G * NWAVES};
    const attn_body::StaticOrder S((int)F.G, F.vcu);
    attn_body::attn_phase8<attn_body::StaticOrder>((char*)lds + RING_OFF, AT, S);
}
__device__ __forceinline__ void ph4(Frame& F) {
    const bf16* PR = (const bf16*)(F.ws + WS_PR); bf16* MG = (bf16*)(F.ws + WS_MG);
    pg8::Gemm g{(const bf16*)(F.ws + WS_YH), (const bf16*)(F.ws + WS_WHU), M, D, 512, nullptr, (const bf16*)(F.ws + WS_AO), (const bf16*)(F.ws + WS_WAU)};
    pg8::ChainOrder S; S.base.init(M, D, F.G, (int)blockIdx.x);
    pg8::EpiGateChain E{MG, D, PR + PR_GH, PR + PR_GA, NREST};
    pg8::gemm_phase<pg8::EpiGateChain, pg8::ChainOrder, true, true>(F.lds + RING_OFF, g, S, E);
}
__device__ __forceinline__ void ph5(Frame& F) {
    pg8::Gemm g{(const bf16*)(F.ws + WS_MG), (const bf16*)(F.ws + WS_WOUT), M, D, D}; pg8::StaticOrder S; S.init(M, D, F.G, (int)blockIdx.x);
    pg8::EpiResBf16 E{F.in[0], (bf16*)(F.ws + WS_HB), D};
    pg8::gemm_phase<pg8::EpiResBf16, pg8::StaticOrder, true, true>(F.lds + RING_OFF, g, S, E);
}
__device__ __forceinline__ void ph8(Frame& F) {
    build_layout(F); const int nrb = (int)F.MISC[16];
    pg8::MoeOrder S; S.init(nrb, 8, F.G, (int)blockIdx.x, (const LAS int*)(F.lds + LX_RBE));
    LAS unsigned short* lidx = (LAS unsigned short*)(F.lds + LX_GIDX); const int* srctok = (const int*)(F.ws + WS_SRC);
    { int tk[GIDX_UNITS];
#pragma unroll
      for (int i = 0; i < GIDX_UNITS; ++i) { pg8::Unit u; tk[i] = (F.tid < 256 && S.next(i, u)) ? srctok[u.pm * 256 + F.tid] : 0; }
#pragma unroll
      for (int i = 0; i < GIDX_UNITS; ++i) if (F.tid < 256) lidx[i * 256 + F.tid] = (unsigned short)tk[i]; }
    __syncthreads();
    pg8::Gemm g{(const bf16*)(F.ws + WS_XN), (const bf16*)(F.ws + WS_W1), nrb * 256, 2 * FF, D / 2, lidx};
    pg8::EpiSwiglu E{(bf16*)(F.ws + WS_H1), F.in[23], 1.0f / (ASCALE * WSCALE), HSCALE};
    pg8::gemm_phase<pg8::EpiSwiglu, pg8::MoeOrder, true, true, true, true>(F.lds + RING_OFF, g, S, E);
}
template <int NOSTORE>
__device__ __forceinline__ void ph9(Frame& F) {
    build_layout(F); const int nrb = (int)F.MISC[16];
    pg8::Gemm g{(const bf16*)(F.ws + WS_H1), (const bf16*)(F.ws + WS_W2), nrb * 256, D, FF / 2}; pg8::MoeOrder S; S.init(nrb, 4, F.G, (int)blockIdx.x, (const LAS int*)(F.lds + LX_RBE)); if (PROBE_SUB & 2048) S.dup = 1;
    pg8::EpiMoe2 E{(bf16*)(F.ws + WS_XG), F.in[25], (const float*)(F.ws + WS_ROWGATE), NOSTORE, 1.0f / (HSCALE * WSCALE), YSCALE};
    pg8::gemm_phase<pg8::EpiMoe2, pg8::MoeOrder, true, true, false, true>(F.lds + RING_OFF, g, S, E);
}
struct Args { const float* in[26]; float* out; unsigned char* ws; int ph_lo, ph_hi; };
__global__ void __launch_bounds__(NWAVES * 64, 2) hybrid_fwd(Args args) {
    extern __shared__ __attribute__((aligned(16))) unsigned char lds[];
    Frame F;
    F.lds = (LAS unsigned char*)lds;
    F.MISC = (volatile LAS unsigned*)(F.lds + LX_MISC);
    F.tid = threadIdx.x; F.lane = F.tid & 63; F.wave = __builtin_amdgcn_readfirstlane(F.tid >> 6);
    F.G = gridDim.x; { const int bx = blockIdx.x; F.vcu = (F.G % 8 == 0) ? (bx % 8) * (F.G / 8) + bx / 8 : bx; }
    F.ws = args.ws; F.ctl = (gu32*)(args.ws + WS_CTL); F.out = args.out;
#pragma unroll
    for (int i = 0; i < 26; ++i) F.in[i] = args.in[i];
    if (F.tid < 64) F.MISC[F.tid] = 0u;
    __syncthreads();
    XcdBarrier bar; bar.bar = (unsigned*)(F.ctl + CW_BAR); bar.x = 0; bar.st = nullptr;
    if (N_LAUNCHES == 1) bar = xcd_barrier_post((unsigned*)(F.ctl + CW_BAR), F.MISC + 8);
#define GRID_BAR() do { if (N_LAUNCHES == 1) xcd_barrier(bar); } while (0)
    const int lo = args.ph_lo, hi = args.ph_hi;
#ifndef ONLYP
#define ONLYP -1
#endif
#define IN(k) (lo <= (k) && (k) < hi && (ONLYP < 0 || ONLYP == (k)))
#ifndef PROBE_DUP
#define PROBE_DUP 0
#endif
#define DUP(k) (((PROBE_DUP) >> (k)) & 1)
#define FRESH() do { int t_ = threadIdx.x; asm volatile("" : "+v"(t_)); F.tid = t_; F.lane = t_ & 63; } while (0)
    if (IN(0)) { FRESH(); p0_prologue(F); if (DUP(0)) { __syncthreads(); p0_prologue(F); } GRID_BAR(); }
    if (IN(1)) { FRESH(); ph1(F); if (DUP(1)) ph1(F); GRID_BAR(); }
    if (IN(2)) { FRESH(); ph2(F); if (DUP(2)) ph2(F); GRID_BAR(); }
    if (IN(3)) { FRESH(); ph3(F, lds); if (DUP(3)) { __syncthreads(); ph3(F, lds); } GRID_BAR(); }
    if (IN(4)) { FRESH(); ph4(F); if (DUP(4)) ph4(F); GRID_BAR(); }
    if (IN(5)) { FRESH(); ph5(F); if (DUP(5)) ph5(F); GRID_BAR(); }
    if (IN(6)) { FRESH(); if (PROBE_SUB & 128) { p6_route<1>(F); __syncthreads(); } p6_route<0>(F); GRID_BAR(); if (PROBE_SUB & 256) { for (int i = 0; i < 10; ++i) GRID_BAR(); } }
    if (IN(7)) { FRESH(); p7_layout(F); if (DUP(7)) p7_layout(F); GRID_BAR(); }
    if (IN(8)) { FRESH(); ph8(F); if (DUP(8)) ph8(F); GRID_BAR(); }
    if (IN(9)) { FRESH(); ph9<0>(F); if (DUP(9)) ph9<0>(F); if (PROBE_SUB & 64) ph9<1>(F); GRID_BAR(); }
    if (IN(10)) { FRESH(); p10_combine(F); if (DUP(10)) p10_combine(F); }
#undef IN
}

extern "C" void kernel_launch(void* const* d_in, const int* in_sizes, int n_in, void* d_out, int out_size, void* d_ws, size_t ws_size, hipStream_t stream) {
    static int grid = 0;
    if (grid == 0) {
        if (n_in != 26 || in_sizes[0] != M * D || out_size != M * D || ws_size < WS_END) { fprintf(stderr, "kernel_launch: unexpected shapes (n_in %d, in0 %d, out %d, ws %zu); nothing launched\n", n_in, n_in > 0 ? in_sizes[0] : -1, out_size, ws_size); grid = -1; return; }
        int dev = 0, cus = 0, per_cu = 0;
        if (hipGetDevice(&dev) != hipSuccess || hipDeviceGetAttribute(&cus, hipDeviceAttributeMultiprocessorCount, dev) != hipSuccess) { grid = -1; return; }
        if (hipFuncSetAttribute((const void*)hybrid_fwd, hipFuncAttributeMaxDynamicSharedMemorySize, LDS_BYTES) != hipSuccess) { fprintf(stderr, "kernel_launch: hipFuncSetAttribute failed\n"); grid = -1; return; }
        if (hipOccupancyMaxActiveBlocksPerMultiprocessor(&per_cu, (const void*)hybrid_fwd, NWAVES * 64, LDS_BYTES) != hipSuccess || per_cu < 1) fprintf(stderr, "kernel_launch: occupancy query reports %d\n", per_cu);
        (void)hipGetLastError();
        grid = cus;
        if (grid != 256) { fprintf(stderr, "kernel_launch: built for 256 CUs, device has %d\n", grid); grid = -1; return; }
    }
    if (grid < 0) return;
    if (hipMemsetAsync((char*)d_ws + WS_CTL, 0, CTL_ZERO_BYTES, stream) != hipSuccess) return;
    Args a{};
    for (int i = 0; i < 26; ++i) a.in[i] = (const float*)d_in[i];
    a.out = (float*)d_out; a.ws = (unsigned char*)d_ws;
    if (N_LAUNCHES == 1) { a.ph_lo = 0; a.ph_hi = N_PHASES; hipLaunchKernelGGL(hybrid_fwd, dim3(grid), dim3(NWAVES * 64), LDS_BYTES, stream, a); }
    else for (int p = 0; p < N_PHASES; ++p) { a.ph_lo = p; a.ph_hi = p + 1; hipLaunchKernelGGL(hybrid_fwd, dim3(grid), dim3(NWAVES * 64), LDS_BYTES, stream, a); }
}
```
